# Optimizing an MI355X kernel written in HIP

```python
import jax, jax.numpy as jnp
from jax import lax
import numpy as np

D_MODEL = 1024
BATCH = 16
SEQ = 4096
DEPTH = 1

CTX_LEN = 256
GRID_W = 64
EPS = 1e-6
N_MOD = 6
GDN_HEADS = 8
GDN_HEAD_DIM = 128
GDN_WIDTH = GDN_HEADS * GDN_HEAD_DIM
GDN_CHUNK = 64
CONV_SIZE = 3
GLA_HEADS = 4
GLA_KEY_DIM = D_MODEL // 2
GLA_VALUE_DIM = D_MODEL
GLA_DK = GLA_KEY_DIM // GLA_HEADS
GLA_DV = GLA_VALUE_DIM // GLA_HEADS
GLA_GATE_RANK = 16
GLA_GATE_NORMALIZER = 16.0
GLA_CHUNK = 64
N_EXPERTS = 32
TOP_K = 4
D_EXPERT = D_MODEL
SWIGLU_LIMIT = 7.0
SWIGLU_ALPHA = 1.702
MOE_BLOCK = 128
IN_SPLITS = (GDN_WIDTH, GDN_WIDTH, GDN_WIDTH, GDN_WIDTH, 2 * GDN_HEADS, 2 * GDN_HEADS,
             GLA_KEY_DIM, GLA_KEY_DIM, GLA_VALUE_DIM, GLA_VALUE_DIM, 2 * GLA_GATE_RANK, 2 * D_MODEL)
D_IN = 4 * GDN_WIDTH + 4 * GDN_HEADS + 2 * GLA_KEY_DIM + 2 * GLA_VALUE_DIM + 2 * GLA_GATE_RANK + 2 * D_MODEL

kernel_name = 'hybrid_gdn_gla_moe_prefix_dit'

F32 = jnp.float32


def rms_norm(x, g):
    xf = x.astype(F32)
    y = xf * lax.rsqrt(jnp.mean(xf * xf, axis=-1, keepdims=True) + EPS)
    return (y * g.astype(F32)).astype(x.dtype)


def l2_normalize(t):
    tf = t.astype(F32)
    return tf * lax.rsqrt(jnp.sum(tf * tf, axis=-1, keepdims=True) + EPS)


def modulate(h, shift, scale):
    return h * (1.0 + scale) + shift


def split_in(p):
    idx = np.cumsum(IN_SPLITS)[:-1].tolist()
    return jnp.split(p, idx, axis=-1)


def to_heads(t, n_heads):
    b, l, _ = t.shape
    return t.reshape(b, l, n_heads, -1).transpose(0, 2, 1, 3)


def from_heads(t):
    return t.transpose(0, 2, 1, 3)


def depthwise_conv2d(img, w):
    ch = img.shape[-1]
    return lax.conv_general_dilated(img, w[:, :, None, :].astype(img.dtype), window_strides=(1, 1), padding='SAME',
                                    dimension_numbers=('NHWC', 'HWIO', 'NHWC'), feature_group_count=ch)


def conv_latent(t, conv_w):
    b, l, ch = t.shape
    rows = l // GRID_W
    return depthwise_conv2d(t.reshape(b, rows, GRID_W, ch), conv_w).reshape(b, l, ch)


def conv_context(t, conv_w):
    mid = CONV_SIZE // 2
    return depthwise_conv2d(t[:, None], conv_w[mid:mid + 1])[:, 0]


def gated_delta_chunked(q, k, v, g, beta, s0):
    b, h, l, dk = q.shape
    dv = v.shape[-1]
    c = GDN_CHUNK
    n = l // c
    q = q.astype(F32).reshape(b, h, n, c, dk) * (dk ** -0.5)
    k = k.astype(F32).reshape(b, h, n, c, dk)
    v = v.astype(F32).reshape(b, h, n, c, dv)
    beta = beta.astype(F32).reshape(b, h, n, c)
    g = jnp.cumsum(g.astype(F32).reshape(b, h, n, c), axis=-1)
    incl = jnp.tril(jnp.ones((c, c), bool))
    strict = jnp.tril(jnp.ones((c, c), bool), -1)
    decay = jnp.exp(jnp.where(incl, g[..., :, None] - g[..., None, :], -jnp.inf))
    kb = k * beta[..., None]
    m = jnp.where(strict, jnp.einsum('bhnid,bhnjd->bhnij', kb, k) * decay, 0.0)
    a = m + jnp.eye(c, dtype=F32)
    rhs = jnp.concatenate([v * beta[..., None], kb * jnp.exp(g)[..., None]], axis=-1)
    sol = lax.linalg.triangular_solve(a, rhs, left_side=True, lower=True, unit_diagonal=True)
    u, w = sol[..., :dv], sol[..., dv:]
    attn = jnp.einsum('bhnid,bhnjd->bhnij', q, k) * decay
    qg = q * jnp.exp(g)[..., None]
    kd = k * jnp.exp(g[..., -1:] - g)[..., None]
    gl = jnp.exp(g[..., -1])
    xs = tuple(jnp.moveaxis(t, 2, 0) for t in (u, w, attn, qg, kd, gl))

    def step(s, xs_n):
        u_n, w_n, attn_n, qg_n, kd_n, gl_n = xs_n
        v_new = u_n - jnp.einsum('bhck,bhkv->bhcv', w_n, s)
        o_n = jnp.einsum('bhck,bhkv->bhcv', qg_n, s) + jnp.einsum('bhij,bhjv->bhiv', attn_n, v_new)
        s = s * gl_n[..., None, None] + jnp.einsum('bhck,bhcv->bhkv', kd_n, v_new)
        return s, o_n

    s, o = lax.scan(step, s0.astype(F32), xs)
    return jnp.moveaxis(o, 0, 2).reshape(b, h, l, dv), s


def gla_chunked(q, k, v, log_a, s0):
    b, h, l, dk = q.shape
    dv = v.shape[-1]
    c = GLA_CHUNK
    n = l // c
    q = q.astype(F32).reshape(b, h, n, c, dk) * (dk ** -0.5)
    k = k.astype(F32).reshape(b, h, n, c, dk)
    v = v.astype(F32).reshape(b, h, n, c, dv)
    gcum = jnp.cumsum(log_a.astype(F32).reshape(b, h, n, c, dk), axis=-2)
    ref = gcum[..., c // 2:c // 2 + 1, :]
    incl = jnp.tril(jnp.ones((c, c), bool))
    attn = jnp.einsum('bhnik,bhnjk->bhnij', q * jnp.exp(gcum - ref), k * jnp.exp(ref - gcum))
    attn = jnp.where(incl, attn, 0.0)
    intra = jnp.einsum('bhnij,bhnjv->bhniv', attn, v)
    qg = q * jnp.exp(gcum)
    kd = k * jnp.exp(gcum[..., -1:, :] - gcum)
    gl = jnp.exp(gcum[..., -1, :])
    xs = tuple(jnp.moveaxis(t, 2, 0) for t in (intra, qg, kd, v, gl))

    def step(s, xs_n):
        intra_n, qg_n, kd_n, v_n, gl_n = xs_n
        o_n = intra_n + jnp.einsum('bhck,bhkv->bhcv', qg_n, s)
        s = s * gl_n[..., :, None] + jnp.einsum('bhck,bhcv->bhkv', kd_n, v_n)
        return s, o_n

    s, o = lax.scan(step, s0.astype(F32), xs)
    return jnp.moveaxis(o, 0, 2).reshape(b, h, l, dv), s


def flip_seq(ts, flip):
    return tuple(jnp.flip(t, axis=2) for t in ts) if flip else tuple(ts)


def bidirectional_prefix_scan(scan_fn, ctx_shared, lat_shared, ctx_gates, lat_gates, s0, need_ctx):
    lat_outs, ctx_outs = [], []
    for direction, flip in enumerate((False, True)):
        o_c, s_c = scan_fn(*flip_seq(ctx_shared, flip), *flip_seq(ctx_gates[direction], flip), s0)
        o_l, _ = scan_fn(*flip_seq(lat_shared, flip), *flip_seq(lat_gates[direction], flip), s_c)
        lat_outs.append(flip_seq((o_l,), flip)[0])
        if need_ctx:
            ctx_outs.append(flip_seq((o_c,), flip)[0])
    o_lat = lat_outs[0] + lat_outs[1]
    o_ctx = ctx_outs[0] + ctx_outs[1] if need_ctx else None
    return o_lat, o_ctx


def gdn_inputs(parts, qkv, a_log_f, a_log_b, dt_bias_f, dt_bias_b):
    q, k, v = jnp.split(qkv, 3, axis=-1)
    q = l2_normalize(to_heads(q, GDN_HEADS))
    k = l2_normalize(to_heads(k, GDN_HEADS))
    v = to_heads(v, GDN_HEADS)
    beta = jax.nn.sigmoid(parts[4].astype(F32)).transpose(0, 2, 1)
    a = parts[5].astype(F32).transpose(0, 2, 1)
    hh = GDN_HEADS
    g_f = -jnp.exp(a_log_f.astype(F32))[:, None] * jax.nn.softplus(a[:, :hh] + dt_bias_f.astype(F32)[:, None])
    g_b = -jnp.exp(a_log_b.astype(F32))[:, None] * jax.nn.softplus(a[:, hh:] + dt_bias_b.astype(F32)[:, None])
    return (q, k, v), ((g_f, beta[:, :hh]), (g_b, beta[:, hh:]))


def gla_log_gate(z, w, bias):
    return to_heads(jax.nn.log_sigmoid((z @ w + bias).astype(F32)) / GLA_GATE_NORMALIZER, GLA_HEADS)


def gla_inputs(parts, w_f, w_b, b_f, b_b):
    q = to_heads(parts[6], GLA_HEADS)
    k = to_heads(parts[7], GLA_HEADS)
    v = to_heads(parts[8], GLA_HEADS)
    lr = parts[10]
    g_f = gla_log_gate(lr[..., :GLA_GATE_RANK], w_f, b_f)
    g_b = gla_log_gate(lr[..., GLA_GATE_RANK:], w_b, b_b)
    return (q, k, v), ((g_f,), (g_b,))


def merge_branches(parts, o_a, o_b, gdn_norm_g, gla_norm_g, w_out_a, w_out_b, w_out):
    dtype = parts[0].dtype
    bsz, l = parts[0].shape[:2]
    za = parts[3].reshape(bsz, l, GDN_HEADS, GDN_HEAD_DIM).astype(F32)
    ya = (rms_norm(from_heads(o_a), gdn_norm_g) * jax.nn.silu(za)).astype(dtype).reshape(bsz, l, GDN_WIDTH) @ w_out_a
    rb = parts[9].reshape(bsz, l, GLA_HEADS, GLA_DV).astype(F32)
    yb = (rms_norm(from_heads(o_b), gla_norm_g) * jax.nn.silu(rb)).astype(dtype).reshape(bsz, l, GLA_VALUE_DIM) @ w_out_b
    gates = jax.nn.sigmoid(parts[11])
    y = gates[..., :D_MODEL] * ya + gates[..., D_MODEL:] * yb
    return y @ w_out


def token_mixer(h_lat, h_ctx, need_ctx, w_in, conv_w, a_log_f, a_log_b, dt_bias_f, dt_bias_b, gdn_norm_g,
                gla_gate_w_f, gla_gate_w_b, gla_gate_b_f, gla_gate_b_b, gla_norm_g, w_out_a, w_out_b, w_out):
    p_lat = h_lat @ w_in
    p_ctx = h_ctx @ w_in
    parts_lat, parts_ctx = split_in(p_lat), split_in(p_ctx)
    bsz = h_lat.shape[0]
    qkv_lat = jax.nn.silu(conv_latent(p_lat[..., :3 * GDN_WIDTH], conv_w))
    qkv_ctx = jax.nn.silu(conv_context(p_ctx[..., :3 * GDN_WIDTH], conv_w))
    a_lat, a_lat_g = gdn_inputs(parts_lat, qkv_lat, a_log_f, a_log_b, dt_bias_f, dt_bias_b)
    a_ctx, a_ctx_g = gdn_inputs(parts_ctx, qkv_ctx, a_log_f, a_log_b, dt_bias_f, dt_bias_b)
    s0_a = jnp.zeros((bsz, GDN_HEADS, GDN_HEAD_DIM, GDN_HEAD_DIM), F32)
    o_a_lat, o_a_ctx = bidirectional_prefix_scan(gated_delta_chunked, a_ctx, a_lat, a_ctx_g, a_lat_g, s0_a, need_ctx)
    b_lat, b_lat_g = gla_inputs(parts_lat, gla_gate_w_f, gla_gate_w_b, gla_gate_b_f, gla_gate_b_b)
    b_ctx, b_ctx_g = gla_inputs(parts_ctx, gla_gate_w_f, gla_gate_w_b, gla_gate_b_f, gla_gate_b_b)
    s0_b = jnp.zeros((bsz, GLA_HEADS, GLA_DK, GLA_DV), F32)
    o_b_lat, o_b_ctx = bidirectional_prefix_scan(gla_chunked, b_ctx, b_lat, b_ctx_g, b_lat_g, s0_b, need_ctx)
    merge_w = (gdn_norm_g, gla_norm_g, w_out_a, w_out_b, w_out)
    y_lat = merge_branches(parts_lat, o_a_lat, o_b_lat, *merge_w)
    y_ctx = merge_branches(parts_ctx, o_a_ctx, o_b_ctx, *merge_w) if need_ctx else None
    return y_lat, y_ctx


def moe_ffn(h, w_router, b_router, w_gu, b_gu, w_down, b_down):
    t, d = h.shape
    n_assign = t * TOP_K
    n_blocks = -(-(n_assign + N_EXPERTS * (MOE_BLOCK - 1)) // MOE_BLOCK)
    logits = (h @ w_router + b_router).astype(F32)
    top_logit, top_idx = lax.top_k(logits, TOP_K)
    top_p = jax.nn.softmax(top_logit, axis=-1)
    flat_e = top_idx.reshape(-1).astype(jnp.int32)
    order = jnp.argsort(flat_e)
    sorted_e = flat_e[order]
    sorted_tok = (order // TOP_K).astype(jnp.int32)
    sorted_p = top_p.reshape(-1)[order]
    counts = jnp.bincount(flat_e, length=N_EXPERTS).astype(jnp.int32)
    start = jnp.cumsum(counts) - counts
    padded = (counts + MOE_BLOCK - 1) // MOE_BLOCK * MOE_BLOCK
    pad_end = jnp.cumsum(padded)
    pad_start = pad_end - padded
    dest = pad_start[sorted_e] + jnp.arange(n_assign, dtype=jnp.int32) - start[sorted_e]
    slot_tok = jnp.full((n_blocks * MOE_BLOCK,), t, jnp.int32).at[dest].set(sorted_tok)
    slot_p = jnp.zeros((n_blocks * MOE_BLOCK,), F32).at[dest].set(sorted_p)
    block_start = jnp.arange(n_blocks, dtype=jnp.int32) * MOE_BLOCK
    block_expert = jnp.minimum(jnp.searchsorted(pad_end, block_start, side='right'), N_EXPERTS - 1)
    h_pad = jnp.concatenate([h, jnp.zeros((1, d), h.dtype)], axis=0)

    def expert_block(args):
        tok, p, e = args
        xb = h_pad[tok]
        gu = xb @ w_gu[e] + b_gu[e]
        glu = jnp.minimum(gu[:, :D_EXPERT], SWIGLU_LIMIT)
        lin = jnp.clip(gu[:, D_EXPERT:], -SWIGLU_LIMIT, SWIGLU_LIMIT)
        act = glu * jax.nn.sigmoid(SWIGLU_ALPHA * glu) * (lin + 1.0)
        return (act @ w_down[e] + b_down[e]) * p[:, None].astype(h.dtype)

    yb = lax.map(expert_block, (slot_tok.reshape(n_blocks, MOE_BLOCK), slot_p.reshape(n_blocks, MOE_BLOCK), block_expert))
    y = jax.ops.segment_sum(yb.reshape(-1, d), slot_tok, num_segments=t + 1)
    return y[:t].astype(h.dtype)


def setup_inputs(seed: int = 0) -> dict:
    key = jax.random.key(seed)
    ks = iter(jax.random.split(key, 40))
    nrm = lambda shape, s: jax.random.normal(next(ks), shape, F32) * s
    gain = lambda shape: 1.0 + nrm(shape, 0.02)
    dd = D_MODEL
    u_dt = jax.random.uniform(next(ks), (2, DEPTH, GDN_HEADS), F32)
    dt = jnp.exp(u_dt * (jnp.log(0.1) - jnp.log(1e-3)) + jnp.log(1e-3))
    dt_bias = dt + jnp.log(-jnp.expm1(-dt))
    a_log = jnp.log(jax.random.uniform(next(ks), (2, DEPTH, GDN_HEADS), F32, 1.0, 16.0))
    return {
        'x': nrm((BATCH, SEQ, dd), 1.0),
        'c': nrm((BATCH, dd), 1.0),
        'ctx': nrm((BATCH, CTX_LEN, dd), 1.0),
        'c_ctx': nrm((dd,), 1.0),
        'w_mod': nrm((DEPTH, dd, N_MOD * dd), 0.5 * dd ** -0.5),
        'b_mod': nrm((DEPTH, N_MOD * dd), 0.02),
        'norm_mix_g': gain((DEPTH, dd)),
        'norm_ffn_g': gain((DEPTH, dd)),
        'w_in': nrm((DEPTH, dd, D_IN), dd ** -0.5),
        'conv_w': nrm((DEPTH, CONV_SIZE, CONV_SIZE, 3 * GDN_WIDTH), 1.0 / CONV_SIZE),
        'a_log_f': a_log[0],
        'a_log_b': a_log[1],
        'dt_bias_f': dt_bias[0],
        'dt_bias_b': dt_bias[1],
        'gdn_norm_g': gain((DEPTH, GDN_HEAD_DIM)),
        'gla_gate_w_f': nrm((DEPTH, GLA_GATE_RANK, GLA_KEY_DIM), GLA_GATE_RANK ** -0.5),
        'gla_gate_w_b': nrm((DEPTH, GLA_GATE_RANK, GLA_KEY_DIM), GLA_GATE_RANK ** -0.5),
        'gla_gate_b_f': nrm((DEPTH, GLA_KEY_DIM), 0.1),
        'gla_gate_b_b': nrm((DEPTH, GLA_KEY_DIM), 0.1),
        'gla_norm_g': gain((DEPTH, GLA_DV)),
        'w_out_a': nrm((DEPTH, GDN_WIDTH, dd), GDN_WIDTH ** -0.5),
        'w_out_b': nrm((DEPTH, GLA_VALUE_DIM, dd), GLA_VALUE_DIM ** -0.5),
        'w_out': nrm((DEPTH, dd, dd), dd ** -0.5),
        'w_router': nrm((DEPTH, dd, N_EXPERTS), dd ** -0.5),
        'b_router': nrm((DEPTH, N_EXPERTS), 0.01),
        'w_gu': nrm((DEPTH, N_EXPERTS, dd, 2 * D_EXPERT), dd ** -0.5),
        'b_gu': nrm((DEPTH, N_EXPERTS, 2 * D_EXPERT), 0.01),
        'w_down': nrm((DEPTH, N_EXPERTS, D_EXPERT, dd), D_EXPERT ** -0.5),
        'b_down': nrm((DEPTH, N_EXPERTS, dd), 0.01),
        'final_norm_g': gain((dd,)),
    }


def reference(x, c, ctx, c_ctx, w_mod, b_mod, norm_mix_g, norm_ffn_g, w_in, conv_w, a_log_f, a_log_b, dt_bias_f,
              dt_bias_b, gdn_norm_g, gla_gate_w_f, gla_gate_w_b, gla_gate_b_f, gla_gate_b_b, gla_norm_g, w_out_a,
              w_out_b, w_out, w_router, b_router, w_gu, b_gu, w_down, b_down, final_norm_g):
    for layer in range(DEPTH):
        need_ctx = layer < DEPTH - 1
        mod_lat = [m[:, None, :] for m in jnp.split(jax.nn.silu(c) @ w_mod[layer] + b_mod[layer], N_MOD, axis=-1)]
        mod_ctx = jnp.split(jax.nn.silu(c_ctx) @ w_mod[layer] + b_mod[layer], N_MOD, axis=-1)
        sh1, sc1, g1, sh2, sc2, g2 = mod_lat
        csh1, csc1, cg1, csh2, csc2, cg2 = mod_ctx
        h_lat = modulate(rms_norm(x, norm_mix_g[layer]), sh1, sc1)
        h_ctx = modulate(rms_norm(ctx, norm_mix_g[layer]), csh1, csc1)
        y_lat, y_ctx = token_mixer(h_lat, h_ctx, need_ctx, w_in[layer], conv_w[layer], a_log_f[layer], a_log_b[layer],
                                   dt_bias_f[layer], dt_bias_b[layer], gdn_norm_g[layer], gla_gate_w_f[layer],
                                   gla_gate_w_b[layer], gla_gate_b_f[layer], gla_gate_b_b[layer], gla_norm_g[layer],
                                   w_out_a[layer], w_out_b[layer], w_out[layer])
        x = x + g1 * y_lat
        h = modulate(rms_norm(x, norm_ffn_g[layer]), sh2, sc2).reshape(-1, D_MODEL)
        moe_w = (w_router[layer], b_router[layer], w_gu[layer], b_gu[layer], w_down[layer], b_down[layer])
        if need_ctx:
            ctx = ctx + cg1 * y_ctx
            hc = modulate(rms_norm(ctx, norm_ffn_g[layer]), csh2, csc2).reshape(-1, D_MODEL)
            n_lat = h.shape[0]
            y = moe_ffn(jnp.concatenate([h, hc], axis=0), *moe_w)
            x = x + g2 * y[:n_lat].reshape(x.shape)
            ctx = ctx + cg2 * y[n_lat:].reshape(ctx.shape)
        else:
            x = x + g2 * moe_ffn(h, *moe_w).reshape(x.shape)
    return rms_norm(x, final_norm_g)
```

```cpp
#include <hip/hip_runtime.h>
#include <cstdio>
#include <cstdint>

#ifndef MK_FUSED
#define MK_FUSED 0
#endif

#define GAS __attribute__((address_space(1)))
#define LAS __attribute__((address_space(3)))
typedef unsigned short bf16;
typedef unsigned v4u __attribute__((ext_vector_type(4)));
typedef unsigned v2u __attribute__((ext_vector_type(2)));
typedef float f32x4 __attribute__((ext_vector_type(4)));
typedef short bf16x8 __attribute__((ext_vector_type(8)));

constexpr int D = 1024, NB = 16, SEQ = 4096, T = NB * SEQ, CTXL = 256, TC = NB * CTXL, TT = T + TC;
constexpr int D_IN = 9280, N_S = 5376, N_G = 4096, NMOD = 6 * D;
constexpr int NE = 32, NG = 2, TG = T / NG, MAXSLOT = 139264, MAXTILE = MAXSLOT / 256;
constexpr float EPS = 1e-6f;
constexpr int NTHREADS = 512, NWAVES = 8;
constexpr int LDS_BYTES = 147456;

constexpr size_t MiB = 1u << 20;
constexpr size_t WS_CTL = 0, CTL_BYTES = 1 * MiB;
constexpr size_t WS_MODV = 1 * MiB, WS_BT_S = 2 * MiB, WS_BT_G = 13 * MiB, WS_BT_OA = 21 * MiB, WS_BT_OB = 23 * MiB, WS_BT_O = 25 * MiB;
constexpr size_t WS_TOPI = 27 * MiB, WS_TOPP = 28 * MiB, WS_TOKSLOT = 29 * MiB, WS_SLOT_TOK = 30 * MiB, WS_SLOT_P = 32 * MiB, WS_TILE_E = 34 * MiB;
constexpr size_t WS_H = 40 * MiB, WS_PB = 176 * MiB, WS_SMALL = 448 * MiB, WS_QKVA = 465 * MiB;
constexpr size_t WS_WB_DN = 176 * MiB, WS_YA_IN = 240 * MiB, WS_YB_IN = 368 * MiB, WS_GATES = 496 * MiB, WS_Y = 752 * MiB, WS_WB_GU = 880 * MiB;
constexpr size_t WS_H2 = 40 * MiB, WS_ACT = 240 * MiB, WS_YSLOT = 512 * MiB, WS_END = 1008 * MiB;
static_assert(WS_QKVA + (size_t)TT * 3072 * 2 <= 873 * MiB && WS_SMALL + (size_t)TT * 64 * 4 <= WS_QKVA && WS_H + (size_t)TT * D * 2 <= WS_PB, "ws map");
static_assert(WS_ACT + (size_t)MAXSLOT * D * 2 <= WS_YSLOT && WS_YSLOT + (size_t)MAXSLOT * D * 2 <= WS_WB_GU, "ws map 2");
constexpr int CW_BAR = 4096, CW_CNT = 8192, CW_CUR = 8192 + 256, CW_NTILE = 8192 + 512;

#define LDS_WAIT() asm volatile("s_waitcnt lgkmcnt(0)" ::: "memory")
#define VM_WAIT() asm volatile("s_waitcnt vmcnt(0)" ::: "memory")
__device__ __forceinline__ float bflo(unsigned u) { return __uint_as_float(u << 16); }
__device__ __forceinline__ float bfhi(unsigned u) { return __uint_as_float(u & 0xffff0000u); }
__device__ __forceinline__ unsigned pk2(float lo, float hi) { unsigned r; asm("v_cvt_pk_bf16_f32 %0, %1, %2" : "=v"(r) : "v"(lo), "v"(hi)); return r; }
__device__ __forceinline__ float wave_sum(float v) {
#pragma unroll
    for (int o = 1; o < 64; o <<= 1) v += __shfl_xor(v, o);
    return v;
}
__device__ __forceinline__ int lds_add(LAS int* p, int v) { return __hip_atomic_fetch_add(p, v, __ATOMIC_RELAXED, __HIP_MEMORY_SCOPE_WORKGROUP); }
__device__ __forceinline__ float sigmoidf_(float x) { return 1.0f / (1.0f + __expf(-x)); }
__device__ __forceinline__ float siluf_(float x) { return x / (1.0f + __expf(-x)); }
__device__ __forceinline__ float softplusf_(float x) { return fmaxf(x, 0.f) + log1pf(__expf(-fabsf(x))); }
__device__ __forceinline__ void unpack8(const v4u w, float (&f)[8]) {
    f[0] = bflo(w.x); f[1] = bfhi(w.x); f[2] = bflo(w.y); f[3] = bfhi(w.y); f[4] = bflo(w.z); f[5] = bfhi(w.z); f[6] = bflo(w.w); f[7] = bfhi(w.w);
}
__device__ __forceinline__ v4u pack8(const float (&f)[8]) { v4u w; w.x = pk2(f[0], f[1]); w.y = pk2(f[2], f[3]); w.z = pk2(f[4], f[5]); w.w = pk2(f[6], f[7]); return w; }

struct P {
    const float *x, *c, *ctx, *c_ctx, *w_mod, *b_mod, *norm_mix_g, *norm_ffn_g, *w_in, *conv_w, *a_log_f, *a_log_b, *dt_bias_f, *dt_bias_b, *gdn_norm_g,
        *gla_gate_w_f, *gla_gate_w_b, *gla_gate_b_f, *gla_gate_b_b, *gla_norm_g, *w_out_a, *w_out_b, *w_out, *w_router, *b_router, *w_gu, *b_gu, *w_down, *b_down, *final_norm_g;
    float* out; unsigned char* ws;
};

namespace pg8 {
constexpr int BM = 256, BK = 64, HALF = 128, HTB = HALF * BK * 2, STAGE_BYTES = 8 * HTB, NXCD = 8, WGM = 8;
__host__ __device__ __forceinline__ int lds_byte(int r, int c) { const int st = (r >> 4) * 2 + (c >> 5), rr = r & 15, cc = c & 31, ob = rr * 64 + cc * 2; return st * 1024 + (ob ^ (((ob >> 9) & 1) << 5)); }
__host__ __device__ __forceinline__ void stage_rc(int b, int& R, int& C) { const int st = b / 1024, sb = b % 1024, swz = sb ^ (((sb >> 9) & 1) << 5); R = (st >> 1) * 16 + swz / 64; C = (st & 1) * 32 + (swz % 64) / 2; }
__host__ __device__ __forceinline__ int perm32(int rho) { const int n = rho >> 4, i = rho & 15; return 8 * (i >> 2) + 4 * n + (i & 3); }
struct Unit { int pm, pn, bt; };

__device__ __forceinline__ void order_map(int L, int nM, int nN, int& pm, int& pn) {
    const int nwg = nM * nN; int wgid = L;
    { const int q = nwg / NXCD, r = nwg % NXCD, xcd = wgid % NXCD, off = wgid / NXCD; wgid = (xcd < r ? xcd * (q + 1) : r * (q + 1) + (xcd - r) * q) + off; }
    const int nig = WGM * nN, gid = wgid / nig, fm = gid * WGM, gsz = (nM - fm) < WGM ? (nM - fm) : WGM;
    pm = fm + ((wgid % nig) % gsz); pn = (wgid % nig) / gsz;
}
struct SchedDense {
    int nM, nN, G, c;
    __device__ __forceinline__ bool next(int i, Unit& u) const { const long L = (long)i * G + c; if (L >= (long)nM * nN) return false; order_map((int)L, nM, nN, u.pm, u.pn); u.bt = u.pn; return true; }
    __device__ __forceinline__ unsigned arow(const Unit& u, int r) const { return (unsigned)(u.pm * BM + r); }
};
struct SchedMoe {
    int nM, nN, G, c; const int* tile_e; const int* slot_tok;
    __device__ __forceinline__ bool next(int i, Unit& u) const { const long L = (long)i * G + c; if (L >= (long)nM * nN) return false; order_map((int)L, nM, nN, u.pm, u.pn); u.bt = tile_e[u.pm] * nN + u.pn; return true; }
    __device__ __forceinline__ unsigned arow(const Unit& u, int r) const { if (slot_tok) { const int t = slot_tok[u.pm * BM + r]; return (unsigned)(t < 0 ? 0 : t); } return (unsigned)(u.pm * BM + r); }
};

template <class Epi, class Sched>
__device__ __forceinline__ void gemm_phase(LAS unsigned char* lds, const bf16* A, const bf16* Bt, const int K, const Sched& S, const Epi& E) {
    const int tid = threadIdx.x, wid = __builtin_amdgcn_readfirstlane(tid >> 6), lane = tid & 63, wr = wid >> 2, wc = wid & 3, fr = lane & 15, fq = lane >> 4;
    const int nt = K / BK;
    int R0, C0; stage_rc(tid * 16, R0, C0);
    unsigned voffB[2];
#pragma unroll
    for (int i = 0; i < 2; ++i) { const int R = R0 + 64 * i; const int Rb = (R & ~31) + perm32(R & 31); voffB[i] = (unsigned)(Rb * K + C0) * 2u; }
    const unsigned rowb = (unsigned)K * 2u, cofs = (unsigned)C0 * 2u;
    const size_t kstep = (size_t)(BK * 2);
    const size_t hstep = (size_t)HALF * K * 2;
    const size_t tstep = 2 * hstep;
    const unsigned ldsw = (unsigned)wid * 1024u;
    const int aoff = lds_byte(wr * 64 + fr, fq * 8), boff = lds_byte(wc * 32 + fr, fq * 8);
#define PG8_SA(b, h) (((b) * 2 + (h)) * HTB)
#define PG8_SB(b, h) ((4 + (b) * 2 + (h)) * HTB)
#define PG8_STAGE(bufoff, gbase, voff) do { _Pragma("unroll") for (int _i = 0; _i < 2; ++_i) \
        __builtin_amdgcn_global_load_lds((const unsigned*)((const char*)(gbase) + (voff)[_i]), (LAS unsigned*)(lds + (bufoff) + ldsw + _i * 8192), 16, 0, 0); } while (0)
#define PG8_STAGE_A(bufoff, gbase, o0, o1) do { \
        __builtin_amdgcn_global_load_lds((const unsigned*)((const char*)(gbase) + (o0)), (LAS unsigned*)(lds + (bufoff) + ldsw), 16, 0, 0); \
        __builtin_amdgcn_global_load_lds((const unsigned*)((const char*)(gbase) + (o1)), (LAS unsigned*)(lds + (bufoff) + ldsw + 8192), 16, 0, 0); } while (0)
#define PG8_LDA(dst, b, h) do { _Pragma("unroll") for (int m = 0; m < 4; ++m) _Pragma("unroll") for (int k = 0; k < 2; ++k) dst[m][k] = *(const LAS bf16x8*)(lds + PG8_SA(b, h) + aoff + m * 2048 + k * 1024); } while (0)
#define PG8_LDB(dst, b, h) do { _Pragma("unroll") for (int n = 0; n < 2; ++n) _Pragma("unroll") for (int k = 0; k < 2; ++k) dst[n][k] = *(const LAS bf16x8*)(lds + PG8_SB(b, h) + boff + n * 2048 + k * 1024); } while (0)
#define PG8_MMA(ai, bj, At, Bt_) do { __builtin_amdgcn_s_setprio(1); _Pragma("unroll") for (int m = 0; m < 4; ++m) _Pragma("unroll") for (int n = 0; n < 2; ++n) _Pragma("unroll") for (int k = 0; k < 2; ++k) \
        acc[ai][bj][m][n] = __builtin_amdgcn_mfma_f32_16x16x32_bf16(Bt_[n][k], At[m][k], acc[ai][bj][m][n], 0, 0, 0); __builtin_amdgcn_s_setprio(0); } while (0)
#define PG8_WAIT_V(n) asm volatile("s_waitcnt vmcnt(" #n ")" ::: "memory")
#define PG8_WAIT_L(n) asm volatile("s_waitcnt lgkmcnt(" #n ")" ::: "memory")
#define PG8_BAR __builtin_amdgcn_s_barrier()
#define PG8_SCHED __builtin_amdgcn_sched_barrier(0)
    Unit cur, nxt; int ui = 0;
    if (!S.next(0, cur)) return;
    f32x4 acc[2][2][4][2];
#pragma unroll
    for (int a = 0; a < 2; ++a)
#pragma unroll
        for (int b = 0; b < 2; ++b)
#pragma unroll
            for (int m = 0; m < 4; ++m)
#pragma unroll
                for (int n = 0; n < 2; ++n) acc[a][b][m][n] = (f32x4){0.f, 0.f, 0.f, 0.f};
    bf16x8 At[4][2], B0[2][2], B1[2][2];
    const char* Ab = (const char*)A;
    const char* cB = (const char*)Bt + (size_t)cur.bt * tstep;
    unsigned c00 = S.arow(cur, R0) * rowb + cofs, c01 = S.arow(cur, R0 + 64) * rowb + cofs, c10 = S.arow(cur, HALF + R0) * rowb + cofs, c11 = S.arow(cur, HALF + R0 + 64) * rowb + cofs;
    unsigned n00, n01, n10, n11;
    PG8_STAGE(PG8_SB(0, 0), cB, voffB); PG8_STAGE(PG8_SB(0, 1), cB + hstep, voffB); PG8_STAGE_A(PG8_SA(0, 0), Ab, c00, c01); PG8_STAGE_A(PG8_SA(0, 1), Ab, c10, c11);
    if (wr == 1) PG8_BAR;
    PG8_WAIT_V(2); PG8_BAR;
    PG8_STAGE(PG8_SB(1, 0), cB + kstep, voffB); PG8_STAGE_A(PG8_SA(1, 0), Ab + kstep, c00, c01); PG8_STAGE(PG8_SB(1, 1), cB + hstep + kstep, voffB);
    PG8_WAIT_V(6); PG8_BAR;
    for (;;) {
        const bool has_next = S.next(ui + 1, nxt);
        const char* nB = has_next ? (const char*)Bt + (size_t)nxt.bt * tstep : cB;
        if (has_next) { n00 = S.arow(nxt, R0) * rowb + cofs; n01 = S.arow(nxt, R0 + 64) * rowb + cofs; n10 = S.arow(nxt, HALF + R0) * rowb + cofs; n11 = S.arow(nxt, HALF + R0 + 64) * rowb + cofs; }
        else { n00 = c00; n01 = c01; n10 = c10; n11 = c11; }
        for (int t = 0; t < nt; t += 2) {
            const bool last = (t == nt - 2);
            const char* a1 = Ab + (size_t)(t + 1) * kstep;
            const char* a2 = last ? Ab : Ab + (size_t)(t + 2) * kstep; const char* b2 = last ? nB : cB + (size_t)(t + 2) * kstep;
            const char* a3 = a2 + kstep; const char* b3 = b2 + kstep;
            const unsigned x00 = last ? n00 : c00, x01 = last ? n01 : c01, x10 = last ? n10 : c10, x11 = last ? n11 : c11;
            PG8_LDB(B0, 0, 0); PG8_LDB(B1, 0, 1); PG8_SCHED; PG8_LDA(At, 0, 0); PG8_STAGE_A(PG8_SA(1, 1), a1, c10, c11);
            PG8_WAIT_V(8); PG8_WAIT_L(0); PG8_BAR; PG8_MMA(0, 0, At, B0); PG8_MMA(0, 1, At, B1); PG8_BAR; PG8_SCHED;
            PG8_LDA(At, 0, 1); PG8_STAGE(PG8_SB(0, 0), b2, voffB); PG8_STAGE(PG8_SB(0, 1), b2 + hstep, voffB); PG8_STAGE_A(PG8_SA(0, 0), a2, x00, x01);
            PG8_WAIT_V(8); PG8_WAIT_L(0); PG8_BAR; PG8_MMA(1, 0, At, B0); PG8_MMA(1, 1, At, B1); PG8_BAR; PG8_SCHED;
            PG8_LDB(B0, 1, 0); PG8_LDB(B1, 1, 1); PG8_SCHED; PG8_LDA(At, 1, 0); PG8_STAGE_A(PG8_SA(0, 1), a2, x10, x11);
            PG8_WAIT_V(8); PG8_WAIT_L(0); PG8_BAR; PG8_MMA(0, 0, At, B0); PG8_MMA(0, 1, At, B1); PG8_BAR; PG8_SCHED;
            PG8_LDA(At, 1, 1); PG8_STAGE(PG8_SB(1, 0), b3, voffB); PG8_STAGE(PG8_SB(1, 1), b3 + hstep, voffB); PG8_STAGE_A(PG8_SA(1, 0), a3, x00, x01);
            PG8_WAIT_V(8); PG8_WAIT_L(0); PG8_BAR; PG8_MMA(1, 0, At, B0); PG8_MMA(1, 1, At, B1); PG8_BAR; PG8_SCHED;
        }
        if (wr == 0) PG8_BAR;
        E(acc, cur, wr, wc, fr, fq);
        if (!has_next) break;
#pragma unroll
        for (int a = 0; a < 2; ++a)
#pragma unroll
            for (int b = 0; b < 2; ++b)
#pragma unroll
                for (int m = 0; m < 4; ++m)
#pragma unroll
                    for (int n = 0; n < 2; ++n) acc[a][b][m][n] = (f32x4){0.f, 0.f, 0.f, 0.f};
        cur = nxt; cB = nB; c00 = n00; c01 = n01; c10 = n10; c11 = n11; ++ui;
        if (wr == 1) PG8_BAR;
    }
    PG8_WAIT_V(0);
    PG8_BAR;
#undef PG8_SA
#undef PG8_SB
#undef PG8_STAGE
#undef PG8_STAGE_A
#undef PG8_LDA
#undef PG8_LDB
#undef PG8_MMA
#undef PG8_WAIT_V
#undef PG8_WAIT_L
#undef PG8_BAR
#undef PG8_SCHED
}
}
typedef f32x4 Acc[2][2][4][2];

#define XB_TMO      128
#define XB_XCNT(j)  (256  + 64 * (j))
#define XB_XSUB(j)  (1280 + 64 * (j))
#define XB_XGEN(j)  (2304 + 64 * (j))
#define XB_TOP      3328
#define XB_TOPGEN   3392
#define XCD_BAR_WORDS 3456
#define XB_SPIN_CAP (1u << 22)
__device__ __forceinline__ unsigned xb_ld(unsigned* p)              { return __hip_atomic_load(p, __ATOMIC_RELAXED, __HIP_MEMORY_SCOPE_AGENT); }
__device__ __forceinline__ unsigned xb_add(unsigned* p, unsigned v) { return __hip_atomic_fetch_add(p, v, __ATOMIC_RELAXED, __HIP_MEMORY_SCOPE_AGENT); }
__device__ __forceinline__ unsigned xb_xcc_id() { return (unsigned)__builtin_amdgcn_s_getreg((3 << 11) | 20) & 0xFu; }
#define XB_SPIN(cond, bar) do { unsigned _sp = 0; while (cond) { __builtin_amdgcn_s_sleep(1); \
    if ((++_sp & 255u) == 0u) { if (xb_ld(&(bar)[XB_TMO])) break; if (_sp > XB_SPIN_CAP) { atomicAdd(&(bar)[XB_TMO], 1u); break; } } } } while (0)
struct XcdBarrier { unsigned* bar; unsigned x; volatile LAS unsigned* st; };
__device__ __forceinline__ XcdBarrier xcd_barrier_post(unsigned* bar, volatile LAS unsigned* st) {
    XcdBarrier b; b.bar = bar; b.x = xb_xcc_id(); b.st = st;
    if (threadIdx.x == 0) (void)xb_add(&bar[XB_XCNT(b.x)], 1u);
    return b;
}
__device__ __forceinline__ void xcd_barrier_complete(unsigned* bar, unsigned x, unsigned& nloc, unsigned& nx) {
    const unsigned G = gridDim.x * gridDim.y * gridDim.z;
    unsigned sum, cnt, mine, sp = 0u;
    for (;;) {
        sum = 0u; cnt = 0u; mine = 0u;
#pragma unroll
        for (unsigned j = 0; j < 16; ++j) { const unsigned c = xb_ld(&bar[XB_XCNT(j)]); sum += c; cnt += (c > 0u) ? 1u : 0u; mine = (j == x) ? c : mine; }
        if (sum == G) break;
        __builtin_amdgcn_s_sleep(1);
        if ((++sp & 255u) == 0u) { if (xb_ld(&bar[XB_TMO])) break; if (sp > XB_SPIN_CAP) { atomicAdd(&bar[XB_TMO], 1u); break; } }
    }
    nloc = mine > 0u ? mine : 1u; nx = cnt > 0u ? cnt : 1u;
}
__device__ __forceinline__ void xcd_barrier(const XcdBarrier& b) {
    asm volatile("s_waitcnt vmcnt(0)" ::: "memory");
    __syncthreads();
    if (threadIdx.x == 0) {
        unsigned* bar = b.bar;
        __builtin_amdgcn_s_waitcnt(0);
        unsigned nloc = b.st[0], nx = b.st[1];
        if (nloc == 0u) { xcd_barrier_complete(bar, b.x, nloc, nx); b.st[0] = nloc; b.st[1] = nx; }
        const unsigned old = xb_add(&bar[XB_XSUB(b.x)], 1u);
        const unsigned gen = old / nloc;
        if (old + 1u == (gen + 1u) * nloc) {
            __builtin_amdgcn_fence(__ATOMIC_RELEASE, "agent");
            asm volatile("s_waitcnt vmcnt(0)" ::: "memory");
            const unsigned og = xb_add(&bar[XB_TOP], 1u);
            const unsigned tg = og / nx;
            if (og + 1u == (tg + 1u) * nx) xb_add(&bar[XB_TOPGEN], 1u);
            else XB_SPIN(xb_ld(&bar[XB_TOPGEN]) == tg, bar);
            __builtin_amdgcn_fence(__ATOMIC_ACQUIRE, "agent");
            xb_add(&bar[XB_XGEN(b.x)], 1u);
            asm volatile("s_waitcnt vmcnt(0)" ::: "memory");
        } else {
            XB_SPIN(xb_ld(&bar[XB_XGEN(b.x)]) == gen, bar);
            __builtin_amdgcn_fence(__ATOMIC_ACQUIRE, "agent");
            asm volatile("s_waitcnt vmcnt(0)" ::: "memory");
        }
    }
    __syncthreads();
}

__device__ __forceinline__ void tr_item(const float* W, int ldw, int col0, bf16* WT, int dstrow0, int k0, LAS float* scr, int lane) {
#pragma unroll 8
    for (int i = 0; i < 32; ++i) { const int kk = 2 * i + (lane >> 5); scr[kk * 33 + (lane & 31)] = W[(size_t)(k0 + kk) * ldw + col0 + (lane & 31)]; }
    LDS_WAIT(); asm volatile("" ::: "memory");
    const int c = lane & 7;
#pragma unroll
    for (int j = 0; j < 4; ++j) { const int n = (lane >> 3) + 8 * j; const LAS float* s = scr + (8 * c) * 33 + n;
        v4u o; o.x = pk2(s[0 * 33], s[1 * 33]); o.y = pk2(s[2 * 33], s[3 * 33]); o.z = pk2(s[4 * 33], s[5 * 33]); o.w = pk2(s[6 * 33], s[7 * 33]);
        *(v4u*)(WT + (size_t)(dstrow0 + n) * D + k0 + 8 * c) = o; }
    LDS_WAIT(); asm volatile("" ::: "memory");
}
__device__ __forceinline__ void phase_prologue(const P& p, LAS unsigned char* lds) {
    const int tid = threadIdx.x, lane = tid & 63, wave = tid >> 6;
    LAS float* scr = (LAS float*)(lds + wave * 8448);
    const int gw = blockIdx.x * NWAVES + wave, NGW = gridDim.x * NWAVES;
    bf16* bt_s = (bf16*)(p.ws + WS_BT_S); bf16* bt_g = (bf16*)(p.ws + WS_BT_G);
    constexpr int I_S = 162 * 16, I_G = 128 * 16, I_O = 32 * 16;
    for (int it = gw; it < I_S + I_G + 3 * I_O; it += NGW) {
        int r = it;
        if (r < I_S) { const int nb = r >> 4, kb = r & 15; const int col0 = nb < 96 ? 32 * nb : (nb < 160 ? 4128 + 32 * (nb - 96) : (nb == 160 ? 4096 : 7200));
            tr_item(p.w_in, D_IN, col0, bt_s, 32 * nb, 64 * kb, scr, lane); continue; } r -= I_S;
        if (r < I_G) { const int nb = r >> 4, kb = r & 15; const int col0 = nb < 32 ? 3072 + 32 * nb : (nb < 64 ? 6176 + 32 * (nb - 32) : 7232 + 32 * (nb - 64));
            tr_item(p.w_in, D_IN, col0, bt_g, 32 * nb, 64 * kb, scr, lane); continue; } r -= I_G;
        const int which = r / I_O; r -= which * I_O; const int nb = r >> 4, kb = r & 15;
        const float* W = which == 0 ? p.w_out_a : (which == 1 ? p.w_out_b : p.w_out);
        bf16* WT = (bf16*)(p.ws + (which == 0 ? WS_BT_OA : (which == 1 ? WS_BT_OB : WS_BT_O)));
        tr_item(W, D, 32 * nb, WT, 32 * nb, 64 * kb, scr, lane);
    }
    { const size_t n16 = (size_t)192 * D * 2 / 16; v4u* z = (v4u*)(bt_s + (size_t)5184 * D);
      for (size_t i = (size_t)blockIdx.x * NTHREADS + tid; i < n16; i += (size_t)gridDim.x * NTHREADS) z[i] = (v4u){0u, 0u, 0u, 0u}; }
    __syncthreads();
    LAS float* sc = (LAS float*)lds;
    LAS float* red = (LAS float*)(lds + 17 * 1024 * 4);
    float* modv = (float*)(p.ws + WS_MODV);
    bool have = false;
    for (int u = blockIdx.x; u < NMOD / 64; u += gridDim.x) {
        if (!have) { for (int i = tid; i < 17 * 1024; i += NTHREADS) { const float v = i < 16 * 1024 ? p.c[i] : p.c_ctx[i - 16 * 1024]; sc[i] = siluf_(v); } have = true; __syncthreads(); }
        float acc[17];
#pragma unroll
        for (int b = 0; b < 17; ++b) acc[b] = 0.f;
        const int n = u * 64 + lane;
        for (int k = wave * 128; k < wave * 128 + 128; ++k) { const float wv = p.w_mod[(size_t)k * NMOD + n];
#pragma unroll
            for (int b = 0; b < 17; ++b) acc[b] += sc[b * 1024 + k] * wv; }
#pragma unroll
        for (int b = 0; b < 17; ++b) red[(wave * 17 + b) * 64 + lane] = acc[b];
        __syncthreads();
        for (int i = tid; i < 17 * 64; i += NTHREADS) { const int b = i >> 6, l = i & 63; float s = p.b_mod[u * 64 + l];
#pragma unroll
            for (int w = 0; w < 8; ++w) s += red[(w * 17 + b) * 64 + l];
            modv[b * NMOD + u * 64 + l] = s; }
        __syncthreads();
    }
}

__device__ __forceinline__ void phase_norm1(const P& p) {
    const int tid = threadIdx.x, lane = tid & 63, wave = tid >> 6;
    const int gw = blockIdx.x * NWAVES + wave, NGW = gridDim.x * NWAVES;
    const float* modv = (const float*)(p.ws + WS_MODV); bf16* h = (bf16*)(p.ws + WS_H);
    for (int r = gw; r < TT; r += NGW) {
        const float* src; int b;
        if (r < T) { src = p.x + (size_t)r * D; b = r >> 12; } else { src = p.ctx + (size_t)(r - T) * D; b = 16; }
        const f32x4* xr = (const f32x4*)src + lane;
        f32x4 v[4]; float s = 0.f;
#pragma unroll
        for (int j = 0; j < 4; ++j) { v[j] = xr[64 * j]; s += (v[j].x * v[j].x + v[j].y * v[j].y) + (v[j].z * v[j].z + v[j].w * v[j].w); }
        const float rstd = 1.0f / sqrtf(wave_sum(s) * (1.f / D) + EPS);
        const f32x4* g = (const f32x4*)p.norm_mix_g + lane; const f32x4* sh = (const f32x4*)(modv + b * NMOD) + lane; const f32x4* scl = (const f32x4*)(modv + b * NMOD + D) + lane;
        v2u* o8 = (v2u*)(h + (size_t)r * D) + lane;
#pragma unroll
        for (int j = 0; j < 4; ++j) { const f32x4 gg = g[64 * j], s1 = sh[64 * j], s2 = scl[64 * j]; const f32x4 o = v[j] * rstd * gg * (1.0f + s2) + s1;
            v2u w; w.x = pk2(o.x, o.y); w.y = pk2(o.z, o.w); o8[64 * j] = w; }
    }
}

struct EpiG1 {
    bf16* qkva; bf16* pb; float* small;
    __device__ __forceinline__ void operator()(const Acc& acc, const pg8::Unit& u, int wr, int wc, int fr, int fq) const {
        const int row0 = u.pm * 256 + wr * 64 + fr, cb = wc * 32 + 8 * fq;
#pragma unroll
        for (int ai = 0; ai < 2; ++ai)
#pragma unroll
            for (int m = 0; m < 4; ++m) { const size_t row = (size_t)(row0 + ai * 128 + m * 16);
#pragma unroll
                for (int bj = 0; bj < 2; ++bj) { const int c = bj * 128 + cb; const f32x4 v0 = acc[ai][bj][m][0], v1 = acc[ai][bj][m][1];
                    if (u.pn < 20) { v4u w; w.x = pk2(v0[0], v0[1]); w.y = pk2(v0[2], v0[3]); w.z = pk2(v1[0], v1[1]); w.w = pk2(v1[2], v1[3]);
                        if (u.pn < 12) *(v4u*)(qkva + row * 3072 + u.pn * 256 + c) = w; else *(v4u*)(pb + row * 2048 + (u.pn - 12) * 256 + c) = w; }
                    else if (c < 64) { *(f32x4*)(small + row * 64 + c) = v0; *(f32x4*)(small + row * 64 + c + 4) = v1; } } }
    }
};
struct EpiG2 {
    const bf16* on; bf16* ya; bf16* yb; bf16* gates;
    __device__ __forceinline__ void operator()(const Acc& acc, const pg8::Unit& u, int wr, int wc, int fr, int fq) const {
        const int row0 = u.pm * 256 + wr * 64 + fr, cb = wc * 32 + 8 * fq;
#pragma unroll
        for (int ai = 0; ai < 2; ++ai)
#pragma unroll
            for (int m = 0; m < 4; ++m) { const size_t row = (size_t)(row0 + ai * 128 + m * 16);
#pragma unroll
                for (int bj = 0; bj < 2; ++bj) { const int c = bj * 128 + cb; float v[8];
#pragma unroll
                    for (int j = 0; j < 4; ++j) { v[j] = acc[ai][bj][m][0][j]; v[4 + j] = acc[ai][bj][m][1][j]; }
                    if (u.pn < 8) { const v4u ow = *(const v4u*)(on + row * 2048 + u.pn * 256 + c); float o[8]; unpack8(ow, o);
#pragma unroll
                        for (int j = 0; j < 8; ++j) v[j] = o[j] * siluf_(v[j]);
                        bf16* dst = u.pn < 4 ? ya + row * 1024 + u.pn * 256 + c : yb + row * 1024 + (u.pn - 4) * 256 + c;
                        *(v4u*)dst = pack8(v); }
                    else {
#pragma unroll
                        for (int j = 0; j < 8; ++j) v[j] = sigmoidf_(v[j]);
                        *(v4u*)(gates + row * 2048 + (u.pn - 8) * 256 + c) = pack8(v); } } }
    }
};
template <int WHICH> struct EpiG34 {
    const bf16* gates; bf16* y;
    __device__ __forceinline__ void operator()(const Acc& acc, const pg8::Unit& u, int wr, int wc, int fr, int fq) const {
        const int row0 = u.pm * 256 + wr * 64 + fr, cb = wc * 32 + 8 * fq;
#pragma unroll
        for (int ai = 0; ai < 2; ++ai)
#pragma unroll
            for (int m = 0; m < 4; ++m) { const size_t row = (size_t)(row0 + ai * 128 + m * 16);
#pragma unroll
                for (int bj = 0; bj < 2; ++bj) { const int c = u.pn * 256 + bj * 128 + cb; float v[8], g[8];
#pragma unroll
                    for (int j = 0; j < 4; ++j) { v[j] = acc[ai][bj][m][0][j]; v[4 + j] = acc[ai][bj][m][1][j]; }
                    unpack8(*(const v4u*)(gates + row * 2048 + WHICH * 1024 + c), g);
                    if (WHICH == 0) {
#pragma unroll
                        for (int j = 0; j < 8; ++j) v[j] = g[j] * v[j];
                    } else { float o[8]; unpack8(*(const v4u*)(y + row * 1024 + c), o);
#pragma unroll
                        for (int j = 0; j < 8; ++j) v[j] = o[j] + g[j] * v[j]; }
                    *(v4u*)(y + row * 1024 + c) = pack8(v); } }
    }
};
struct EpiG5 {
    const float* x; const float* modv; float* out;
    __device__ __forceinline__ void operator()(const Acc& acc, const pg8::Unit& u, int wr, int wc, int fr, int fq) const {
        const int row0 = u.pm * 256 + wr * 64 + fr, cb = wc * 32 + 8 * fq;
        const float* g1 = modv + (u.pm >> 4) * NMOD + 2 * D;
#pragma unroll
        for (int ai = 0; ai < 2; ++ai)
#pragma unroll
            for (int m = 0; m < 4; ++m) { const size_t row = (size_t)(row0 + ai * 128 + m * 16);
#pragma unroll
                for (int bj = 0; bj < 2; ++bj) { const int c = u.pn * 256 + bj * 128 + cb;
#pragma unroll
                    for (int n = 0; n < 2; ++n) { const f32x4 xv = *(const f32x4*)(x + row * D + c + 4 * n), gv = *(const f32x4*)(g1 + c + 4 * n);
                        *(f32x4*)(out + row * D + c + 4 * n) = xv + gv * acc[ai][bj][m][n]; } } }
    }
};
struct EpiGU {
    const float* b_gu; bf16* act;
    __device__ __forceinline__ void operator()(const Acc& acc, const pg8::Unit& u, int wr, int wc, int fr, int fq) const {
        const int row0 = u.pm * 256 + wr * 64 + fr, cb = wc * 32 + 8 * fq; const int e = u.bt >> 3;
        const float* bg = b_gu + (size_t)e * 2048 + u.pn * 128 + cb; const float* bl = bg + 1024;
        float bgv[8], blv[8];
#pragma unroll
        for (int j = 0; j < 8; ++j) { bgv[j] = bg[j]; blv[j] = bl[j]; }
#pragma unroll
        for (int ai = 0; ai < 2; ++ai)
#pragma unroll
            for (int m = 0; m < 4; ++m) { const size_t row = (size_t)(row0 + ai * 128 + m * 16); float v[8];
#pragma unroll
                for (int j = 0; j < 8; ++j) { const float gl = fminf(acc[ai][0][m][j >> 2][j & 3] + bgv[j], 7.0f); const float ln = fminf(fmaxf(acc[ai][1][m][j >> 2][j & 3] + blv[j], -7.0f), 7.0f);
                    v[j] = gl * sigmoidf_(1.702f * gl) * (ln + 1.0f); }
                *(v4u*)(act + row * 1024 + u.pn * 128 + cb) = pack8(v); }
    }
};
struct EpiDN {
    const float* b_down; const float* slot_p; bf16* ys;
    __device__ __forceinline__ void operator()(const Acc& acc, const pg8::Unit& u, int wr, int wc, int fr, int fq) const {
        const int row0 = u.pm * 256 + wr * 64 + fr, cb = wc * 32 + 8 * fq; const int e = u.bt >> 2;
#pragma unroll
        for (int bj = 0; bj < 2; ++bj) { const int c = u.pn * 256 + bj * 128 + cb; float bv[8];
#pragma unroll
            for (int j = 0; j < 8; ++j) bv[j] = b_down[(size_t)e * 1024 + c + j];
#pragma unroll
            for (int ai = 0; ai < 2; ++ai)
#pragma unroll
                for (int m = 0; m < 4; ++m) { const size_t row = (size_t)(row0 + ai * 128 + m * 16); const float pr = slot_p[row]; float v[8];
#pragma unroll
                    for (int j = 0; j < 8; ++j) v[j] = (acc[ai][bj][m][j >> 2][j & 3] + bv[j]) * pr;
                    *(v4u*)(ys + row * 1024 + c) = pack8(v); } }
    }
};

__device__ __forceinline__ void phase_conv(const P& p, LAS unsigned char* lds) {
    const int tid = threadIdx.x;
    bf16* qkva = (bf16*)(p.ws + WS_QKVA);
    LAS unsigned char* rowbuf = lds;
    LAS unsigned char* cbuf = lds + 3 * 16896;
    const int cg = tid & 15, c0 = tid >> 4;
    for (int u = blockIdx.x; u < NB * 24; u += gridDim.x) {
        const int b = u / 24, s = u % 24;
        float w[9][8];
#pragma unroll
        for (int k = 0; k < 9; ++k)
#pragma unroll
            for (int e = 0; e < 8; ++e) w[k][e] = p.conv_w[k * 3072 + s * 128 + cg * 8 + e];
        const bool donorm = s < 16;
        if (tid < 96) { const int bi = tid / 32, r = tid % 32; *(LAS v4u*)(rowbuf + bi * 16896 + ((r >> 4) ? 65 : 0) * 256 + (r & 15) * 16) = (v4u){0u, 0u, 0u, 0u}; }
        if (tid >= 128 && tid < 160) { const int r = tid - 128; *(LAS v4u*)(cbuf + ((r >> 4) ? 257 : 0) * 256 + (r & 15) * 16) = (v4u){0u, 0u, 0u, 0u}; }
        { bf16* base = qkva + (size_t)(T + b * CTXL) * 3072 + s * 128 + cg * 8;
#pragma unroll
          for (int jj = 0; jj < 8; ++jj) { const int t = c0 + 32 * jj; *(LAS v4u*)(cbuf + (t + 1) * 256 + cg * 16) = *(const v4u*)(base + (size_t)t * 3072); }
          __syncthreads();
#pragma unroll
          for (int jj = 0; jj < 8; ++jj) { const int t = c0 + 32 * jj; float a[8];
#pragma unroll
              for (int e = 0; e < 8; ++e) a[e] = 0.f;
#pragma unroll
              for (int kw = 0; kw < 3; ++kw) { float f[8]; unpack8(*(const LAS v4u*)(cbuf + (t + kw) * 256 + cg * 16), f);
#pragma unroll
                  for (int e = 0; e < 8; ++e) a[e] += f[e] * w[3 + kw][e]; }
              float ss = 0.f;
#pragma unroll
              for (int e = 0; e < 8; ++e) { a[e] = siluf_(a[e]); ss += a[e] * a[e]; }
              if (donorm) { ss += __shfl_xor(ss, 1); ss += __shfl_xor(ss, 2); ss += __shfl_xor(ss, 4); ss += __shfl_xor(ss, 8); const float sc = 1.0f / sqrtf(ss + EPS);
#pragma unroll
                  for (int e = 0; e < 8; ++e) a[e] *= sc; }
              *(v4u*)(base + (size_t)t * 3072) = pack8(a); }
        }
        bf16* base = qkva + (size_t)(b * SEQ) * 3072 + s * 128 + cg * 8;
#pragma unroll
        for (int rr = 0; rr < 2; ++rr)
#pragma unroll
            for (int jj = 0; jj < 2; ++jj) { const int c = c0 + 32 * jj; *(LAS v4u*)(rowbuf + rr * 16896 + (c + 1) * 256 + cg * 16) = *(const v4u*)(base + (size_t)(rr * 64 + c) * 3072); }
        __syncthreads();
        for (int r = 0; r < 64; ++r) {
            v4u pre[2];
            if (r + 2 < 64) {
#pragma unroll
                for (int jj = 0; jj < 2; ++jj) pre[jj] = *(const v4u*)(base + (size_t)((r + 2) * 64 + c0 + 32 * jj) * 3072);
            }
#pragma unroll
            for (int jj = 0; jj < 2; ++jj) { const int c = c0 + 32 * jj; float a[8];
#pragma unroll
                for (int e = 0; e < 8; ++e) a[e] = 0.f;
#pragma unroll
                for (int kh = 0; kh < 3; ++kh) { const int rr = r + kh - 1; if (rr < 0 || rr > 63) continue; LAS unsigned char* rb = rowbuf + (rr % 3) * 16896;
#pragma unroll
                    for (int kw = 0; kw < 3; ++kw) { float f[8]; unpack8(*(const LAS v4u*)(rb + (c + kw) * 256 + cg * 16), f);
#pragma unroll
                        for (int e = 0; e < 8; ++e) a[e] += f[e] * w[kh * 3 + kw][e]; } }
                float ss = 0.f;
#pragma unroll
                for (int e = 0; e < 8; ++e) { a[e] = siluf_(a[e]); ss += a[e] * a[e]; }
                if (donorm) { ss += __shfl_xor(ss, 1); ss += __shfl_xor(ss, 2); ss += __shfl_xor(ss, 4); ss += __shfl_xor(ss, 8); const float sc = 1.0f / sqrtf(ss + EPS);
#pragma unroll
                    for (int e = 0; e < 8; ++e) a[e] *= sc; }
                *(v4u*)(base + (size_t)(r * 64 + c) * 3072) = pack8(a); }
            __syncthreads();
            if (r + 2 < 64) {
#pragma unroll
                for (int jj = 0; jj < 2; ++jj) *(LAS v4u*)(rowbuf + ((r + 2) % 3) * 16896 + (c0 + 32 * jj + 1) * 256 + cg * 16) = pre[jj];
            }
            __syncthreads();
        }
    }
}

template <bool GLA>
__device__ __forceinline__ void scan_unit(const P& p, LAS unsigned char* lds, int b, int h, int vh) {
    const int tid = threadIdx.x, j = tid >> 2, part = tid & 3;
    LAS float* qf = (LAS float*)lds; LAS float* kf = qf + 32 * 144; LAS float* af = kf + 32 * 144; LAS float* vf = af + 32 * 144; LAS float* ob = vf + 32 * 128;
    LAS float* sa = ob + 32 * 128; LAS float* sb = sa + 32;
    const bf16* qkva = (const bf16*)(p.ws + WS_QKVA); const bf16* pbuf = (const bf16*)(p.ws + WS_PB); const float* small = (const float*)(p.ws + WS_SMALL);
    bf16* on = (bf16*)p.out;
    const int lt = tid >> 4, piece = tid & 15;
    const float scale = 0.08838834764831845f;
    for (int dir = 0; dir < 2; ++dir) {
        float S[32];
#pragma unroll
        for (int i = 0; i < 32; ++i) S[i] = 0.f;
        float wcol[16]; float gbias = 0.f, alog = 0.f, dtb = 0.f;
        if (GLA) { const float* gw = dir ? p.gla_gate_w_b : p.gla_gate_w_f; const int i = tid & 127;
#pragma unroll
            for (int r = 0; r < 16; ++r) wcol[r] = gw[r * 512 + h * 128 + i];
            gbias = (dir ? p.gla_gate_b_b : p.gla_gate_b_f)[h * 128 + i]; }
        else { alog = __expf((dir ? p.a_log_b : p.a_log_f)[h]); dtb = (dir ? p.dt_bias_b : p.dt_bias_f)[h]; }
        for (int s = 0; s < 136; ++s) {
            const bool is_ctx = s < 8;
            const int sci = is_ctx ? (dir ? 7 - s : s) : (dir ? 127 - (s - 8) : s - 8);
            const size_t row0 = is_ctx ? (size_t)(T + b * CTXL + sci * 32) : (size_t)(b * SEQ + sci * 32);
            __syncthreads();
            { v4u qw, kw, vw;
              if (GLA) { const bf16* r = pbuf + (row0 + lt) * 2048; qw = *(const v4u*)(r + h * 128 + piece * 8); kw = *(const v4u*)(r + 512 + h * 128 + piece * 8); vw = *(const v4u*)(r + 1024 + h * 256 + vh * 128 + piece * 8); }
              else { const bf16* r = qkva + (row0 + lt) * 3072; qw = *(const v4u*)(r + h * 128 + piece * 8); kw = *(const v4u*)(r + 1024 + h * 128 + piece * 8); vw = *(const v4u*)(r + 2048 + h * 128 + piece * 8); }
              float f[8]; const int o = lt * 144 + (piece >> 2) * 36 + (piece & 3) * 8;
              unpack8(qw, f);
#pragma unroll
              for (int e = 0; e < 8; ++e) qf[o + e] = f[e] * scale;
              unpack8(kw, f);
#pragma unroll
              for (int e = 0; e < 8; ++e) kf[o + e] = f[e];
              unpack8(vw, f);
#pragma unroll
              for (int e = 0; e < 8; ++e) vf[lt * 128 + piece * 8 + e] = f[e]; }
            if (GLA) { const int i = tid & 127, tq = tid >> 7;
#pragma unroll
                for (int tt = 0; tt < 8; ++tt) { const int t = tq * 8 + tt; const float* z = small + (row0 + t) * 64 + 32 + dir * 16; float u = gbias;
#pragma unroll
                    for (int r = 0; r < 16; ++r) u += z[r] * wcol[r];
                    const float ls = fminf(u, 0.f) - log1pf(__expf(-fabsf(u)));
                    af[t * 144 + (i >> 5) * 36 + (i & 31)] = __expf(ls * (1.0f / 16.0f)); } }
            else if (tid < 32) { const float* sm = small + (row0 + tid) * 64; sb[tid] = sigmoidf_(sm[dir * 8 + h]); sa[tid] = __expf(-alog * softplusf_(sm[16 + dir * 8 + h] + dtb)); }
            __syncthreads();
            for (int tt = 0; tt < 32; ++tt) { const int t = dir ? 31 - tt : tt;
                const LAS float* kp = kf + t * 144 + part * 36; const LAS float* qp = qf + t * 144 + part * 36;
                float kk[32], qq[32];
#pragma unroll
                for (int i = 0; i < 32; i += 4) { const f32x4 a = *(const LAS f32x4*)(kp + i); kk[i] = a.x; kk[i + 1] = a.y; kk[i + 2] = a.z; kk[i + 3] = a.w;
                    const f32x4 q4 = *(const LAS f32x4*)(qp + i); qq[i] = q4.x; qq[i + 1] = q4.y; qq[i + 2] = q4.z; qq[i + 3] = q4.w; }
                const float vj = vf[t * 128 + j];
                float os = 0.f;
                if (GLA) { const LAS float* ap = af + t * 144 + part * 36;
#pragma unroll
                    for (int i = 0; i < 32; i += 4) { const f32x4 a = *(const LAS f32x4*)(ap + i);
                        S[i] = a.x * S[i] + kk[i] * vj; S[i + 1] = a.y * S[i + 1] + kk[i + 1] * vj; S[i + 2] = a.z * S[i + 2] + kk[i + 2] * vj; S[i + 3] = a.w * S[i + 3] + kk[i + 3] * vj; }
                } else { const float a = sa[t], be = sb[t]; float ks = 0.f;
#pragma unroll
                    for (int i = 0; i < 32; ++i) ks += kk[i] * S[i];
                    ks += __shfl_xor(ks, 1); ks += __shfl_xor(ks, 2);
                    const float vn = be * (vj - a * ks);
#pragma unroll
                    for (int i = 0; i < 32; ++i) S[i] = a * S[i] + kk[i] * vn; }
                if (!is_ctx) {
#pragma unroll
                    for (int i = 0; i < 32; ++i) os += qq[i] * S[i];
                    os += __shfl_xor(os, 1); os += __shfl_xor(os, 2);
                    if (part == 0) ob[t * 128 + j] = os; }
            }
            if (!is_ctx) { __syncthreads();
                bf16* dst = on + (row0 + lt) * 2048 + (GLA ? 1024 + h * 256 + vh * 128 : h * 128) + piece * 8; float f[8];
#pragma unroll
                for (int e = 0; e < 8; ++e) f[e] = ob[lt * 128 + piece * 8 + e];
                if (dir) { float g[8]; unpack8(*(const v4u*)dst, g);
#pragma unroll
                    for (int e = 0; e < 8; ++e) f[e] += g[e]; }
                *(v4u*)dst = pack8(f); }
        }
    }
}
__device__ __forceinline__ void phase_scan(const P& p, LAS unsigned char* lds) {
    for (int u = blockIdx.x; u < 256; u += gridDim.x) {
        if (u < 128) scan_unit<false>(p, lds, u >> 3, u & 7, 0);
        else { const int v = u - 128; scan_unit<true>(p, lds, v >> 3, (v >> 1) & 3, v & 1); }
        __syncthreads();
    }
}

__device__ __forceinline__ void phase_onorm(const P& p) {
    const int tid = threadIdx.x, lane = tid & 63, wave = tid >> 6;
    const int gw = blockIdx.x * NWAVES + wave, NGW = gridDim.x * NWAVES;
    bf16* on = (bf16*)p.out;
    const float* gp = lane < 32 ? p.gdn_norm_g + (lane & 3) * 32 : p.gla_norm_g + ((lane - 32) & 7) * 32;
    float g[32];
#pragma unroll
    for (int i = 0; i < 32; ++i) g[i] = gp[i];
    for (int r = gw; r < T; r += NGW) {
        v4u* ptr = (v4u*)(on + (size_t)r * 2048 + lane * 32); float f[32]; float ss = 0.f;
#pragma unroll
        for (int q = 0; q < 4; ++q) { float t8[8]; unpack8(ptr[q], t8);
#pragma unroll
            for (int e = 0; e < 8; ++e) { f[q * 8 + e] = t8[e]; ss += t8[e] * t8[e]; } }
        ss += __shfl_xor(ss, 1); ss += __shfl_xor(ss, 2);
        const float s4 = __shfl_xor(ss, 4);
        const float rstd = lane < 32 ? 1.0f / sqrtf(ss * (1.f / 128.f) + EPS) : 1.0f / sqrtf((ss + s4) * (1.f / 256.f) + EPS);
#pragma unroll
        for (int q = 0; q < 4; ++q) { float t8[8];
#pragma unroll
            for (int e = 0; e < 8; ++e) t8[e] = f[q * 8 + e] * rstd * g[q * 8 + e];
            ptr[q] = pack8(t8); }
    }
}

__device__ __forceinline__ void phase_wconv(const P& p, LAS unsigned char* lds) {
    const int tid = threadIdx.x, lane = tid & 63, wave = tid >> 6;
    LAS float* scr = (LAS float*)(lds + wave * 8448);
    const int gw = blockIdx.x * NWAVES + wave, NGW = gridDim.x * NWAVES;
    bf16* wgu = (bf16*)(p.ws + WS_WB_GU); bf16* wdn = (bf16*)(p.ws + WS_WB_DN);
    constexpr int I_GU = NE * 64 * 16, I_DN = NE * 32 * 16;
    for (int it = gw; it < I_GU + I_DN; it += NGW) {
        if (it < I_GU) { const int e = it >> 10, r = it & 1023, nb = r >> 4, kb = r & 15;
            const int dstrow = nb < 32 ? (nb >> 2) * 256 + (nb & 3) * 32 : ((nb - 32) >> 2) * 256 + 128 + ((nb - 32) & 3) * 32;
            tr_item(p.w_gu + (size_t)e * D * 2048, 2048, 32 * nb, wgu + (size_t)e * 2048 * D, dstrow, 64 * kb, scr, lane); }
        else { const int r2 = it - I_GU; const int e = r2 >> 9, r = r2 & 511, nb = r >> 4, kb = r & 15;
            tr_item(p.w_down + (size_t)e * D * D, D, 32 * nb, wdn + (size_t)e * D * D, 32 * nb, 64 * kb, scr, lane); }
    }
}

__device__ __forceinline__ void phase_ffnprep(const P& p, LAS unsigned char* lds) {
    const int tid = threadIdx.x, lane = tid & 63, wave = tid >> 6;
    const int gw = blockIdx.x * NWAVES + wave, NGW = gridDim.x * NWAVES;
    LAS float* wrt = (LAS float*)lds;
    LAS int* lcnt = (LAS int*)(lds + 131072);
    for (int i = tid; i < 32 * 1024; i += NTHREADS) { const int k = i >> 5, e = i & 31; wrt[e * 1024 + k] = p.w_router[i]; }
    if (tid < NG * 32) lcnt[tid] = 0;
    { int* st = (int*)(p.ws + WS_SLOT_TOK); float* sp = (float*)(p.ws + WS_SLOT_P);
      for (int i = blockIdx.x * NTHREADS + tid; i < NG * MAXSLOT; i += gridDim.x * NTHREADS) { st[i] = -1; sp[i] = 0.f; } }
    __syncthreads();
    const float* modv = (const float*)(p.ws + WS_MODV); bf16* h2 = (bf16*)(p.ws + WS_H2);
    int* topi = (int*)(p.ws + WS_TOPI); float* topp = (float*)(p.ws + WS_TOPP);
    float br[32];
#pragma unroll
    for (int e = 0; e < 32; ++e) br[e] = p.b_router[e];
    for (int r = gw; r < T; r += NGW) {
        const int b = r >> 12;
        const f32x4* xr = (const f32x4*)(p.out + (size_t)r * D) + lane;
        f32x4 v[4]; float s = 0.f;
#pragma unroll
        for (int j = 0; j < 4; ++j) { v[j] = xr[64 * j]; s += (v[j].x * v[j].x + v[j].y * v[j].y) + (v[j].z * v[j].z + v[j].w * v[j].w); }
        const float rstd = 1.0f / sqrtf(wave_sum(s) * (1.f / D) + EPS);
        const f32x4* g = (const f32x4*)p.norm_ffn_g + lane; const f32x4* sh = (const f32x4*)(modv + b * NMOD + 3 * D) + lane; const f32x4* scl = (const f32x4*)(modv + b * NMOD + 4 * D) + lane;
        v2u* o8 = (v2u*)(h2 + (size_t)r * D) + lane;
#pragma unroll
        for (int j = 0; j < 4; ++j) { const f32x4 gg = g[64 * j], s1 = sh[64 * j], s2 = scl[64 * j]; v[j] = v[j] * rstd * gg * (1.0f + s2) + s1;
            v2u w; w.x = pk2(v[j].x, v[j].y); w.y = pk2(v[j].z, v[j].w); o8[64 * j] = w; }
        float lg[32];
#pragma unroll
        for (int e = 0; e < 32; ++e) { float a = 0.f;
#pragma unroll
            for (int j = 0; j < 4; ++j) { const f32x4 wv = *(const LAS f32x4*)(wrt + e * 1024 + (lane + 64 * j) * 4); a += (v[j].x * wv.x + v[j].y * wv.y) + (v[j].z * wv.z + v[j].w * wv.w); }
            lg[e] = wave_sum(a) + br[e]; }
        int sel[4]; float val[4];
#pragma unroll
        for (int k = 0; k < 4; ++k) { float best = -3.0e38f; int bi = 0;
#pragma unroll
            for (int e = 0; e < 32; ++e) { if (lg[e] > best) { best = lg[e]; bi = e; } }
            sel[k] = bi; val[k] = best;
#pragma unroll
            for (int e = 0; e < 32; ++e) lg[e] = (e == bi) ? -3.0e38f : lg[e]; }
        float pe[4], ps = 0.f;
#pragma unroll
        for (int k = 0; k < 4; ++k) { pe[k] = __expf(val[k] - val[0]); ps += pe[k]; }
        if (lane < 4) { const int k = lane; const int e = k == 0 ? sel[0] : (k == 1 ? sel[1] : (k == 2 ? sel[2] : sel[3])); const float pv = (k == 0 ? pe[0] : (k == 1 ? pe[1] : (k == 2 ? pe[2] : pe[3]))) / ps;
            topi[r * 4 + k] = e; topp[r * 4 + k] = pv; lds_add(&lcnt[(r / TG) * 32 + e], 1); }
    }
    __syncthreads();
    if (tid < NG * 32) { const int v = lcnt[tid]; if (v) atomicAdd((int*)(p.ws + WS_CTL) + CW_CNT + tid, v); }
}

__device__ __forceinline__ void phase_route(const P& p, LAS unsigned char* lds) {
    const int tid = threadIdx.x;
    LAS int* seg = (LAS int*)lds;
    LAS int* lcnt = seg + 64; LAS int* gb = lcnt + 32;
    int* ctl = (int*)(p.ws + WS_CTL);
    int* tile_e = (int*)(p.ws + WS_TILE_E);
    if (tid == 0) {
        for (int g = 0; g < NG; ++g) { int acc = 0;
            for (int e = 0; e < NE; ++e) { const int c = __hip_atomic_load(ctl + CW_CNT + g * 32 + e, __ATOMIC_RELAXED, __HIP_MEMORY_SCOPE_AGENT); const int padded = (c + 255) & ~255; seg[g * 32 + e] = acc;
                if (blockIdx.x == 0) for (int t = acc >> 8; t < (acc + padded) >> 8; ++t) tile_e[g * MAXTILE + t] = e;
                acc += padded; }
            if (blockIdx.x == 0) ctl[CW_NTILE + g] = acc >> 8; }
    }
    __syncthreads();
    const int* topi = (const int*)(p.ws + WS_TOPI); const float* topp = (const float*)(p.ws + WS_TOPP);
    int* slot_tok = (int*)(p.ws + WS_SLOT_TOK); float* slot_p = (float*)(p.ws + WS_SLOT_P); int* tokslot = (int*)(p.ws + WS_TOKSLOT);
    for (int base = blockIdx.x * 256; base < T; base += gridDim.x * 256) {
        const int g = base / TG;
        if (tid < 32) lcnt[tid] = 0;
        __syncthreads();
        int e2[2], lp[2];
#pragma unroll
        for (int jj = 0; jj < 2; ++jj) { const int i = tid + 512 * jj; e2[jj] = topi[base * 4 + i]; lp[jj] = lds_add(&lcnt[e2[jj]], 1); }
        __syncthreads();
        if (tid < 32) gb[tid] = lcnt[tid] ? atomicAdd(ctl + CW_CUR + g * 32 + tid, lcnt[tid]) : 0;
        __syncthreads();
#pragma unroll
        for (int jj = 0; jj < 2; ++jj) { const int i = tid + 512 * jj; const int slot = seg[g * 32 + e2[jj]] + gb[e2[jj]] + lp[jj];
            slot_tok[g * MAXSLOT + slot] = base + (i >> 2); slot_p[g * MAXSLOT + slot] = topp[base * 4 + i]; tokslot[base * 4 + i] = slot; }
        __syncthreads();
    }
}

__device__ __forceinline__ void phase_combine(const P& p, int g) {
    const int tid = threadIdx.x, lane = tid & 63, wave = tid >> 6;
    const int gw = blockIdx.x * NWAVES + wave, NGW = gridDim.x * NWAVES;
    const float* modv = (const float*)(p.ws + WS_MODV); const bf16* ys = (const bf16*)(p.ws + WS_YSLOT); const int* tokslot = (const int*)(p.ws + WS_TOKSLOT);
    for (int r = g * TG + gw; r < (g + 1) * TG; r += NGW) {
        const int b = r >> 12;
        f32x4* xr = (f32x4*)(p.out + (size_t)r * D) + lane;
        const f32x4* g2 = (const f32x4*)(modv + b * NMOD + 5 * D) + lane;
        f32x4 y[4];
#pragma unroll
        for (int j = 0; j < 4; ++j) y[j] = (f32x4){0.f, 0.f, 0.f, 0.f};
#pragma unroll
        for (int k = 0; k < 4; ++k) { const int slot = tokslot[r * 4 + k]; const v2u* yr = (const v2u*)(ys + (size_t)slot * D) + lane;
#pragma unroll
            for (int j = 0; j < 4; ++j) { const v2u w = yr[64 * j]; y[j].x += bflo(w.x); y[j].y += bfhi(w.x); y[j].z += bflo(w.y); y[j].w += bfhi(w.y); } }
        f32x4 v[4]; float s = 0.f;
#pragma unroll
        for (int j = 0; j < 4; ++j) { v[j] = xr[64 * j] + g2[64 * j] * y[j]; s += (v[j].x * v[j].x + v[j].y * v[j].y) + (v[j].z * v[j].z + v[j].w * v[j].w); }
        const float rstd = 1.0f / sqrtf(wave_sum(s) * (1.f / D) + EPS);
        const f32x4* fg = (const f32x4*)p.final_norm_g + lane;
#pragma unroll
        for (int j = 0; j < 4; ++j) xr[64 * j] = v[j] * rstd * fg[64 * j];
    }
}

constexpr int N_PHASES = 13 + 3 * NG;
template <int PH>
__device__ __forceinline__ void run_phase(const P& p, LAS unsigned char* lds) {
    const int G = gridDim.x, c = blockIdx.x;
    unsigned char* ws = p.ws;
    if constexpr (PH == 0) phase_prologue(p, lds);
    else if constexpr (PH == 1) phase_norm1(p);
    else if constexpr (PH == 2) { pg8::SchedDense S{TT / 256, N_S / 256, G, c}; EpiG1 E{(bf16*)(ws + WS_QKVA), (bf16*)(ws + WS_PB), (float*)(ws + WS_SMALL)};
        pg8::gemm_phase(lds, (const bf16*)(ws + WS_H), (const bf16*)(ws + WS_BT_S), D, S, E); }
    else if constexpr (PH == 3) phase_conv(p, lds);
    else if constexpr (PH == 4) phase_scan(p, lds);
    else if constexpr (PH == 5) phase_onorm(p);
    else if constexpr (PH == 6) phase_wconv(p, lds);
    else if constexpr (PH == 7) { pg8::SchedDense S{T / 256, N_G / 256, G, c}; EpiG2 E{(const bf16*)p.out, (bf16*)(ws + WS_YA_IN), (bf16*)(ws + WS_YB_IN), (bf16*)(ws + WS_GATES)};
        pg8::gemm_phase(lds, (const bf16*)(ws + WS_H), (const bf16*)(ws + WS_BT_G), D, S, E); }
    else if constexpr (PH == 8) { pg8::SchedDense S{T / 256, 4, G, c}; EpiG34<0> E{(const bf16*)(ws + WS_GATES), (bf16*)(ws + WS_Y)};
        pg8::gemm_phase(lds, (const bf16*)(ws + WS_YA_IN), (const bf16*)(ws + WS_BT_OA), D, S, E); }
    else if constexpr (PH == 9) { pg8::SchedDense S{T / 256, 4, G, c}; EpiG34<1> E{(const bf16*)(ws + WS_GATES), (bf16*)(ws + WS_Y)};
        pg8::gemm_phase(lds, (const bf16*)(ws + WS_YB_IN), (const bf16*)(ws + WS_BT_OB), D, S, E); }
    else if constexpr (PH == 10) { pg8::SchedDense S{T / 256, 4, G, c}; EpiG5 E{p.x, (const float*)(ws + WS_MODV), p.out};
        pg8::gemm_phase(lds, (const bf16*)(ws + WS_Y), (const bf16*)(ws + WS_BT_O), D, S, E); }
    else if constexpr (PH == 11) phase_ffnprep(p, lds);
    else if constexpr (PH == 12) phase_route(p, lds);
    else {
        constexpr int g = (PH - 13) / 3, sub = (PH - 13) % 3;
        const int ntile = ((const int*)(ws + WS_CTL))[CW_NTILE + g];
        const int* tile_e = (const int*)(ws + WS_TILE_E) + g * MAXTILE;
        if constexpr (sub == 0) { pg8::SchedMoe S{ntile, 8, G, c, tile_e, (const int*)(ws + WS_SLOT_TOK) + g * MAXSLOT}; EpiGU E{p.b_gu, (bf16*)(ws + WS_ACT)};
            pg8::gemm_phase(lds, (const bf16*)(ws + WS_H2), (const bf16*)(ws + WS_WB_GU), D, S, E); }
        else if constexpr (sub == 1) { pg8::SchedMoe S{ntile, 4, G, c, tile_e, nullptr}; EpiDN E{p.b_down, (const float*)(ws + WS_SLOT_P) + g * MAXSLOT, (bf16*)(ws + WS_YSLOT)};
            pg8::gemm_phase(lds, (const bf16*)(ws + WS_ACT), (const bf16*)(ws + WS_WB_DN), D, S, E); }
        else phase_combine(p, g);
    }
}

#if MK_FUSED
template <int PH>
__device__ __forceinline__ void run_from(const P& p, LAS unsigned char* lds, const XcdBarrier& bar) {
    if constexpr (PH < N_PHASES) { run_phase<PH>(p, lds); if constexpr (PH + 1 < N_PHASES) xcd_barrier(bar); run_from<PH + 1>(p, lds, bar); }
}
__global__ void __launch_bounds__(NTHREADS, 2) k_fused(P p) {
    extern __shared__ __attribute__((aligned(16))) unsigned char lds_raw[];
    LAS unsigned char* lds = (LAS unsigned char*)lds_raw;
    volatile LAS unsigned* misc = (volatile LAS unsigned*)(lds + 144 * 1024 - 64);
    if (threadIdx.x < 4) misc[threadIdx.x] = 0u;
    __syncthreads();
    XcdBarrier bar = xcd_barrier_post((unsigned*)(p.ws + WS_CTL) + CW_BAR, misc);
    run_from<0>(p, lds, bar);
}
#else
template <int PH>
__global__ void __launch_bounds__(NTHREADS, 2) k_phase(P p) {
    extern __shared__ __attribute__((aligned(16))) unsigned char lds_raw[];
    run_phase<PH>(p, (LAS unsigned char*)lds_raw);
}
template <int PH>
static void launch_all(const P& p, int grid, hipStream_t stream) {
    if constexpr (PH < N_PHASES) {
        static bool attr = false;
        if (!attr) { (void)hipFuncSetAttribute((const void*)k_phase<PH>, hipFuncAttributeMaxDynamicSharedMemorySize, LDS_BYTES); attr = true; }
        hipLaunchKernelGGL(k_phase<PH>, dim3(grid), dim3(NTHREADS), LDS_BYTES, stream, p);
        launch_all<PH + 1>(p, grid, stream);
    }
}
#endif

extern "C" void kernel_launch(void* const* d_in, const int* in_sizes, int n_in, void* d_out, int out_size, void* d_ws, size_t ws_size, hipStream_t stream) {
    static int grid = 0;
    if (grid == 0) {
        if (n_in != 30 || in_sizes[0] != T * D || out_size != T * D || ws_size < WS_END) { fprintf(stderr, "kernel_launch: unexpected shapes (n_in %d, in0 %d, out %d, ws %zu)\n", n_in, n_in > 0 ? in_sizes[0] : -1, out_size, ws_size); grid = -1; return; }
        int dev = 0, cus = 0;
        if (hipGetDevice(&dev) != hipSuccess || hipDeviceGetAttribute(&cus, hipDeviceAttributeMultiprocessorCount, dev) != hipSuccess) { grid = -1; return; }
#if MK_FUSED
        if (hipFuncSetAttribute((const void*)k_fused, hipFuncAttributeMaxDynamicSharedMemorySize, LDS_BYTES) != hipSuccess) { fprintf(stderr, "kernel_launch: hipFuncSetAttribute failed\n"); grid = -1; return; }
        int per_cu = 0;
        if (hipOccupancyMaxActiveBlocksPerMultiprocessor(&per_cu, (const void*)k_fused, NTHREADS, LDS_BYTES) != hipSuccess || per_cu < 1) fprintf(stderr, "kernel_launch: occupancy query reports %d\n", per_cu);
        (void)hipGetLastError();
#endif
        grid = cus;
    }
    if (grid < 0) return;
    (void)hipMemsetAsync((char*)d_ws + WS_CTL, 0, CTL_BYTES, stream);
    P p{};
    const float** pp = (const float**)&p;
    for (int i = 0; i < 30; ++i) pp[i] = (const float*)d_in[i];
    p.out = (float*)d_out; p.ws = (unsigned char*)d_ws;
#if MK_FUSED
    hipLaunchKernelGGL(k_fused, dim3(grid), dim3(NTHREADS), LDS_BYTES, stream, p);
#else
    launch_all<0>(p, grid, stream);
#endif
}
```

```cpp
#include <hip/hip_runtime.h>
#include <cstdio>
#include <cstdint>

#ifndef MK_FUSED
#define MK_FUSED 1
#endif

#define GAS __attribute__((address_space(1)))
#define LAS __attribute__((address_space(3)))
typedef unsigned short bf16;
typedef unsigned v4u __attribute__((ext_vector_type(4)));
typedef unsigned v2u __attribute__((ext_vector_type(2)));
typedef float f32x4 __attribute__((ext_vector_type(4)));
typedef short bf16x8 __attribute__((ext_vector_type(8)));

constexpr int D = 1024, NB = 16, SEQ = 4096, T = NB * SEQ, CTXL = 256, TC = NB * CTXL, TT = T + TC;
constexpr int D_IN = 9280, N_S = 5376, N_G = 4096, NMOD = 6 * D;
constexpr int NE = 32, NG = 2, TG = T / NG, MAXSLOT = 139264, MAXTILE = MAXSLOT / 256;
constexpr float EPS = 1e-6f;
constexpr int NTHREADS = 512, NWAVES = 8;
constexpr int LDS_BYTES = 147456;

constexpr size_t MiB = 1u << 20;
constexpr size_t WS_CTL = 0, CTL_BYTES = 1 * MiB;
constexpr size_t WS_MODV = 1 * MiB, WS_BT_S = 2 * MiB, WS_BT_G = 13 * MiB, WS_BT_OA = 21 * MiB, WS_BT_OB = 23 * MiB, WS_BT_O = 25 * MiB;
constexpr size_t WS_TOPI = 27 * MiB, WS_TOPP = 28 * MiB, WS_TOKSLOT = 29 * MiB, WS_SLOT_TOK = 30 * MiB, WS_SLOT_P = 32 * MiB, WS_TILE_E = 34 * MiB;
constexpr size_t WS_H = 40 * MiB, WS_PB = 176 * MiB, WS_SMALL = 448 * MiB, WS_QKVA = 465 * MiB;
constexpr size_t WS_WB_DN = 176 * MiB, WS_YA_IN = 240 * MiB, WS_YB_IN = 368 * MiB, WS_GATES = 496 * MiB, WS_Y = 752 * MiB, WS_WB_GU = 880 * MiB;
constexpr size_t WS_H2 = 40 * MiB, WS_ACT = 240 * MiB, WS_YSLOT = 512 * MiB, WS_END = 1008 * MiB;
static_assert(WS_QKVA + (size_t)TT * 3072 * 2 <= 873 * MiB && WS_SMALL + (size_t)TT * 64 * 4 <= WS_QKVA && WS_H + (size_t)TT * D * 2 <= WS_PB, "ws map");
static_assert(WS_ACT + (size_t)MAXSLOT * D * 2 <= WS_YSLOT && WS_YSLOT + (size_t)MAXSLOT * D * 2 <= WS_WB_GU, "ws map 2");
constexpr int CW_BAR = 4096, CW_CNT = 8192, CW_CUR = 8192 + 256, CW_NTILE = 8192 + 512;

#define LDS_WAIT() asm volatile("s_waitcnt lgkmcnt(0)" ::: "memory")
#define VM_WAIT() asm volatile("s_waitcnt vmcnt(0)" ::: "memory")
__device__ __forceinline__ float bflo(unsigned u) { return __uint_as_float(u << 16); }
__device__ __forceinline__ float bfhi(unsigned u) { return __uint_as_float(u & 0xffff0000u); }
__device__ __forceinline__ unsigned pk2(float lo, float hi) { unsigned r; asm("v_cvt_pk_bf16_f32 %0, %1, %2" : "=v"(r) : "v"(lo), "v"(hi)); return r; }
__device__ __forceinline__ float wave_sum(float v) {
#pragma unroll
    for (int o = 1; o < 64; o <<= 1) v += __shfl_xor(v, o);
    return v;
}
__device__ __forceinline__ int lds_add(LAS int* p, int v) { return __hip_atomic_fetch_add(p, v, __ATOMIC_RELAXED, __HIP_MEMORY_SCOPE_WORKGROUP); }
__device__ __forceinline__ float sigmoidf_(float x) { return 1.0f / (1.0f + __expf(-x)); }
__device__ __forceinline__ float siluf_(float x) { return x / (1.0f + __expf(-x)); }
__device__ __forceinline__ float softplusf_(float x) { return fmaxf(x, 0.f) + log1pf(__expf(-fabsf(x))); }
__device__ __forceinline__ void unpack8(const v4u w, float (&f)[8]) {
    f[0] = bflo(w.x); f[1] = bfhi(w.x); f[2] = bflo(w.y); f[3] = bfhi(w.y); f[4] = bflo(w.z); f[5] = bfhi(w.z); f[6] = bflo(w.w); f[7] = bfhi(w.w);
}
__device__ __forceinline__ v4u pack8(const float (&f)[8]) { v4u w; w.x = pk2(f[0], f[1]); w.y = pk2(f[2], f[3]); w.z = pk2(f[4], f[5]); w.w = pk2(f[6], f[7]); return w; }

struct P {
    const float *x, *c, *ctx, *c_ctx, *w_mod, *b_mod, *norm_mix_g, *norm_ffn_g, *w_in, *conv_w, *a_log_f, *a_log_b, *dt_bias_f, *dt_bias_b, *gdn_norm_g,
        *gla_gate_w_f, *gla_gate_w_b, *gla_gate_b_f, *gla_gate_b_b, *gla_norm_g, *w_out_a, *w_out_b, *w_out, *w_router, *b_router, *w_gu, *b_gu, *w_down, *b_down, *final_norm_g;
    float* out; unsigned char* ws;
};

namespace pg8 {
constexpr int BM = 256, BK = 64, HALF = 128, HTB = HALF * BK * 2, STAGE_BYTES = 8 * HTB, NXCD = 8, WGM = 8;
__host__ __device__ __forceinline__ int lds_byte(int r, int c) { const int st = (r >> 4) * 2 + (c >> 5), rr = r & 15, cc = c & 31, ob = rr * 64 + cc * 2; return st * 1024 + (ob ^ (((ob >> 9) & 1) << 5)); }
__host__ __device__ __forceinline__ void stage_rc(int b, int& R, int& C) { const int st = b / 1024, sb = b % 1024, swz = sb ^ (((sb >> 9) & 1) << 5); R = (st >> 1) * 16 + swz / 64; C = (st & 1) * 32 + (swz % 64) / 2; }
__host__ __device__ __forceinline__ int perm32(int rho) { const int n = rho >> 4, i = rho & 15; return 8 * (i >> 2) + 4 * n + (i & 3); }
struct Unit { int pm, pn, bt; };

__device__ __forceinline__ void order_map(int L, int nM, int nN, int& pm, int& pn) {
    const int nwg = nM * nN; int wgid = L;
    { const int q = nwg / NXCD, r = nwg % NXCD, xcd = wgid % NXCD, off = wgid / NXCD; wgid = (xcd < r ? xcd * (q + 1) : r * (q + 1) + (xcd - r) * q) + off; }
    const int nig = WGM * nN, gid = wgid / nig, fm = gid * WGM, gsz = (nM - fm) < WGM ? (nM - fm) : WGM;
    pm = fm + ((wgid % nig) % gsz); pn = (wgid % nig) / gsz;
}
struct SchedDense {
    int nM, nN, G, c;
    __device__ __forceinline__ bool next(int i, Unit& u) const { const long L = (long)i * G + c; if (L >= (long)nM * nN) return false; order_map((int)L, nM, nN, u.pm, u.pn); u.bt = u.pn; return true; }
    __device__ __forceinline__ unsigned arow(const Unit& u, int r) const { return (unsigned)(u.pm * BM + r); }
};
struct SchedMoe {
    int nM, nN, G, c; const int* tile_e; const int* slot_tok;
    __device__ __forceinline__ bool next(int i, Unit& u) const { const long L = (long)i * G + c; if (L >= (long)nM * nN) return false; order_map((int)L, nM, nN, u.pm, u.pn); u.bt = tile_e[u.pm] * nN + u.pn; return true; }
    __device__ __forceinline__ unsigned arow(const Unit& u, int r) const { if (slot_tok) { const int t = slot_tok[u.pm * BM + r]; return (unsigned)(t < 0 ? 0 : t); } return (unsigned)(u.pm * BM + r); }
};

template <class Epi, class Sched>
__device__ __forceinline__ void gemm_phase(LAS unsigned char* lds, const bf16* A, const bf16* Bt, const int K, const Sched& S, const Epi& E) {
    const int tid = threadIdx.x, wid = __builtin_amdgcn_readfirstlane(tid >> 6), lane = tid & 63, wr = wid >> 2, wc = wid & 3, fr = lane & 15, fq = lane >> 4;
    const int nt = K / BK;
    int R0, C0; stage_rc(tid * 16, R0, C0);
    unsigned voffB[2];
#pragma unroll
    for (int i = 0; i < 2; ++i) { const int R = R0 + 64 * i; const int Rb = (R & ~31) + perm32(R & 31); voffB[i] = (unsigned)(Rb * K + C0) * 2u; }
    const unsigned rowb = (unsigned)K * 2u, cofs = (unsigned)C0 * 2u;
    const size_t kstep = (size_t)(BK * 2);
    const size_t hstep = (size_t)HALF * K * 2;
    const size_t tstep = 2 * hstep;
    const unsigned ldsw = (unsigned)wid * 1024u;
    const int aoff = lds_byte(wr * 64 + fr, fq * 8), boff = lds_byte(wc * 32 + fr, fq * 8);
#define PG8_SA(b, h) (((b) * 2 + (h)) * HTB)
#define PG8_SB(b, h) ((4 + (b) * 2 + (h)) * HTB)
#define PG8_STAGE(bufoff, gbase, voff) do { _Pragma("unroll") for (int _i = 0; _i < 2; ++_i) \
        __builtin_amdgcn_global_load_lds((const unsigned*)((const char*)(gbase) + (voff)[_i]), (LAS unsigned*)(lds + (bufoff) + ldsw + _i * 8192), 16, 0, 0); } while (0)
#define PG8_STAGE_A(bufoff, gbase, o0, o1) do { \
        __builtin_amdgcn_global_load_lds((const unsigned*)((const char*)(gbase) + (o0)), (LAS unsigned*)(lds + (bufoff) + ldsw), 16, 0, 0); \
        __builtin_amdgcn_global_load_lds((const unsigned*)((const char*)(gbase) + (o1)), (LAS unsigned*)(lds + (bufoff) + ldsw + 8192), 16, 0, 0); } while (0)
#define PG8_LDA(dst, b, h) do { _Pragma("unroll") for (int m = 0; m < 4; ++m) _Pragma("unroll") for (int k = 0; k < 2; ++k) dst[m][k] = *(const LAS bf16x8*)(lds + PG8_SA(b, h) + aoff + m * 2048 + k * 1024); } while (0)
#define PG8_LDB(dst, b, h) do { _Pragma("unroll") for (int n = 0; n < 2; ++n) _Pragma("unroll") for (int k = 0; k < 2; ++k) dst[n][k] = *(const LAS bf16x8*)(lds + PG8_SB(b, h) + boff + n * 2048 + k * 1024); } while (0)
#define PG8_MMA(ai, bj, At, Bt_) do { __builtin_amdgcn_s_setprio(1); _Pragma("unroll") for (int m = 0; m < 4; ++m) _Pragma("unroll") for (int n = 0; n < 2; ++n) _Pragma("unroll") for (int k = 0; k < 2; ++k) \
        acc[ai][bj][m][n] = __builtin_amdgcn_mfma_f32_16x16x32_bf16(Bt_[n][k], At[m][k], acc[ai][bj][m][n], 0, 0, 0); __builtin_amdgcn_s_setprio(0); } while (0)
#define PG8_WAIT_V(n) asm volatile("s_waitcnt vmcnt(" #n ")" ::: "memory")
#define PG8_WAIT_L(n) asm volatile("s_waitcnt lgkmcnt(" #n ")" ::: "memory")
#define PG8_BAR __builtin_amdgcn_s_barrier()
#define PG8_SCHED __builtin_amdgcn_sched_barrier(0)
    Unit cur, nxt; int ui = 0;
    if (!S.next(0, cur)) return;
    f32x4 acc[2][2][4][2];
#pragma unroll
    for (int a = 0; a < 2; ++a)
#pragma unroll
        for (int b = 0; b < 2; ++b)
#pragma unroll
            for (int m = 0; m < 4; ++m)
#pragma unroll
                for (int n = 0; n < 2; ++n) acc[a][b][m][n] = (f32x4){0.f, 0.f, 0.f, 0.f};
    bf16x8 At[4][2], B0[2][2], B1[2][2];
    const char* Ab = (const char*)A;
    const char* cB = (const char*)Bt + (size_t)cur.bt * tstep;
    unsigned c00 = S.arow(cur, R0) * rowb + cofs, c01 = S.arow(cur, R0 + 64) * rowb + cofs, c10 = S.arow(cur, HALF + R0) * rowb + cofs, c11 = S.arow(cur, HALF + R0 + 64) * rowb + cofs;
    unsigned n00, n01, n10, n11;
    PG8_STAGE(PG8_SB(0, 0), cB, voffB); PG8_STAGE(PG8_SB(0, 1), cB + hstep, voffB); PG8_STAGE_A(PG8_SA(0, 0), Ab, c00, c01); PG8_STAGE_A(PG8_SA(0, 1), Ab, c10, c11);
    if (wr == 1) PG8_BAR;
    PG8_WAIT_V(2); PG8_BAR;
    PG8_STAGE(PG8_SB(1, 0), cB + kstep, voffB); PG8_STAGE_A(PG8_SA(1, 0), Ab + kstep, c00, c01); PG8_STAGE(PG8_SB(1, 1), cB + hstep + kstep, voffB);
    PG8_WAIT_V(6); PG8_BAR;
    for (;;) {
        const bool has_next = S.next(ui + 1, nxt);
        const char* nB = has_next ? (const char*)Bt + (size_t)nxt.bt * tstep : cB;
        if (has_next) { n00 = S.arow(nxt, R0) * rowb + cofs; n01 = S.arow(nxt, R0 + 64) * rowb + cofs; n10 = S.arow(nxt, HALF + R0) * rowb + cofs; n11 = S.arow(nxt, HALF + R0 + 64) * rowb + cofs; }
        else { n00 = c00; n01 = c01; n10 = c10; n11 = c11; }
        for (int t = 0; t < nt; t += 2) {
            const bool last = (t == nt - 2);
            const char* a1 = Ab + (size_t)(t + 1) * kstep;
            const char* a2 = last ? Ab : Ab + (size_t)(t + 2) * kstep; const char* b2 = last ? nB : cB + (size_t)(t + 2) * kstep;
            const char* a3 = a2 + kstep; const char* b3 = b2 + kstep;
            const unsigned x00 = last ? n00 : c00, x01 = last ? n01 : c01, x10 = last ? n10 : c10, x11 = last ? n11 : c11;
            PG8_LDB(B0, 0, 0); PG8_LDB(B1, 0, 1); PG8_SCHED; PG8_LDA(At, 0, 0); PG8_STAGE_A(PG8_SA(1, 1), a1, c10, c11);
            PG8_WAIT_V(8); PG8_WAIT_L(0); PG8_BAR; PG8_MMA(0, 0, At, B0); PG8_MMA(0, 1, At, B1); PG8_BAR; PG8_SCHED;
            PG8_LDA(At, 0, 1); PG8_STAGE(PG8_SB(0, 0), b2, voffB); PG8_STAGE(PG8_SB(0, 1), b2 + hstep, voffB); PG8_STAGE_A(PG8_SA(0, 0), a2, x00, x01);
            PG8_WAIT_V(8); PG8_WAIT_L(0); PG8_BAR; PG8_MMA(1, 0, At, B0); PG8_MMA(1, 1, At, B1); PG8_BAR; PG8_SCHED;
            PG8_LDB(B0, 1, 0); PG8_LDB(B1, 1, 1); PG8_SCHED; PG8_LDA(At, 1, 0); PG8_STAGE_A(PG8_SA(0, 1), a2, x10, x11);
            PG8_WAIT_V(8); PG8_WAIT_L(0); PG8_BAR; PG8_MMA(0, 0, At, B0); PG8_MMA(0, 1, At, B1); PG8_BAR; PG8_SCHED;
            PG8_LDA(At, 1, 1); PG8_STAGE(PG8_SB(1, 0), b3, voffB); PG8_STAGE(PG8_SB(1, 1), b3 + hstep, voffB); PG8_STAGE_A(PG8_SA(1, 0), a3, x00, x01);
            PG8_WAIT_V(8); PG8_WAIT_L(0); PG8_BAR; PG8_MMA(1, 0, At, B0); PG8_MMA(1, 1, At, B1); PG8_BAR; PG8_SCHED;
        }
        if (wr == 0) PG8_BAR;
        E(acc, cur, wr, wc, fr, fq);
        if (!has_next) break;
#pragma unroll
        for (int a = 0; a < 2; ++a)
#pragma unroll
            for (int b = 0; b < 2; ++b)
#pragma unroll
                for (int m = 0; m < 4; ++m)
#pragma unroll
                    for (int n = 0; n < 2; ++n) acc[a][b][m][n] = (f32x4){0.f, 0.f, 0.f, 0.f};
        cur = nxt; cB = nB; c00 = n00; c01 = n01; c10 = n10; c11 = n11; ++ui;
        if (wr == 1) PG8_BAR;
    }
    PG8_WAIT_V(0);
    PG8_BAR;
#undef PG8_SA
#undef PG8_SB
#undef PG8_STAGE
#undef PG8_STAGE_A
#undef PG8_LDA
#undef PG8_LDB
#undef PG8_MMA
#undef PG8_WAIT_V
#undef PG8_WAIT_L
#undef PG8_BAR
#undef PG8_SCHED
}
}
typedef f32x4 Acc[2][2][4][2];

#define XB_TMO      128
#define XB_XCNT(j)  (256  + 64 * (j))
#define XB_XSUB(j)  (1280 + 64 * (j))
#define XB_XGEN(j)  (2304 + 64 * (j))
#define XB_TOP      3328
#define XB_TOPGEN   3392
#define XCD_BAR_WORDS 3456
#define XB_SPIN_CAP (1u << 22)
__device__ __forceinline__ unsigned xb_ld(unsigned* p)              { return __hip_atomic_load(p, __ATOMIC_RELAXED, __HIP_MEMORY_SCOPE_AGENT); }
__device__ __forceinline__ unsigned xb_add(unsigned* p, unsigned v) { return __hip_atomic_fetch_add(p, v, __ATOMIC_RELAXED, __HIP_MEMORY_SCOPE_AGENT); }
__device__ __forceinline__ unsigned xb_xcc_id() { return (unsigned)__builtin_amdgcn_s_getreg((3 << 11) | 20) & 0xFu; }
#define XB_SPIN(cond, bar) do { unsigned _sp = 0; while (cond) { __builtin_amdgcn_s_sleep(1); \
    if ((++_sp & 255u) == 0u) { if (xb_ld(&(bar)[XB_TMO])) break; if (_sp > XB_SPIN_CAP) { atomicAdd(&(bar)[XB_TMO], 1u); break; } } } } while (0)
struct XcdBarrier { unsigned* bar; unsigned x; volatile LAS unsigned* st; };
__device__ __forceinline__ XcdBarrier xcd_barrier_post(unsigned* bar, volatile LAS unsigned* st) {
    XcdBarrier b; b.bar = bar; b.x = xb_xcc_id(); b.st = st;
    if (threadIdx.x == 0) (void)xb_add(&bar[XB_XCNT(b.x)], 1u);
    return b;
}
__device__ __forceinline__ void xcd_barrier_complete(unsigned* bar, unsigned x, unsigned& nloc, unsigned& nx) {
    const unsigned G = gridDim.x * gridDim.y * gridDim.z;
    unsigned sum, cnt, mine, sp = 0u;
    for (;;) {
        sum = 0u; cnt = 0u; mine = 0u;
#pragma unroll
        for (unsigned j = 0; j < 16; ++j) { const unsigned c = xb_ld(&bar[XB_XCNT(j)]); sum += c; cnt += (c > 0u) ? 1u : 0u; mine = (j == x) ? c : mine; }
        if (sum == G) break;
        __builtin_amdgcn_s_sleep(1);
        if ((++sp & 255u) == 0u) { if (xb_ld(&bar[XB_TMO])) break; if (sp > XB_SPIN_CAP) { atomicAdd(&bar[XB_TMO], 1u); break; } }
    }
    nloc = mine > 0u ? mine : 1u; nx = cnt > 0u ? cnt : 1u;
}
__device__ __forceinline__ void xcd_barrier(const XcdBarrier& b) {
    asm volatile("s_waitcnt vmcnt(0)" ::: "memory");
    __syncthreads();
    if (threadIdx.x == 0) {
        unsigned* bar = b.bar;
        __builtin_amdgcn_s_waitcnt(0);
        unsigned nloc = b.st[0], nx = b.st[1];
        if (nloc == 0u) { xcd_barrier_complete(bar, b.x, nloc, nx); b.st[0] = nloc; b.st[1] = nx; }
        const unsigned old = xb_add(&bar[XB_XSUB(b.x)], 1u);
        const unsigned gen = old / nloc;
        if (old + 1u == (gen + 1u) * nloc) {
            __builtin_amdgcn_fence(__ATOMIC_RELEASE, "agent");
            asm volatile("s_waitcnt vmcnt(0)" ::: "memory");
            const unsigned og = xb_add(&bar[XB_TOP], 1u);
            const unsigned tg = og / nx;
            if (og + 1u == (tg + 1u) * nx) xb_add(&bar[XB_TOPGEN], 1u);
            else XB_SPIN(xb_ld(&bar[XB_TOPGEN]) == tg, bar);
            __builtin_amdgcn_fence(__ATOMIC_ACQUIRE, "agent");
            xb_add(&bar[XB_XGEN(b.x)], 1u);
            asm volatile("s_waitcnt vmcnt(0)" ::: "memory");
        } else {
            XB_SPIN(xb_ld(&bar[XB_XGEN(b.x)]) == gen, bar);
            __builtin_amdgcn_fence(__ATOMIC_ACQUIRE, "agent");
            asm volatile("s_waitcnt vmcnt(0)" ::: "memory");
        }
    }
    __syncthreads();
}

__device__ __forceinline__ void tr_item(const float* W, int ldw, int col0, bf16* WT, int dstrow0, int k0, LAS float* scr, int lane) {
#pragma unroll 8
    for (int i = 0; i < 32; ++i) { const int kk = 2 * i + (lane >> 5); scr[kk * 33 + (lane & 31)] = W[(size_t)(k0 + kk) * ldw + col0 + (lane & 31)]; }
    LDS_WAIT(); asm volatile("" ::: "memory");
    const int c = lane & 7;
#pragma unroll
    for (int j = 0; j < 4; ++j) { const int n = (lane >> 3) + 8 * j; const LAS float* s = scr + (8 * c) * 33 + n;
        v4u o; o.x = pk2(s[0 * 33], s[1 * 33]); o.y = pk2(s[2 * 33], s[3 * 33]); o.z = pk2(s[4 * 33], s[5 * 33]); o.w = pk2(s[6 * 33], s[7 * 33]);
        *(v4u*)(WT + (size_t)(dstrow0 + n) * D + k0 + 8 * c) = o; }
    LDS_WAIT(); asm volatile("" ::: "memory");
}
__device__ __forceinline__ void phase_prologue(const P& p, LAS unsigned char* lds) {
    const int tid = threadIdx.x, lane = tid & 63, wave = tid >> 6;
    LAS float* scr = (LAS float*)(lds + wave * 8448);
    const int gw = blockIdx.x * NWAVES + wave, NGW = gridDim.x * NWAVES;
    bf16* bt_s = (bf16*)(p.ws + WS_BT_S); bf16* bt_g = (bf16*)(p.ws + WS_BT_G);
    constexpr int I_S = 162 * 16, I_G = 128 * 16, I_O = 32 * 16;
    for (int it = gw; it < I_S + I_G + 3 * I_O; it += NGW) {
        int r = it;
        if (r < I_S) { const int nb = r >> 4, kb = r & 15; const int col0 = nb < 96 ? 32 * nb : (nb < 160 ? 4128 + 32 * (nb - 96) : (nb == 160 ? 4096 : 7200));
            tr_item(p.w_in, D_IN, col0, bt_s, 32 * nb, 64 * kb, scr, lane); continue; } r -= I_S;
        if (r < I_G) { const int nb = r >> 4, kb = r & 15; const int col0 = nb < 32 ? 3072 + 32 * nb : (nb < 64 ? 6176 + 32 * (nb - 32) : 7232 + 32 * (nb - 64));
            tr_item(p.w_in, D_IN, col0, bt_g, 32 * nb, 64 * kb, scr, lane); continue; } r -= I_G;
        const int which = r / I_O; r -= which * I_O; const int nb = r >> 4, kb = r & 15;
        const float* W = which == 0 ? p.w_out_a : (which == 1 ? p.w_out_b : p.w_out);
        bf16* WT = (bf16*)(p.ws + (which == 0 ? WS_BT_OA : (which == 1 ? WS_BT_OB : WS_BT_O)));
        tr_item(W, D, 32 * nb, WT, 32 * nb, 64 * kb, scr, lane);
    }
    { const size_t n16 = (size_t)192 * D * 2 / 16; v4u* z = (v4u*)(bt_s + (size_t)5184 * D);
      for (size_t i = (size_t)blockIdx.x * NTHREADS + tid; i < n16; i += (size_t)gridDim.x * NTHREADS) z[i] = (v4u){0u, 0u, 0u, 0u}; }
    __syncthreads();
    LAS float* sc = (LAS float*)lds;
    LAS float* red = (LAS float*)(lds + 17 * 1024 * 4);
    float* modv = (float*)(p.ws + WS_MODV);
    bool have = false;
    for (int u = blockIdx.x; u < NMOD / 64; u += gridDim.x) {
        if (!have) { for (int i = tid; i < 17 * 1024; i += NTHREADS) { const float v = i < 16 * 1024 ? p.c[i] : p.c_ctx[i - 16 * 1024]; sc[i] = siluf_(v); } have = true; __syncthreads(); }
        float acc[17];
#pragma unroll
        for (int b = 0; b < 17; ++b) acc[b] = 0.f;
        const int n = u * 64 + lane;
        for (int k = wave * 128; k < wave * 128 + 128; ++k) { const float wv = p.w_mod[(size_t)k * NMOD + n];
#pragma unroll
            for (int b = 0; b < 17; ++b) acc[b] += sc[b * 1024 + k] * wv; }
#pragma unroll
        for (int b = 0; b < 17; ++b) red[(wave * 17 + b) * 64 + lane] = acc[b];
        __syncthreads();
        for (int i = tid; i < 17 * 64; i += NTHREADS) { const int b = i >> 6, l = i & 63; float s = p.b_mod[u * 64 + l];
#pragma unroll
            for (int w = 0; w < 8; ++w) s += red[(w * 17 + b) * 64 + l];
            modv[b * NMOD + u * 64 + l] = s; }
        __syncthreads();
    }
}

__device__ __forceinline__ void phase_norm1(const P& p) {
    const int tid = threadIdx.x, lane = tid & 63, wave = tid >> 6;
    const int gw = blockIdx.x * NWAVES + wave, NGW = gridDim.x * NWAVES;
    const float* modv = (const float*)(p.ws + WS_MODV); bf16* h = (bf16*)(p.ws + WS_H);
    for (int r = gw; r < TT; r += NGW) {
        const float* src; int b;
        if (r < T) { src = p.x + (size_t)r * D; b = r >> 12; } else { src = p.ctx + (size_t)(r - T) * D; b = 16; }
        const f32x4* xr = (const f32x4*)src + lane;
        f32x4 v[4]; float s = 0.f;
#pragma unroll
        for (int j = 0; j < 4; ++j) { v[j] = xr[64 * j]; s += (v[j].x * v[j].x + v[j].y * v[j].y) + (v[j].z * v[j].z + v[j].w * v[j].w); }
        const float rstd = 1.0f / sqrtf(wave_sum(s) * (1.f / D) + EPS);
        const f32x4* g = (const f32x4*)p.norm_mix_g + lane; const f32x4* sh = (const f32x4*)(modv + b * NMOD) + lane; const f32x4* scl = (const f32x4*)(modv + b * NMOD + D) + lane;
        v2u* o8 = (v2u*)(h + (size_t)r * D) + lane;
#pragma unroll
        for (int j = 0; j < 4; ++j) { const f32x4 gg = g[64 * j], s1 = sh[64 * j], s2 = scl[64 * j]; const f32x4 o = v[j] * rstd * gg * (1.0f + s2) + s1;
            v2u w; w.x = pk2(o.x, o.y); w.y = pk2(o.z, o.w); o8[64 * j] = w; }
    }
}

struct EpiG1 {
    bf16* qkva; bf16* pb; float* small;
    __device__ __forceinline__ void operator()(const Acc& acc, const pg8::Unit& u, int wr, int wc, int fr, int fq) const {
        const int row0 = u.pm * 256 + wr * 64 + fr, cb = wc * 32 + 8 * fq;
#pragma unroll
        for (int ai = 0; ai < 2; ++ai)
#pragma unroll
            for (int m = 0; m < 4; ++m) { const size_t row = (size_t)(row0 + ai * 128 + m * 16);
#pragma unroll
                for (int bj = 0; bj < 2; ++bj) { const int c = bj * 128 + cb; const f32x4 v0 = acc[ai][bj][m][0], v1 = acc[ai][bj][m][1];
                    if (u.pn < 20) { v4u w; w.x = pk2(v0[0], v0[1]); w.y = pk2(v0[2], v0[3]); w.z = pk2(v1[0], v1[1]); w.w = pk2(v1[2], v1[3]);
                        if (u.pn < 12) *(v4u*)(qkva + row * 3072 + u.pn * 256 + c) = w; else *(v4u*)(pb + row * 2048 + (u.pn - 12) * 256 + c) = w; }
                    else if (c < 64) { *(f32x4*)(small + row * 64 + c) = v0; *(f32x4*)(small + row * 64 + c + 4) = v1; } } }
    }
};
struct EpiG2 {
    const bf16* on; bf16* ya; bf16* yb; bf16* gates;
    __device__ __forceinline__ void operator()(const Acc& acc, const pg8::Unit& u, int wr, int wc, int fr, int fq) const {
        const int row0 = u.pm * 256 + wr * 64 + fr, cb = wc * 32 + 8 * fq;
#pragma unroll
        for (int ai = 0; ai < 2; ++ai)
#pragma unroll
            for (int m = 0; m < 4; ++m) { const size_t row = (size_t)(row0 + ai * 128 + m * 16);
#pragma unroll
                for (int bj = 0; bj < 2; ++bj) { const int c = bj * 128 + cb; float v[8];
#pragma unroll
                    for (int j = 0; j < 4; ++j) { v[j] = acc[ai][bj][m][0][j]; v[4 + j] = acc[ai][bj][m][1][j]; }
                    if (u.pn < 8) { const v4u ow = *(const v4u*)(on + row * 2048 + u.pn * 256 + c); float o[8]; unpack8(ow, o);
#pragma unroll
                        for (int j = 0; j < 8; ++j) v[j] = o[j] * siluf_(v[j]);
                        bf16* dst = u.pn < 4 ? ya + row * 1024 + u.pn * 256 + c : yb + row * 1024 + (u.pn - 4) * 256 + c;
                        *(v4u*)dst = pack8(v); }
                    else {
#pragma unroll
                        for (int j = 0; j < 8; ++j) v[j] = sigmoidf_(v[j]);
                        *(v4u*)(gates + row * 2048 + (u.pn - 8) * 256 + c) = pack8(v); } } }
    }
};
template <int WHICH> struct EpiG34 {
    const bf16* gates; bf16* y;
    __device__ __forceinline__ void operator()(const Acc& acc, const pg8::Unit& u, int wr, int wc, int fr, int fq) const {
        const int row0 = u.pm * 256 + wr * 64 + fr, cb = wc * 32 + 8 * fq;
#pragma unroll
        for (int ai = 0; ai < 2; ++ai)
#pragma unroll
            for (int m = 0; m < 4; ++m) { const size_t row = (size_t)(row0 + ai * 128 + m * 16);
#pragma unroll
                for (int bj = 0; bj < 2; ++bj) { const int c = u.pn * 256 + bj * 128 + cb; float v[8], g[8];
#pragma unroll
                    for (int j = 0; j < 4; ++j) { v[j] = acc[ai][bj][m][0][j]; v[4 + j] = acc[ai][bj][m][1][j]; }
                    unpack8(*(const v4u*)(gates + row * 2048 + WHICH * 1024 + c), g);
                    if (WHICH == 0) {
#pragma unroll
                        for (int j = 0; j < 8; ++j) v[j] = g[j] * v[j];
                    } else { float o[8]; unpack8(*(const v4u*)(y + row * 1024 + c), o);
#pragma unroll
                        for (int j = 0; j < 8; ++j) v[j] = o[j] + g[j] * v[j]; }
                    *(v4u*)(y + row * 1024 + c) = pack8(v); } }
    }
};
struct EpiG5 {
    const float* x; const float* modv; float* out;
    __device__ __forceinline__ void operator()(const Acc& acc, const pg8::Unit& u, int wr, int wc, int fr, int fq) const {
        const int row0 = u.pm * 256 + wr * 64 + fr, cb = wc * 32 + 8 * fq;
        const float* g1 = modv + (u.pm >> 4) * NMOD + 2 * D;
#pragma unroll
        for (int ai = 0; ai < 2; ++ai)
#pragma unroll
            for (int m = 0; m < 4; ++m) { const size_t row = (size_t)(row0 + ai * 128 + m * 16);
#pragma unroll
                for (int bj = 0; bj < 2; ++bj) { const int c = u.pn * 256 + bj * 128 + cb;
#pragma unroll
                    for (int n = 0; n < 2; ++n) { const f32x4 xv = *(const f32x4*)(x + row * D + c + 4 * n), gv = *(const f32x4*)(g1 + c + 4 * n);
                        *(f32x4*)(out + row * D + c + 4 * n) = xv + gv * acc[ai][bj][m][n]; } } }
    }
};
struct EpiGU {
    const float* b_gu; bf16* act;
    __device__ __forceinline__ void operator()(const Acc& acc, const pg8::Unit& u, int wr, int wc, int fr, int fq) const {
        const int row0 = u.pm * 256 + wr * 64 + fr, cb = wc * 32 + 8 * fq; const int e = u.bt >> 3;
        const float* bg = b_gu + (size_t)e * 2048 + u.pn * 128 + cb; const float* bl = bg + 1024;
        float bgv[8], blv[8];
#pragma unroll
        for (int j = 0; j < 8; ++j) { bgv[j] = bg[j]; blv[j] = bl[j]; }
#pragma unroll
        for (int ai = 0; ai < 2; ++ai)
#pragma unroll
            for (int m = 0; m < 4; ++m) { const size_t row = (size_t)(row0 + ai * 128 + m * 16); float v[8];
#pragma unroll
                for (int j = 0; j < 8; ++j) { const float gl = fminf(acc[ai][0][m][j >> 2][j & 3] + bgv[j], 7.0f); const float ln = fminf(fmaxf(acc[ai][1][m][j >> 2][j & 3] + blv[j], -7.0f), 7.0f);
                    v[j] = gl * sigmoidf_(1.702f * gl) * (ln + 1.0f); }
                *(v4u*)(act + row * 1024 + u.pn * 128 + cb) = pack8(v); }
    }
};
struct EpiDN {
    const float* b_down; const float* slot_p; bf16* ys;
    __device__ __forceinline__ void operator()(const Acc& acc, const pg8::Unit& u, int wr, int wc, int fr, int fq) const {
        const int row0 = u.pm * 256 + wr * 64 + fr, cb = wc * 32 + 8 * fq; const int e = u.bt >> 2;
#pragma unroll
        for (int bj = 0; bj < 2; ++bj) { const int c = u.pn * 256 + bj * 128 + cb; float bv[8];
#pragma unroll
            for (int j = 0; j < 8; ++j) bv[j] = b_down[(size_t)e * 1024 + c + j];
#pragma unroll
            for (int ai = 0; ai < 2; ++ai)
#pragma unroll
                for (int m = 0; m < 4; ++m) { const size_t row = (size_t)(row0 + ai * 128 + m * 16); const float pr = slot_p[row]; float v[8];
#pragma unroll
                    for (int j = 0; j < 8; ++j) v[j] = (acc[ai][bj][m][j >> 2][j & 3] + bv[j]) * pr;
                    *(v4u*)(ys + row * 1024 + c) = pack8(v); } }
    }
};

__device__ __forceinline__ void phase_conv(const P& p, LAS unsigned char* lds) {
    const int tid = threadIdx.x;
    bf16* qkva = (bf16*)(p.ws + WS_QKVA);
    LAS unsigned char* rowbuf = lds;
    LAS unsigned char* cbuf = lds + 3 * 16896;
    const int cg = tid & 15, c0 = tid >> 4;
    for (int u = blockIdx.x; u < NB * 24; u += gridDim.x) {
        const int b = u / 24, s = u % 24;
        float w[9][8];
#pragma unroll
        for (int k = 0; k < 9; ++k)
#pragma unroll
            for (int e = 0; e < 8; ++e) w[k][e] = p.conv_w[k * 3072 + s * 128 + cg * 8 + e];
        const bool donorm = s < 16;
        if (tid < 96) { const int bi = tid / 32, r = tid % 32; *(LAS v4u*)(rowbuf + bi * 16896 + ((r >> 4) ? 65 : 0) * 256 + (r & 15) * 16) = (v4u){0u, 0u, 0u, 0u}; }
        if (tid >= 128 && tid < 160) { const int r = tid - 128; *(LAS v4u*)(cbuf + ((r >> 4) ? 257 : 0) * 256 + (r & 15) * 16) = (v4u){0u, 0u, 0u, 0u}; }
        { bf16* base = qkva + (size_t)(T + b * CTXL) * 3072 + s * 128 + cg * 8;
#pragma unroll
          for (int jj = 0; jj < 8; ++jj) { const int t = c0 + 32 * jj; *(LAS v4u*)(cbuf + (t + 1) * 256 + cg * 16) = *(const v4u*)(base + (size_t)t * 3072); }
          __syncthreads();
#pragma unroll
          for (int jj = 0; jj < 8; ++jj) { const int t = c0 + 32 * jj; float a[8];
#pragma unroll
              for (int e = 0; e < 8; ++e) a[e] = 0.f;
#pragma unroll
              for (int kw = 0; kw < 3; ++kw) { float f[8]; unpack8(*(const LAS v4u*)(cbuf + (t + kw) * 256 + cg * 16), f);
#pragma unroll
                  for (int e = 0; e < 8; ++e) a[e] += f[e] * w[3 + kw][e]; }
              float ss = 0.f;
#pragma unroll
              for (int e = 0; e < 8; ++e) { a[e] = siluf_(a[e]); ss += a[e] * a[e]; }
              if (donorm) { ss += __shfl_xor(ss, 1); ss += __shfl_xor(ss, 2); ss += __shfl_xor(ss, 4); ss += __shfl_xor(ss, 8); const float sc = 1.0f / sqrtf(ss + EPS);
#pragma unroll
                  for (int e = 0; e < 8; ++e) a[e] *= sc; }
              *(v4u*)(base + (size_t)t * 3072) = pack8(a); }
        }
        bf16* base = qkva + (size_t)(b * SEQ) * 3072 + s * 128 + cg * 8;
#pragma unroll
        for (int rr = 0; rr < 2; ++rr)
#pragma unroll
            for (int jj = 0; jj < 2; ++jj) { const int c = c0 + 32 * jj; *(LAS v4u*)(rowbuf + rr * 16896 + (c + 1) * 256 + cg * 16) = *(const v4u*)(base + (size_t)(rr * 64 + c) * 3072); }
        __syncthreads();
        for (int r = 0; r < 64; ++r) {
            v4u pre[2];
            if (r + 2 < 64) {
#pragma unroll
                for (int jj = 0; jj < 2; ++jj) pre[jj] = *(const v4u*)(base + (size_t)((r + 2) * 64 + c0 + 32 * jj) * 3072);
            }
#pragma unroll
            for (int jj = 0; jj < 2; ++jj) { const int c = c0 + 32 * jj; float a[8];
#pragma unroll
                for (int e = 0; e < 8; ++e) a[e] = 0.f;
#pragma unroll
                for (int kh = 0; kh < 3; ++kh) { const int rr = r + kh - 1; if (rr < 0 || rr > 63) continue; LAS unsigned char* rb = rowbuf + (rr % 3) * 16896;
#pragma unroll
                    for (int kw = 0; kw < 3; ++kw) { float f[8]; unpack8(*(const LAS v4u*)(rb + (c + kw) * 256 + cg * 16), f);
#pragma unroll
                        for (int e = 0; e < 8; ++e) a[e] += f[e] * w[kh * 3 + kw][e]; } }
                float ss = 0.f;
#pragma unroll
                for (int e = 0; e < 8; ++e) { a[e] = siluf_(a[e]); ss += a[e] * a[e]; }
                if (donorm) { ss += __shfl_xor(ss, 1); ss += __shfl_xor(ss, 2); ss += __shfl_xor(ss, 4); ss += __shfl_xor(ss, 8); const float sc = 1.0f / sqrtf(ss + EPS);
#pragma unroll
                    for (int e = 0; e < 8; ++e) a[e] *= sc; }
                *(v4u*)(base + (size_t)(r * 64 + c) * 3072) = pack8(a); }
            __syncthreads();
            if (r + 2 < 64) {
#pragma unroll
                for (int jj = 0; jj < 2; ++jj) *(LAS v4u*)(rowbuf + ((r + 2) % 3) * 16896 + (c0 + 32 * jj + 1) * 256 + cg * 16) = pre[jj];
            }
            __syncthreads();
        }
    }
}

template <bool GLA>
__device__ __forceinline__ void scan_unit(const P& p, LAS unsigned char* lds, int b, int h, int vh) {
    const int tid = threadIdx.x, j = tid >> 2, part = tid & 3;
    LAS float* qf = (LAS float*)lds; LAS float* kf = qf + 32 * 144; LAS float* af = kf + 32 * 144; LAS float* vf = af + 32 * 144; LAS float* ob = vf + 32 * 128;
    LAS float* sa = ob + 32 * 128; LAS float* sb = sa + 32;
    const bf16* qkva = (const bf16*)(p.ws + WS_QKVA); const bf16* pbuf = (const bf16*)(p.ws + WS_PB); const float* small = (const float*)(p.ws + WS_SMALL);
    bf16* on = (bf16*)p.out;
    const int lt = tid >> 4, piece = tid & 15;
    const float scale = 0.08838834764831845f;
    for (int dir = 0; dir < 2; ++dir) {
        float S[32];
#pragma unroll
        for (int i = 0; i < 32; ++i) S[i] = 0.f;
        float wcol[16]; float gbias = 0.f, alog = 0.f, dtb = 0.f;
        if (GLA) { const float* gw = dir ? p.gla_gate_w_b : p.gla_gate_w_f; const int i = tid & 127;
#pragma unroll
            for (int r = 0; r < 16; ++r) wcol[r] = gw[r * 512 + h * 128 + i];
            gbias = (dir ? p.gla_gate_b_b : p.gla_gate_b_f)[h * 128 + i]; }
        else { alog = __expf((dir ? p.a_log_b : p.a_log_f)[h]); dtb = (dir ? p.dt_bias_b : p.dt_bias_f)[h]; }
        for (int s = 0; s < 136; ++s) {
            const bool is_ctx = s < 8;
            const int sci = is_ctx ? (dir ? 7 - s : s) : (dir ? 127 - (s - 8) : s - 8);
            const size_t row0 = is_ctx ? (size_t)(T + b * CTXL + sci * 32) : (size_t)(b * SEQ + sci * 32);
            __syncthreads();
            { v4u qw, kw, vw;
              if (GLA) { const bf16* r = pbuf + (row0 + lt) * 2048; qw = *(const v4u*)(r + h * 128 + piece * 8); kw = *(const v4u*)(r + 512 + h * 128 + piece * 8); vw = *(const v4u*)(r + 1024 + h * 256 + vh * 128 + piece * 8); }
              else { const bf16* r = qkva + (row0 + lt) * 3072; qw = *(const v4u*)(r + h * 128 + piece * 8); kw = *(const v4u*)(r + 1024 + h * 128 + piece * 8); vw = *(const v4u*)(r + 2048 + h * 128 + piece * 8); }
              float f[8]; const int o = lt * 144 + (piece >> 2) * 36 + (piece & 3) * 8;
              unpack8(qw, f);
#pragma unroll
              for (int e = 0; e < 8; ++e) qf[o + e] = f[e] * scale;
              unpack8(kw, f);
#pragma unroll
              for (int e = 0; e < 8; ++e) kf[o + e] = f[e];
              unpack8(vw, f);
#pragma unroll
              for (int e = 0; e < 8; ++e) vf[lt * 128 + piece * 8 + e] = f[e]; }
            if (GLA) { const int i = tid & 127, tq = tid >> 7;
#pragma unroll
                for (int tt = 0; tt < 8; ++tt) { const int t = tq * 8 + tt; const float* z = small + (row0 + t) * 64 + 32 + dir * 16; float u = gbias;
#pragma unroll
                    for (int r = 0; r < 16; ++r) u += z[r] * wcol[r];
                    const float ls = fminf(u, 0.f) - log1pf(__expf(-fabsf(u)));
                    af[t * 144 + (i >> 5) * 36 + (i & 31)] = __expf(ls * (1.0f / 16.0f)); } }
            else if (tid < 32) { const float* sm = small + (row0 + tid) * 64; sb[tid] = sigmoidf_(sm[dir * 8 + h]); sa[tid] = __expf(-alog * softplusf_(sm[16 + dir * 8 + h] + dtb)); }
            __syncthreads();
            for (int tt = 0; tt < 32; ++tt) { const int t = dir ? 31 - tt : tt;
                const LAS float* kp = kf + t * 144 + part * 36; const LAS float* qp = qf + t * 144 + part * 36;
                float kk[32], qq[32];
#pragma unroll
                for (int i = 0; i < 32; i += 4) { const f32x4 a = *(const LAS f32x4*)(kp + i); kk[i] = a.x; kk[i + 1] = a.y; kk[i + 2] = a.z; kk[i + 3] = a.w;
                    const f32x4 q4 = *(const LAS f32x4*)(qp + i); qq[i] = q4.x; qq[i + 1] = q4.y; qq[i + 2] = q4.z; qq[i + 3] = q4.w; }
                const float vj = vf[t * 128 + j];
                float os = 0.f;
                if (GLA) { const LAS float* ap = af + t * 144 + part * 36;
#pragma unroll
                    for (int i = 0; i < 32; i += 4) { const f32x4 a = *(const LAS f32x4*)(ap + i);
                        S[i] = a.x * S[i] + kk[i] * vj; S[i + 1] = a.y * S[i + 1] + kk[i + 1] * vj; S[i + 2] = a.z * S[i + 2] + kk[i + 2] * vj; S[i + 3] = a.w * S[i + 3] + kk[i + 3] * vj; }
                } else { const float a = sa[t], be = sb[t]; float ks = 0.f;
#pragma unroll
                    for (int i = 0; i < 32; ++i) ks += kk[i] * S[i];
                    ks += __shfl_xor(ks, 1); ks += __shfl_xor(ks, 2);
                    const float vn = be * (vj - a * ks);
#pragma unroll
                    for (int i = 0; i < 32; ++i) S[i] = a * S[i] + kk[i] * vn; }
                if (!is_ctx) {
#pragma unroll
                    for (int i = 0; i < 32; ++i) os += qq[i] * S[i];
                    os += __shfl_xor(os, 1); os += __shfl_xor(os, 2);
                    if (part == 0) ob[t * 128 + j] = os; }
            }
            if (!is_ctx) { __syncthreads();
                bf16* dst = on + (row0 + lt) * 2048 + (GLA ? 1024 + h * 256 + vh * 128 : h * 128) + piece * 8; float f[8];
#pragma unroll
                for (int e = 0; e < 8; ++e) f[e] = ob[lt * 128 + piece * 8 + e];
                if (dir) { float g[8]; unpack8(*(const v4u*)dst, g);
#pragma unroll
                    for (int e = 0; e < 8; ++e) f[e] += g[e]; }
                *(v4u*)dst = pack8(f); }
        }
    }
}
__device__ __forceinline__ void phase_scan(const P& p, LAS unsigned char* lds) {
    for (int u = blockIdx.x; u < 256; u += gridDim.x) {
        if (u < 128) scan_unit<false>(p, lds, u >> 3, u & 7, 0);
        else { const int v = u - 128; scan_unit<true>(p, lds, v >> 3, (v >> 1) & 3, v & 1); }
        __syncthreads();
    }
}

__device__ __forceinline__ void phase_onorm(const P& p) {
    const int tid = threadIdx.x, lane = tid & 63, wave = tid >> 6;
    const int gw = blockIdx.x * NWAVES + wave, NGW = gridDim.x * NWAVES;
    bf16* on = (bf16*)p.out;
    const float* gp = lane < 32 ? p.gdn_norm_g + (lane & 3) * 32 : p.gla_norm_g + ((lane - 32) & 7) * 32;
    float g[32];
#pragma unroll
    for (int i = 0; i < 32; ++i) g[i] = gp[i];
    for (int r = gw; r < T; r += NGW) {
        v4u* ptr = (v4u*)(on + (size_t)r * 2048 + lane * 32); float f[32]; float ss = 0.f;
#pragma unroll
        for (int q = 0; q < 4; ++q) { float t8[8]; unpack8(ptr[q], t8);
#pragma unroll
            for (int e = 0; e < 8; ++e) { f[q * 8 + e] = t8[e]; ss += t8[e] * t8[e]; } }
        ss += __shfl_xor(ss, 1); ss += __shfl_xor(ss, 2);
        const float s4 = __shfl_xor(ss, 4);
        const float rstd = lane < 32 ? 1.0f / sqrtf(ss * (1.f / 128.f) + EPS) : 1.0f / sqrtf((ss + s4) * (1.f / 256.f) + EPS);
#pragma unroll
        for (int q = 0; q < 4; ++q) { float t8[8];
#pragma unroll
            for (int e = 0; e < 8; ++e) t8[e] = f[q * 8 + e] * rstd * g[q * 8 + e];
            ptr[q] = pack8(t8); }
    }
}

__device__ __forceinline__ void phase_wconv(const P& p, LAS unsigned char* lds) {
    const int tid = threadIdx.x, lane = tid & 63, wave = tid >> 6;
    LAS float* scr = (LAS float*)(lds + wave * 8448);
    const int gw = blockIdx.x * NWAVES + wave, NGW = gridDim.x * NWAVES;
    bf16* wgu = (bf16*)(p.ws + WS_WB_GU); bf16* wdn = (bf16*)(p.ws + WS_WB_DN);
    constexpr int I_GU = NE * 64 * 16, I_DN = NE * 32 * 16;
    for (int it = gw; it < I_GU + I_DN; it += NGW) {
        if (it < I_GU) { const int e = it >> 10, r = it & 1023, nb = r >> 4, kb = r & 15;
            const int dstrow = nb < 32 ? (nb >> 2) * 256 + (nb & 3) * 32 : ((nb - 32) >> 2) * 256 + 128 + ((nb - 32) & 3) * 32;
            tr_item(p.w_gu + (size_t)e * D * 2048, 2048, 32 * nb, wgu + (size_t)e * 2048 * D, dstrow, 64 * kb, scr, lane); }
        else { const int r2 = it - I_GU; const int e = r2 >> 9, r = r2 & 511, nb = r >> 4, kb = r & 15;
            tr_item(p.w_down + (size_t)e * D * D, D, 32 * nb, wdn + (size_t)e * D * D, 32 * nb, 64 * kb, scr, lane); }
    }
}

__device__ __forceinline__ void phase_ffnprep(const P& p, LAS unsigned char* lds) {
    const int tid = threadIdx.x, lane = tid & 63, wave = tid >> 6;
    const int gw = blockIdx.x * NWAVES + wave, NGW = gridDim.x * NWAVES;
    LAS float* wrt = (LAS float*)lds;
    LAS int* lcnt = (LAS int*)(lds + 131072);
    for (int i = tid; i < 32 * 1024; i += NTHREADS) { const int k = i >> 5, e = i & 31; wrt[e * 1024 + k] = p.w_router[i]; }
    if (tid < NG * 32) lcnt[tid] = 0;
    { int* st = (int*)(p.ws + WS_SLOT_TOK); float* sp = (float*)(p.ws + WS_SLOT_P);
      for (int i = blockIdx.x * NTHREADS + tid; i < NG * MAXSLOT; i += gridDim.x * NTHREADS) { st[i] = -1; sp[i] = 0.f; } }
    __syncthreads();
    const float* modv = (const float*)(p.ws + WS_MODV); bf16* h2 = (bf16*)(p.ws + WS_H2);
    int* topi = (int*)(p.ws + WS_TOPI); float* topp = (float*)(p.ws + WS_TOPP);
    float br[32];
#pragma unroll
    for (int e = 0; e < 32; ++e) br[e] = p.b_router[e];
    for (int r = gw; r < T; r += NGW) {
        const int b = r >> 12;
        const f32x4* xr = (const f32x4*)(p.out + (size_t)r * D) + lane;
        f32x4 v[4]; float s = 0.f;
#pragma unroll
        for (int j = 0; j < 4; ++j) { v[j] = xr[64 * j]; s += (v[j].x * v[j].x + v[j].y * v[j].y) + (v[j].z * v[j].z + v[j].w * v[j].w); }
        const float rstd = 1.0f / sqrtf(wave_sum(s) * (1.f / D) + EPS);
        const f32x4* g = (const f32x4*)p.norm_ffn_g + lane; const f32x4* sh = (const f32x4*)(modv + b * NMOD + 3 * D) + lane; const f32x4* scl = (const f32x4*)(modv + b * NMOD + 4 * D) + lane;
        v2u* o8 = (v2u*)(h2 + (size_t)r * D) + lane;
#pragma unroll
        for (int j = 0; j < 4; ++j) { const f32x4 gg = g[64 * j], s1 = sh[64 * j], s2 = scl[64 * j]; v[j] = v[j] * rstd * gg * (1.0f + s2) + s1;
            v2u w; w.x = pk2(v[j].x, v[j].y); w.y = pk2(v[j].z, v[j].w); o8[64 * j] = w; }
        float lg[32];
#pragma unroll
        for (int e = 0; e < 32; ++e) { float a = 0.f;
#pragma unroll
            for (int j = 0; j < 4; ++j) { const f32x4 wv = *(const LAS f32x4*)(wrt + e * 1024 + (lane + 64 * j) * 4); a += (v[j].x * wv.x + v[j].y * wv.y) + (v[j].z * wv.z + v[j].w * wv.w); }
            lg[e] = wave_sum(a) + br[e]; }
        int sel[4]; float val[4];
#pragma unroll
        for (int k = 0; k < 4; ++k) { float best = -3.0e38f; int bi = 0;
#pragma unroll
            for (int e = 0; e < 32; ++e) { if (lg[e] > best) { best = lg[e]; bi = e; } }
            sel[k] = bi; val[k] = best;
#pragma unroll
            for (int e = 0; e < 32; ++e) lg[e] = (e == bi) ? -3.0e38f : lg[e]; }
        float pe[4], ps = 0.f;
#pragma unroll
        for (int k = 0; k < 4; ++k) { pe[k] = __expf(val[k] - val[0]); ps += pe[k]; }
        if (lane < 4) { const int k = lane; const int e = k == 0 ? sel[0] : (k == 1 ? sel[1] : (k == 2 ? sel[2] : sel[3])); const float pv = (k == 0 ? pe[0] : (k == 1 ? pe[1] : (k == 2 ? pe[2] : pe[3]))) / ps;
            topi[r * 4 + k] = e; topp[r * 4 + k] = pv; lds_add(&lcnt[(r / TG) * 32 + e], 1); }
    }
    __syncthreads();
    if (tid < NG * 32) { const int v = lcnt[tid]; if (v) atomicAdd((int*)(p.ws + WS_CTL) + CW_CNT + tid, v); }
}

__device__ __forceinline__ void phase_route(const P& p, LAS unsigned char* lds) {
    const int tid = threadIdx.x;
    LAS int* seg = (LAS int*)lds;
    LAS int* lcnt = seg + 64; LAS int* gb = lcnt + 32;
    int* ctl = (int*)(p.ws + WS_CTL);
    int* tile_e = (int*)(p.ws + WS_TILE_E);
    if (tid == 0) {
        for (int g = 0; g < NG; ++g) { int acc = 0;
            for (int e = 0; e < NE; ++e) { const int c = __hip_atomic_load(ctl + CW_CNT + g * 32 + e, __ATOMIC_RELAXED, __HIP_MEMORY_SCOPE_AGENT); const int padded = (c + 255) & ~255; seg[g * 32 + e] = acc;
                if (blockIdx.x == 0) for (int t = acc >> 8; t < (acc + padded) >> 8; ++t) tile_e[g * MAXTILE + t] = e;
                acc += padded; }
            if (blockIdx.x == 0) ctl[CW_NTILE + g] = acc >> 8; }
    }
    __syncthreads();
    const int* topi = (const int*)(p.ws + WS_TOPI); const float* topp = (const float*)(p.ws + WS_TOPP);
    int* slot_tok = (int*)(p.ws + WS_SLOT_TOK); float* slot_p = (float*)(p.ws + WS_SLOT_P); int* tokslot = (int*)(p.ws + WS_TOKSLOT);
    for (int base = blockIdx.x * 256; base < T; base += gridDim.x * 256) {
        const int g = base / TG;
        if (tid < 32) lcnt[tid] = 0;
        __syncthreads();
        int e2[2], lp[2];
#pragma unroll
        for (int jj = 0; jj < 2; ++jj) { const int i = tid + 512 * jj; e2[jj] = topi[base * 4 + i]; lp[jj] = lds_add(&lcnt[e2[jj]], 1); }
        __syncthreads();
        if (tid < 32) gb[tid] = lcnt[tid] ? atomicAdd(ctl + CW_CUR + g * 32 + tid, lcnt[tid]) : 0;
        __syncthreads();
#pragma unroll
        for (int jj = 0; jj < 2; ++jj) { const int i = tid + 512 * jj; const int slot = seg[g * 32 + e2[jj]] + gb[e2[jj]] + lp[jj];
            slot_tok[g * MAXSLOT + slot] = base + (i >> 2); slot_p[g * MAXSLOT + slot] = topp[base * 4 + i]; tokslot[base * 4 + i] = slot; }
        __syncthreads();
    }
}

__device__ __forceinline__ void phase_combine(const P& p, int g) {
    const int tid = threadIdx.x, lane = tid & 63, wave = tid >> 6;
    const int gw = blockIdx.x * NWAVES + wave, NGW = gridDim.x * NWAVES;
    const float* modv = (const float*)(p.ws + WS_MODV); const bf16* ys = (const bf16*)(p.ws + WS_YSLOT); const int* tokslot = (const int*)(p.ws + WS_TOKSLOT);
    for (int r = g * TG + gw; r < (g + 1) * TG; r += NGW) {
        const int b = r >> 12;
        f32x4* xr = (f32x4*)(p.out + (size_t)r * D) + lane;
        const f32x4* g2 = (const f32x4*)(modv + b * NMOD + 5 * D) + lane;
        f32x4 y[4];
#pragma unroll
        for (int j = 0; j < 4; ++j) y[j] = (f32x4){0.f, 0.f, 0.f, 0.f};
#pragma unroll
        for (int k = 0; k < 4; ++k) { const int slot = tokslot[r * 4 + k]; const v2u* yr = (const v2u*)(ys + (size_t)slot * D) + lane;
#pragma unroll
            for (int j = 0; j < 4; ++j) { const v2u w = yr[64 * j]; y[j].x += bflo(w.x); y[j].y += bfhi(w.x); y[j].z += bflo(w.y); y[j].w += bfhi(w.y); } }
        f32x4 v[4]; float s = 0.f;
#pragma unroll
        for (int j = 0; j < 4; ++j) { v[j] = xr[64 * j] + g2[64 * j] * y[j]; s += (v[j].x * v[j].x + v[j].y * v[j].y) + (v[j].z * v[j].z + v[j].w * v[j].w); }
        const float rstd = 1.0f / sqrtf(wave_sum(s) * (1.f / D) + EPS);
        const f32x4* fg = (const f32x4*)p.final_norm_g + lane;
#pragma unroll
        for (int j = 0; j < 4; ++j) xr[64 * j] = v[j] * rstd * fg[64 * j];
    }
}

constexpr int N_PHASES = 13 + 3 * NG;
template <int PH>
__device__ __forceinline__ void run_phase(const P& p, LAS unsigned char* lds) {
    const int G = gridDim.x, c = blockIdx.x;
    unsigned char* ws = p.ws;
    if constexpr (PH == 0) phase_prologue(p, lds);
    else if constexpr (PH == 1) phase_norm1(p);
    else if constexpr (PH == 2) { pg8::SchedDense S{TT / 256, N_S / 256, G, c}; EpiG1 E{(bf16*)(ws + WS_QKVA), (bf16*)(ws + WS_PB), (float*)(ws + WS_SMALL)};
        pg8::gemm_phase(lds, (const bf16*)(ws + WS_H), (const bf16*)(ws + WS_BT_S), D, S, E); }
    else if constexpr (PH == 3) phase_conv(p, lds);
    else if constexpr (PH == 4) phase_scan(p, lds);
    else if constexpr (PH == 5) phase_onorm(p);
    else if constexpr (PH == 6) phase_wconv(p, lds);
    else if constexpr (PH == 7) { pg8::SchedDense S{T / 256, N_G / 256, G, c}; EpiG2 E{(const bf16*)p.out, (bf16*)(ws + WS_YA_IN), (bf16*)(ws + WS_YB_IN), (bf16*)(ws + WS_GATES)};
        pg8::gemm_phase(lds, (const bf16*)(ws + WS_H), (const bf16*)(ws + WS_BT_G), D, S, E); }
    else if constexpr (PH == 8) { pg8::SchedDense S{T / 256, 4, G, c}; EpiG34<0> E{(const bf16*)(ws + WS_GATES), (bf16*)(ws + WS_Y)};
        pg8::gemm_phase(lds, (const bf16*)(ws + WS_YA_IN), (const bf16*)(ws + WS_BT_OA), D, S, E); }
    else if constexpr (PH == 9) { pg8::SchedDense S{T / 256, 4, G, c}; EpiG34<1> E{(const bf16*)(ws + WS_GATES), (bf16*)(ws + WS_Y)};
        pg8::gemm_phase(lds, (const bf16*)(ws + WS_YB_IN), (const bf16*)(ws + WS_BT_OB), D, S, E); }
    else if constexpr (PH == 10) { pg8::SchedDense S{T / 256, 4, G, c}; EpiG5 E{p.x, (const float*)(ws + WS_MODV), p.out};
        pg8::gemm_phase(lds, (const bf16*)(ws + WS_Y), (const bf16*)(ws + WS_BT_O), D, S, E); }
    else if constexpr (PH == 11) phase_ffnprep(p, lds);
    else if constexpr (PH == 12) phase_route(p, lds);
    else {
        constexpr int g = (PH - 13) / 3, sub = (PH - 13) % 3;
        const int ntile = ((const int*)(ws + WS_CTL))[CW_NTILE + g];
        const int* tile_e = (const int*)(ws + WS_TILE_E) + g * MAXTILE;
        if constexpr (sub == 0) { pg8::SchedMoe S{ntile, 8, G, c, tile_e, (const int*)(ws + WS_SLOT_TOK) + g * MAXSLOT}; EpiGU E{p.b_gu, (bf16*)(ws + WS_ACT)};
            pg8::gemm_phase(lds, (const bf16*)(ws + WS_H2), (const bf16*)(ws + WS_WB_GU), D, S, E); }
        else if constexpr (sub == 1) { pg8::SchedMoe S{ntile, 4, G, c, tile_e, nullptr}; EpiDN E{p.b_down, (const float*)(ws + WS_SLOT_P) + g * MAXSLOT, (bf16*)(ws + WS_YSLOT)};
            pg8::gemm_phase(lds, (const bf16*)(ws + WS_ACT), (const bf16*)(ws + WS_WB_DN), D, S, E); }
        else phase_combine(p, g);
    }
}

#if MK_FUSED
template <int PH>
__device__ __forceinline__ void run_from(const P& p, LAS unsigned char* lds, const XcdBarrier& bar) {
    if constexpr (PH < N_PHASES) { run_phase<PH>(p, lds); if constexpr (PH + 1 < N_PHASES) xcd_barrier(bar); run_from<PH + 1>(p, lds, bar); }
}
__global__ void __launch_bounds__(NTHREADS, 2) k_fused(P p) {
    extern __shared__ __attribute__((aligned(16))) unsigned char lds_raw[];
    LAS unsigned char* lds = (LAS unsigned char*)lds_raw;
    volatile LAS unsigned* misc = (volatile LAS unsigned*)(lds + 144 * 1024 - 64);
    if (threadIdx.x < 4) misc[threadIdx.x] = 0u;
    __syncthreads();
    XcdBarrier bar = xcd_barrier_post((unsigned*)(p.ws + WS_CTL) + CW_BAR, misc);
    run_from<0>(p, lds, bar);
}
#else
template <int PH>
__global__ void __launch_bounds__(NTHREADS, 2) k_phase(P p) {
    extern __shared__ __attribute__((aligned(16))) unsigned char lds_raw[];
    run_phase<PH>(p, (LAS unsigned char*)lds_raw);
}
template <int PH>
static void launch_all(const P& p, int grid, hipStream_t stream) {
    if constexpr (PH < N_PHASES) {
        static bool attr = false;
        if (!attr) { (void)hipFuncSetAttribute((const void*)k_phase<PH>, hipFuncAttributeMaxDynamicSharedMemorySize, LDS_BYTES); attr = true; }
        hipLaunchKernelGGL(k_phase<PH>, dim3(grid), dim3(NTHREADS), LDS_BYTES, stream, p);
        launch_all<PH + 1>(p, grid, stream);
    }
}
#endif

extern "C" void kernel_launch(void* const* d_in, const int* in_sizes, int n_in, void* d_out, int out_size, void* d_ws, size_t ws_size, hipStream_t stream) {
    static int grid = 0;
    if (grid == 0) {
        if (n_in != 30 || in_sizes[0] != T * D || out_size != T * D || ws_size < WS_END) { fprintf(stderr, "kernel_launch: unexpected shapes (n_in %d, in0 %d, out %d, ws %zu)\n", n_in, n_in > 0 ? in_sizes[0] : -1, out_size, ws_size); grid = -1; return; }
        int dev = 0, cus = 0;
        if (hipGetDevice(&dev) != hipSuccess || hipDeviceGetAttribute(&cus, hipDeviceAttributeMultiprocessorCount, dev) != hipSuccess) { grid = -1; return; }
#if MK_FUSED
        if (hipFuncSetAttribute((const void*)k_fused, hipFuncAttributeMaxDynamicSharedMemorySize, LDS_BYTES) != hipSuccess) { fprintf(stderr, "kernel_launch: hipFuncSetAttribute failed\n"); grid = -1; return; }
        int per_cu = 0;
        if (hipOccupancyMaxActiveBlocksPerMultiprocessor(&per_cu, (const void*)k_fused, NTHREADS, LDS_BYTES) != hipSuccess || per_cu < 1) fprintf(stderr, "kernel_launch: occupancy query reports %d\n", per_cu);
        (void)hipGetLastError();
#endif
        grid = cus;
    }
    if (grid < 0) return;
    (void)hipMemsetAsync((char*)d_ws + WS_CTL, 0, CTL_BYTES, stream);
    P p{};
    const float** pp = (const float**)&p;
    for (int i = 0; i < 30; ++i) pp[i] = (const float*)d_in[i];
    p.out = (float*)d_out; p.ws = (unsigned char*)d_ws;
#if MK_FUSED
    hipLaunchKernelGGL(k_fused, dim3(grid), dim3(NTHREADS), LDS_BYTES, stream, p);
#else
    launch_all<0>(p, grid, stream);
#endif
}
```

```cpp
#include <hip/hip_runtime.h>
#include <cstdio>
#include <cstdint>

#ifndef MK_FUSED
#define MK_FUSED 1
#endif

#define GAS __attribute__((address_space(1)))
#define LAS __attribute__((address_space(3)))
typedef unsigned short bf16;
typedef unsigned v4u __attribute__((ext_vector_type(4)));
typedef unsigned v2u __attribute__((ext_vector_type(2)));
typedef float f32x4 __attribute__((ext_vector_type(4)));
typedef short bf16x8 __attribute__((ext_vector_type(8)));

constexpr int D = 1024, NB = 16, SEQ = 4096, T = NB * SEQ, CTXL = 256, TC = NB * CTXL, TT = T + TC;
constexpr int D_IN = 9280, N_S = 5376, N_G = 4096, NMOD = 6 * D;
constexpr int NE = 32, NG = 2, TG = T / NG, MAXSLOT = 139264, MAXTILE = MAXSLOT / 256;
constexpr float EPS = 1e-6f;
constexpr int NTHREADS = 512, NWAVES = 8;
constexpr int LDS_BYTES = 147456;

constexpr size_t MiB = 1u << 20;
constexpr size_t WS_CTL = 0, CTL_BYTES = 1 * MiB;
constexpr size_t WS_MODV = 1 * MiB, WS_BT_S = 2 * MiB, WS_BT_G = 13 * MiB, WS_BT_OA = 21 * MiB, WS_BT_OB = 23 * MiB, WS_BT_O = 25 * MiB;
constexpr size_t WS_TOPI = 27 * MiB, WS_TOPP = 28 * MiB, WS_TOKSLOT = 29 * MiB, WS_SLOT_TOK = 30 * MiB, WS_SLOT_P = 32 * MiB, WS_TILE_E = 34 * MiB;
constexpr size_t WS_H = 40 * MiB, WS_PB = 176 * MiB, WS_SMALL = 448 * MiB, WS_QKVA = 465 * MiB;
constexpr size_t WS_WB_DN = 176 * MiB, WS_YA_IN = 240 * MiB, WS_YB_IN = 368 * MiB, WS_GATES = 496 * MiB, WS_Y = 752 * MiB, WS_WB_GU = 880 * MiB;
constexpr size_t WS_H2 = 40 * MiB, WS_ACT = 240 * MiB, WS_YSLOT = 512 * MiB, WS_END = 1008 * MiB;
static_assert(WS_QKVA + (size_t)TT * 3072 * 2 <= 873 * MiB && WS_SMALL + (size_t)TT * 64 * 4 <= WS_QKVA && WS_H + (size_t)TT * D * 2 <= WS_PB, "ws map");
static_assert(WS_ACT + (size_t)MAXSLOT * D * 2 <= WS_YSLOT && WS_YSLOT + (size_t)MAXSLOT * D * 2 <= WS_WB_GU, "ws map 2");
constexpr int CW_BAR = 4096, CW_CNT = 8192, CW_CUR = 8192 + 256, CW_NTILE = 8192 + 512;

#define LDS_WAIT() asm volatile("s_waitcnt lgkmcnt(0)" ::: "memory")
#define VM_WAIT() asm volatile("s_waitcnt vmcnt(0)" ::: "memory")
__device__ __forceinline__ float bflo(unsigned u) { return __uint_as_float(u << 16); }
__device__ __forceinline__ float bfhi(unsigned u) { return __uint_as_float(u & 0xffff0000u); }
__device__ __forceinline__ unsigned pk2(float lo, float hi) { unsigned r; asm("v_cvt_pk_bf16_f32 %0, %1, %2" : "=v"(r) : "v"(lo), "v"(hi)); return r; }
__device__ __forceinline__ float wave_sum(float v) {
#pragma unroll
    for (int o = 1; o < 64; o <<= 1) v += __shfl_xor(v, o);
    return v;
}
__device__ __forceinline__ int lds_add(LAS int* p, int v) { return __hip_atomic_fetch_add(p, v, __ATOMIC_RELAXED, __HIP_MEMORY_SCOPE_WORKGROUP); }
__device__ __forceinline__ float sigmoidf_(float x) { return 1.0f / (1.0f + __expf(-x)); }
__device__ __forceinline__ float siluf_(float x) { return x / (1.0f + __expf(-x)); }
__device__ __forceinline__ float softplusf_(float x) { return fmaxf(x, 0.f) + log1pf(__expf(-fabsf(x))); }
__device__ __forceinline__ void unpack8(const v4u w, float (&f)[8]) {
    f[0] = bflo(w.x); f[1] = bfhi(w.x); f[2] = bflo(w.y); f[3] = bfhi(w.y); f[4] = bflo(w.z); f[5] = bfhi(w.z); f[6] = bflo(w.w); f[7] = bfhi(w.w);
}
__device__ __forceinline__ v4u pack8(const float (&f)[8]) { v4u w; w.x = pk2(f[0], f[1]); w.y = pk2(f[2], f[3]); w.z = pk2(f[4], f[5]); w.w = pk2(f[6], f[7]); return w; }

struct P {
    const float *x, *c, *ctx, *c_ctx, *w_mod, *b_mod, *norm_mix_g, *norm_ffn_g, *w_in, *conv_w, *a_log_f, *a_log_b, *dt_bias_f, *dt_bias_b, *gdn_norm_g,
        *gla_gate_w_f, *gla_gate_w_b, *gla_gate_b_f, *gla_gate_b_b, *gla_norm_g, *w_out_a, *w_out_b, *w_out, *w_router, *b_router, *w_gu, *b_gu, *w_down, *b_down, *final_norm_g;
    float* out; unsigned char* ws;
};

namespace pg8 {
constexpr int BM = 256, BK = 64, HALF = 128, HTB = HALF * BK * 2, STAGE_BYTES = 8 * HTB, NXCD = 8, WGM = 8;
__host__ __device__ __forceinline__ int lds_byte(int r, int c) { const int st = (r >> 4) * 2 + (c >> 5), rr = r & 15, cc = c & 31, ob = rr * 64 + cc * 2; return st * 1024 + (ob ^ (((ob >> 9) & 1) << 5)); }
__host__ __device__ __forceinline__ void stage_rc(int b, int& R, int& C) { const int st = b / 1024, sb = b % 1024, swz = sb ^ (((sb >> 9) & 1) << 5); R = (st >> 1) * 16 + swz / 64; C = (st & 1) * 32 + (swz % 64) / 2; }
__host__ __device__ __forceinline__ int perm32(int rho) { const int n = rho >> 4, i = rho & 15; return 8 * (i >> 2) + 4 * n + (i & 3); }
struct Unit { int pm, pn, bt; };

__device__ __forceinline__ void order_map(int L, int nM, int nN, int& pm, int& pn) {
    const int nwg = nM * nN; int wgid = L;
    { const int q = nwg / NXCD, r = nwg % NXCD, xcd = wgid % NXCD, off = wgid / NXCD; wgid = (xcd < r ? xcd * (q + 1) : r * (q + 1) + (xcd - r) * q) + off; }
    const int nig = WGM * nN, gid = wgid / nig, fm = gid * WGM, gsz = (nM - fm) < WGM ? (nM - fm) : WGM;
    pm = fm + ((wgid % nig) % gsz); pn = (wgid % nig) / gsz;
}
struct SchedDense {
    int nM, nN, G, c;
    __device__ __forceinline__ bool next(int i, Unit& u) const { const long L = (long)i * G + c; if (L >= (long)nM * nN) return false; order_map((int)L, nM, nN, u.pm, u.pn); u.bt = u.pn; return true; }
    __device__ __forceinline__ unsigned arow(const Unit& u, int r) const { return (unsigned)(u.pm * BM + r); }
};
struct SchedMoe {
    int nM, nN, G, c; const int* tile_e; const int* slot_tok;
    __device__ __forceinline__ bool next(int i, Unit& u) const { const long L = (long)i * G + c; if (L >= (long)nM * nN) return false; order_map((int)L, nM, nN, u.pm, u.pn); u.bt = tile_e[u.pm] * nN + u.pn; return true; }
    __device__ __forceinline__ unsigned arow(const Unit& u, int r) const { if (slot_tok) { const int t = slot_tok[u.pm * BM + r]; return (unsigned)(t < 0 ? 0 : t); } return (unsigned)(u.pm * BM + r); }
};

template <class Epi, class Sched>
__device__ __forceinline__ void gemm_phase(LAS unsigned char* lds, const bf16* A, const bf16* Bt, const int K, const Sched& S, const Epi& E) {
    const int tid = threadIdx.x, wid = __builtin_amdgcn_readfirstlane(tid >> 6), lane = tid & 63, wr = wid >> 2, wc = wid & 3, fr = lane & 15, fq = lane >> 4;
    const int nt = K / BK;
    int R0, C0; stage_rc(tid * 16, R0, C0);
    unsigned voffB[2];
#pragma unroll
    for (int i = 0; i < 2; ++i) { const int R = R0 + 64 * i; const int Rb = (R & ~31) + perm32(R & 31); voffB[i] = (unsigned)(Rb * K + C0) * 2u; }
    const unsigned rowb = (unsigned)K * 2u, cofs = (unsigned)C0 * 2u;
    const size_t kstep = (size_t)(BK * 2);
    const size_t hstep = (size_t)HALF * K * 2;
    const size_t tstep = 2 * hstep;
    const unsigned ldsw = (unsigned)wid * 1024u;
    const int aoff = lds_byte(wr * 64 + fr, fq * 8), boff = lds_byte(wc * 32 + fr, fq * 8);
#define PG8_SA(b, h) (((b) * 2 + (h)) * HTB)
#define PG8_SB(b, h) ((4 + (b) * 2 + (h)) * HTB)
#define PG8_STAGE(bufoff, gbase, voff) do { _Pragma("unroll") for (int _i = 0; _i < 2; ++_i) \
        __builtin_amdgcn_global_load_lds((const unsigned*)((const char*)(gbase) + (voff)[_i]), (LAS unsigned*)(lds + (bufoff) + ldsw + _i * 8192), 16, 0, 0); } while (0)
#define PG8_STAGE_A(bufoff, gbase, o0, o1) do { \
        __builtin_amdgcn_global_load_lds((const unsigned*)((const char*)(gbase) + (o0)), (LAS unsigned*)(lds + (bufoff) + ldsw), 16, 0, 0); \
        __builtin_amdgcn_global_load_lds((const unsigned*)((const char*)(gbase) + (o1)), (LAS unsigned*)(lds + (bufoff) + ldsw + 8192), 16, 0, 0); } while (0)
#define PG8_LDA(dst, b, h) do { _Pragma("unroll") for (int m = 0; m < 4; ++m) _Pragma("unroll") for (int k = 0; k < 2; ++k) dst[m][k] = *(const LAS bf16x8*)(lds + PG8_SA(b, h) + aoff + m * 2048 + k * 1024); } while (0)
#define PG8_LDB(dst, b, h) do { _Pragma("unroll") for (int n = 0; n < 2; ++n) _Pragma("unroll") for (int k = 0; k < 2; ++k) dst[n][k] = *(const LAS bf16x8*)(lds + PG8_SB(b, h) + boff + n * 2048 + k * 1024); } while (0)
#define PG8_MMA(ai, bj, At, Bt_) do { __builtin_amdgcn_s_setprio(1); _Pragma("unroll") for (int m = 0; m < 4; ++m) _Pragma("unroll") for (int n = 0; n < 2; ++n) _Pragma("unroll") for (int k = 0; k < 2; ++k) \
        acc[ai][bj][m][n] = __builtin_amdgcn_mfma_f32_16x16x32_bf16(Bt_[n][k], At[m][k], acc[ai][bj][m][n], 0, 0, 0); __builtin_amdgcn_s_setprio(0); } while (0)
#define PG8_WAIT_V(n) asm volatile("s_waitcnt vmcnt(" #n ")" ::: "memory")
#define PG8_WAIT_L(n) asm volatile("s_waitcnt lgkmcnt(" #n ")" ::: "memory")
#define PG8_BAR __builtin_amdgcn_s_barrier()
#define PG8_SCHED __builtin_amdgcn_sched_barrier(0)
    Unit cur, nxt; int ui = 0;
    if (!S.next(0, cur)) return;
    f32x4 acc[2][2][4][2];
#pragma unroll
    for (int a = 0; a < 2; ++a)
#pragma unroll
        for (int b = 0; b < 2; ++b)
#pragma unroll
            for (int m = 0; m < 4; ++m)
#pragma unroll
                for (int n = 0; n < 2; ++n) acc[a][b][m][n] = (f32x4){0.f, 0.f, 0.f, 0.f};
    bf16x8 At[4][2], B0[2][2], B1[2][2];
    const char* Ab = (const char*)A;
    const char* cB = (const char*)Bt + (size_t)cur.bt * tstep;
    unsigned c00 = S.arow(cur, R0) * rowb + cofs, c01 = S.arow(cur, R0 + 64) * rowb + cofs, c10 = S.arow(cur, HALF + R0) * rowb + cofs, c11 = S.arow(cur, HALF + R0 + 64) * rowb + cofs;
    unsigned n00, n01, n10, n11;
    PG8_STAGE(PG8_SB(0, 0), cB, voffB); PG8_STAGE(PG8_SB(0, 1), cB + hstep, voffB); PG8_STAGE_A(PG8_SA(0, 0), Ab, c00, c01); PG8_STAGE_A(PG8_SA(0, 1), Ab, c10, c11);
    if (wr == 1) PG8_BAR;
    PG8_WAIT_V(2); PG8_BAR;
    PG8_STAGE(PG8_SB(1, 0), cB + kstep, voffB); PG8_STAGE_A(PG8_SA(1, 0), Ab + kstep, c00, c01); PG8_STAGE(PG8_SB(1, 1), cB + hstep + kstep, voffB);
    PG8_WAIT_V(6); PG8_BAR;
    for (;;) {
        const bool has_next = S.next(ui + 1, nxt);
        const char* nB = has_next ? (const char*)Bt + (size_t)nxt.bt * tstep : cB;
        if (has_next) { n00 = S.arow(nxt, R0) * rowb + cofs; n01 = S.arow(nxt, R0 + 64) * rowb + cofs; n10 = S.arow(nxt, HALF + R0) * rowb + cofs; n11 = S.arow(nxt, HALF + R0 + 64) * rowb + cofs; }
        else { n00 = c00; n01 = c01; n10 = c10; n11 = c11; }
        for (int t = 0; t < nt; t += 2) {
            const bool last = (t == nt - 2);
            const char* a1 = Ab + (size_t)(t + 1) * kstep;
            const char* a2 = last ? Ab : Ab + (size_t)(t + 2) * kstep; const char* b2 = last ? nB : cB + (size_t)(t + 2) * kstep;
            const char* a3 = a2 + kstep; const char* b3 = b2 + kstep;
            const unsigned x00 = last ? n00 : c00, x01 = last ? n01 : c01, x10 = last ? n10 : c10, x11 = last ? n11 : c11;
            PG8_LDB(B0, 0, 0); PG8_LDB(B1, 0, 1); PG8_SCHED; PG8_LDA(At, 0, 0); PG8_STAGE_A(PG8_SA(1, 1), a1, c10, c11);
            PG8_WAIT_V(8); PG8_WAIT_L(0); PG8_BAR; PG8_MMA(0, 0, At, B0); PG8_MMA(0, 1, At, B1); PG8_BAR; PG8_SCHED;
            PG8_LDA(At, 0, 1); PG8_STAGE(PG8_SB(0, 0), b2, voffB); PG8_STAGE(PG8_SB(0, 1), b2 + hstep, voffB); PG8_STAGE_A(PG8_SA(0, 0), a2, x00, x01);
            PG8_WAIT_V(8); PG8_WAIT_L(0); PG8_BAR; PG8_MMA(1, 0, At, B0); PG8_MMA(1, 1, At, B1); PG8_BAR; PG8_SCHED;
            PG8_LDB(B0, 1, 0); PG8_LDB(B1, 1, 1); PG8_SCHED; PG8_LDA(At, 1, 0); PG8_STAGE_A(PG8_SA(0, 1), a2, x10, x11);
            PG8_WAIT_V(8); PG8_WAIT_L(0); PG8_BAR; PG8_MMA(0, 0, At, B0); PG8_MMA(0, 1, At, B1); PG8_BAR; PG8_SCHED;
            PG8_LDA(At, 1, 1); PG8_STAGE(PG8_SB(1, 0), b3, voffB); PG8_STAGE(PG8_SB(1, 1), b3 + hstep, voffB); PG8_STAGE_A(PG8_SA(1, 0), a3, x00, x01);
            PG8_WAIT_V(8); PG8_WAIT_L(0); PG8_BAR; PG8_MMA(1, 0, At, B0); PG8_MMA(1, 1, At, B1); PG8_BAR; PG8_SCHED;
        }
        if (wr == 0) PG8_BAR;
        E(acc, cur, wr, wc, fr, fq);
        if (!has_next) break;
#pragma unroll
        for (int a = 0; a < 2; ++a)
#pragma unroll
            for (int b = 0; b < 2; ++b)
#pragma unroll
                for (int m = 0; m < 4; ++m)
#pragma unroll
                    for (int n = 0; n < 2; ++n) acc[a][b][m][n] = (f32x4){0.f, 0.f, 0.f, 0.f};
        cur = nxt; cB = nB; c00 = n00; c01 = n01; c10 = n10; c11 = n11; ++ui;
        if (wr == 1) PG8_BAR;
    }
    PG8_WAIT_V(0);
    PG8_BAR;
#undef PG8_SA
#undef PG8_SB
#undef PG8_STAGE
#undef PG8_STAGE_A
#undef PG8_LDA
#undef PG8_LDB
#undef PG8_MMA
#undef PG8_WAIT_V
#undef PG8_WAIT_L
#undef PG8_BAR
#undef PG8_SCHED
}
}
typedef f32x4 Acc[2][2][4][2];

#define XB_TMO      128
#define XB_XCNT(j)  (256  + 64 * (j))
#define XB_XSUB(j)  (1280 + 64 * (j))
#define XB_XGEN(j)  (2304 + 64 * (j))
#define XB_TOP      3328
#define XB_TOPGEN   3392
#define XCD_BAR_WORDS 3456
#define XB_SPIN_CAP (1u << 22)
__device__ __forceinline__ unsigned xb_ld(unsigned* p)              { return __hip_atomic_load(p, __ATOMIC_RELAXED, __HIP_MEMORY_SCOPE_AGENT); }
__device__ __forceinline__ unsigned xb_add(unsigned* p, unsigned v) { return __hip_atomic_fetch_add(p, v, __ATOMIC_RELAXED, __HIP_MEMORY_SCOPE_AGENT); }
__device__ __forceinline__ unsigned xb_xcc_id() { return (unsigned)__builtin_amdgcn_s_getreg((3 << 11) | 20) & 0xFu; }
#define XB_SPIN(cond, bar) do { unsigned _sp = 0; while (cond) { __builtin_amdgcn_s_sleep(1); \
    if ((++_sp & 255u) == 0u) { if (xb_ld(&(bar)[XB_TMO])) break; if (_sp > XB_SPIN_CAP) { atomicAdd(&(bar)[XB_TMO], 1u); break; } } } } while (0)
struct XcdBarrier { unsigned* bar; unsigned x; volatile LAS unsigned* st; };
__device__ __forceinline__ XcdBarrier xcd_barrier_post(unsigned* bar, volatile LAS unsigned* st) {
    XcdBarrier b; b.bar = bar; b.x = xb_xcc_id(); b.st = st;
    if (threadIdx.x == 0) (void)xb_add(&bar[XB_XCNT(b.x)], 1u);
    return b;
}
__device__ __forceinline__ void xcd_barrier_complete(unsigned* bar, unsigned x, unsigned& nloc, unsigned& nx) {
    const unsigned G = gridDim.x * gridDim.y * gridDim.z;
    unsigned sum, cnt, mine, sp = 0u;
    for (;;) {
        sum = 0u; cnt = 0u; mine = 0u;
#pragma unroll
        for (unsigned j = 0; j < 16; ++j) { const unsigned c = xb_ld(&bar[XB_XCNT(j)]); sum += c; cnt += (c > 0u) ? 1u : 0u; mine = (j == x) ? c : mine; }
        if (sum == G) break;
        __builtin_amdgcn_s_sleep(1);
        if ((++sp & 255u) == 0u) { if (xb_ld(&bar[XB_TMO])) break; if (sp > XB_SPIN_CAP) { atomicAdd(&bar[XB_TMO], 1u); break; } }
    }
    nloc = mine > 0u ? mine : 1u; nx = cnt > 0u ? cnt : 1u;
}
__device__ __forceinline__ void xcd_barrier(const XcdBarrier& b) {
    asm volatile("s_waitcnt vmcnt(0)" ::: "memory");
    __syncthreads();
    if (threadIdx.x == 0) {
        unsigned* bar = b.bar;
        __builtin_amdgcn_s_waitcnt(0);
        unsigned nloc = b.st[0], nx = b.st[1];
        if (nloc == 0u) { xcd_barrier_complete(bar, b.x, nloc, nx); b.st[0] = nloc; b.st[1] = nx; }
        const unsigned old = xb_add(&bar[XB_XSUB(b.x)], 1u);
        const unsigned gen = old / nloc;
        if (old + 1u == (gen + 1u) * nloc) {
            __builtin_amdgcn_fence(__ATOMIC_RELEASE, "agent");
            asm volatile("s_waitcnt vmcnt(0)" ::: "memory");
            const unsigned og = xb_add(&bar[XB_TOP], 1u);
            const unsigned tg = og / nx;
            if (og + 1u == (tg + 1u) * nx) xb_add(&bar[XB_TOPGEN], 1u);
            else XB_SPIN(xb_ld(&bar[XB_TOPGEN]) == tg, bar);
            __builtin_amdgcn_fence(__ATOMIC_ACQUIRE, "agent");
            xb_add(&bar[XB_XGEN(b.x)], 1u);
            asm volatile("s_waitcnt vmcnt(0)" ::: "memory");
        } else {
            XB_SPIN(xb_ld(&bar[XB_XGEN(b.x)]) == gen, bar);
            __builtin_amdgcn_fence(__ATOMIC_ACQUIRE, "agent");
            asm volatile("s_waitcnt vmcnt(0)" ::: "memory");
        }
    }
    __syncthreads();
}

__device__ __forceinline__ void tr_item(const float* W, int ldw, int col0, bf16* WT, int dstrow0, int k0, LAS float* scr, int lane) {
#pragma unroll 8
    for (int i = 0; i < 32; ++i) { const int kk = 2 * i + (lane >> 5); scr[kk * 33 + (lane & 31)] = W[(size_t)(k0 + kk) * ldw + col0 + (lane & 31)]; }
    LDS_WAIT(); asm volatile("" ::: "memory");
    const int c = lane & 7;
#pragma unroll
    for (int j = 0; j < 4; ++j) { const int n = (lane >> 3) + 8 * j; const LAS float* s = scr + (8 * c) * 33 + n;
        v4u o; o.x = pk2(s[0 * 33], s[1 * 33]); o.y = pk2(s[2 * 33], s[3 * 33]); o.z = pk2(s[4 * 33], s[5 * 33]); o.w = pk2(s[6 * 33], s[7 * 33]);
        *(v4u*)(WT + (size_t)(dstrow0 + n) * D + k0 + 8 * c) = o; }
    LDS_WAIT(); asm volatile("" ::: "memory");
}
__device__ __forceinline__ void phase_prologue(const P& p, LAS unsigned char* lds) {
    const int tid = threadIdx.x, lane = tid & 63, wave = tid >> 6;
    LAS float* scr = (LAS float*)(lds + wave * 8448);
    const int gw = blockIdx.x * NWAVES + wave, NGW = gridDim.x * NWAVES;
    bf16* bt_s = (bf16*)(p.ws + WS_BT_S); bf16* bt_g = (bf16*)(p.ws + WS_BT_G);
    constexpr int I_S = 162 * 16, I_G = 128 * 16, I_O = 32 * 16;
    for (int it = gw; it < I_S + I_G + 3 * I_O; it += NGW) {
        int r = it;
        if (r < I_S) { const int nb = r >> 4, kb = r & 15; const int col0 = nb < 96 ? 32 * nb : (nb < 160 ? 4128 + 32 * (nb - 96) : (nb == 160 ? 4096 : 7200));
            tr_item(p.w_in, D_IN, col0, bt_s, 32 * nb, 64 * kb, scr, lane); continue; } r -= I_S;
        if (r < I_G) { const int nb = r >> 4, kb = r & 15; const int col0 = nb < 32 ? 3072 + 32 * nb : (nb < 64 ? 6176 + 32 * (nb - 32) : 7232 + 32 * (nb - 64));
            tr_item(p.w_in, D_IN, col0, bt_g, 32 * nb, 64 * kb, scr, lane); continue; } r -= I_G;
        const int which = r / I_O; r -= which * I_O; const int nb = r >> 4, kb = r & 15;
        const float* W = which == 0 ? p.w_out_a : (which == 1 ? p.w_out_b : p.w_out);
        bf16* WT = (bf16*)(p.ws + (which == 0 ? WS_BT_OA : (which == 1 ? WS_BT_OB : WS_BT_O)));
        tr_item(W, D, 32 * nb, WT, 32 * nb, 64 * kb, scr, lane);
    }
    { const size_t n16 = (size_t)192 * D * 2 / 16; v4u* z = (v4u*)(bt_s + (size_t)5184 * D);
      for (size_t i = (size_t)blockIdx.x * NTHREADS + tid; i < n16; i += (size_t)gridDim.x * NTHREADS) z[i] = (v4u){0u, 0u, 0u, 0u}; }
    __syncthreads();
    LAS float* sc = (LAS float*)lds;
    LAS float* red = (LAS float*)(lds + 17 * 1024 * 4);
    float* modv = (float*)(p.ws + WS_MODV);
    bool have = false;
    for (int u = blockIdx.x; u < NMOD / 64; u += gridDim.x) {
        if (!have) { for (int i = tid; i < 17 * 1024; i += NTHREADS) { const float v = i < 16 * 1024 ? p.c[i] : p.c_ctx[i - 16 * 1024]; sc[i] = siluf_(v); } have = true; __syncthreads(); }
        float acc[17];
#pragma unroll
        for (int b = 0; b < 17; ++b) acc[b] = 0.f;
        const int n = u * 64 + lane;
        for (int k = wave * 128; k < wave * 128 + 128; ++k) { const float wv = p.w_mod[(size_t)k * NMOD + n];
#pragma unroll
            for (int b = 0; b < 17; ++b) acc[b] += sc[b * 1024 + k] * wv; }
#pragma unroll
        for (int b = 0; b < 17; ++b) red[(wave * 17 + b) * 64 + lane] = acc[b];
        __syncthreads();
        for (int i = tid; i < 17 * 64; i += NTHREADS) { const int b = i >> 6, l = i & 63; float s = p.b_mod[u * 64 + l];
#pragma unroll
            for (int w = 0; w < 8; ++w) s += red[(w * 17 + b) * 64 + l];
            modv[b * NMOD + u * 64 + l] = s; }
        __syncthreads();
    }
}

__device__ __forceinline__ void phase_norm1(const P& p) {
    const int tid = threadIdx.x, lane = tid & 63, wave = tid >> 6;
    const int gw = blockIdx.x * NWAVES + wave, NGW = gridDim.x * NWAVES;
    const float* modv = (const float*)(p.ws + WS_MODV); bf16* h = (bf16*)(p.ws + WS_H);
    for (int r = gw; r < TT; r += NGW) {
        const float* src; int b;
        if (r < T) { src = p.x + (size_t)r * D; b = r >> 12; } else { src = p.ctx + (size_t)(r - T) * D; b = 16; }
        const f32x4* xr = (const f32x4*)src + lane;
        f32x4 v[4]; float s = 0.f;
#pragma unroll
        for (int j = 0; j < 4; ++j) { v[j] = xr[64 * j]; s += (v[j].x * v[j].x + v[j].y * v[j].y) + (v[j].z * v[j].z + v[j].w * v[j].w); }
        const float rstd = 1.0f / sqrtf(wave_sum(s) * (1.f / D) + EPS);
        const f32x4* g = (const f32x4*)p.norm_mix_g + lane; const f32x4* sh = (const f32x4*)(modv + b * NMOD) + lane; const f32x4* scl = (const f32x4*)(modv + b * NMOD + D) + lane;
        v2u* o8 = (v2u*)(h + (size_t)r * D) + lane;
#pragma unroll
        for (int j = 0; j < 4; ++j) { const f32x4 gg = g[64 * j], s1 = sh[64 * j], s2 = scl[64 * j]; const f32x4 o = v[j] * rstd * gg * (1.0f + s2) + s1;
            v2u w; w.x = pk2(o.x, o.y); w.y = pk2(o.z, o.w); o8[64 * j] = w; }
    }
}

struct EpiG1 {
    bf16* qkva; bf16* pb; float* small;
    __device__ __forceinline__ void operator()(const Acc& acc, const pg8::Unit& u, int wr, int wc, int fr, int fq) const {
        const int row0 = u.pm * 256 + wr * 64 + fr, cb = wc * 32 + 8 * fq;
#pragma unroll
        for (int ai = 0; ai < 2; ++ai)
#pragma unroll
            for (int m = 0; m < 4; ++m) { const size_t row = (size_t)(row0 + ai * 128 + m * 16);
#pragma unroll
                for (int bj = 0; bj < 2; ++bj) { const int c = bj * 128 + cb; const f32x4 v0 = acc[ai][bj][m][0], v1 = acc[ai][bj][m][1];
                    if (u.pn < 20) { v4u w; w.x = pk2(v0[0], v0[1]); w.y = pk2(v0[2], v0[3]); w.z = pk2(v1[0], v1[1]); w.w = pk2(v1[2], v1[3]);
                        if (u.pn < 12) *(v4u*)(qkva + row * 3072 + u.pn * 256 + c) = w; else *(v4u*)(pb + row * 2048 + (u.pn - 12) * 256 + c) = w; }
                    else if (c < 64) { *(f32x4*)(small + row * 64 + c) = v0; *(f32x4*)(small + row * 64 + c + 4) = v1; } } }
    }
};
struct EpiG2 {
    const bf16* on; bf16* ya; bf16* yb; bf16* gates;
    __device__ __forceinline__ void operator()(const Acc& acc, const pg8::Unit& u, int wr, int wc, int fr, int fq) const {
        const int row0 = u.pm * 256 + wr * 64 + fr, cb = wc * 32 + 8 * fq;
#pragma unroll
        for (int ai = 0; ai < 2; ++ai)
#pragma unroll
            for (int m = 0; m < 4; ++m) { const size_t row = (size_t)(row0 + ai * 128 + m * 16);
#pragma unroll
                for (int bj = 0; bj < 2; ++bj) { const int c = bj * 128 + cb; float v[8];
#pragma unroll
                    for (int j = 0; j < 4; ++j) { v[j] = acc[ai][bj][m][0][j]; v[4 + j] = acc[ai][bj][m][1][j]; }
                    if (u.pn < 8) { const v4u ow = *(const v4u*)(on + row * 2048 + u.pn * 256 + c); float o[8]; unpack8(ow, o);
#pragma unroll
                        for (int j = 0; j < 8; ++j) v[j] = o[j] * siluf_(v[j]);
                        bf16* dst = u.pn < 4 ? ya + row * 1024 + u.pn * 256 + c : yb + row * 1024 + (u.pn - 4) * 256 + c;
                        *(v4u*)dst = pack8(v); }
                    else {
#pragma unroll
                        for (int j = 0; j < 8; ++j) v[j] = sigmoidf_(v[j]);
                        *(v4u*)(gates + row * 2048 + (u.pn - 8) * 256 + c) = pack8(v); } } }
    }
};
template <int WHICH> struct EpiG34 {
    const bf16* gates; bf16* y;
    __device__ __forceinline__ void operator()(const Acc& acc, const pg8::Unit& u, int wr, int wc, int fr, int fq) const {
        const int row0 = u.pm * 256 + wr * 64 + fr, cb = wc * 32 + 8 * fq;
#pragma unroll
        for (int ai = 0; ai < 2; ++ai)
#pragma unroll
            for (int m = 0; m < 4; ++m) { const size_t row = (size_t)(row0 + ai * 128 + m * 16);
#pragma unroll
                for (int bj = 0; bj < 2; ++bj) { const int c = u.pn * 256 + bj * 128 + cb; float v[8], g[8];
#pragma unroll
                    for (int j = 0; j < 4; ++j) { v[j] = acc[ai][bj][m][0][j]; v[4 + j] = acc[ai][bj][m][1][j]; }
                    unpack8(*(const v4u*)(gates + row * 2048 + WHICH * 1024 + c), g);
                    if (WHICH == 0) {
#pragma unroll
                        for (int j = 0; j < 8; ++j) v[j] = g[j] * v[j];
                    } else { float o[8]; unpack8(*(const v4u*)(y + row * 1024 + c), o);
#pragma unroll
                        for (int j = 0; j < 8; ++j) v[j] = o[j] + g[j] * v[j]; }
                    *(v4u*)(y + row * 1024 + c) = pack8(v); } }
    }
};
struct EpiG5 {
    const float* x; const float* modv; float* out;
    __device__ __forceinline__ void operator()(const Acc& acc, const pg8::Unit& u, int wr, int wc, int fr, int fq) const {
        const int row0 = u.pm * 256 + wr * 64 + fr, cb = wc * 32 + 8 * fq;
        const float* g1 = modv + (u.pm >> 4) * NMOD + 2 * D;
#pragma unroll
        for (int ai = 0; ai < 2; ++ai)
#pragma unroll
            for (int m = 0; m < 4; ++m) { const size_t row = (size_t)(row0 + ai * 128 + m * 16);
#pragma unroll
                for (int bj = 0; bj < 2; ++bj) { const int c = u.pn * 256 + bj * 128 + cb;
#pragma unroll
                    for (int n = 0; n < 2; ++n) { const f32x4 xv = *(const f32x4*)(x + row * D + c + 4 * n), gv = *(const f32x4*)(g1 + c + 4 * n);
                        *(f32x4*)(out + row * D + c + 4 * n) = xv + gv * acc[ai][bj][m][n]; } } }
    }
};
struct EpiGU {
    const float* b_gu; bf16* act;
    __device__ __forceinline__ void operator()(const Acc& acc, const pg8::Unit& u, int wr, int wc, int fr, int fq) const {
        const int row0 = u.pm * 256 + wr * 64 + fr, cb = wc * 32 + 8 * fq; const int e = u.bt >> 3;
        const float* bg = b_gu + (size_t)e * 2048 + u.pn * 128 + cb; const float* bl = bg + 1024;
        float bgv[8], blv[8];
#pragma unroll
        for (int j = 0; j < 8; ++j) { bgv[j] = bg[j]; blv[j] = bl[j]; }
#pragma unroll
        for (int ai = 0; ai < 2; ++ai)
#pragma unroll
            for (int m = 0; m < 4; ++m) { const size_t row = (size_t)(row0 + ai * 128 + m * 16); float v[8];
#pragma unroll
                for (int j = 0; j < 8; ++j) { const float gl = fminf(acc[ai][0][m][j >> 2][j & 3] + bgv[j], 7.0f); const float ln = fminf(fmaxf(acc[ai][1][m][j >> 2][j & 3] + blv[j], -7.0f), 7.0f);
                    v[j] = gl * sigmoidf_(1.702f * gl) * (ln + 1.0f); }
                *(v4u*)(act + row * 1024 + u.pn * 128 + cb) = pack8(v); }
    }
};
struct EpiDN {
    const float* b_down; const float* slot_p; bf16* ys;
    __device__ __forceinline__ void operator()(const Acc& acc, const pg8::Unit& u, int wr, int wc, int fr, int fq) const {
        const int row0 = u.pm * 256 + wr * 64 + fr, cb = wc * 32 + 8 * fq; const int e = u.bt >> 2;
#pragma unroll
        for (int bj = 0; bj < 2; ++bj) { const int c = u.pn * 256 + bj * 128 + cb; float bv[8];
#pragma unroll
            for (int j = 0; j < 8; ++j) bv[j] = b_down[(size_t)e * 1024 + c + j];
#pragma unroll
            for (int ai = 0; ai < 2; ++ai)
#pragma unroll
                for (int m = 0; m < 4; ++m) { const size_t row = (size_t)(row0 + ai * 128 + m * 16); const float pr = slot_p[row]; float v[8];
#pragma unroll
                    for (int j = 0; j < 8; ++j) v[j] = (acc[ai][bj][m][j >> 2][j & 3] + bv[j]) * pr;
                    *(v4u*)(ys + row * 1024 + c) = pack8(v); } }
    }
};

__device__ __forceinline__ void phase_conv(const P& p, LAS unsigned char* lds) {
    const int tid = threadIdx.x;
    bf16* qkva = (bf16*)(p.ws + WS_QKVA);
    LAS unsigned char* rowbuf = lds;
    LAS unsigned char* cbuf = lds + 3 * 16896;
    const int cg = tid & 15, c0 = tid >> 4;
    for (int u = blockIdx.x; u < NB * 24; u += gridDim.x) {
        const int b = u / 24, s = u % 24;
        float w[9][8];
#pragma unroll
        for (int k = 0; k < 9; ++k)
#pragma unroll
            for (int e = 0; e < 8; ++e) w[k][e] = p.conv_w[k * 3072 + s * 128 + cg * 8 + e];
        const bool donorm = s < 16;
        if (tid < 96) { const int bi = tid / 32, r = tid % 32; *(LAS v4u*)(rowbuf + bi * 16896 + ((r >> 4) ? 65 : 0) * 256 + (r & 15) * 16) = (v4u){0u, 0u, 0u, 0u}; }
        if (tid >= 128 && tid < 160) { const int r = tid - 128; *(LAS v4u*)(cbuf + ((r >> 4) ? 257 : 0) * 256 + (r & 15) * 16) = (v4u){0u, 0u, 0u, 0u}; }
        { bf16* base = qkva + (size_t)(T + b * CTXL) * 3072 + s * 128 + cg * 8;
#pragma unroll
          for (int jj = 0; jj < 8; ++jj) { const int t = c0 + 32 * jj; *(LAS v4u*)(cbuf + (t + 1) * 256 + cg * 16) = *(const v4u*)(base + (size_t)t * 3072); }
          __syncthreads();
#pragma unroll
          for (int jj = 0; jj < 8; ++jj) { const int t = c0 + 32 * jj; float a[8];
#pragma unroll
              for (int e = 0; e < 8; ++e) a[e] = 0.f;
#pragma unroll
              for (int kw = 0; kw < 3; ++kw) { float f[8]; unpack8(*(const LAS v4u*)(cbuf + (t + kw) * 256 + cg * 16), f);
#pragma unroll
                  for (int e = 0; e < 8; ++e) a[e] += f[e] * w[3 + kw][e]; }
              float ss = 0.f;
#pragma unroll
              for (int e = 0; e < 8; ++e) { a[e] = siluf_(a[e]); ss += a[e] * a[e]; }
              if (donorm) { ss += __shfl_xor(ss, 1); ss += __shfl_xor(ss, 2); ss += __shfl_xor(ss, 4); ss += __shfl_xor(ss, 8); const float sc = 1.0f / sqrtf(ss + EPS);
#pragma unroll
                  for (int e = 0; e < 8; ++e) a[e] *= sc; }
              *(v4u*)(base + (size_t)t * 3072) = pack8(a); }
        }
        bf16* base = qkva + (size_t)(b * SEQ) * 3072 + s * 128 + cg * 8;
#pragma unroll
        for (int rr = 0; rr < 2; ++rr)
#pragma unroll
            for (int jj = 0; jj < 2; ++jj) { const int c = c0 + 32 * jj; *(LAS v4u*)(rowbuf + rr * 16896 + (c + 1) * 256 + cg * 16) = *(const v4u*)(base + (size_t)(rr * 64 + c) * 3072); }
        __syncthreads();
        for (int r = 0; r < 64; ++r) {
            v4u pre[2];
            if (r + 2 < 64) {
#pragma unroll
                for (int jj = 0; jj < 2; ++jj) pre[jj] = *(const v4u*)(base + (size_t)((r + 2) * 64 + c0 + 32 * jj) * 3072);
            }
#pragma unroll
            for (int jj = 0; jj < 2; ++jj) { const int c = c0 + 32 * jj; float a[8];
#pragma unroll
                for (int e = 0; e < 8; ++e) a[e] = 0.f;
#pragma unroll
                for (int kh = 0; kh < 3; ++kh) { const int rr = r + kh - 1; if (rr < 0 || rr > 63) continue; LAS unsigned char* rb = rowbuf + (rr % 3) * 16896;
#pragma unroll
                    for (int kw = 0; kw < 3; ++kw) { float f[8]; unpack8(*(const LAS v4u*)(rb + (c + kw) * 256 + cg * 16), f);
#pragma unroll
                        for (int e = 0; e < 8; ++e) a[e] += f[e] * w[kh * 3 + kw][e]; } }
                float ss = 0.f;
#pragma unroll
                for (int e = 0; e < 8; ++e) { a[e] = siluf_(a[e]); ss += a[e] * a[e]; }
                if (donorm) { ss += __shfl_xor(ss, 1); ss += __shfl_xor(ss, 2); ss += __shfl_xor(ss, 4); ss += __shfl_xor(ss, 8); const float sc = 1.0f / sqrtf(ss + EPS);
#pragma unroll
                    for (int e = 0; e < 8; ++e) a[e] *= sc; }
                *(v4u*)(base + (size_t)(r * 64 + c) * 3072) = pack8(a); }
            __syncthreads();
            if (r + 2 < 64) {
#pragma unroll
                for (int jj = 0; jj < 2; ++jj) *(LAS v4u*)(rowbuf + ((r + 2) % 3) * 16896 + (c0 + 32 * jj + 1) * 256 + cg * 16) = pre[jj];
            }
            __syncthreads();
        }
    }
}

template <bool GLA>
__device__ __forceinline__ void scan_unit(const P& p, LAS unsigned char* lds, int b, int h, int vh) {
    const int tid = threadIdx.x, j = tid >> 2, part = tid & 3;
    LAS float* qf = (LAS float*)lds; LAS float* kf = qf + 32 * 144; LAS float* af = kf + 32 * 144; LAS float* vf = af + 32 * 144; LAS float* ob = vf + 32 * 128;
    LAS float* sa = ob + 32 * 128; LAS float* sb = sa + 32;
    const bf16* qkva = (const bf16*)(p.ws + WS_QKVA); const bf16* pbuf = (const bf16*)(p.ws + WS_PB); const float* small = (const float*)(p.ws + WS_SMALL);
    bf16* on = (bf16*)p.out;
    const int lt = tid >> 4, piece = tid & 15;
    const float scale = 0.08838834764831845f;
    for (int dir = 0; dir < 2; ++dir) {
        float S[32];
#pragma unroll
        for (int i = 0; i < 32; ++i) S[i] = 0.f;
        float wcol[16]; float gbias = 0.f, alog = 0.f, dtb = 0.f;
        if (GLA) { const float* gw = dir ? p.gla_gate_w_b : p.gla_gate_w_f; const int i = tid & 127;
#pragma unroll
            for (int r = 0; r < 16; ++r) wcol[r] = gw[r * 512 + h * 128 + i];
            gbias = (dir ? p.gla_gate_b_b : p.gla_gate_b_f)[h * 128 + i]; }
        else { alog = __expf((dir ? p.a_log_b : p.a_log_f)[h]); dtb = (dir ? p.dt_bias_b : p.dt_bias_f)[h]; }
        for (int s = 0; s < 136; ++s) {
            const bool is_ctx = s < 8;
            const int sci = is_ctx ? (dir ? 7 - s : s) : (dir ? 127 - (s - 8) : s - 8);
            const size_t row0 = is_ctx ? (size_t)(T + b * CTXL + sci * 32) : (size_t)(b * SEQ + sci * 32);
            __syncthreads();
            { v4u qw, kw, vw;
              if (GLA) { const bf16* r = pbuf + (row0 + lt) * 2048; qw = *(const v4u*)(r + h * 128 + piece * 8); kw = *(const v4u*)(r + 512 + h * 128 + piece * 8); vw = *(const v4u*)(r + 1024 + h * 256 + vh * 128 + piece * 8); }
              else { const bf16* r = qkva + (row0 + lt) * 3072; qw = *(const v4u*)(r + h * 128 + piece * 8); kw = *(const v4u*)(r + 1024 + h * 128 + piece * 8); vw = *(const v4u*)(r + 2048 + h * 128 + piece * 8); }
              float f[8]; const int o = lt * 144 + (piece >> 2) * 36 + (piece & 3) * 8;
              unpack8(qw, f);
#pragma unroll
              for (int e = 0; e < 8; ++e) qf[o + e] = f[e] * scale;
              unpack8(kw, f);
#pragma unroll
              for (int e = 0; e < 8; ++e) kf[o + e] = f[e];
              unpack8(vw, f);
#pragma unroll
              for (int e = 0; e < 8; ++e) vf[lt * 128 + piece * 8 + e] = f[e]; }
            if (GLA) { const int i = tid & 127, tq = tid >> 7;
#pragma unroll
                for (int tt = 0; tt < 8; ++tt) { const int t = tq * 8 + tt; const float* z = small + (row0 + t) * 64 + 32 + dir * 16; float u = gbias;
#pragma unroll
                    for (int r = 0; r < 16; ++r) u += z[r] * wcol[r];
                    const float ls = fminf(u, 0.f) - log1pf(__expf(-fabsf(u)));
                    af[t * 144 + (i >> 5) * 36 + (i & 31)] = __expf(ls * (1.0f / 16.0f)); } }
            else if (tid < 32) { const float* sm = small + (row0 + tid) * 64; sb[tid] = sigmoidf_(sm[dir * 8 + h]); sa[tid] = __expf(-alog * softplusf_(sm[16 + dir * 8 + h] + dtb)); }
            __syncthreads();
            for (int tt = 0; tt < 32; ++tt) { const int t = dir ? 31 - tt : tt;
                const LAS float* kp = kf + t * 144 + part * 36; const LAS float* qp = qf + t * 144 + part * 36;
                float kk[32], qq[32];
#pragma unroll
                for (int i = 0; i < 32; i += 4) { const f32x4 a = *(const LAS f32x4*)(kp + i); kk[i] = a.x; kk[i + 1] = a.y; kk[i + 2] = a.z; kk[i + 3] = a.w;
                    const f32x4 q4 = *(const LAS f32x4*)(qp + i); qq[i] = q4.x; qq[i + 1] = q4.y; qq[i + 2] = q4.z; qq[i + 3] = q4.w; }
                const float vj = vf[t * 128 + j];
                float os = 0.f;
                if (GLA) { const LAS float* ap = af + t * 144 + part * 36;
#pragma unroll
                    for (int i = 0; i < 32; i += 4) { const f32x4 a = *(const LAS f32x4*)(ap + i);
                        S[i] = a.x * S[i] + kk[i] * vj; S[i + 1] = a.y * S[i + 1] + kk[i + 1] * vj; S[i + 2] = a.z * S[i + 2] + kk[i + 2] * vj; S[i + 3] = a.w * S[i + 3] + kk[i + 3] * vj; }
                } else { const float a = sa[t], be = sb[t]; float ks = 0.f;
#pragma unroll
                    for (int i = 0; i < 32; ++i) ks += kk[i] * S[i];
                    ks += __shfl_xor(ks, 1); ks += __shfl_xor(ks, 2);
                    const float vn = be * (vj - a * ks);
#pragma unroll
                    for (int i = 0; i < 32; ++i) S[i] = a * S[i] + kk[i] * vn; }
                if (!is_ctx) {
#pragma unroll
                    for (int i = 0; i < 32; ++i) os += qq[i] * S[i];
                    os += __shfl_xor(os, 1); os += __shfl_xor(os, 2);
                    if (part == 0) ob[t * 128 + j] = os; }
            }
            if (!is_ctx) { __syncthreads();
                bf16* dst = on + (row0 + lt) * 2048 + (GLA ? 1024 + h * 256 + vh * 128 : h * 128) + piece * 8; float f[8];
#pragma unroll
                for (int e = 0; e < 8; ++e) f[e] = ob[lt * 128 + piece * 8 + e];
                if (dir) { float g[8]; unpack8(*(const v4u*)dst, g);
#pragma unroll
                    for (int e = 0; e < 8; ++e) f[e] += g[e]; }
                *(v4u*)dst = pack8(f); }
        }
    }
}

typedef short s16x4 __attribute__((ext_vector_type(4)));
typedef float f32x2_t __attribute__((ext_vector_type(2)));
typedef __bf16 bf16x2_t __attribute__((ext_vector_type(2)));
#define MF16(a, b, c) __builtin_amdgcn_mfma_f32_16x16x16bf16_1k((a), (b), (c), 0, 0, 0)
#define MF32(a, b, c) __builtin_amdgcn_mfma_f32_16x16x32_bf16((a), (b), (c), 0, 0, 0)
__device__ __forceinline__ unsigned pk2c(float lo, float hi) { const f32x2_t v = {lo, hi}; return __builtin_bit_cast(unsigned, __builtin_convertvector(v, bf16x2_t)); }
__device__ __forceinline__ s16x4 cvt4(const f32x4 v) { v2u p; p.x = pk2c(v[0], v[1]); p.y = pk2c(v[2], v[3]); return __builtin_bit_cast(s16x4, p); }
__device__ __forceinline__ bf16x8 cat8(const s16x4 a, const s16x4 b) { return __builtin_shufflevector(a, b, 0, 1, 2, 3, 4, 5, 6, 7); }
__device__ __forceinline__ bf16x8 ldfrag(const LAS unsigned char* img, int row, int strideB, int s, int q) {
    const LAS unsigned char* p = img + row * strideB + (32 * s + 4 * q) * 2;
    return cat8(*(const LAS s16x4*)p, *(const LAS s16x4*)(p + 32));
}
__device__ __forceinline__ v4u pack8c(const float (&f)[8]) { v4u w; w.x = pk2c(f[0], f[1]); w.y = pk2c(f[2], f[3]); w.z = pk2c(f[4], f[5]); w.w = pk2c(f[6], f[7]); return w; }
constexpr int CS_KS = 272, CS_TS = 144;
constexpr int L_K = 0, L_Q = 17408, L_V = 34816, L_KT = 52224, L_O = 70656, L_AOFF = 88064, L_TD = 91136, L_ATT = 93184, L_SC = 98304;
constexpr float QSCALE = 0.08838834764831845f;
__device__ __forceinline__ int tri_idx(int bi, int bj) { return bi * (bi + 1) / 2 + bj; }
__device__ __forceinline__ int off_idx(int bi, int bj) { return bi * (bi - 1) / 2 + bj; }

__device__ __forceinline__ void build_kt_plain(LAS unsigned char* lds, int tid) {
    const int a = tid & 127, seg = tid >> 7;
#pragma unroll
    for (int mm = 0; mm < 4; ++mm) { unsigned short v[4];
#pragma unroll
        for (int e = 0; e < 4; ++e) v[e] = *(const LAS unsigned short*)(lds + L_K + (16 * seg + 4 * mm + e) * CS_KS + a * 2);
        v2u w; w.x = (unsigned)v[0] | ((unsigned)v[1] << 16); w.y = (unsigned)v[2] | ((unsigned)v[3] << 16);
        *(LAS v2u*)(lds + L_KT + a * CS_TS + (16 * seg + 4 * mm) * 2) = w; }
}

__device__ __forceinline__ void gdn_unit(const P& p, LAS unsigned char* lds, const int b, const int h) {
    const int tid = threadIdx.x, lane = tid & 63, wave = __builtin_amdgcn_readfirstlane(tid >> 6), r = lane & 15, q = lane >> 4;
    const int c0 = wave * 16;
    const bf16* qkva = (const bf16*)(p.ws + WS_QKVA); const float* small = (const float*)(p.ws + WS_SMALL); bf16* on = (bf16*)p.out;
    const int lt = tid >> 4, piece = tid & 15;
    LAS float* scb = (LAS float*)(lds + L_SC); LAS float* scG = scb + 64; LAS float* sceG = scb + 128; LAS float* scdK = scb + 192; LAS float* scl = scb + 256;
    float gn[8];
#pragma unroll
    for (int e = 0; e < 8; ++e) gn[e] = p.gdn_norm_g[piece * 8 + e];
    for (int dir = 0; dir < 2; ++dir) {
        f32x4 S[8];
#pragma unroll
        for (int u = 0; u < 8; ++u) S[u] = (f32x4){0.f, 0.f, 0.f, 0.f};
        const float alog = __expf((dir ? p.a_log_b : p.a_log_f)[h]), dtb = (dir ? p.dt_bias_b : p.dt_bias_f)[h];
        v4u pq[2], pk[2], pv[2]; float pgb = 0.f, pga = 0.f;
#define GDN_ROW0(s_) (((s_) < 4) ? (size_t)(T + b * CTXL + (dir ? 3 - (s_) : (s_)) * 64) : (size_t)(b * SEQ + (dir ? 63 - ((s_) - 4) : (s_) - 4) * 64))
#define GDN_PREFETCH(s_) do { const size_t r0_ = GDN_ROW0(s_); \
            _Pragma("unroll") for (int jj = 0; jj < 2; ++jj) { const int pp = lt + 32 * jj; const bf16* rp = qkva + (r0_ + (dir ? 63 - pp : pp)) * 3072 + h * 128 + piece * 8; \
                pq[jj] = *(const v4u*)rp; pk[jj] = *(const v4u*)(rp + 1024); pv[jj] = *(const v4u*)(rp + 2048); } \
            if (wave == 0) { const float* sm = small + (r0_ + (dir ? 63 - lane : lane)) * 64; pgb = sm[dir * 8 + h]; pga = sm[16 + dir * 8 + h]; } } while (0)
        GDN_PREFETCH(0);
        for (int s = 0; s < 68; ++s) {
            const bool is_ctx = s < 4;
            const size_t row0 = GDN_ROW0(s);
            __syncthreads();
            if (wave == 0) {
                const float be = sigmoidf_(pgb); float G = -alog * softplusf_(pga + dtb);
#pragma unroll
                for (int d = 1; d < 64; d <<= 1) { const float t = __shfl_up(G, d); if (lane >= d) G += t; }
                const float G63 = __shfl(G, 63);
                scb[lane] = be; scG[lane] = G; sceG[lane] = __expf(G); scdK[lane] = __expf(G63 - G); if (lane == 0) scl[0] = __expf(G63);
            }
#pragma unroll
            for (int jj = 0; jj < 2; ++jj) { const int pp = lt + 32 * jj;
                *(LAS v4u*)(lds + L_K + pp * CS_KS + piece * 16) = pk[jj]; *(LAS v4u*)(lds + L_Q + pp * CS_KS + piece * 16) = pq[jj]; *(LAS v4u*)(lds + L_V + pp * CS_KS + piece * 16) = pv[jj]; }
            __syncthreads();
            if (s + 1 < 68) GDN_PREFETCH(s + 1);
            build_kt_plain(lds, tid);
            if (wave < 4) {
                const int bb = wave; f32x4 kk = (f32x4){0.f, 0.f, 0.f, 0.f}, qk = (f32x4){0.f, 0.f, 0.f, 0.f};
#pragma unroll
                for (int ks = 0; ks < 4; ++ks) { const bf16x8 kf = ldfrag(lds + L_K, 16 * bb + r, CS_KS, ks, q); const bf16x8 qf = ldfrag(lds + L_Q, 16 * bb + r, CS_KS, ks, q);
                    kk = MF32(kf, kf, kk); qk = MF32(kf, qf, qk); }
                const float Gr = scG[16 * bb + r], br = scb[16 * bb + r];
                const f32x4 Ge = *(const LAS f32x4*)(scG + 16 * bb + 4 * q), be4 = *(const LAS f32x4*)(scb + 16 * bb + 4 * q);
                f32x4 A, At, att;
#pragma unroll
                for (int e = 0; e < 4; ++e) { const int ie = 4 * q + e; const float dlo = __expf(fminf(Ge[e] - Gr, 0.f)), dhi = __expf(fminf(Gr - Ge[e], 0.f));
                    A[e] = (r < ie) ? be4[e] * kk[e] * dlo : 0.f;
                    At[e] = (ie < r) ? br * kk[e] * dhi : 0.f;
                    att[e] = (ie <= r) ? QSCALE * qk[e] * dhi : 0.f; }
                *(LAS s16x4*)(lds + L_ATT + tri_idx(bb, bb) * 512 + lane * 8) = cvt4(att);
                const f32x4 Z = (f32x4){0.f, 0.f, 0.f, 0.f};
                f32x4 Rt;
#pragma unroll
                for (int e = 0; e < 4; ++e) Rt[e] = ((4 * q + e) == r ? 1.f : 0.f) - At[e];
                f32x4 Pm = MF16(cvt4(At), cvt4(A), Z), Pt = MF16(cvt4(A), cvt4(At), Z);
                Rt = MF16(cvt4(Pm), cvt4(Rt), Rt);
                f32x4 P2 = MF16(cvt4(Pt), cvt4(Pm), Z), Pt2 = MF16(cvt4(Pm), cvt4(Pt), Z);
                Rt = MF16(cvt4(P2), cvt4(Rt), Rt);
                f32x4 P4 = MF16(cvt4(Pt2), cvt4(P2), Z);
                Rt = MF16(cvt4(P4), cvt4(Rt), Rt);
                *(LAS s16x4*)(lds + L_TD + bb * 512 + lane * 8) = cvt4(Rt);
            } else {
#pragma unroll
                for (int uu = 0; uu < 3; ++uu) { const int un = (wave - 4) + 4 * uu; const int pr = un % 6; const bool isqk = un >= 6;
                    const int bi = pr == 0 ? 1 : (pr < 3 ? 2 : 3), bj = pr == 0 ? 0 : (pr < 3 ? pr - 1 : pr - 3);
                    f32x4 d = (f32x4){0.f, 0.f, 0.f, 0.f};
                    const LAS unsigned char* bimg = lds + (isqk ? L_Q : L_K);
#pragma unroll
                    for (int ks = 0; ks < 4; ++ks) d = MF32(ldfrag(lds + L_K, 16 * bj + r, CS_KS, ks, q), ldfrag(bimg, 16 * bi + r, CS_KS, ks, q), d);
                    const float Gi = scG[16 * bi + r], bi_ = scb[16 * bi + r]; const f32x4 Gj = *(const LAS f32x4*)(scG + 16 * bj + 4 * q);
                    const float f = isqk ? QSCALE : -bi_;
#pragma unroll
                    for (int e = 0; e < 4; ++e) d[e] = f * d[e] * __expf(fminf(Gi - Gj[e], 0.f));
                    *(LAS s16x4*)(lds + (isqk ? L_ATT + tri_idx(bi, bj) * 512 : L_AOFF + off_idx(bi, bj) * 512) + lane * 8) = cvt4(d); }
            }
            __syncthreads();
            bf16x8 Sb[4];
#pragma unroll
            for (int ks = 0; ks < 4; ++ks) Sb[ks] = cat8(cvt4(S[2 * ks]), cvt4(S[2 * ks + 1]));
            f32x4 vn[4];
#pragma unroll
            for (int t = 0; t < 4; ++t) { f32x4 X = (f32x4){0.f, 0.f, 0.f, 0.f};
#pragma unroll
                for (int ks = 0; ks < 4; ++ks) X = MF32(ldfrag(lds + L_K, 16 * t + r, CS_KS, ks, q), Sb[ks], X);
                const f32x4 be4 = *(const LAS f32x4*)(scb + 16 * t + 4 * q), eg4 = *(const LAS f32x4*)(sceG + 16 * t + 4 * q);
#pragma unroll
                for (int e = 0; e < 4; ++e) { const float v = bflo((unsigned)*(const LAS unsigned short*)(lds + L_V + (16 * t + 4 * q + e) * CS_KS + (c0 + r) * 2));
                    vn[t][e] = be4[e] * (v - eg4[e] * X[e]); } }
            vn[0] = MF16(*(const LAS s16x4*)(lds + L_TD + lane * 8), cvt4(vn[0]), ((f32x4){0.f, 0.f, 0.f, 0.f}));
#pragma unroll
            for (int bi = 1; bi < 4; ++bi) { f32x4 a = vn[bi];
#pragma unroll
                for (int bj = 0; bj < bi; ++bj) a = MF16(*(const LAS s16x4*)(lds + L_AOFF + off_idx(bi, bj) * 512 + lane * 8), cvt4(vn[bj]), a);
                vn[bi] = MF16(*(const LAS s16x4*)(lds + L_TD + bi * 512 + lane * 8), cvt4(a), ((f32x4){0.f, 0.f, 0.f, 0.f})); }
            if (!is_ctx) {
#pragma unroll
                for (int t = 0; t < 4; ++t) { f32x4 o = (f32x4){0.f, 0.f, 0.f, 0.f};
#pragma unroll
                    for (int ks = 0; ks < 4; ++ks) o = MF32(ldfrag(lds + L_Q, 16 * t + r, CS_KS, ks, q), Sb[ks], o);
                    const f32x4 eg4 = *(const LAS f32x4*)(sceG + 16 * t + 4 * q);
#pragma unroll
                    for (int e = 0; e < 4; ++e) o[e] *= QSCALE * eg4[e];
#pragma unroll
                    for (int tj = 0; tj <= t; ++tj) o = MF16(*(const LAS s16x4*)(lds + L_ATT + tri_idx(t, tj) * 512 + lane * 8), cvt4(vn[tj]), o);
#pragma unroll
                    for (int e = 0; e < 4; ++e) *(LAS unsigned short*)(lds + L_O + (16 * t + 4 * q + e) * CS_KS + (c0 + r) * 2) = (unsigned short)(pk2c(o[e], 0.f) & 0xffffu); }
            }
            { const float egl = scl[0]; s16x4 vd[4];
#pragma unroll
              for (int t = 0; t < 4; ++t) { const f32x4 dk4 = *(const LAS f32x4*)(scdK + 16 * t + 4 * q); vd[t] = cvt4(vn[t] * dk4); }
              const bf16x8 vb0 = cat8(vd[0], vd[1]), vb1 = cat8(vd[2], vd[3]);
#pragma unroll
              for (int u = 0; u < 8; ++u) { f32x4 a = S[u] * egl;
                  a = MF32(ldfrag(lds + L_KT, 16 * u + r, CS_TS, 0, q), vb0, a); a = MF32(ldfrag(lds + L_KT, 16 * u + r, CS_TS, 1, q), vb1, a); S[u] = a; } }
            if (!is_ctx) {
                __syncthreads();
#pragma unroll
                for (int jj = 0; jj < 2; ++jj) { const int pp = lt + 32 * jj; float f[8]; unpack8(*(const LAS v4u*)(lds + L_O + pp * CS_KS + piece * 16), f);
                    bf16* dst = on + (row0 + (dir ? 63 - pp : pp)) * 2048 + h * 128 + piece * 8;
                    if (dir) { float g[8]; unpack8(*(const v4u*)dst, g); float ss = 0.f;
#pragma unroll
                        for (int e = 0; e < 8; ++e) { f[e] += g[e]; ss += f[e] * f[e]; }
                        ss += __shfl_xor(ss, 1); ss += __shfl_xor(ss, 2); ss += __shfl_xor(ss, 4); ss += __shfl_xor(ss, 8);
                        const float rstd = 1.0f / sqrtf(ss * (1.f / 128.f) + EPS);
#pragma unroll
                        for (int e = 0; e < 8; ++e) f[e] *= rstd * gn[e]; }
                    *(v4u*)dst = pack8c(f); }
            }
        }
#undef GDN_PREFETCH
#undef GDN_ROW0
    }
}

__device__ __forceinline__ void gla_unit(const P& p, LAS unsigned char* lds, const int b, const int h, const int vh) {
    const int tid = threadIdx.x, lane = tid & 63, wave = __builtin_amdgcn_readfirstlane(tid >> 6), r = lane & 15, q = lane >> 4;
    const int c0 = wave * 16;
    const bf16* pbuf = (const bf16*)(p.ws + WS_PB); const float* small = (const float*)(p.ws + WS_SMALL); bf16* on = (bf16*)p.out;
    const int lt = tid >> 4, piece = tid & 15;
    LAS float* gl = (LAS float*)(lds + L_SC); LAS float* segsum = gl + 128; LAS float* zl = gl + 1152;
    const int cp = tid & 63, sg = tid >> 6;
    for (int dir = 0; dir < 2; ++dir) {
        f32x4 S[8];
#pragma unroll
        for (int u = 0; u < 8; ++u) S[u] = (f32x4){0.f, 0.f, 0.f, 0.f};
        float wc0[16], wc1[16];
        { const float* gw = dir ? p.gla_gate_w_b : p.gla_gate_w_f;
#pragma unroll
          for (int rr = 0; rr < 16; ++rr) { const f32x2_t w2 = *(const f32x2_t*)(gw + rr * 512 + h * 128 + 2 * cp); wc0[rr] = w2[0]; wc1[rr] = w2[1]; } }
        const f32x2_t gb2 = *(const f32x2_t*)((dir ? p.gla_gate_b_b : p.gla_gate_b_f) + h * 128 + 2 * cp);
        v4u pq[2], pk[2], pv[2]; float pz[2];
#define GLA_ROW0(s_) (((s_) < 4) ? (size_t)(T + b * CTXL + (dir ? 3 - (s_) : (s_)) * 64) : (size_t)(b * SEQ + (dir ? 63 - ((s_) - 4) : (s_) - 4) * 64))
#define GLA_PREFETCH(s_) do { const size_t r0_ = GLA_ROW0(s_); \
            _Pragma("unroll") for (int jj = 0; jj < 2; ++jj) { const int pp = lt + 32 * jj; const bf16* rp = pbuf + (r0_ + (dir ? 63 - pp : pp)) * 2048; \
                pq[jj] = *(const v4u*)(rp + h * 128 + piece * 8); pk[jj] = *(const v4u*)(rp + 512 + h * 128 + piece * 8); pv[jj] = *(const v4u*)(rp + 1024 + h * 256 + vh * 128 + piece * 8); \
                pz[jj] = small[(r0_ + (dir ? 63 - pp : pp)) * 64 + 32 + dir * 16 + piece]; } } while (0)
        GLA_PREFETCH(0);
        for (int s = 0; s < 68; ++s) {
            const bool is_ctx = s < 4;
            const size_t row0 = GLA_ROW0(s);
            __syncthreads();
#pragma unroll
            for (int jj = 0; jj < 2; ++jj) { const int pp = lt + 32 * jj;
                *(LAS v4u*)(lds + L_K + pp * CS_KS + piece * 16) = pk[jj]; *(LAS v4u*)(lds + L_Q + pp * CS_KS + piece * 16) = pq[jj]; *(LAS v4u*)(lds + L_V + pp * CS_KS + piece * 16) = pv[jj];
                zl[pp * 16 + piece] = pz[jj]; }
            __syncthreads();
            if (s + 1 < 68) GLA_PREFETCH(s + 1);
            float gc0[8], gc1[8];
            { float run0 = 0.f, run1 = 0.f;
#pragma unroll
              for (int m = 0; m < 8; ++m) { const LAS float* z = zl + (8 * sg + m) * 16; float u0 = gb2[0], u1 = gb2[1];
#pragma unroll
                  for (int rr = 0; rr < 16; rr += 4) { const f32x4 z4 = *(const LAS f32x4*)(z + rr);
#pragma unroll
                      for (int e = 0; e < 4; ++e) { u0 += z4[e] * wc0[rr + e]; u1 += z4[e] * wc1[rr + e]; } }
                  const float ls0 = fminf(u0, 0.f) - __logf(1.0f + __expf(-fabsf(u0))), ls1 = fminf(u1, 0.f) - __logf(1.0f + __expf(-fabsf(u1)));
                  run0 += ls0 * (1.0f / 16.0f); run1 += ls1 * (1.0f / 16.0f); gc0[m] = run0; gc1[m] = run1; }
              *(LAS f32x2_t*)(segsum + sg * 128 + 2 * cp) = (f32x2_t){run0, run1}; }
            __syncthreads();
            { float pre0 = 0.f, pre1 = 0.f, tot0 = 0.f, tot1 = 0.f;
#pragma unroll
              for (int s2 = 0; s2 < 8; ++s2) { const f32x2_t v = *(const LAS f32x2_t*)(segsum + s2 * 128 + 2 * cp); tot0 += v[0]; tot1 += v[1]; if (s2 < sg) { pre0 += v[0]; pre1 += v[1]; } }
              if (sg == 0) *(LAS f32x2_t*)(gl + 2 * cp) = (f32x2_t){__expf(tot0), __expf(tot1)};
              float kd0[8], kd1[8];
#pragma unroll
              for (int m = 0; m < 8; ++m) { const int pp = 8 * sg + m; const float g0 = gc0[m] + pre0, g1 = gc1[m] + pre1;
                  LAS unsigned* qp = (LAS unsigned*)(lds + L_Q + pp * CS_KS + cp * 4); LAS unsigned* kp = (LAS unsigned*)(lds + L_K + pp * CS_KS + cp * 4);
                  const unsigned qw = *qp, kw = *kp;
                  *qp = pk2c(bflo(qw) * QSCALE * __expf(g0), bfhi(qw) * QSCALE * __expf(g1));
                  *kp = pk2c(bflo(kw) * __expf(fminf(-g0, 80.f)), bfhi(kw) * __expf(fminf(-g1, 80.f)));
                  kd0[m] = bflo(kw) * __expf(tot0 - g0); kd1[m] = bfhi(kw) * __expf(tot1 - g1); }
              *(LAS v4u*)(lds + L_KT + (2 * cp) * CS_TS + sg * 16) = pack8c(kd0);
              *(LAS v4u*)(lds + L_KT + (2 * cp + 1) * CS_TS + sg * 16) = pack8c(kd1); }
            __syncthreads();
            if (!is_ctx) {
#pragma unroll
                for (int uu = 0; uu < 2; ++uu) { const int un = wave + 8 * uu; if (un < 10) {
                    const int bi = un < 1 ? 0 : (un < 3 ? 1 : (un < 6 ? 2 : 3)), bj = un - bi * (bi + 1) / 2;
                    f32x4 d = (f32x4){0.f, 0.f, 0.f, 0.f};
#pragma unroll
                    for (int ks = 0; ks < 4; ++ks) d = MF32(ldfrag(lds + L_K, 16 * bj + r, CS_KS, ks, q), ldfrag(lds + L_Q, 16 * bi + r, CS_KS, ks, q), d);
                    if (bi == bj) {
#pragma unroll
                        for (int e = 0; e < 4; ++e) d[e] = ((4 * q + e) <= r) ? d[e] : 0.f; }
                    *(LAS s16x4*)(lds + L_ATT + un * 512 + lane * 8) = cvt4(d); } }
                __syncthreads();
            }
            bf16x8 Sb[4];
#pragma unroll
            for (int ks = 0; ks < 4; ++ks) Sb[ks] = cat8(cvt4(S[2 * ks]), cvt4(S[2 * ks + 1]));
            s16x4 vt[4];
#pragma unroll
            for (int t = 0; t < 4; ++t) { unsigned short v[4];
#pragma unroll
                for (int e = 0; e < 4; ++e) v[e] = *(const LAS unsigned short*)(lds + L_V + (16 * t + 4 * q + e) * CS_KS + (c0 + r) * 2);
                v2u w; w.x = (unsigned)v[0] | ((unsigned)v[1] << 16); w.y = (unsigned)v[2] | ((unsigned)v[3] << 16); vt[t] = __builtin_bit_cast(s16x4, w); }
            if (!is_ctx) {
#pragma unroll
                for (int t = 0; t < 4; ++t) { f32x4 o = (f32x4){0.f, 0.f, 0.f, 0.f};
#pragma unroll
                    for (int ks = 0; ks < 4; ++ks) o = MF32(ldfrag(lds + L_Q, 16 * t + r, CS_KS, ks, q), Sb[ks], o);
#pragma unroll
                    for (int tj = 0; tj <= t; ++tj) o = MF16(*(const LAS s16x4*)(lds + L_ATT + tri_idx(t, tj) * 512 + lane * 8), vt[tj], o);
#pragma unroll
                    for (int e = 0; e < 4; ++e) *(LAS unsigned short*)(lds + L_O + (16 * t + 4 * q + e) * CS_KS + (c0 + r) * 2) = (unsigned short)(pk2c(o[e], 0.f) & 0xffffu); }
            }
            { const bf16x8 vb0 = cat8(vt[0], vt[1]), vb1 = cat8(vt[2], vt[3]);
#pragma unroll
              for (int u = 0; u < 8; ++u) { const f32x4 g4 = *(const LAS f32x4*)(gl + 16 * u + 4 * q); f32x4 a = S[u] * g4;
                  a = MF32(ldfrag(lds + L_KT, 16 * u + r, CS_TS, 0, q), vb0, a); a = MF32(ldfrag(lds + L_KT, 16 * u + r, CS_TS, 1, q), vb1, a); S[u] = a; } }
            if (!is_ctx) {
                __syncthreads();
#pragma unroll
                for (int jj = 0; jj < 2; ++jj) { const int pp = lt + 32 * jj; float f[8]; unpack8(*(const LAS v4u*)(lds + L_O + pp * CS_KS + piece * 16), f);
                    bf16* dst = on + (row0 + (dir ? 63 - pp : pp)) * 2048 + 1024 + h * 256 + vh * 128 + piece * 8;
                    if (dir) { float g[8]; unpack8(*(const v4u*)dst, g);
#pragma unroll
                        for (int e = 0; e < 8; ++e) f[e] += g[e]; }
                    *(v4u*)dst = pack8c(f); }
            }
        }
#undef GLA_PREFETCH
#undef GLA_ROW0
    }
}
#ifndef SCAN_ORACLE
#define SCAN_ORACLE 0
#endif
__device__ __forceinline__ void phase_scan(const P& p, LAS unsigned char* lds) {
    for (int u = blockIdx.x; u < 256; u += gridDim.x) {
#if SCAN_ORACLE
        if (u < 128) scan_unit<false>(p, lds, u >> 3, u & 7, 0);
        else { const int v = u - 128; scan_unit<true>(p, lds, v >> 3, (v >> 1) & 3, v & 1); }
#else
#ifndef GLA_ORACLE
#define GLA_ORACLE 0
#endif
        if ((u & 1) == 0) { const int v = u >> 1; gdn_unit(p, lds, v >> 3, v & 7); }
#if GLA_ORACLE
        else { const int v = u >> 1; scan_unit<true>(p, lds, v >> 3, (v >> 1) & 3, v & 1); }
#else
        else { const int v = u >> 1; gla_unit(p, lds, v >> 3, (v >> 1) & 3, v & 1); }
#endif
#endif
        __syncthreads();
    }
}

__device__ __forceinline__ void phase_onorm(const P& p) {
    const int tid = threadIdx.x, lane = tid & 63, wave = tid >> 6;
    const int gw = blockIdx.x * NWAVES + wave, NGW = gridDim.x * NWAVES;
    bf16* on = (bf16*)p.out;
#if SCAN_ORACLE
    const float* gp = lane < 32 ? p.gdn_norm_g + (lane & 3) * 32 : p.gla_norm_g + ((lane - 32) & 7) * 32;
    float g[32];
#pragma unroll
    for (int i = 0; i < 32; ++i) g[i] = gp[i];
    for (int r = gw; r < T; r += NGW) {
        v4u* ptr = (v4u*)(on + (size_t)r * 2048 + lane * 32); float f[32]; float ss = 0.f;
#pragma unroll
        for (int q = 0; q < 4; ++q) { float t8[8]; unpack8(ptr[q], t8);
#pragma unroll
            for (int e = 0; e < 8; ++e) { f[q * 8 + e] = t8[e]; ss += t8[e] * t8[e]; } }
        ss += __shfl_xor(ss, 1); ss += __shfl_xor(ss, 2);
        const float s4 = __shfl_xor(ss, 4);
        const float rstd = lane < 32 ? 1.0f / sqrtf(ss * (1.f / 128.f) + EPS) : 1.0f / sqrtf((ss + s4) * (1.f / 256.f) + EPS);
#pragma unroll
        for (int q = 0; q < 4; ++q) { float t8[8];
#pragma unroll
            for (int e = 0; e < 8; ++e) t8[e] = f[q * 8 + e] * rstd * g[q * 8 + e];
            ptr[q] = pack8(t8); }
    }
#else
    float g[16];
#pragma unroll
    for (int i = 0; i < 16; ++i) g[i] = p.gla_norm_g[(lane & 15) * 16 + i];
    for (int r = gw; r < T; r += NGW) {
        v4u* ptr = (v4u*)(on + (size_t)r * 2048 + 1024 + lane * 16); float f[16]; float ss = 0.f;
#pragma unroll
        for (int q = 0; q < 2; ++q) { float t8[8]; unpack8(ptr[q], t8);
#pragma unroll
            for (int e = 0; e < 8; ++e) { f[q * 8 + e] = t8[e]; ss += t8[e] * t8[e]; } }
        ss += __shfl_xor(ss, 1); ss += __shfl_xor(ss, 2); ss += __shfl_xor(ss, 4); ss += __shfl_xor(ss, 8);
        const float rstd = 1.0f / sqrtf(ss * (1.f / 256.f) + EPS);
#pragma unroll
        for (int q = 0; q < 2; ++q) { float t8[8];
#pragma unroll
            for (int e = 0; e < 8; ++e) t8[e] = f[q * 8 + e] * rstd * g[q * 8 + e];
            ptr[q] = pack8(t8); }
    }
#endif
}

__device__ __forceinline__ void phase_wconv(const P& p, LAS unsigned char* lds) {
    const int tid = threadIdx.x, lane = tid & 63, wave = tid >> 6;
    LAS float* scr = (LAS float*)(lds + wave * 8448);
    const int gw = blockIdx.x * NWAVES + wave, NGW = gridDim.x * NWAVES;
    bf16* wgu = (bf16*)(p.ws + WS_WB_GU); bf16* wdn = (bf16*)(p.ws + WS_WB_DN);
    constexpr int I_GU = NE * 64 * 16, I_DN = NE * 32 * 16;
    for (int it = gw; it < I_GU + I_DN; it += NGW) {
        if (it < I_GU) { const int e = it >> 10, r = it & 1023, nb = r >> 4, kb = r & 15;
            const int dstrow = nb < 32 ? (nb >> 2) * 256 + (nb & 3) * 32 : ((nb - 32) >> 2) * 256 + 128 + ((nb - 32) & 3) * 32;
            tr_item(p.w_gu + (size_t)e * D * 2048, 2048, 32 * nb, wgu + (size_t)e * 2048 * D, dstrow, 64 * kb, scr, lane); }
        else { const int r2 = it - I_GU; const int e = r2 >> 9, r = r2 & 511, nb = r >> 4, kb = r & 15;
            tr_item(p.w_down + (size_t)e * D * D, D, 32 * nb, wdn + (size_t)e * D * D, 32 * nb, 64 * kb, scr, lane); }
    }
}

__device__ __forceinline__ void phase_ffnprep(const P& p, LAS unsigned char* lds) {
    const int tid = threadIdx.x, lane = tid & 63, wave = tid >> 6;
    const int gw = blockIdx.x * NWAVES + wave, NGW = gridDim.x * NWAVES;
    LAS float* wrt = (LAS float*)lds;
    LAS int* lcnt = (LAS int*)(lds + 131072);
    for (int i = tid; i < 32 * 1024; i += NTHREADS) { const int k = i >> 5, e = i & 31; wrt[e * 1024 + k] = p.w_router[i]; }
    if (tid < NG * 32) lcnt[tid] = 0;
    { int* st = (int*)(p.ws + WS_SLOT_TOK); float* sp = (float*)(p.ws + WS_SLOT_P);
      for (int i = blockIdx.x * NTHREADS + tid; i < NG * MAXSLOT; i += gridDim.x * NTHREADS) { st[i] = -1; sp[i] = 0.f; } }
    __syncthreads();
    const float* modv = (const float*)(p.ws + WS_MODV); bf16* h2 = (bf16*)(p.ws + WS_H2);
    int* topi = (int*)(p.ws + WS_TOPI); float* topp = (float*)(p.ws + WS_TOPP);
    float br[32];
#pragma unroll
    for (int e = 0; e < 32; ++e) br[e] = p.b_router[e];
    for (int r = gw; r < T; r += NGW) {
        const int b = r >> 12;
        const f32x4* xr = (const f32x4*)(p.out + (size_t)r * D) + lane;
        f32x4 v[4]; float s = 0.f;
#pragma unroll
        for (int j = 0; j < 4; ++j) { v[j] = xr[64 * j]; s += (v[j].x * v[j].x + v[j].y * v[j].y) + (v[j].z * v[j].z + v[j].w * v[j].w); }
        const float rstd = 1.0f / sqrtf(wave_sum(s) * (1.f / D) + EPS);
        const f32x4* g = (const f32x4*)p.norm_ffn_g + lane; const f32x4* sh = (const f32x4*)(modv + b * NMOD + 3 * D) + lane; const f32x4* scl = (const f32x4*)(modv + b * NMOD + 4 * D) + lane;
        v2u* o8 = (v2u*)(h2 + (size_t)r * D) + lane;
#pragma unroll
        for (int j = 0; j < 4; ++j) { const f32x4 gg = g[64 * j], s1 = sh[64 * j], s2 = scl[64 * j]; v[j] = v[j] * rstd * gg * (1.0f + s2) + s1;
            v2u w; w.x = pk2(v[j].x, v[j].y); w.y = pk2(v[j].z, v[j].w); o8[64 * j] = w; }
        float lg[32];
#pragma unroll
        for (int e = 0; e < 32; ++e) { float a = 0.f;
#pragma unroll
            for (int j = 0; j < 4; ++j) { const f32x4 wv = *(const LAS f32x4*)(wrt + e * 1024 + (lane + 64 * j) * 4); a += (v[j].x * wv.x + v[j].y * wv.y) + (v[j].z * wv.z + v[j].w * wv.w); }
            lg[e] = wave_sum(a) + br[e]; }
        int sel[4]; float val[4];
#pragma unroll
        for (int k = 0; k < 4; ++k) { float best = -3.0e38f; int bi = 0;
#pragma unroll
            for (int e = 0; e < 32; ++e) { if (lg[e] > best) { best = lg[e]; bi = e; } }
            sel[k] = bi; val[k] = best;
#pragma unroll
            for (int e = 0; e < 32; ++e) lg[e] = (e == bi) ? -3.0e38f : lg[e]; }
        float pe[4], ps = 0.f;
#pragma unroll
        for (int k = 0; k < 4; ++k) { pe[k] = __expf(val[k] - val[0]); ps += pe[k]; }
        if (lane < 4) { const int k = lane; const int e = k == 0 ? sel[0] : (k == 1 ? sel[1] : (k == 2 ? sel[2] : sel[3])); const float pv = (k == 0 ? pe[0] : (k == 1 ? pe[1] : (k == 2 ? pe[2] : pe[3]))) / ps;
            topi[r * 4 + k] = e; topp[r * 4 + k] = pv; lds_add(&lcnt[(r / TG) * 32 + e], 1); }
    }
    __syncthreads();
    if (tid < NG * 32) { const int v = lcnt[tid]; if (v) atomicAdd((int*)(p.ws + WS_CTL) + CW_CNT + tid, v); }
}

__device__ __forceinline__ void phase_route(const P& p, LAS unsigned char* lds) {
    const int tid = threadIdx.x;
    LAS int* seg = (LAS int*)lds;
    LAS int* lcnt = seg + 64; LAS int* gb = lcnt + 32;
    int* ctl = (int*)(p.ws + WS_CTL);
    int* tile_e = (int*)(p.ws + WS_TILE_E);
    if (tid == 0) {
        for (int g = 0; g < NG; ++g) { int acc = 0;
            for (int e = 0; e < NE; ++e) { const int c = __hip_atomic_load(ctl + CW_CNT + g * 32 + e, __ATOMIC_RELAXED, __HIP_MEMORY_SCOPE_AGENT); const int padded = (c + 255) & ~255; seg[g * 32 + e] = acc;
                if (blockIdx.x == 0) for (int t = acc >> 8; t < (acc + padded) >> 8; ++t) tile_e[g * MAXTILE + t] = e;
                acc += padded; }
            if (blockIdx.x == 0) ctl[CW_NTILE + g] = acc >> 8; }
    }
    __syncthreads();
    const int* topi = (const int*)(p.ws + WS_TOPI); const float* topp = (const float*)(p.ws + WS_TOPP);
    int* slot_tok = (int*)(p.ws + WS_SLOT_TOK); float* slot_p = (float*)(p.ws + WS_SLOT_P); int* tokslot = (int*)(p.ws + WS_TOKSLOT);
    for (int base = blockIdx.x * 256; base < T; base += gridDim.x * 256) {
        const int g = base / TG;
        if (tid < 32) lcnt[tid] = 0;
        __syncthreads();
        int e2[2], lp[2];
#pragma unroll
        for (int jj = 0; jj < 2; ++jj) { const int i = tid + 512 * jj; e2[jj] = topi[base * 4 + i]; lp[jj] = lds_add(&lcnt[e2[jj]], 1); }
        __syncthreads();
        if (tid < 32) gb[tid] = lcnt[tid] ? atomicAdd(ctl + CW_CUR + g * 32 + tid, lcnt[tid]) : 0;
        __syncthreads();
#pragma unroll
        for (int jj = 0; jj < 2; ++jj) { const int i = tid + 512 * jj; const int slot = seg[g * 32 + e2[jj]] + gb[e2[jj]] + lp[jj];
            slot_tok[g * MAXSLOT + slot] = base + (i >> 2); slot_p[g * MAXSLOT + slot] = topp[base * 4 + i]; tokslot[base * 4 + i] = slot; }
        __syncthreads();
    }
}

__device__ __forceinline__ void phase_combine(const P& p, int g) {
    const int tid = threadIdx.x, lane = tid & 63, wave = tid >> 6;
    const int gw = blockIdx.x * NWAVES + wave, NGW = gridDim.x * NWAVES;
    const float* modv = (const float*)(p.ws + WS_MODV); const bf16* ys = (const bf16*)(p.ws + WS_YSLOT); const int* tokslot = (const int*)(p.ws + WS_TOKSLOT);
    for (int r = g * TG + gw; r < (g + 1) * TG; r += NGW) {
        const int b = r >> 12;
        f32x4* xr = (f32x4*)(p.out + (size_t)r * D) + lane;
        const f32x4* g2 = (const f32x4*)(modv + b * NMOD + 5 * D) + lane;
        f32x4 y[4];
#pragma unroll
        for (int j = 0; j < 4; ++j) y[j] = (f32x4){0.f, 0.f, 0.f, 0.f};
#pragma unroll
        for (int k = 0; k < 4; ++k) { const int slot = tokslot[r * 4 + k]; const v2u* yr = (const v2u*)(ys + (size_t)slot * D) + lane;
#pragma unroll
            for (int j = 0; j < 4; ++j) { const v2u w = yr[64 * j]; y[j].x += bflo(w.x); y[j].y += bfhi(w.x); y[j].z += bflo(w.y); y[j].w += bfhi(w.y); } }
        f32x4 v[4]; float s = 0.f;
#pragma unroll
        for (int j = 0; j < 4; ++j) { v[j] = xr[64 * j] + g2[64 * j] * y[j]; s += (v[j].x * v[j].x + v[j].y * v[j].y) + (v[j].z * v[j].z + v[j].w * v[j].w); }
        const float rstd = 1.0f / sqrtf(wave_sum(s) * (1.f / D) + EPS);
        const f32x4* fg = (const f32x4*)p.final_norm_g + lane;
#pragma unroll
        for (int j = 0; j < 4; ++j) xr[64 * j] = v[j] * rstd * fg[64 * j];
    }
}

constexpr int N_PHASES = 13 + 3 * NG;
template <int PH>
__device__ __forceinline__ void run_phase(const P& p, LAS unsigned char* lds) {
    const int G = gridDim.x, c = blockIdx.x;
    unsigned char* ws = p.ws;
    if constexpr (PH == 0) phase_prologue(p, lds);
    else if constexpr (PH == 1) phase_norm1(p);
    else if constexpr (PH == 2) { pg8::SchedDense S{TT / 256, N_S / 256, G, c}; EpiG1 E{(bf16*)(ws + WS_QKVA), (bf16*)(ws + WS_PB), (float*)(ws + WS_SMALL)};
        pg8::gemm_phase(lds, (const bf16*)(ws + WS_H), (const bf16*)(ws + WS_BT_S), D, S, E); }
    else if constexpr (PH == 3) phase_conv(p, lds);
    else if constexpr (PH == 4) phase_scan(p, lds);
    else if constexpr (PH == 5) phase_onorm(p);
    else if constexpr (PH == 6) phase_wconv(p, lds);
    else if constexpr (PH == 7) { pg8::SchedDense S{T / 256, N_G / 256, G, c}; EpiG2 E{(const bf16*)p.out, (bf16*)(ws + WS_YA_IN), (bf16*)(ws + WS_YB_IN), (bf16*)(ws + WS_GATES)};
        pg8::gemm_phase(lds, (const bf16*)(ws + WS_H), (const bf16*)(ws + WS_BT_G), D, S, E); }
    else if constexpr (PH == 8) { pg8::SchedDense S{T / 256, 4, G, c}; EpiG34<0> E{(const bf16*)(ws + WS_GATES), (bf16*)(ws + WS_Y)};
        pg8::gemm_phase(lds, (const bf16*)(ws + WS_YA_IN), (const bf16*)(ws + WS_BT_OA), D, S, E); }
    else if constexpr (PH == 9) { pg8::SchedDense S{T / 256, 4, G, c}; EpiG34<1> E{(const bf16*)(ws + WS_GATES), (bf16*)(ws + WS_Y)};
        pg8::gemm_phase(lds, (const bf16*)(ws + WS_YB_IN), (const bf16*)(ws + WS_BT_OB), D, S, E); }
    else if constexpr (PH == 10) { pg8::SchedDense S{T / 256, 4, G, c}; EpiG5 E{p.x, (const float*)(ws + WS_MODV), p.out};
        pg8::gemm_phase(lds, (const bf16*)(ws + WS_Y), (const bf16*)(ws + WS_BT_O), D, S, E); }
    else if constexpr (PH == 11) phase_ffnprep(p, lds);
    else if constexpr (PH == 12) phase_route(p, lds);
    else {
        constexpr int g = (PH - 13) / 3, sub = (PH - 13) % 3;
        const int ntile = ((const int*)(ws + WS_CTL))[CW_NTILE + g];
        const int* tile_e = (const int*)(ws + WS_TILE_E) + g * MAXTILE;
        if constexpr (sub == 0) { pg8::SchedMoe S{ntile, 8, G, c, tile_e, (const int*)(ws + WS_SLOT_TOK) + g * MAXSLOT}; EpiGU E{p.b_gu, (bf16*)(ws + WS_ACT)};
            pg8::gemm_phase(lds, (const bf16*)(ws + WS_H2), (const bf16*)(ws + WS_WB_GU), D, S, E); }
        else if constexpr (sub == 1) { pg8::SchedMoe S{ntile, 4, G, c, tile_e, nullptr}; EpiDN E{p.b_down, (const float*)(ws + WS_SLOT_P) + g * MAXSLOT, (bf16*)(ws + WS_YSLOT)};
            pg8::gemm_phase(lds, (const bf16*)(ws + WS_ACT), (const bf16*)(ws + WS_WB_DN), D, S, E); }
        else phase_combine(p, g);
    }
}

#ifndef PROBE_DUP_MASK
#define PROBE_DUP_MASK 0u
#endif
#if MK_FUSED
template <int PH>
__device__ __forceinline__ void run_from(const P& p, LAS unsigned char* lds, const XcdBarrier& bar) {
    if constexpr (PH < N_PHASES) { run_phase<PH>(p, lds);
        if constexpr ((PROBE_DUP_MASK >> PH) & 1u) { xcd_barrier(bar); run_phase<PH>(p, lds); }
        if constexpr (PH + 1 < N_PHASES) xcd_barrier(bar); run_from<PH + 1>(p, lds, bar); }
}
__global__ void __launch_bounds__(NTHREADS, 2) k_fused(P p) {
    extern __shared__ __attribute__((aligned(16))) unsigned char lds_raw[];
    LAS unsigned char* lds = (LAS unsigned char*)lds_raw;
    volatile LAS unsigned* misc = (volatile LAS unsigned*)(lds + 144 * 1024 - 64);
    if (threadIdx.x < 4) misc[threadIdx.x] = 0u;
    __syncthreads();
    XcdBarrier bar = xcd_barrier_post((unsigned*)(p.ws + WS_CTL) + CW_BAR, misc);
    run_from<0>(p, lds, bar);
}
#else
template <int PH>
__global__ void __launch_bounds__(NTHREADS, 2) k_phase(P p) {
    extern __shared__ __attribute__((aligned(16))) unsigned char lds_raw[];
    run_phase<PH>(p, (LAS unsigned char*)lds_raw);
}
template <int PH>
static void launch_all(const P& p, int grid, hipStream_t stream) {
    if constexpr (PH < N_PHASES) {
        static bool attr = false;
        if (!attr) { (void)hipFuncSetAttribute((const void*)k_phase<PH>, hipFuncAttributeMaxDynamicSharedMemorySize, LDS_BYTES); attr = true; }
        hipLaunchKernelGGL(k_phase<PH>, dim3(grid), dim3(NTHREADS), LDS_BYTES, stream, p);
        launch_all<PH + 1>(p, grid, stream);
    }
}
#endif

extern "C" void kernel_launch(void* const* d_in, const int* in_sizes, int n_in, void* d_out, int out_size, void* d_ws, size_t ws_size, hipStream_t stream) {
    static int grid = 0;
    if (grid == 0) {
        if (n_in != 30 || in_sizes[0] != T * D || out_size != T * D || ws_size < WS_END) { fprintf(stderr, "kernel_launch: unexpected shapes (n_in %d, in0 %d, out %d, ws %zu)\n", n_in, n_in > 0 ? in_sizes[0] : -1, out_size, ws_size); grid = -1; return; }
        int dev = 0, cus = 0;
        if (hipGetDevice(&dev) != hipSuccess || hipDeviceGetAttribute(&cus, hipDeviceAttributeMultiprocessorCount, dev) != hipSuccess) { grid = -1; return; }
#if MK_FUSED
        if (hipFuncSetAttribute((const void*)k_fused, hipFuncAttributeMaxDynamicSharedMemorySize, LDS_BYTES) != hipSuccess) { fprintf(stderr, "kernel_launch: hipFuncSetAttribute failed\n"); grid = -1; return; }
        int per_cu = 0;
        if (hipOccupancyMaxActiveBlocksPerMultiprocessor(&per_cu, (const void*)k_fused, NTHREADS, LDS_BYTES) != hipSuccess || per_cu < 1) fprintf(stderr, "kernel_launch: occupancy query reports %d\n", per_cu);
        (void)hipGetLastError();
#endif
        grid = cus;
    }
    if (grid < 0) return;
    (void)hipMemsetAsync((char*)d_ws + WS_CTL, 0, CTL_BYTES, stream);
    P p{};
    const float** pp = (const float**)&p;
    for (int i = 0; i < 30; ++i) pp[i] = (const float*)d_in[i];
    p.out = (float*)d_out; p.ws = (unsigned char*)d_ws;
#if MK_FUSED
    hipLaunchKernelGGL(k_fused, dim3(grid), dim3(NTHREADS), LDS_BYTES, stream, p);
#else
    launch_all<0>(p, grid, stream);
#endif
}
```

```cpp
#include <hip/hip_runtime.h>
#include <cstdio>
#include <cstdint>

#ifndef MK_FUSED
#define MK_FUSED 1
#endif

#define GAS __attribute__((address_space(1)))
#define LAS __attribute__((address_space(3)))
typedef unsigned short bf16;
typedef unsigned v4u __attribute__((ext_vector_type(4)));
typedef unsigned v2u __attribute__((ext_vector_type(2)));
typedef float f32x4 __attribute__((ext_vector_type(4)));
typedef short bf16x8 __attribute__((ext_vector_type(8)));

constexpr int D = 1024, NB = 16, SEQ = 4096, T = NB * SEQ, CTXL = 256, TC = NB * CTXL, TT = T + TC;
constexpr int D_IN = 9280, N_S = 5376, N_G = 4096, NMOD = 6 * D;
constexpr int NE = 32, NG = 2, TG = T / NG, MAXSLOT = 139264, MAXTILE = MAXSLOT / 256;
constexpr float EPS = 1e-6f;
constexpr int NTHREADS = 512, NWAVES = 8;
constexpr int LDS_BYTES = 147456;

constexpr size_t MiB = 1u << 20;
constexpr size_t WS_CTL = 0, CTL_BYTES = 1 * MiB;
constexpr size_t WS_MODV = 1 * MiB, WS_BT_S = 2 * MiB, WS_BT_G = 13 * MiB, WS_BT_OA = 21 * MiB, WS_BT_OB = 23 * MiB, WS_BT_O = 25 * MiB;
constexpr size_t WS_TOPI = 27 * MiB, WS_TOPP = 28 * MiB, WS_TOKSLOT = 29 * MiB, WS_SLOT_TOK = 30 * MiB, WS_SLOT_P = 32 * MiB, WS_TILE_E = 34 * MiB;
constexpr size_t WS_H = 40 * MiB, WS_PB = 176 * MiB, WS_SMALL = 448 * MiB, WS_QKVA = 465 * MiB;
constexpr size_t WS_WB_DN = 176 * MiB, WS_YA_IN = 240 * MiB, WS_YB_IN = 368 * MiB, WS_GATES = 496 * MiB, WS_Y = 752 * MiB, WS_WB_GU = 880 * MiB;
constexpr size_t WS_H2 = 40 * MiB, WS_ACT = 240 * MiB, WS_YSLOT = 512 * MiB, WS_END = 1008 * MiB;
static_assert(WS_QKVA + (size_t)TT * 3072 * 2 <= 873 * MiB && WS_SMALL + (size_t)TT * 64 * 4 <= WS_QKVA && WS_H + (size_t)TT * D * 2 <= WS_PB, "ws map");
static_assert(WS_ACT + (size_t)MAXSLOT * D * 2 <= WS_YSLOT && WS_YSLOT + (size_t)MAXSLOT * D * 2 <= WS_WB_GU, "ws map 2");
constexpr int CW_BAR = 4096, CW_CNT = 8192, CW_CUR = 8192 + 256, CW_NTILE = 8192 + 512;

#define LDS_WAIT() asm volatile("s_waitcnt lgkmcnt(0)" ::: "memory")
#define VM_WAIT() asm volatile("s_waitcnt vmcnt(0)" ::: "memory")
__device__ __forceinline__ float bflo(unsigned u) { return __uint_as_float(u << 16); }
__device__ __forceinline__ float bfhi(unsigned u) { return __uint_as_float(u & 0xffff0000u); }
__device__ __forceinline__ unsigned pk2(float lo, float hi) { unsigned r; asm("v_cvt_pk_bf16_f32 %0, %1, %2" : "=v"(r) : "v"(lo), "v"(hi)); return r; }
__device__ __forceinline__ float wave_sum(float v) {
#pragma unroll
    for (int o = 1; o < 64; o <<= 1) v += __shfl_xor(v, o);
    return v;
}
__device__ __forceinline__ int lds_add(LAS int* p, int v) { return __hip_atomic_fetch_add(p, v, __ATOMIC_RELAXED, __HIP_MEMORY_SCOPE_WORKGROUP); }
__device__ __forceinline__ float sigmoidf_(float x) { return 1.0f / (1.0f + __expf(-x)); }
__device__ __forceinline__ float siluf_(float x) { return x / (1.0f + __expf(-x)); }
__device__ __forceinline__ float softplusf_(float x) { return fmaxf(x, 0.f) + log1pf(__expf(-fabsf(x))); }
__device__ __forceinline__ void unpack8(const v4u w, float (&f)[8]) {
    f[0] = bflo(w.x); f[1] = bfhi(w.x); f[2] = bflo(w.y); f[3] = bfhi(w.y); f[4] = bflo(w.z); f[5] = bfhi(w.z); f[6] = bflo(w.w); f[7] = bfhi(w.w);
}
__device__ __forceinline__ v4u pack8(const float (&f)[8]) { v4u w; w.x = pk2(f[0], f[1]); w.y = pk2(f[2], f[3]); w.z = pk2(f[4], f[5]); w.w = pk2(f[6], f[7]); return w; }

struct P {
    const float *x, *c, *ctx, *c_ctx, *w_mod, *b_mod, *norm_mix_g, *norm_ffn_g, *w_in, *conv_w, *a_log_f, *a_log_b, *dt_bias_f, *dt_bias_b, *gdn_norm_g,
        *gla_gate_w_f, *gla_gate_w_b, *gla_gate_b_f, *gla_gate_b_b, *gla_norm_g, *w_out_a, *w_out_b, *w_out, *w_router, *b_router, *w_gu, *b_gu, *w_down, *b_down, *final_norm_g;
    float* out; unsigned char* ws; int probe; int pad_;
};

namespace pg8 {
constexpr int BM = 256, BK = 64, HALF = 128, HTB = HALF * BK * 2, STAGE_BYTES = 8 * HTB, NXCD = 8, WGM = 8;
__host__ __device__ __forceinline__ int lds_byte(int r, int c) { const int st = (r >> 4) * 2 + (c >> 5), rr = r & 15, cc = c & 31, ob = rr * 64 + cc * 2; return st * 1024 + (ob ^ (((ob >> 9) & 1) << 5)); }
__host__ __device__ __forceinline__ void stage_rc(int b, int& R, int& C) { const int st = b / 1024, sb = b % 1024, swz = sb ^ (((sb >> 9) & 1) << 5); R = (st >> 1) * 16 + swz / 64; C = (st & 1) * 32 + (swz % 64) / 2; }
__host__ __device__ __forceinline__ int perm32(int rho) { const int n = rho >> 4, i = rho & 15; return 8 * (i >> 2) + 4 * n + (i & 3); }
struct Unit { int pm, pn, bt; };

__device__ __forceinline__ void order_map(int L, int nM, int nN, int& pm, int& pn) {
    const int nwg = nM * nN; int wgid = L;
    { const int q = nwg / NXCD, r = nwg % NXCD, xcd = wgid % NXCD, off = wgid / NXCD; wgid = (xcd < r ? xcd * (q + 1) : r * (q + 1) + (xcd - r) * q) + off; }
    const int nig = WGM * nN, gid = wgid / nig, fm = gid * WGM, gsz = (nM - fm) < WGM ? (nM - fm) : WGM;
    pm = fm + ((wgid % nig) % gsz); pn = (wgid % nig) / gsz;
}
struct SchedDense {
    int nM, nN, G, c;
    __device__ __forceinline__ bool next(int i, Unit& u) const { const long L = (long)i * G + c; if (L >= (long)nM * nN) return false; order_map((int)L, nM, nN, u.pm, u.pn); u.bt = u.pn; return true; }
    __device__ __forceinline__ unsigned arow(const Unit& u, int r) const { return (unsigned)(u.pm * BM + r); }
};
struct SchedMoe {
    int nM, nN, G, c; const int* tile_e; const int* slot_tok;
    __device__ __forceinline__ bool next(int i, Unit& u) const { const long L = (long)i * G + c; if (L >= (long)nM * nN) return false; order_map((int)L, nM, nN, u.pm, u.pn); u.bt = tile_e[u.pm] * nN + u.pn; return true; }
    __device__ __forceinline__ unsigned arow(const Unit& u, int r) const { if (slot_tok) { const int t = slot_tok[u.pm * BM + r]; return (unsigned)(t < 0 ? 0 : t); } return (unsigned)(u.pm * BM + r); }
};

template <class Epi, class Sched>
__device__ __forceinline__ void gemm_phase(LAS unsigned char* lds, const bf16* A, const bf16* Bt, const int K, const Sched& S, const Epi& E) {
    const int tid = threadIdx.x, wid = __builtin_amdgcn_readfirstlane(tid >> 6), lane = tid & 63, wr = wid >> 2, wc = wid & 3, fr = lane & 15, fq = lane >> 4;
    const int nt = K / BK;
    int R0, C0; stage_rc(tid * 16, R0, C0);
    unsigned voffB[2];
#pragma unroll
    for (int i = 0; i < 2; ++i) { const int R = R0 + 64 * i; const int Rb = (R & ~31) + perm32(R & 31); voffB[i] = (unsigned)(Rb * K + C0) * 2u; }
    const unsigned rowb = (unsigned)K * 2u, cofs = (unsigned)C0 * 2u;
    const size_t kstep = (size_t)(BK * 2);
    const size_t hstep = (size_t)HALF * K * 2;
    const size_t tstep = 2 * hstep;
    const unsigned ldsw = (unsigned)wid * 1024u;
    const int aoff = lds_byte(wr * 64 + fr, fq * 8), boff = lds_byte(wc * 32 + fr, fq * 8);
#define PG8_SA(b, h) (((b) * 2 + (h)) * HTB)
#define PG8_SB(b, h) ((4 + (b) * 2 + (h)) * HTB)
#define PG8_STAGE(bufoff, gbase, voff) do { _Pragma("unroll") for (int _i = 0; _i < 2; ++_i) \
        __builtin_amdgcn_global_load_lds((const unsigned*)((const char*)(gbase) + (voff)[_i]), (LAS unsigned*)(lds + (bufoff) + ldsw + _i * 8192), 16, 0, 0); } while (0)
#define PG8_STAGE_A(bufoff, gbase, o0, o1) do { \
        __builtin_amdgcn_global_load_lds((const unsigned*)((const char*)(gbase) + (o0)), (LAS unsigned*)(lds + (bufoff) + ldsw), 16, 0, 0); \
        __builtin_amdgcn_global_load_lds((const unsigned*)((const char*)(gbase) + (o1)), (LAS unsigned*)(lds + (bufoff) + ldsw + 8192), 16, 0, 0); } while (0)
#define PG8_LDA(dst, b, h) do { _Pragma("unroll") for (int m = 0; m < 4; ++m) _Pragma("unroll") for (int k = 0; k < 2; ++k) dst[m][k] = *(const LAS bf16x8*)(lds + PG8_SA(b, h) + aoff + m * 2048 + k * 1024); } while (0)
#define PG8_LDB(dst, b, h) do { _Pragma("unroll") for (int n = 0; n < 2; ++n) _Pragma("unroll") for (int k = 0; k < 2; ++k) dst[n][k] = *(const LAS bf16x8*)(lds + PG8_SB(b, h) + boff + n * 2048 + k * 1024); } while (0)
#define PG8_MMA(ai, bj, At, Bt_) do { __builtin_amdgcn_s_setprio(1); _Pragma("unroll") for (int m = 0; m < 4; ++m) _Pragma("unroll") for (int n = 0; n < 2; ++n) _Pragma("unroll") for (int k = 0; k < 2; ++k) \
        acc[ai][bj][m][n] = __builtin_amdgcn_mfma_f32_16x16x32_bf16(Bt_[n][k], At[m][k], acc[ai][bj][m][n], 0, 0, 0); __builtin_amdgcn_s_setprio(0); } while (0)
#define PG8_WAIT_V(n) asm volatile("s_waitcnt vmcnt(" #n ")" ::: "memory")
#define PG8_WAIT_L(n) asm volatile("s_waitcnt lgkmcnt(" #n ")" ::: "memory")
#define PG8_BAR __builtin_amdgcn_s_barrier()
#define PG8_SCHED __builtin_amdgcn_sched_barrier(0)
    Unit cur, nxt; int ui = 0;
    if (!S.next(0, cur)) return;
    f32x4 acc[2][2][4][2];
#pragma unroll
    for (int a = 0; a < 2; ++a)
#pragma unroll
        for (int b = 0; b < 2; ++b)
#pragma unroll
            for (int m = 0; m < 4; ++m)
#pragma unroll
                for (int n = 0; n < 2; ++n) acc[a][b][m][n] = (f32x4){0.f, 0.f, 0.f, 0.f};
    bf16x8 At[4][2], B0[2][2], B1[2][2];
    const char* Ab = (const char*)A;
    const char* cB = (const char*)Bt + (size_t)cur.bt * tstep;
    unsigned c00 = S.arow(cur, R0) * rowb + cofs, c01 = S.arow(cur, R0 + 64) * rowb + cofs, c10 = S.arow(cur, HALF + R0) * rowb + cofs, c11 = S.arow(cur, HALF + R0 + 64) * rowb + cofs;
    unsigned n00, n01, n10, n11;
    PG8_STAGE(PG8_SB(0, 0), cB, voffB); PG8_STAGE(PG8_SB(0, 1), cB + hstep, voffB); PG8_STAGE_A(PG8_SA(0, 0), Ab, c00, c01); PG8_STAGE_A(PG8_SA(0, 1), Ab, c10, c11);
    if (wr == 1) PG8_BAR;
    PG8_WAIT_V(2); PG8_BAR;
    PG8_STAGE(PG8_SB(1, 0), cB + kstep, voffB); PG8_STAGE_A(PG8_SA(1, 0), Ab + kstep, c00, c01); PG8_STAGE(PG8_SB(1, 1), cB + hstep + kstep, voffB);
    PG8_WAIT_V(6); PG8_BAR;
    for (;;) {
        const bool has_next = S.next(ui + 1, nxt);
        const char* nB = has_next ? (const char*)Bt + (size_t)nxt.bt * tstep : cB;
        if (has_next) { n00 = S.arow(nxt, R0) * rowb + cofs; n01 = S.arow(nxt, R0 + 64) * rowb + cofs; n10 = S.arow(nxt, HALF + R0) * rowb + cofs; n11 = S.arow(nxt, HALF + R0 + 64) * rowb + cofs; }
        else { n00 = c00; n01 = c01; n10 = c10; n11 = c11; }
        for (int t = 0; t < nt; t += 2) {
            const bool last = (t == nt - 2);
            const char* a1 = Ab + (size_t)(t + 1) * kstep;
            const char* a2 = last ? Ab : Ab + (size_t)(t + 2) * kstep; const char* b2 = last ? nB : cB + (size_t)(t + 2) * kstep;
            const char* a3 = a2 + kstep; const char* b3 = b2 + kstep;
            const unsigned x00 = last ? n00 : c00, x01 = last ? n01 : c01, x10 = last ? n10 : c10, x11 = last ? n11 : c11;
            PG8_LDB(B0, 0, 0); PG8_LDB(B1, 0, 1); PG8_SCHED; PG8_LDA(At, 0, 0); PG8_STAGE_A(PG8_SA(1, 1), a1, c10, c11);
            PG8_WAIT_V(8); PG8_WAIT_L(0); PG8_BAR; PG8_MMA(0, 0, At, B0); PG8_MMA(0, 1, At, B1); PG8_BAR; PG8_SCHED;
            PG8_LDA(At, 0, 1); PG8_STAGE(PG8_SB(0, 0), b2, voffB); PG8_STAGE(PG8_SB(0, 1), b2 + hstep, voffB); PG8_STAGE_A(PG8_SA(0, 0), a2, x00, x01);
            PG8_WAIT_V(8); PG8_WAIT_L(0); PG8_BAR; PG8_MMA(1, 0, At, B0); PG8_MMA(1, 1, At, B1); PG8_BAR; PG8_SCHED;
            PG8_LDB(B0, 1, 0); PG8_LDB(B1, 1, 1); PG8_SCHED; PG8_LDA(At, 1, 0); PG8_STAGE_A(PG8_SA(0, 1), a2, x10, x11);
            PG8_WAIT_V(8); PG8_WAIT_L(0); PG8_BAR; PG8_MMA(0, 0, At, B0); PG8_MMA(0, 1, At, B1); PG8_BAR; PG8_SCHED;
            PG8_LDA(At, 1, 1); PG8_STAGE(PG8_SB(1, 0), b3, voffB); PG8_STAGE(PG8_SB(1, 1), b3 + hstep, voffB); PG8_STAGE_A(PG8_SA(1, 0), a3, x00, x01);
            PG8_WAIT_V(8); PG8_WAIT_L(0); PG8_BAR; PG8_MMA(1, 0, At, B0); PG8_MMA(1, 1, At, B1); PG8_BAR; PG8_SCHED;
        }
        if (wr == 0) PG8_BAR;
        E(acc, cur, wr, wc, fr, fq);
        if (!has_next) break;
#pragma unroll
        for (int a = 0; a < 2; ++a)
#pragma unroll
            for (int b = 0; b < 2; ++b)
#pragma unroll
                for (int m = 0; m < 4; ++m)
#pragma unroll
                    for (int n = 0; n < 2; ++n) acc[a][b][m][n] = (f32x4){0.f, 0.f, 0.f, 0.f};
        cur = nxt; cB = nB; c00 = n00; c01 = n01; c10 = n10; c11 = n11; ++ui;
        if (wr == 1) PG8_BAR;
    }
    PG8_WAIT_V(0);
    PG8_BAR;
#undef PG8_SA
#undef PG8_SB
#undef PG8_STAGE
#undef PG8_STAGE_A
#undef PG8_LDA
#undef PG8_LDB
#undef PG8_MMA
#undef PG8_WAIT_V
#undef PG8_WAIT_L
#undef PG8_BAR
#undef PG8_SCHED
}
}
typedef f32x4 Acc[2][2][4][2];

#define XB_TMO      128
#define XB_XCNT(j)  (256  + 64 * (j))
#define XB_XSUB(j)  (1280 + 64 * (j))
#define XB_XGEN(j)  (2304 + 64 * (j))
#define XB_TOP      3328
#define XB_TOPGEN   3392
#define XCD_BAR_WORDS 3456
#define XB_SPIN_CAP (1u << 22)
__device__ __forceinline__ unsigned xb_ld(unsigned* p)              { return __hip_atomic_load(p, __ATOMIC_RELAXED, __HIP_MEMORY_SCOPE_AGENT); }
__device__ __forceinline__ unsigned xb_add(unsigned* p, unsigned v) { return __hip_atomic_fetch_add(p, v, __ATOMIC_RELAXED, __HIP_MEMORY_SCOPE_AGENT); }
__device__ __forceinline__ unsigned xb_xcc_id() { return (unsigned)__builtin_amdgcn_s_getreg((3 << 11) | 20) & 0xFu; }
#define XB_SPIN(cond, bar) do { unsigned _sp = 0; while (cond) { __builtin_amdgcn_s_sleep(1); \
    if ((++_sp & 255u) == 0u) { if (xb_ld(&(bar)[XB_TMO])) break; if (_sp > XB_SPIN_CAP) { atomicAdd(&(bar)[XB_TMO], 1u); break; } } } } while (0)
struct XcdBarrier { unsigned* bar; unsigned x; volatile LAS unsigned* st; };
__device__ __forceinline__ XcdBarrier xcd_barrier_post(unsigned* bar, volatile LAS unsigned* st) {
    XcdBarrier b; b.bar = bar; b.x = xb_xcc_id(); b.st = st;
    if (threadIdx.x == 0) (void)xb_add(&bar[XB_XCNT(b.x)], 1u);
    return b;
}
__device__ __forceinline__ void xcd_barrier_complete(unsigned* bar, unsigned x, unsigned& nloc, unsigned& nx) {
    const unsigned G = gridDim.x * gridDim.y * gridDim.z;
    unsigned sum, cnt, mine, sp = 0u;
    for (;;) {
        sum = 0u; cnt = 0u; mine = 0u;
#pragma unroll
        for (unsigned j = 0; j < 16; ++j) { const unsigned c = xb_ld(&bar[XB_XCNT(j)]); sum += c; cnt += (c > 0u) ? 1u : 0u; mine = (j == x) ? c : mine; }
        if (sum == G) break;
        __builtin_amdgcn_s_sleep(1);
        if ((++sp & 255u) == 0u) { if (xb_ld(&bar[XB_TMO])) break; if (sp > XB_SPIN_CAP) { atomicAdd(&bar[XB_TMO], 1u); break; } }
    }
    nloc = mine > 0u ? mine : 1u; nx = cnt > 0u ? cnt : 1u;
}
__device__ __forceinline__ void xcd_barrier(const XcdBarrier& b) {
    asm volatile("s_waitcnt vmcnt(0)" ::: "memory");
    __syncthreads();
    if (threadIdx.x == 0) {
        unsigned* bar = b.bar;
        __builtin_amdgcn_s_waitcnt(0);
        unsigned nloc = b.st[0], nx = b.st[1];
        if (nloc == 0u) { xcd_barrier_complete(bar, b.x, nloc, nx); b.st[0] = nloc; b.st[1] = nx; }
        const unsigned old = xb_add(&bar[XB_XSUB(b.x)], 1u);
        const unsigned gen = old / nloc;
        if (old + 1u == (gen + 1u) * nloc) {
            __builtin_amdgcn_fence(__ATOMIC_RELEASE, "agent");
            asm volatile("s_waitcnt vmcnt(0)" ::: "memory");
            const unsigned og = xb_add(&bar[XB_TOP], 1u);
            const unsigned tg = og / nx;
            if (og + 1u == (tg + 1u) * nx) xb_add(&bar[XB_TOPGEN], 1u);
            else XB_SPIN(xb_ld(&bar[XB_TOPGEN]) == tg, bar);
            __builtin_amdgcn_fence(__ATOMIC_ACQUIRE, "agent");
            xb_add(&bar[XB_XGEN(b.x)], 1u);
            asm volatile("s_waitcnt vmcnt(0)" ::: "memory");
        } else {
            XB_SPIN(xb_ld(&bar[XB_XGEN(b.x)]) == gen, bar);
            __builtin_amdgcn_fence(__ATOMIC_ACQUIRE, "agent");
            asm volatile("s_waitcnt vmcnt(0)" ::: "memory");
        }
    }
    __syncthreads();
}

__device__ __forceinline__ void tr_item(const float* W, int ldw, int col0, bf16* WT, int dstrow0, int k0, LAS float* scr, int lane) {
#pragma unroll 8
    for (int i = 0; i < 32; ++i) { const int kk = 2 * i + (lane >> 5); scr[kk * 33 + (lane & 31)] = W[(size_t)(k0 + kk) * ldw + col0 + (lane & 31)]; }
    LDS_WAIT(); asm volatile("" ::: "memory");
    const int c = lane & 7;
#pragma unroll
    for (int j = 0; j < 4; ++j) { const int n = (lane >> 3) + 8 * j; const LAS float* s = scr + (8 * c) * 33 + n;
        v4u o; o.x = pk2(s[0 * 33], s[1 * 33]); o.y = pk2(s[2 * 33], s[3 * 33]); o.z = pk2(s[4 * 33], s[5 * 33]); o.w = pk2(s[6 * 33], s[7 * 33]);
        *(v4u*)(WT + (size_t)(dstrow0 + n) * D + k0 + 8 * c) = o; }
    LDS_WAIT(); asm volatile("" ::: "memory");
}
__device__ __forceinline__ void phase_prologue(const P& p, LAS unsigned char* lds) {
    const int tid = threadIdx.x, lane = tid & 63, wave = tid >> 6;
    LAS float* scr = (LAS float*)(lds + wave * 8448);
    const int gw = blockIdx.x * NWAVES + wave, NGW = gridDim.x * NWAVES;
    bf16* bt_s = (bf16*)(p.ws + WS_BT_S); bf16* bt_g = (bf16*)(p.ws + WS_BT_G);
    constexpr int I_S = 162 * 16, I_G = 128 * 16, I_O = 32 * 16;
    for (int it = gw; it < I_S + I_G + 3 * I_O; it += NGW) {
        int r = it;
        if (r < I_S) { const int nb = r >> 4, kb = r & 15; const int col0 = nb < 96 ? 32 * nb : (nb < 160 ? 4128 + 32 * (nb - 96) : (nb == 160 ? 4096 : 7200));
            tr_item(p.w_in, D_IN, col0, bt_s, 32 * nb, 64 * kb, scr, lane); continue; } r -= I_S;
        if (r < I_G) { const int nb = r >> 4, kb = r & 15; const int col0 = nb < 32 ? 3072 + 32 * nb : (nb < 64 ? 6176 + 32 * (nb - 32) : 7232 + 32 * (nb - 64));
            tr_item(p.w_in, D_IN, col0, bt_g, 32 * nb, 64 * kb, scr, lane); continue; } r -= I_G;
        const int which = r / I_O; r -= which * I_O; const int nb = r >> 4, kb = r & 15;
        const float* W = which == 0 ? p.w_out_a : (which == 1 ? p.w_out_b : p.w_out);
        bf16* WT = (bf16*)(p.ws + (which == 0 ? WS_BT_OA : (which == 1 ? WS_BT_OB : WS_BT_O)));
        tr_item(W, D, 32 * nb, WT, 32 * nb, 64 * kb, scr, lane);
    }
    { const size_t n16 = (size_t)192 * D * 2 / 16; v4u* z = (v4u*)(bt_s + (size_t)5184 * D);
      for (size_t i = (size_t)blockIdx.x * NTHREADS + tid; i < n16; i += (size_t)gridDim.x * NTHREADS) z[i] = (v4u){0u, 0u, 0u, 0u}; }
    __syncthreads();
    LAS float* sc = (LAS float*)lds;
    LAS float* red = (LAS float*)(lds + 17 * 1024 * 4);
    float* modv = (float*)(p.ws + WS_MODV);
    bool have = false;
    for (int u = blockIdx.x; u < NMOD / 64; u += gridDim.x) {
        if (!have) { for (int i = tid; i < 17 * 1024; i += NTHREADS) { const float v = i < 16 * 1024 ? p.c[i] : p.c_ctx[i - 16 * 1024]; sc[i] = siluf_(v); } have = true; __syncthreads(); }
        float acc[17];
#pragma unroll
        for (int b = 0; b < 17; ++b) acc[b] = 0.f;
        const int n = u * 64 + lane;
        for (int k = wave * 128; k < wave * 128 + 128; ++k) { const float wv = p.w_mod[(size_t)k * NMOD + n];
#pragma unroll
            for (int b = 0; b < 17; ++b) acc[b] += sc[b * 1024 + k] * wv; }
#pragma unroll
        for (int b = 0; b < 17; ++b) red[(wave * 17 + b) * 64 + lane] = acc[b];
        __syncthreads();
        for (int i = tid; i < 17 * 64; i += NTHREADS) { const int b = i >> 6, l = i & 63; float s = p.b_mod[u * 64 + l];
#pragma unroll
            for (int w = 0; w < 8; ++w) s += red[(w * 17 + b) * 64 + l];
            modv[b * NMOD + u * 64 + l] = s; }
        __syncthreads();
    }
}

__device__ __forceinline__ void phase_norm1(const P& p) {
    const int tid = threadIdx.x, lane = tid & 63, wave = tid >> 6;
    const int gw = blockIdx.x * NWAVES + wave, NGW = gridDim.x * NWAVES;
    const float* modv = (const float*)(p.ws + WS_MODV); bf16* h = (bf16*)(p.ws + WS_H);
    for (int r = gw; r < TT; r += NGW) {
        const float* src; int b;
        if (r < T) { src = p.x + (size_t)r * D; b = r >> 12; } else { src = p.ctx + (size_t)(r - T) * D; b = 16; }
        const f32x4* xr = (const f32x4*)src + lane;
        f32x4 v[4]; float s = 0.f;
#pragma unroll
        for (int j = 0; j < 4; ++j) { v[j] = xr[64 * j]; s += (v[j].x * v[j].x + v[j].y * v[j].y) + (v[j].z * v[j].z + v[j].w * v[j].w); }
        const float rstd = 1.0f / sqrtf(wave_sum(s) * (1.f / D) + EPS);
        const f32x4* g = (const f32x4*)p.norm_mix_g + lane; const f32x4* sh = (const f32x4*)(modv + b * NMOD) + lane; const f32x4* scl = (const f32x4*)(modv + b * NMOD + D) + lane;
        v2u* o8 = (v2u*)(h + (size_t)r * D) + lane;
#pragma unroll
        for (int j = 0; j < 4; ++j) { const f32x4 gg = g[64 * j], s1 = sh[64 * j], s2 = scl[64 * j]; const f32x4 o = v[j] * rstd * gg * (1.0f + s2) + s1;
            v2u w; w.x = pk2(o.x, o.y); w.y = pk2(o.z, o.w); o8[64 * j] = w; }
    }
}

struct EpiG1 {
    bf16* qkva; bf16* pb; float* small;
    __device__ __forceinline__ void operator()(const Acc& acc, const pg8::Unit& u, int wr, int wc, int fr, int fq) const {
        const int row0 = u.pm * 256 + wr * 64 + fr, cb = wc * 32 + 8 * fq;
#pragma unroll
        for (int ai = 0; ai < 2; ++ai)
#pragma unroll
            for (int m = 0; m < 4; ++m) { const size_t row = (size_t)(row0 + ai * 128 + m * 16);
#pragma unroll
                for (int bj = 0; bj < 2; ++bj) { const int c = bj * 128 + cb; const f32x4 v0 = acc[ai][bj][m][0], v1 = acc[ai][bj][m][1];
                    if (u.pn < 20) { v4u w; w.x = pk2(v0[0], v0[1]); w.y = pk2(v0[2], v0[3]); w.z = pk2(v1[0], v1[1]); w.w = pk2(v1[2], v1[3]);
                        if (u.pn < 12) *(v4u*)(qkva + row * 3072 + u.pn * 256 + c) = w; else *(v4u*)(pb + row * 2048 + (u.pn - 12) * 256 + c) = w; }
                    else if (c < 64) { *(f32x4*)(small + row * 64 + c) = v0; *(f32x4*)(small + row * 64 + c + 4) = v1; } } }
    }
};
struct EpiG2 {
    const bf16* on; bf16* ya; bf16* yb; bf16* gates;
    __device__ __forceinline__ void operator()(const Acc& acc, const pg8::Unit& u, int wr, int wc, int fr, int fq) const {
        const int row0 = u.pm * 256 + wr * 64 + fr, cb = wc * 32 + 8 * fq;
#pragma unroll
        for (int ai = 0; ai < 2; ++ai)
#pragma unroll
            for (int m = 0; m < 4; ++m) { const size_t row = (size_t)(row0 + ai * 128 + m * 16);
#pragma unroll
                for (int bj = 0; bj < 2; ++bj) { const int c = bj * 128 + cb; float v[8];
#pragma unroll
                    for (int j = 0; j < 4; ++j) { v[j] = acc[ai][bj][m][0][j]; v[4 + j] = acc[ai][bj][m][1][j]; }
                    if (u.pn < 8) { const v4u ow = *(const v4u*)(on + row * 2048 + u.pn * 256 + c); float o[8]; unpack8(ow, o);
#pragma unroll
                        for (int j = 0; j < 8; ++j) v[j] = o[j] * siluf_(v[j]);
                        bf16* dst = u.pn < 4 ? ya + row * 1024 + u.pn * 256 + c : yb + row * 1024 + (u.pn - 4) * 256 + c;
                        *(v4u*)dst = pack8(v); }
                    else {
#pragma unroll
                        for (int j = 0; j < 8; ++j) v[j] = sigmoidf_(v[j]);
                        *(v4u*)(gates + row * 2048 + (u.pn - 8) * 256 + c) = pack8(v); } } }
    }
};
template <int WHICH> struct EpiG34 {
    const bf16* gates; bf16* y;
    __device__ __forceinline__ void operator()(const Acc& acc, const pg8::Unit& u, int wr, int wc, int fr, int fq) const {
        const int row0 = u.pm * 256 + wr * 64 + fr, cb = wc * 32 + 8 * fq;
#pragma unroll
        for (int ai = 0; ai < 2; ++ai)
#pragma unroll
            for (int m = 0; m < 4; ++m) { const size_t row = (size_t)(row0 + ai * 128 + m * 16);
#pragma unroll
                for (int bj = 0; bj < 2; ++bj) { const int c = u.pn * 256 + bj * 128 + cb; float v[8], g[8];
#pragma unroll
                    for (int j = 0; j < 4; ++j) { v[j] = acc[ai][bj][m][0][j]; v[4 + j] = acc[ai][bj][m][1][j]; }
                    unpack8(*(const v4u*)(gates + row * 2048 + WHICH * 1024 + c), g);
                    if (WHICH == 0) {
#pragma unroll
                        for (int j = 0; j < 8; ++j) v[j] = g[j] * v[j];
                    } else { float o[8]; unpack8(*(const v4u*)(y + row * 1024 + c), o);
#pragma unroll
                        for (int j = 0; j < 8; ++j) v[j] = o[j] + g[j] * v[j]; }
                    *(v4u*)(y + row * 1024 + c) = pack8(v); } }
    }
};
struct EpiG5 {
    const float* x; const float* modv; float* out;
    __device__ __forceinline__ void operator()(const Acc& acc, const pg8::Unit& u, int wr, int wc, int fr, int fq) const {
        const int row0 = u.pm * 256 + wr * 64 + fr, cb = wc * 32 + 8 * fq;
        const float* g1 = modv + (u.pm >> 4) * NMOD + 2 * D;
#pragma unroll
        for (int ai = 0; ai < 2; ++ai)
#pragma unroll
            for (int m = 0; m < 4; ++m) { const size_t row = (size_t)(row0 + ai * 128 + m * 16);
#pragma unroll
                for (int bj = 0; bj < 2; ++bj) { const int c = u.pn * 256 + bj * 128 + cb;
#pragma unroll
                    for (int n = 0; n < 2; ++n) { const f32x4 xv = *(const f32x4*)(x + row * D + c + 4 * n), gv = *(const f32x4*)(g1 + c + 4 * n);
                        *(f32x4*)(out + row * D + c + 4 * n) = xv + gv * acc[ai][bj][m][n]; } } }
    }
};
struct EpiGU {
    const float* b_gu; bf16* act;
    __device__ __forceinline__ void operator()(const Acc& acc, const pg8::Unit& u, int wr, int wc, int fr, int fq) const {
        const int row0 = u.pm * 256 + wr * 64 + fr, cb = wc * 32 + 8 * fq; const int e = u.bt >> 3;
        const float* bg = b_gu + (size_t)e * 2048 + u.pn * 128 + cb; const float* bl = bg + 1024;
        float bgv[8], blv[8];
#pragma unroll
        for (int j = 0; j < 8; ++j) { bgv[j] = bg[j]; blv[j] = bl[j]; }
#pragma unroll
        for (int ai = 0; ai < 2; ++ai)
#pragma unroll
            for (int m = 0; m < 4; ++m) { const size_t row = (size_t)(row0 + ai * 128 + m * 16); float v[8];
#pragma unroll
                for (int j = 0; j < 8; ++j) { const float gl = fminf(acc[ai][0][m][j >> 2][j & 3] + bgv[j], 7.0f); const float ln = fminf(fmaxf(acc[ai][1][m][j >> 2][j & 3] + blv[j], -7.0f), 7.0f);
                    v[j] = gl * sigmoidf_(1.702f * gl) * (ln + 1.0f); }
                *(v4u*)(act + row * 1024 + u.pn * 128 + cb) = pack8(v); }
    }
};
struct EpiDN {
    const float* b_down; const float* slot_p; bf16* ys;
    __device__ __forceinline__ void operator()(const Acc& acc, const pg8::Unit& u, int wr, int wc, int fr, int fq) const {
        const int row0 = u.pm * 256 + wr * 64 + fr, cb = wc * 32 + 8 * fq; const int e = u.bt >> 2;
#pragma unroll
        for (int bj = 0; bj < 2; ++bj) { const int c = u.pn * 256 + bj * 128 + cb; float bv[8];
#pragma unroll
            for (int j = 0; j < 8; ++j) bv[j] = b_down[(size_t)e * 1024 + c + j];
#pragma unroll
            for (int ai = 0; ai < 2; ++ai)
#pragma unroll
                for (int m = 0; m < 4; ++m) { const size_t row = (size_t)(row0 + ai * 128 + m * 16); const float pr = slot_p[row]; float v[8];
#pragma unroll
                    for (int j = 0; j < 8; ++j) v[j] = (acc[ai][bj][m][j >> 2][j & 3] + bv[j]) * pr;
                    *(v4u*)(ys + row * 1024 + c) = pack8(v); } }
    }
};

__device__ __forceinline__ void phase_conv(const P& p, LAS unsigned char* lds) {
    const int tid = threadIdx.x;
    bf16* qkva = (bf16*)(p.ws + WS_QKVA);
    LAS unsigned char* rowbuf = lds;
    LAS unsigned char* cbuf = lds + 3 * 16896;
    const int cg = tid & 15, c0 = tid >> 4;
    for (int u = blockIdx.x; u < NB * 24; u += gridDim.x) {
        const int b = u / 24, s = u % 24;
        float w[9][8];
#pragma unroll
        for (int k = 0; k < 9; ++k)
#pragma unroll
            for (int e = 0; e < 8; ++e) w[k][e] = p.conv_w[k * 3072 + s * 128 + cg * 8 + e];
        const bool donorm = s < 16;
        if (tid < 96) { const int bi = tid / 32, r = tid % 32; *(LAS v4u*)(rowbuf + bi * 16896 + ((r >> 4) ? 65 : 0) * 256 + (r & 15) * 16) = (v4u){0u, 0u, 0u, 0u}; }
        if (tid >= 128 && tid < 160) { const int r = tid - 128; *(LAS v4u*)(cbuf + ((r >> 4) ? 257 : 0) * 256 + (r & 15) * 16) = (v4u){0u, 0u, 0u, 0u}; }
        { bf16* base = qkva + (size_t)(T + b * CTXL) * 3072 + s * 128 + cg * 8;
#pragma unroll
          for (int jj = 0; jj < 8; ++jj) { const int t = c0 + 32 * jj; *(LAS v4u*)(cbuf + (t + 1) * 256 + cg * 16) = *(const v4u*)(base + (size_t)t * 3072); }
          __syncthreads();
#pragma unroll
          for (int jj = 0; jj < 8; ++jj) { const int t = c0 + 32 * jj; float a[8];
#pragma unroll
              for (int e = 0; e < 8; ++e) a[e] = 0.f;
#pragma unroll
              for (int kw = 0; kw < 3; ++kw) { float f[8]; unpack8(*(const LAS v4u*)(cbuf + (t + kw) * 256 + cg * 16), f);
#pragma unroll
                  for (int e = 0; e < 8; ++e) a[e] += f[e] * w[3 + kw][e]; }
              float ss = 0.f;
#pragma unroll
              for (int e = 0; e < 8; ++e) { a[e] = siluf_(a[e]); ss += a[e] * a[e]; }
              if (donorm) { ss += __shfl_xor(ss, 1); ss += __shfl_xor(ss, 2); ss += __shfl_xor(ss, 4); ss += __shfl_xor(ss, 8); const float sc = 1.0f / sqrtf(ss + EPS);
#pragma unroll
                  for (int e = 0; e < 8; ++e) a[e] *= sc; }
              *(v4u*)(base + (size_t)t * 3072) = pack8(a); }
        }
        bf16* base = qkva + (size_t)(b * SEQ) * 3072 + s * 128 + cg * 8;
#pragma unroll
        for (int rr = 0; rr < 2; ++rr)
#pragma unroll
            for (int jj = 0; jj < 2; ++jj) { const int c = c0 + 32 * jj; *(LAS v4u*)(rowbuf + rr * 16896 + (c + 1) * 256 + cg * 16) = *(const v4u*)(base + (size_t)(rr * 64 + c) * 3072); }
        __syncthreads();
        for (int r = 0; r < 64; ++r) {
            v4u pre[2];
            if (r + 2 < 64) {
#pragma unroll
                for (int jj = 0; jj < 2; ++jj) pre[jj] = *(const v4u*)(base + (size_t)((r + 2) * 64 + c0 + 32 * jj) * 3072);
            }
#pragma unroll
            for (int jj = 0; jj < 2; ++jj) { const int c = c0 + 32 * jj; float a[8];
#pragma unroll
                for (int e = 0; e < 8; ++e) a[e] = 0.f;
#pragma unroll
                for (int kh = 0; kh < 3; ++kh) { const int rr = r + kh - 1; if (rr < 0 || rr > 63) continue; LAS unsigned char* rb = rowbuf + (rr % 3) * 16896;
#pragma unroll
                    for (int kw = 0; kw < 3; ++kw) { float f[8]; unpack8(*(const LAS v4u*)(rb + (c + kw) * 256 + cg * 16), f);
#pragma unroll
                        for (int e = 0; e < 8; ++e) a[e] += f[e] * w[kh * 3 + kw][e]; } }
                float ss = 0.f;
#pragma unroll
                for (int e = 0; e < 8; ++e) { a[e] = siluf_(a[e]); ss += a[e] * a[e]; }
                if (donorm) { ss += __shfl_xor(ss, 1); ss += __shfl_xor(ss, 2); ss += __shfl_xor(ss, 4); ss += __shfl_xor(ss, 8); const float sc = 1.0f / sqrtf(ss + EPS);
#pragma unroll
                    for (int e = 0; e < 8; ++e) a[e] *= sc; }
                *(v4u*)(base + (size_t)(r * 64 + c) * 3072) = pack8(a); }
            __syncthreads();
            if (r + 2 < 64) {
#pragma unroll
                for (int jj = 0; jj < 2; ++jj) *(LAS v4u*)(rowbuf + ((r + 2) % 3) * 16896 + (c0 + 32 * jj + 1) * 256 + cg * 16) = pre[jj];
            }
            __syncthreads();
        }
    }
}

template <bool GLA>
__device__ __forceinline__ void scan_unit(const P& p, LAS unsigned char* lds, int b, int h, int vh) {
    const int tid = threadIdx.x, j = tid >> 2, part = tid & 3;
    LAS float* qf = (LAS float*)lds; LAS float* kf = qf + 32 * 144; LAS float* af = kf + 32 * 144; LAS float* vf = af + 32 * 144; LAS float* ob = vf + 32 * 128;
    LAS float* sa = ob + 32 * 128; LAS float* sb = sa + 32;
    const bf16* qkva = (const bf16*)(p.ws + WS_QKVA); const bf16* pbuf = (const bf16*)(p.ws + WS_PB); const float* small = (const float*)(p.ws + WS_SMALL);
    bf16* on = (bf16*)p.out;
    const int lt = tid >> 4, piece = tid & 15;
    const float scale = 0.08838834764831845f;
    for (int dir = 0; dir < 2; ++dir) {
        float S[32];
#pragma unroll
        for (int i = 0; i < 32; ++i) S[i] = 0.f;
        float wcol[16]; float gbias = 0.f, alog = 0.f, dtb = 0.f;
        if (GLA) { const float* gw = dir ? p.gla_gate_w_b : p.gla_gate_w_f; const int i = tid & 127;
#pragma unroll
            for (int r = 0; r < 16; ++r) wcol[r] = gw[r * 512 + h * 128 + i];
            gbias = (dir ? p.gla_gate_b_b : p.gla_gate_b_f)[h * 128 + i]; }
        else { alog = __expf((dir ? p.a_log_b : p.a_log_f)[h]); dtb = (dir ? p.dt_bias_b : p.dt_bias_f)[h]; }
        for (int s = 0; s < 136; ++s) {
            const bool is_ctx = s < 8;
            const int sci = is_ctx ? (dir ? 7 - s : s) : (dir ? 127 - (s - 8) : s - 8);
            const size_t row0 = is_ctx ? (size_t)(T + b * CTXL + sci * 32) : (size_t)(b * SEQ + sci * 32);
            __syncthreads();
            { v4u qw, kw, vw;
              if (GLA) { const bf16* r = pbuf + (row0 + lt) * 2048; qw = *(const v4u*)(r + h * 128 + piece * 8); kw = *(const v4u*)(r + 512 + h * 128 + piece * 8); vw = *(const v4u*)(r + 1024 + h * 256 + vh * 128 + piece * 8); }
              else { const bf16* r = qkva + (row0 + lt) * 3072; qw = *(const v4u*)(r + h * 128 + piece * 8); kw = *(const v4u*)(r + 1024 + h * 128 + piece * 8); vw = *(const v4u*)(r + 2048 + h * 128 + piece * 8); }
              float f[8]; const int o = lt * 144 + (piece >> 2) * 36 + (piece & 3) * 8;
              unpack8(qw, f);
#pragma unroll
              for (int e = 0; e < 8; ++e) qf[o + e] = f[e] * scale;
              unpack8(kw, f);
#pragma unroll
              for (int e = 0; e < 8; ++e) kf[o + e] = f[e];
              unpack8(vw, f);
#pragma unroll
              for (int e = 0; e < 8; ++e) vf[lt * 128 + piece * 8 + e] = f[e]; }
            if (GLA) { const int i = tid & 127, tq = tid >> 7;
#pragma unroll
                for (int tt = 0; tt < 8; ++tt) { const int t = tq * 8 + tt; const float* z = small + (row0 + t) * 64 + 32 + dir * 16; float u = gbias;
#pragma unroll
                    for (int r = 0; r < 16; ++r) u += z[r] * wcol[r];
                    const float ls = fminf(u, 0.f) - log1pf(__expf(-fabsf(u)));
                    af[t * 144 + (i >> 5) * 36 + (i & 31)] = __expf(ls * (1.0f / 16.0f)); } }
            else if (tid < 32) { const float* sm = small + (row0 + tid) * 64; sb[tid] = sigmoidf_(sm[dir * 8 + h]); sa[tid] = __expf(-alog * softplusf_(sm[16 + dir * 8 + h] + dtb)); }
            __syncthreads();
            for (int tt = 0; tt < 32; ++tt) { const int t = dir ? 31 - tt : tt;
                const LAS float* kp = kf + t * 144 + part * 36; const LAS float* qp = qf + t * 144 + part * 36;
                float kk[32], qq[32];
#pragma unroll
                for (int i = 0; i < 32; i += 4) { const f32x4 a = *(const LAS f32x4*)(kp + i); kk[i] = a.x; kk[i + 1] = a.y; kk[i + 2] = a.z; kk[i + 3] = a.w;
                    const f32x4 q4 = *(const LAS f32x4*)(qp + i); qq[i] = q4.x; qq[i + 1] = q4.y; qq[i + 2] = q4.z; qq[i + 3] = q4.w; }
                const float vj = vf[t * 128 + j];
                float os = 0.f;
                if (GLA) { const LAS float* ap = af + t * 144 + part * 36;
#pragma unroll
                    for (int i = 0; i < 32; i += 4) { const f32x4 a = *(const LAS f32x4*)(ap + i);
                        S[i] = a.x * S[i] + kk[i] * vj; S[i + 1] = a.y * S[i + 1] + kk[i + 1] * vj; S[i + 2] = a.z * S[i + 2] + kk[i + 2] * vj; S[i + 3] = a.w * S[i + 3] + kk[i + 3] * vj; }
                } else { const float a = sa[t], be = sb[t]; float ks = 0.f;
#pragma unroll
                    for (int i = 0; i < 32; ++i) ks += kk[i] * S[i];
                    ks += __shfl_xor(ks, 1); ks += __shfl_xor(ks, 2);
                    const float vn = be * (vj - a * ks);
#pragma unroll
                    for (int i = 0; i < 32; ++i) S[i] = a * S[i] + kk[i] * vn; }
                if (!is_ctx) {
#pragma unroll
                    for (int i = 0; i < 32; ++i) os += qq[i] * S[i];
                    os += __shfl_xor(os, 1); os += __shfl_xor(os, 2);
                    if (part == 0) ob[t * 128 + j] = os; }
            }
            if (!is_ctx) { __syncthreads();
                bf16* dst = on + (row0 + lt) * 2048 + (GLA ? 1024 + h * 256 + vh * 128 : h * 128) + piece * 8; float f[8];
#pragma unroll
                for (int e = 0; e < 8; ++e) f[e] = ob[lt * 128 + piece * 8 + e];
                if (dir) { float g[8]; unpack8(*(const v4u*)dst, g);
#pragma unroll
                    for (int e = 0; e < 8; ++e) f[e] += g[e]; }
                *(v4u*)dst = pack8(f); }
        }
    }
}

typedef short s16x4 __attribute__((ext_vector_type(4)));
typedef float f32x2_t __attribute__((ext_vector_type(2)));
typedef __bf16 bf16x2_t __attribute__((ext_vector_type(2)));
#define MF16(a, b, c) __builtin_amdgcn_mfma_f32_16x16x16bf16_1k((a), (b), (c), 0, 0, 0)
#define MF32(a, b, c) __builtin_amdgcn_mfma_f32_16x16x32_bf16((a), (b), (c), 0, 0, 0)
__device__ __forceinline__ unsigned pk2c(float lo, float hi) { const f32x2_t v = {lo, hi}; return __builtin_bit_cast(unsigned, __builtin_convertvector(v, bf16x2_t)); }
__device__ __forceinline__ s16x4 cvt4(const f32x4 v) { v2u p; p.x = pk2c(v[0], v[1]); p.y = pk2c(v[2], v[3]); return __builtin_bit_cast(s16x4, p); }
__device__ __forceinline__ bf16x8 cat8(const s16x4 a, const s16x4 b) { return __builtin_shufflevector(a, b, 0, 1, 2, 3, 4, 5, 6, 7); }
__device__ __forceinline__ bf16x8 ldfrag(const LAS unsigned char* img, int row, int strideB, int s, int q) {
    const LAS unsigned char* p = img + row * strideB + (32 * s + 4 * q) * 2;
    return cat8(*(const LAS s16x4*)p, *(const LAS s16x4*)(p + 32));
}
__device__ __forceinline__ v4u pack8c(const float (&f)[8]) { v4u w; w.x = pk2c(f[0], f[1]); w.y = pk2c(f[2], f[3]); w.z = pk2c(f[4], f[5]); w.w = pk2c(f[6], f[7]); return w; }
constexpr int CS_KS = 272, CS_TS = 144;
constexpr int L_K = 0, L_Q = 17408, L_V = 34816, L_KT = 52224, L_O = 70656, L_AOFF = 88064, L_TD = 91136, L_ATT = 93184, L_SC = 98304;
constexpr float QSCALE = 0.08838834764831845f;
__device__ __forceinline__ int tri_idx(int bi, int bj) { return bi * (bi + 1) / 2 + bj; }
__device__ __forceinline__ int off_idx(int bi, int bj) { return bi * (bi - 1) / 2 + bj; }

__device__ __forceinline__ void build_kt_plain(LAS unsigned char* lds, int tid) {
    const int a = tid & 127, seg = tid >> 7;
#pragma unroll
    for (int mm = 0; mm < 4; ++mm) { unsigned short v[4];
#pragma unroll
        for (int e = 0; e < 4; ++e) v[e] = *(const LAS unsigned short*)(lds + L_K + (16 * seg + 4 * mm + e) * CS_KS + a * 2);
        v2u w; w.x = (unsigned)v[0] | ((unsigned)v[1] << 16); w.y = (unsigned)v[2] | ((unsigned)v[3] << 16);
        *(LAS v2u*)(lds + L_KT + a * CS_TS + (16 * seg + 4 * mm) * 2) = w; }
}

__device__ __forceinline__ void gdn_unit(const P& p, LAS unsigned char* lds, const int b, const int h) {
    const int wave = __builtin_amdgcn_readfirstlane(threadIdx.x >> 6);
    const int c0 = wave * 16;
    const bf16* qkva = (const bf16*)(p.ws + WS_QKVA); const float* small = (const float*)(p.ws + WS_SMALL); bf16* on = (bf16*)p.out;
    LAS float* scb = (LAS float*)(lds + L_SC); LAS float* scG = scb + 64; LAS float* sceG = scb + 128; LAS float* scdK = scb + 192; LAS float* scl = scb + 256;
    for (int dir = 0; dir < 2; ++dir) {
        f32x4 S[8];
#pragma unroll
        for (int u = 0; u < 8; ++u) S[u] = (f32x4){0.f, 0.f, 0.f, 0.f};
        const float alog = __expf((dir ? p.a_log_b : p.a_log_f)[h]), dtb = (dir ? p.dt_bias_b : p.dt_bias_f)[h];
        v4u pq[2], pk[2], pv[2]; float pgb = 0.f, pga = 0.f;
#define LANE_VARS int tz_ = threadIdx.x; asm volatile("" : "+v"(tz_)); const int tid = tz_, lane = tz_ & 63, r = lane & 15, q = lane >> 4, lt = tz_ >> 4, piece = tz_ & 15; (void)tid; (void)r; (void)q; (void)lt; (void)piece;
#define GDN_ROW0(s_) (((s_) < 4) ? (size_t)(T + b * CTXL + (dir ? 3 - (s_) : (s_)) * 64) : (size_t)(b * SEQ + (dir ? 63 - ((s_) - 4) : (s_) - 4) * 64))
#define GDN_PREFETCH(s_) do { const size_t r0_ = GDN_ROW0(s_); \
            _Pragma("unroll") for (int jj = 0; jj < 2; ++jj) { const int pp = lt + 32 * jj; const bf16* rp = qkva + (r0_ + (dir ? 63 - pp : pp)) * 3072 + h * 128 + piece * 8; \
                pq[jj] = *(const v4u*)rp; pk[jj] = *(const v4u*)(rp + 1024); pv[jj] = *(const v4u*)(rp + 2048); } \
            if (wave == 0) { const float* sm = small + (r0_ + (dir ? 63 - lane : lane)) * 64; pgb = sm[dir * 8 + h]; pga = sm[16 + dir * 8 + h]; } } while (0)
        { LANE_VARS GDN_PREFETCH(0); }
        for (int s = 0; s < 68; ++s) {
            LANE_VARS
            const bool is_ctx = s < 4;
            const size_t row0 = GDN_ROW0(s);
            __syncthreads();
            if (wave == 0) {
                const float be = sigmoidf_(pgb); float G = -alog * softplusf_(pga + dtb);
#pragma unroll
                for (int d = 1; d < 64; d <<= 1) { const float t = __shfl_up(G, d); if (lane >= d) G += t; }
                const float G63 = __shfl(G, 63);
                scb[lane] = be; scG[lane] = G; sceG[lane] = __expf(G); scdK[lane] = __expf(G63 - G); if (lane == 0) scl[0] = __expf(G63);
            }
#pragma unroll
            for (int jj = 0; jj < 2; ++jj) { const int pp = lt + 32 * jj;
                *(LAS v4u*)(lds + L_K + pp * CS_KS + piece * 16) = pk[jj]; *(LAS v4u*)(lds + L_Q + pp * CS_KS + piece * 16) = pq[jj]; *(LAS v4u*)(lds + L_V + pp * CS_KS + piece * 16) = pv[jj]; }
            __syncthreads();
            if (s + 1 < 68) GDN_PREFETCH(s + 1);
            v4u fwdv[2];
            if (dir && !is_ctx) {
#pragma unroll
                for (int jj = 0; jj < 2; ++jj) fwdv[jj] = *(const v4u*)(on + (row0 + (63 - (lt + 32 * jj))) * 2048 + h * 128 + piece * 8); }
            build_kt_plain(lds, tid);
            if (wave < 4) {
                const int bb = wave; f32x4 kk = (f32x4){0.f, 0.f, 0.f, 0.f}, qk = (f32x4){0.f, 0.f, 0.f, 0.f};
#pragma unroll
                for (int ks = 0; ks < 4; ++ks) { const bf16x8 kf = ldfrag(lds + L_K, 16 * bb + r, CS_KS, ks, q); const bf16x8 qf = ldfrag(lds + L_Q, 16 * bb + r, CS_KS, ks, q);
                    kk = MF32(kf, kf, kk); qk = MF32(kf, qf, qk); }
                const float Gr = scG[16 * bb + r], br = scb[16 * bb + r];
                const f32x4 Ge = *(const LAS f32x4*)(scG + 16 * bb + 4 * q), be4 = *(const LAS f32x4*)(scb + 16 * bb + 4 * q);
                f32x4 A, At, att;
#pragma unroll
                for (int e = 0; e < 4; ++e) { const int ie = 4 * q + e; const float dlo = __expf(fminf(Ge[e] - Gr, 0.f)), dhi = __expf(fminf(Gr - Ge[e], 0.f));
                    A[e] = (r < ie) ? be4[e] * kk[e] * dlo : 0.f;
                    At[e] = (ie < r) ? br * kk[e] * dhi : 0.f;
                    att[e] = (ie <= r) ? QSCALE * qk[e] * dhi : 0.f; }
                *(LAS s16x4*)(lds + L_ATT + tri_idx(bb, bb) * 512 + lane * 8) = cvt4(att);
                const f32x4 Z = (f32x4){0.f, 0.f, 0.f, 0.f};
                f32x4 Rt;
#pragma unroll
                for (int e = 0; e < 4; ++e) Rt[e] = ((4 * q + e) == r ? 1.f : 0.f) - At[e];
                f32x4 Pm = MF16(cvt4(At), cvt4(A), Z), Pt = MF16(cvt4(A), cvt4(At), Z);
                Rt = MF16(cvt4(Pm), cvt4(Rt), Rt);
                f32x4 P2 = MF16(cvt4(Pt), cvt4(Pm), Z), Pt2 = MF16(cvt4(Pm), cvt4(Pt), Z);
                Rt = MF16(cvt4(P2), cvt4(Rt), Rt);
                f32x4 P4 = MF16(cvt4(Pt2), cvt4(P2), Z);
                Rt = MF16(cvt4(P4), cvt4(Rt), Rt);
                *(LAS s16x4*)(lds + L_TD + bb * 512 + lane * 8) = cvt4(Rt);
            } else {
#pragma unroll
                for (int uu = 0; uu < 3; ++uu) { const int un = (wave - 4) + 4 * uu; const int pr = un % 6; const bool isqk = un >= 6;
                    const int bi = pr == 0 ? 1 : (pr < 3 ? 2 : 3), bj = pr == 0 ? 0 : (pr < 3 ? pr - 1 : pr - 3);
                    f32x4 d = (f32x4){0.f, 0.f, 0.f, 0.f};
                    const LAS unsigned char* bimg = lds + (isqk ? L_Q : L_K);
#pragma unroll
                    for (int ks = 0; ks < 4; ++ks) d = MF32(ldfrag(lds + L_K, 16 * bj + r, CS_KS, ks, q), ldfrag(bimg, 16 * bi + r, CS_KS, ks, q), d);
                    const float Gi = scG[16 * bi + r], bi_ = scb[16 * bi + r]; const f32x4 Gj = *(const LAS f32x4*)(scG + 16 * bj + 4 * q);
                    const float f = isqk ? QSCALE : -bi_;
#pragma unroll
                    for (int e = 0; e < 4; ++e) d[e] = f * d[e] * __expf(fminf(Gi - Gj[e], 0.f));
                    *(LAS s16x4*)(lds + (isqk ? L_ATT + tri_idx(bi, bj) * 512 : L_AOFF + off_idx(bi, bj) * 512) + lane * 8) = cvt4(d); }
            }
            __syncthreads();
            bf16x8 Sb[4];
#pragma unroll
            for (int ks = 0; ks < 4; ++ks) Sb[ks] = cat8(cvt4(S[2 * ks]), cvt4(S[2 * ks + 1]));
            bf16x8 fa[8];
#define LD8(img, t0) do { _Pragma("unroll") for (int t_ = 0; t_ < 2; ++t_) _Pragma("unroll") for (int ks_ = 0; ks_ < 4; ++ks_) fa[t_ * 4 + ks_] = ldfrag(lds + (img), 16 * ((t0) + t_) + r, CS_KS, ks_, q); } while (0)
#define LD8T(u0) do { _Pragma("unroll") for (int u_ = 0; u_ < 4; ++u_) { fa[2 * u_] = ldfrag(lds + L_KT, 16 * ((u0) + u_) + r, CS_TS, 0, q); fa[2 * u_ + 1] = ldfrag(lds + L_KT, 16 * ((u0) + u_) + r, CS_TS, 1, q); } } while (0)
            f32x4 vn[4];
            LD8(L_K, 0);
#pragma unroll
            for (int t = 0; t < 2; ++t) { f32x4 X = (f32x4){0.f, 0.f, 0.f, 0.f};
#pragma unroll
                for (int ks = 0; ks < 4; ++ks) X = MF32(fa[t * 4 + ks], Sb[ks], X);
                vn[t] = X; }
            LD8(L_K, 2);
#pragma unroll
            for (int t = 0; t < 2; ++t) { f32x4 X = (f32x4){0.f, 0.f, 0.f, 0.f};
#pragma unroll
                for (int ks = 0; ks < 4; ++ks) X = MF32(fa[t * 4 + ks], Sb[ks], X);
                vn[2 + t] = X; }
            if (!is_ctx) LD8(L_Q, 0);
#pragma unroll
            for (int t = 0; t < 4; ++t) { const f32x4 be4 = *(const LAS f32x4*)(scb + 16 * t + 4 * q), eg4 = *(const LAS f32x4*)(sceG + 16 * t + 4 * q);
#pragma unroll
                for (int e = 0; e < 4; ++e) { const float v = bflo((unsigned)*(const LAS unsigned short*)(lds + L_V + (16 * t + 4 * q + e) * CS_KS + (c0 + r) * 2));
                    vn[t][e] = be4[e] * (v - eg4[e] * vn[t][e]); } }
            { s16x4 td[4], ao[6];
#pragma unroll
              for (int i = 0; i < 4; ++i) td[i] = *(const LAS s16x4*)(lds + L_TD + i * 512 + lane * 8);
#pragma unroll
              for (int i = 0; i < 6; ++i) ao[i] = *(const LAS s16x4*)(lds + L_AOFF + i * 512 + lane * 8);
              vn[0] = MF16(td[0], cvt4(vn[0]), ((f32x4){0.f, 0.f, 0.f, 0.f}));
#pragma unroll
              for (int bi = 1; bi < 4; ++bi) { f32x4 a = vn[bi];
#pragma unroll
                  for (int bj = 0; bj < bi; ++bj) a = MF16(ao[off_idx(bi, bj)], cvt4(vn[bj]), a);
                  vn[bi] = MF16(td[bi], cvt4(a), ((f32x4){0.f, 0.f, 0.f, 0.f})); } }
            if (!is_ctx) {
                s16x4 vc[4];
#pragma unroll
                for (int t = 0; t < 4; ++t) vc[t] = cvt4(vn[t]);
#define GDN_OFIN(t) do { const f32x4 eg4 = *(const LAS f32x4*)(sceG + 16 * (t) + 4 * q); \
                    _Pragma("unroll") for (int e = 0; e < 4; ++e) a[e] *= QSCALE * eg4[e]; \
                    _Pragma("unroll") for (int tj = 0; tj <= (t); ++tj) a = MF16(*(const LAS s16x4*)(lds + L_ATT + tri_idx((t), tj) * 512 + lane * 8), vc[tj], a); \
                    _Pragma("unroll") for (int e = 0; e < 4; ++e) *(LAS unsigned short*)(lds + L_O + (16 * (t) + 4 * q + e) * CS_KS + (c0 + r) * 2) = (unsigned short)(pk2c(a[e], 0.f) & 0xffffu); } while (0)
                f32x4 o1;
                { f32x4 a = (f32x4){0.f, 0.f, 0.f, 0.f};
#pragma unroll
                  for (int ks = 0; ks < 4; ++ks) a = MF32(fa[ks], Sb[ks], a);
                  o1 = (f32x4){0.f, 0.f, 0.f, 0.f};
#pragma unroll
                  for (int ks = 0; ks < 4; ++ks) o1 = MF32(fa[4 + ks], Sb[ks], o1);
                  LD8(L_Q, 2);
                  GDN_OFIN(0); a = o1; GDN_OFIN(1); }
                { f32x4 a = (f32x4){0.f, 0.f, 0.f, 0.f};
#pragma unroll
                  for (int ks = 0; ks < 4; ++ks) a = MF32(fa[ks], Sb[ks], a);
                  o1 = (f32x4){0.f, 0.f, 0.f, 0.f};
#pragma unroll
                  for (int ks = 0; ks < 4; ++ks) o1 = MF32(fa[4 + ks], Sb[ks], o1);
                  LD8T(0);
                  GDN_OFIN(2); a = o1; GDN_OFIN(3); }
#undef GDN_OFIN
            } else { LD8T(0); }
            { const float egl = scl[0]; s16x4 vd[4];
#pragma unroll
              for (int t = 0; t < 4; ++t) { const f32x4 dk4 = *(const LAS f32x4*)(scdK + 16 * t + 4 * q); vd[t] = cvt4(vn[t] * dk4); }
              const bf16x8 vb0 = cat8(vd[0], vd[1]), vb1 = cat8(vd[2], vd[3]);
#pragma unroll
              for (int u = 0; u < 4; ++u) { f32x4 a = S[u] * egl; a = MF32(fa[2 * u], vb0, a); a = MF32(fa[2 * u + 1], vb1, a); S[u] = a; }
              LD8T(4);
#pragma unroll
              for (int u = 0; u < 4; ++u) { f32x4 a = S[4 + u] * egl; a = MF32(fa[2 * u], vb0, a); a = MF32(fa[2 * u + 1], vb1, a); S[4 + u] = a; } }
            if (!is_ctx) {
                __syncthreads();
#pragma unroll
                for (int jj = 0; jj < 2; ++jj) { const int pp = lt + 32 * jj; float f[8]; unpack8(*(const LAS v4u*)(lds + L_O + pp * CS_KS + piece * 16), f);
                    bf16* dst = on + (row0 + (dir ? 63 - pp : pp)) * 2048 + h * 128 + piece * 8;
                    if (dir) { float g[8]; unpack8(fwdv[jj], g); float ss = 0.f;
#pragma unroll
                        for (int e = 0; e < 8; ++e) { f[e] += g[e]; ss += f[e] * f[e]; }
                        ss += __shfl_xor(ss, 1); ss += __shfl_xor(ss, 2); ss += __shfl_xor(ss, 4); ss += __shfl_xor(ss, 8);
                        const float rstd = 1.0f / sqrtf(ss * (1.f / 128.f) + EPS);
                        const f32x4 g0 = *(const f32x4*)(p.gdn_norm_g + piece * 8), g1 = *(const f32x4*)(p.gdn_norm_g + piece * 8 + 4);
#pragma unroll
                        for (int e = 0; e < 4; ++e) { f[e] *= rstd * g0[e]; f[4 + e] *= rstd * g1[e]; } }
                    *(v4u*)dst = pack8c(f); }
            }
        }
#undef GDN_PREFETCH
#undef GDN_ROW0
    }
}

constexpr int GL_ATT = 88064, GL_G = 93184, GL_SC = 125952;
__device__ __forceinline__ void gla_unit(const P& p, LAS unsigned char* lds, const int b, const int h, const int vh) {
    const int wave = __builtin_amdgcn_readfirstlane(threadIdx.x >> 6);
    const int c0 = wave * 16;
    const bf16* pbuf = (const bf16*)(p.ws + WS_PB); const float* small = (const float*)(p.ws + WS_SMALL); bf16* on = (bf16*)p.out;
    LAS float* gl = (LAS float*)(lds + GL_SC);
    LAS unsigned char* zb = lds + GL_SC + 512;
    LAS unsigned char* wb = lds + GL_SC + 2560;
    LAS float* gbias = (LAS float*)(lds + GL_SC + 6656);
    for (int dir = 0; dir < 2; ++dir) {
        f32x4 S[8];
#pragma unroll
        for (int u = 0; u < 8; ++u) S[u] = (f32x4){0.f, 0.f, 0.f, 0.f};
        __syncthreads();
        { const float* gw = dir ? p.gla_gate_w_b : p.gla_gate_w_f; const float* gbp = dir ? p.gla_gate_b_b : p.gla_gate_b_f;
          for (int i = threadIdx.x; i < 2048; i += NTHREADS) { const int dim = i >> 4, k = i & 15; *(LAS unsigned short*)(wb + i * 2) = (unsigned short)(pk2c(gw[k * 512 + h * 128 + dim], 0.f) & 0xffffu); }
          if (threadIdx.x < 128) gbias[threadIdx.x] = gbp[h * 128 + threadIdx.x]; }
        v4u pq[2], pk[2], pv[2]; float pz[2];
#define LANE_VARS int tz_ = threadIdx.x; asm volatile("" : "+v"(tz_)); const int tid = tz_, lane = tz_ & 63, r = lane & 15, q = lane >> 4, lt = tz_ >> 4, piece = tz_ & 15; (void)tid; (void)r; (void)q; (void)lt; (void)piece;
#define GLA_ROW0(s_) (((s_) < 4) ? (size_t)(T + b * CTXL + (dir ? 3 - (s_) : (s_)) * 64) : (size_t)(b * SEQ + (dir ? 63 - ((s_) - 4) : (s_) - 4) * 64))
#define GLA_PREFETCH(s_) do { const size_t r0_ = GLA_ROW0(s_); \
            _Pragma("unroll") for (int jj = 0; jj < 2; ++jj) { const int pp = lt + 32 * jj; const bf16* rp = pbuf + (r0_ + (dir ? 63 - pp : pp)) * 2048; \
                pq[jj] = *(const v4u*)(rp + h * 128 + piece * 8); pk[jj] = *(const v4u*)(rp + 512 + h * 128 + piece * 8); pv[jj] = *(const v4u*)(rp + 1024 + h * 256 + vh * 128 + piece * 8); \
                pz[jj] = small[(r0_ + (dir ? 63 - pp : pp)) * 64 + 32 + dir * 16 + piece]; } } while (0)
        { LANE_VARS GLA_PREFETCH(0); }
        for (int s = 0; s < 68; ++s) {
            LANE_VARS
            const bool is_ctx = s < 4;
            const size_t row0 = GLA_ROW0(s);
            __syncthreads();
#pragma unroll
            for (int jj = 0; jj < 2; ++jj) { const int pp = lt + 32 * jj;
                *(LAS v4u*)(lds + L_K + pp * CS_KS + piece * 16) = pk[jj]; *(LAS v4u*)(lds + L_V + pp * CS_KS + piece * 16) = pv[jj];
                *(LAS unsigned short*)(zb + (pp * 16 + piece) * 2) = (unsigned short)(pk2c(pz[jj], 0.f) & 0xffffu); }
            __syncthreads();
            v4u fwdv[2];
            if (dir && !is_ctx) {
#pragma unroll
                for (int jj = 0; jj < 2; ++jj) fwdv[jj] = *(const v4u*)(on + (row0 + (63 - (lt + 32 * jj))) * 2048 + 1024 + h * 256 + vh * 128 + piece * 8); }
            { const s16x4 wfr = *(const LAS s16x4*)(wb + (c0 + r) * 32 + q * 8); const float bia = gbias[c0 + r];
              s16x4 lgb[4];
#pragma unroll
              for (int t = 0; t < 4; ++t) { f32x4 u = MF16(*(const LAS s16x4*)(zb + (16 * t + r) * 32 + q * 8), wfr, ((f32x4){0.f, 0.f, 0.f, 0.f}));
#pragma unroll
                  for (int e = 0; e < 4; ++e) { const float x = u[e] + bia; u[e] = (fminf(x, 0.f) - __logf(1.0f + __expf(-fabsf(x)))) * (1.0f / 16.0f); }
                  lgb[t] = cvt4(u); }
              s16x4 ltri, lone;
              { v2u a, o1; const unsigned one = 0x3f80u;
                a.x = ((4 * q + 0 <= r) ? one : 0u) | (((4 * q + 1 <= r) ? one : 0u) << 16); a.y = ((4 * q + 2 <= r) ? one : 0u) | (((4 * q + 3 <= r) ? one : 0u) << 16);
                o1.x = one | (one << 16); o1.y = o1.x; ltri = __builtin_bit_cast(s16x4, a); lone = __builtin_bit_cast(s16x4, o1); }
              f32x4 gc[4];
#pragma unroll
              for (int ti = 0; ti < 4; ++ti) { f32x4 a = (f32x4){0.f, 0.f, 0.f, 0.f};
#pragma unroll
                  for (int tj = 0; tj <= ti; ++tj) a = MF16(tj == ti ? ltri : lone, lgb[tj], a);
                  gc[ti] = a; }
              const float tot = __shfl(gc[3][3], 48 + r);
              if (q == 0) gl[c0 + r] = __expf(tot);
#pragma unroll
              for (int t = 0; t < 4; ++t) { float kd[4];
#pragma unroll
                  for (int e = 0; e < 4; ++e) { *(LAS float*)(lds + GL_G + (16 * t + 4 * q + e) * 512 + (c0 + r) * 4) = gc[t][e];
                      const float kv = bflo((unsigned)*(const LAS unsigned short*)(lds + L_K + (16 * t + 4 * q + e) * CS_KS + (c0 + r) * 2));
                      kd[e] = kv * __expf(tot - gc[t][e]); }
                  v2u w; w.x = pk2c(kd[0], kd[1]); w.y = pk2c(kd[2], kd[3]);
                  *(LAS v2u*)(lds + L_KT + (c0 + r) * CS_TS + (16 * t + 4 * q) * 2) = w; } }
            __syncthreads();
#pragma unroll
            for (int jj = 0; jj < 2; ++jj) { const int pp = lt + 32 * jj;
                const f32x4 g0 = *(const LAS f32x4*)(lds + GL_G + pp * 512 + piece * 32), g1 = *(const LAS f32x4*)(lds + GL_G + pp * 512 + piece * 32 + 16);
                float qf[8], kf[8]; unpack8(pq[jj], qf); unpack8(pk[jj], kf);
#pragma unroll
                for (int e = 0; e < 4; ++e) { qf[e] *= QSCALE * __expf(g0[e]); kf[e] *= __expf(fminf(-g0[e], 80.f)); qf[4 + e] *= QSCALE * __expf(g1[e]); kf[4 + e] *= __expf(fminf(-g1[e], 80.f)); }
                *(LAS v4u*)(lds + L_Q + pp * CS_KS + piece * 16) = pack8c(qf); *(LAS v4u*)(lds + L_K + pp * CS_KS + piece * 16) = pack8c(kf); }
            if (s + 1 < 68) GLA_PREFETCH(s + 1);
            __syncthreads();
            if (!is_ctx) {
#pragma unroll
                for (int uu = 0; uu < 2; ++uu) { const int un = wave + 8 * uu; if (un < 10) {
                    const int bi = un < 1 ? 0 : (un < 3 ? 1 : (un < 6 ? 2 : 3)), bj = un - bi * (bi + 1) / 2;
                    bf16x8 fk[4], fq[4];
#pragma unroll
                    for (int ks = 0; ks < 4; ++ks) { fk[ks] = ldfrag(lds + L_K, 16 * bj + r, CS_KS, ks, q); fq[ks] = ldfrag(lds + L_Q, 16 * bi + r, CS_KS, ks, q); }
                    f32x4 d = (f32x4){0.f, 0.f, 0.f, 0.f};
#pragma unroll
                    for (int ks = 0; ks < 4; ++ks) d = MF32(fk[ks], fq[ks], d);
                    if (bi == bj) {
#pragma unroll
                        for (int e = 0; e < 4; ++e) d[e] = ((4 * q + e) <= r) ? d[e] : 0.f; }
                    *(LAS s16x4*)(lds + GL_ATT + un * 512 + lane * 8) = cvt4(d); } }
                __syncthreads();
            }
            bf16x8 Sb[4];
#pragma unroll
            for (int ks = 0; ks < 4; ++ks) Sb[ks] = cat8(cvt4(S[2 * ks]), cvt4(S[2 * ks + 1]));
            bf16x8 fa[8];
            if (!is_ctx) LD8(L_Q, 0); else LD8T(0);
            s16x4 vt[4];
#pragma unroll
            for (int t = 0; t < 4; ++t) { unsigned short v[4];
#pragma unroll
                for (int e = 0; e < 4; ++e) v[e] = *(const LAS unsigned short*)(lds + L_V + (16 * t + 4 * q + e) * CS_KS + (c0 + r) * 2);
                v2u w; w.x = (unsigned)v[0] | ((unsigned)v[1] << 16); w.y = (unsigned)v[2] | ((unsigned)v[3] << 16); vt[t] = __builtin_bit_cast(s16x4, w); }
            if (!is_ctx) {
                f32x4 o[4];
#pragma unroll
                for (int t = 0; t < 2; ++t) { f32x4 a = (f32x4){0.f, 0.f, 0.f, 0.f};
#pragma unroll
                    for (int ks = 0; ks < 4; ++ks) a = MF32(fa[t * 4 + ks], Sb[ks], a);
                    o[t] = a; }
                LD8(L_Q, 2);
#pragma unroll
                for (int t = 0; t < 2; ++t) { f32x4 a = (f32x4){0.f, 0.f, 0.f, 0.f};
#pragma unroll
                    for (int ks = 0; ks < 4; ++ks) a = MF32(fa[t * 4 + ks], Sb[ks], a);
                    o[2 + t] = a; }
                LD8T(0);
#pragma unroll
                for (int t = 0; t < 4; ++t) { f32x4 a = o[t];
#pragma unroll
                    for (int tj = 0; tj <= t; ++tj) a = MF16(*(const LAS s16x4*)(lds + GL_ATT + tri_idx(t, tj) * 512 + lane * 8), vt[tj], a);
#pragma unroll
                    for (int e = 0; e < 4; ++e) *(LAS unsigned short*)(lds + L_O + (16 * t + 4 * q + e) * CS_KS + (c0 + r) * 2) = (unsigned short)(pk2c(a[e], 0.f) & 0xffffu); }
            }
            { const bf16x8 vb0 = cat8(vt[0], vt[1]), vb1 = cat8(vt[2], vt[3]);
#pragma unroll
              for (int u = 0; u < 4; ++u) { const f32x4 g4 = *(const LAS f32x4*)(gl + 16 * u + 4 * q); f32x4 a = S[u] * g4; a = MF32(fa[2 * u], vb0, a); a = MF32(fa[2 * u + 1], vb1, a); S[u] = a; }
              LD8T(4);
#pragma unroll
              for (int u = 0; u < 4; ++u) { const f32x4 g4 = *(const LAS f32x4*)(gl + 16 * (4 + u) + 4 * q); f32x4 a = S[4 + u] * g4; a = MF32(fa[2 * u], vb0, a); a = MF32(fa[2 * u + 1], vb1, a); S[4 + u] = a; } }
            if (!is_ctx) {
                __syncthreads();
#pragma unroll
                for (int jj = 0; jj < 2; ++jj) { const int pp = lt + 32 * jj; float f[8]; unpack8(*(const LAS v4u*)(lds + L_O + pp * CS_KS + piece * 16), f);
                    bf16* dst = on + (row0 + (dir ? 63 - pp : pp)) * 2048 + 1024 + h * 256 + vh * 128 + piece * 8;
                    if (dir) { float g[8]; unpack8(fwdv[jj], g);
#pragma unroll
                        for (int e = 0; e < 8; ++e) f[e] += g[e]; }
                    *(v4u*)dst = pack8c(f); }
            }
        }
#undef GLA_PREFETCH
#undef GLA_ROW0
#undef LANE_VARS
    }
}
#ifndef SCAN_ORACLE
#define SCAN_ORACLE 0
#endif
__device__ __forceinline__ void phase_scan(const P& p, LAS unsigned char* lds) {
  const int nrep = p.probe ? 2 : 1;
  for (int rep = 0; rep < nrep; ++rep) {
    const int kinds = rep ? p.probe : 3;
    for (int u = blockIdx.x; u < 256; u += gridDim.x) {
        if (!((kinds >> (u & 1)) & 1)) continue;
#if SCAN_ORACLE
        if (u < 128) scan_unit<false>(p, lds, u >> 3, u & 7, 0);
        else { const int v = u - 128; scan_unit<true>(p, lds, v >> 3, (v >> 1) & 3, v & 1); }
#else
#ifndef GLA_ORACLE
#define GLA_ORACLE 0
#endif
#if !defined(TEST_NO_GDN)
        if ((u & 1) == 0) { const int v = u >> 1; gdn_unit(p, lds, v >> 3, v & 7); }
#else
        if ((u & 1) == 0) {}
#endif
#if defined(TEST_NO_GLA)
        else {}
#elif GLA_ORACLE
        else { const int v = u >> 1; scan_unit<true>(p, lds, v >> 3, (v >> 1) & 3, v & 1); }
#else
        else { const int v = u >> 1; gla_unit(p, lds, v >> 3, (v >> 1) & 3, v & 1); }
#endif
#endif
        __syncthreads();
    }
    __syncthreads();
  }
}

__device__ __forceinline__ void phase_onorm(const P& p) {
    const int tid = threadIdx.x, lane = tid & 63, wave = tid >> 6;
    const int gw = blockIdx.x * NWAVES + wave, NGW = gridDim.x * NWAVES;
    bf16* on = (bf16*)p.out;
#if SCAN_ORACLE
    const float* gp = lane < 32 ? p.gdn_norm_g + (lane & 3) * 32 : p.gla_norm_g + ((lane - 32) & 7) * 32;
    float g[32];
#pragma unroll
    for (int i = 0; i < 32; ++i) g[i] = gp[i];
    for (int r = gw; r < T; r += NGW) {
        v4u* ptr = (v4u*)(on + (size_t)r * 2048 + lane * 32); float f[32]; float ss = 0.f;
#pragma unroll
        for (int q = 0; q < 4; ++q) { float t8[8]; unpack8(ptr[q], t8);
#pragma unroll
            for (int e = 0; e < 8; ++e) { f[q * 8 + e] = t8[e]; ss += t8[e] * t8[e]; } }
        ss += __shfl_xor(ss, 1); ss += __shfl_xor(ss, 2);
        const float s4 = __shfl_xor(ss, 4);
        const float rstd = lane < 32 ? 1.0f / sqrtf(ss * (1.f / 128.f) + EPS) : 1.0f / sqrtf((ss + s4) * (1.f / 256.f) + EPS);
#pragma unroll
        for (int q = 0; q < 4; ++q) { float t8[8];
#pragma unroll
            for (int e = 0; e < 8; ++e) t8[e] = f[q * 8 + e] * rstd * g[q * 8 + e];
            ptr[q] = pack8(t8); }
    }
#else
    float g[16];
#pragma unroll
    for (int i = 0; i < 16; ++i) g[i] = p.gla_norm_g[(lane & 15) * 16 + i];
    for (int r = gw; r < T; r += NGW) {
        v4u* ptr = (v4u*)(on + (size_t)r * 2048 + 1024 + lane * 16); float f[16]; float ss = 0.f;
#pragma unroll
        for (int q = 0; q < 2; ++q) { float t8[8]; unpack8(ptr[q], t8);
#pragma unroll
            for (int e = 0; e < 8; ++e) { f[q * 8 + e] = t8[e]; ss += t8[e] * t8[e]; } }
        ss += __shfl_xor(ss, 1); ss += __shfl_xor(ss, 2); ss += __shfl_xor(ss, 4); ss += __shfl_xor(ss, 8);
        const float rstd = 1.0f / sqrtf(ss * (1.f / 256.f) + EPS);
#pragma unroll
        for (int q = 0; q < 2; ++q) { float t8[8];
#pragma unroll
            for (int e = 0; e < 8; ++e) t8[e] = f[q * 8 + e] * rstd * g[q * 8 + e];
            ptr[q] = pack8(t8); }
    }
#endif
}

__device__ __forceinline__ void phase_wconv(const P& p, LAS unsigned char* lds) {
    const int tid = threadIdx.x, lane = tid & 63, wave = tid >> 6;
    LAS float* scr = (LAS float*)(lds + wave * 8448);
    const int gw = blockIdx.x * NWAVES + wave, NGW = gridDim.x * NWAVES;
    bf16* wgu = (bf16*)(p.ws + WS_WB_GU); bf16* wdn = (bf16*)(p.ws + WS_WB_DN);
    constexpr int I_GU = NE * 64 * 16, I_DN = NE * 32 * 16;
    for (int it = gw; it < I_GU + I_DN; it += NGW) {
        if (it < I_GU) { const int e = it >> 10, r = it & 1023, nb = r >> 4, kb = r & 15;
            const int dstrow = nb < 32 ? (nb >> 2) * 256 + (nb & 3) * 32 : ((nb - 32) >> 2) * 256 + 128 + ((nb - 32) & 3) * 32;
            tr_item(p.w_gu + (size_t)e * D * 2048, 2048, 32 * nb, wgu + (size_t)e * 2048 * D, dstrow, 64 * kb, scr, lane); }
        else { const int r2 = it - I_GU; const int e = r2 >> 9, r = r2 & 511, nb = r >> 4, kb = r & 15;
            tr_item(p.w_down + (size_t)e * D * D, D, 32 * nb, wdn + (size_t)e * D * D, 32 * nb, 64 * kb, scr, lane); }
    }
}

__device__ __forceinline__ void phase_ffnprep(const P& p, LAS unsigned char* lds) {
    const int tid = threadIdx.x, lane = tid & 63, wave = tid >> 6;
    const int gw = blockIdx.x * NWAVES + wave, NGW = gridDim.x * NWAVES;
    LAS float* wrt = (LAS float*)lds;
    LAS int* lcnt = (LAS int*)(lds + 131072);
    for (int i = tid; i < 32 * 1024; i += NTHREADS) { const int k = i >> 5, e = i & 31; wrt[e * 1024 + k] = p.w_router[i]; }
    if (tid < NG * 32) lcnt[tid] = 0;
    { int* st = (int*)(p.ws + WS_SLOT_TOK); float* sp = (float*)(p.ws + WS_SLOT_P);
      for (int i = blockIdx.x * NTHREADS + tid; i < NG * MAXSLOT; i += gridDim.x * NTHREADS) { st[i] = -1; sp[i] = 0.f; } }
    __syncthreads();
    const float* modv = (const float*)(p.ws + WS_MODV); bf16* h2 = (bf16*)(p.ws + WS_H2);
    int* topi = (int*)(p.ws + WS_TOPI); float* topp = (float*)(p.ws + WS_TOPP);
    float br[32];
#pragma unroll
    for (int e = 0; e < 32; ++e) br[e] = p.b_router[e];
    for (int r = gw; r < T; r += NGW) {
        const int b = r >> 12;
        const f32x4* xr = (const f32x4*)(p.out + (size_t)r * D) + lane;
        f32x4 v[4]; float s = 0.f;
#pragma unroll
        for (int j = 0; j < 4; ++j) { v[j] = xr[64 * j]; s += (v[j].x * v[j].x + v[j].y * v[j].y) + (v[j].z * v[j].z + v[j].w * v[j].w); }
        const float rstd = 1.0f / sqrtf(wave_sum(s) * (1.f / D) + EPS);
        const f32x4* g = (const f32x4*)p.norm_ffn_g + lane; const f32x4* sh = (const f32x4*)(modv + b * NMOD + 3 * D) + lane; const f32x4* scl = (const f32x4*)(modv + b * NMOD + 4 * D) + lane;
        v2u* o8 = (v2u*)(h2 + (size_t)r * D) + lane;
#pragma unroll
        for (int j = 0; j < 4; ++j) { const f32x4 gg = g[64 * j], s1 = sh[64 * j], s2 = scl[64 * j]; v[j] = v[j] * rstd * gg * (1.0f + s2) + s1;
            v2u w; w.x = pk2(v[j].x, v[j].y); w.y = pk2(v[j].z, v[j].w); o8[64 * j] = w; }
        float lg[32];
#pragma unroll
        for (int e = 0; e < 32; ++e) { float a = 0.f;
#pragma unroll
            for (int j = 0; j < 4; ++j) { const f32x4 wv = *(const LAS f32x4*)(wrt + e * 1024 + (lane + 64 * j) * 4); a += (v[j].x * wv.x + v[j].y * wv.y) + (v[j].z * wv.z + v[j].w * wv.w); }
            lg[e] = wave_sum(a) + br[e]; }
        int sel[4]; float val[4];
#pragma unroll
        for (int k = 0; k < 4; ++k) { float best = -3.0e38f; int bi = 0;
#pragma unroll
            for (int e = 0; e < 32; ++e) { if (lg[e] > best) { best = lg[e]; bi = e; } }
            sel[k] = bi; val[k] = best;
#pragma unroll
            for (int e = 0; e < 32; ++e) lg[e] = (e == bi) ? -3.0e38f : lg[e]; }
        float pe[4], ps = 0.f;
#pragma unroll
        for (int k = 0; k < 4; ++k) { pe[k] = __expf(val[k] - val[0]); ps += pe[k]; }
        if (lane < 4) { const int k = lane; const int e = k == 0 ? sel[0] : (k == 1 ? sel[1] : (k == 2 ? sel[2] : sel[3])); const float pv = (k == 0 ? pe[0] : (k == 1 ? pe[1] : (k == 2 ? pe[2] : pe[3]))) / ps;
            topi[r * 4 + k] = e; topp[r * 4 + k] = pv; lds_add(&lcnt[(r / TG) * 32 + e], 1); }
    }
    __syncthreads();
    if (tid < NG * 32) { const int v = lcnt[tid]; if (v) atomicAdd((int*)(p.ws + WS_CTL) + CW_CNT + tid, v); }
}

__device__ __forceinline__ void phase_route(const P& p, LAS unsigned char* lds) {
    const int tid = threadIdx.x;
    LAS int* seg = (LAS int*)lds;
    LAS int* lcnt = seg + 64; LAS int* gb = lcnt + 32;
    int* ctl = (int*)(p.ws + WS_CTL);
    int* tile_e = (int*)(p.ws + WS_TILE_E);
    if (tid == 0) {
        for (int g = 0; g < NG; ++g) { int acc = 0;
            for (int e = 0; e < NE; ++e) { const int c = __hip_atomic_load(ctl + CW_CNT + g * 32 + e, __ATOMIC_RELAXED, __HIP_MEMORY_SCOPE_AGENT); const int padded = (c + 255) & ~255; seg[g * 32 + e] = acc;
                if (blockIdx.x == 0) for (int t = acc >> 8; t < (acc + padded) >> 8; ++t) tile_e[g * MAXTILE + t] = e;
                acc += padded; }
            if (blockIdx.x == 0) ctl[CW_NTILE + g] = acc >> 8; }
    }
    __syncthreads();
    const int* topi = (const int*)(p.ws + WS_TOPI); const float* topp = (const float*)(p.ws + WS_TOPP);
    int* slot_tok = (int*)(p.ws + WS_SLOT_TOK); float* slot_p = (float*)(p.ws + WS_SLOT_P); int* tokslot = (int*)(p.ws + WS_TOKSLOT);
    for (int base = blockIdx.x * 256; base < T; base += gridDim.x * 256) {
        const int g = base / TG;
        if (tid < 32) lcnt[tid] = 0;
        __syncthreads();
        int e2[2], lp[2];
#pragma unroll
        for (int jj = 0; jj < 2; ++jj) { const int i = tid + 512 * jj; e2[jj] = topi[base * 4 + i]; lp[jj] = lds_add(&lcnt[e2[jj]], 1); }
        __syncthreads();
        if (tid < 32) gb[tid] = lcnt[tid] ? atomicAdd(ctl + CW_CUR + g * 32 + tid, lcnt[tid]) : 0;
        __syncthreads();
#pragma unroll
        for (int jj = 0; jj < 2; ++jj) { const int i = tid + 512 * jj; const int slot = seg[g * 32 + e2[jj]] + gb[e2[jj]] + lp[jj];
            slot_tok[g * MAXSLOT + slot] = base + (i >> 2); slot_p[g * MAXSLOT + slot] = topp[base * 4 + i]; tokslot[base * 4 + i] = slot; }
        __syncthreads();
    }
}

__device__ __forceinline__ void phase_combine(const P& p, int g) {
    const int tid = threadIdx.x, lane = tid & 63, wave = tid >> 6;
    const int gw = blockIdx.x * NWAVES + wave, NGW = gridDim.x * NWAVES;
    const float* modv = (const float*)(p.ws + WS_MODV); const bf16* ys = (const bf16*)(p.ws + WS_YSLOT); const int* tokslot = (const int*)(p.ws + WS_TOKSLOT);
    for (int r = g * TG + gw; r < (g + 1) * TG; r += NGW) {
        const int b = r >> 12;
        f32x4* xr = (f32x4*)(p.out + (size_t)r * D) + lane;
        const f32x4* g2 = (const f32x4*)(modv + b * NMOD + 5 * D) + lane;
        f32x4 y[4];
#pragma unroll
        for (int j = 0; j < 4; ++j) y[j] = (f32x4){0.f, 0.f, 0.f, 0.f};
#pragma unroll
        for (int k = 0; k < 4; ++k) { const int slot = tokslot[r * 4 + k]; const v2u* yr = (const v2u*)(ys + (size_t)slot * D) + lane;
#pragma unroll
            for (int j = 0; j < 4; ++j) { const v2u w = yr[64 * j]; y[j].x += bflo(w.x); y[j].y += bfhi(w.x); y[j].z += bflo(w.y); y[j].w += bfhi(w.y); } }
        f32x4 v[4]; float s = 0.f;
#pragma unroll
        for (int j = 0; j < 4; ++j) { v[j] = xr[64 * j] + g2[64 * j] * y[j]; s += (v[j].x * v[j].x + v[j].y * v[j].y) + (v[j].z * v[j].z + v[j].w * v[j].w); }
        const float rstd = 1.0f / sqrtf(wave_sum(s) * (1.f / D) + EPS);
        const f32x4* fg = (const f32x4*)p.final_norm_g + lane;
#pragma unroll
        for (int j = 0; j < 4; ++j) xr[64 * j] = v[j] * rstd * fg[64 * j];
    }
}

constexpr int N_PHASES = 13 + 3 * NG;
template <int PH>
__device__ __forceinline__ void run_phase(const P& p, LAS unsigned char* lds) {
    const int G = gridDim.x, c = blockIdx.x;
    unsigned char* ws = p.ws;
    if constexpr (PH == 0) phase_prologue(p, lds);
    else if constexpr (PH == 1) phase_norm1(p);
    else if constexpr (PH == 2) { pg8::SchedDense S{TT / 256, N_S / 256, G, c}; EpiG1 E{(bf16*)(ws + WS_QKVA), (bf16*)(ws + WS_PB), (float*)(ws + WS_SMALL)};
        pg8::gemm_phase(lds, (const bf16*)(ws + WS_H), (const bf16*)(ws + WS_BT_S), D, S, E); }
    else if constexpr (PH == 3) phase_conv(p, lds);
    else if constexpr (PH == 4) phase_scan(p, lds);
    else if constexpr (PH == 5) phase_onorm(p);
    else if constexpr (PH == 6) phase_wconv(p, lds);
    else if constexpr (PH == 7) { pg8::SchedDense S{T / 256, N_G / 256, G, c}; EpiG2 E{(const bf16*)p.out, (bf16*)(ws + WS_YA_IN), (bf16*)(ws + WS_YB_IN), (bf16*)(ws + WS_GATES)};
        pg8::gemm_phase(lds, (const bf16*)(ws + WS_H), (const bf16*)(ws + WS_BT_G), D, S, E); }
    else if constexpr (PH == 8) { pg8::SchedDense S{T / 256, 4, G, c}; EpiG34<0> E{(const bf16*)(ws + WS_GATES), (bf16*)(ws + WS_Y)};
        pg8::gemm_phase(lds, (const bf16*)(ws + WS_YA_IN), (const bf16*)(ws + WS_BT_OA), D, S, E); }
    else if constexpr (PH == 9) { pg8::SchedDense S{T / 256, 4, G, c}; EpiG34<1> E{(const bf16*)(ws + WS_GATES), (bf16*)(ws + WS_Y)};
        pg8::gemm_phase(lds, (const bf16*)(ws + WS_YB_IN), (const bf16*)(ws + WS_BT_OB), D, S, E); }
    else if constexpr (PH == 10) { pg8::SchedDense S{T / 256, 4, G, c}; EpiG5 E{p.x, (const float*)(ws + WS_MODV), p.out};
        pg8::gemm_phase(lds, (const bf16*)(ws + WS_Y), (const bf16*)(ws + WS_BT_O), D, S, E); }
    else if constexpr (PH == 11) phase_ffnprep(p, lds);
    else if constexpr (PH == 12) phase_route(p, lds);
    else {
        constexpr int g = (PH - 13) / 3, sub = (PH - 13) % 3;
        const int ntile = ((const int*)(ws + WS_CTL))[CW_NTILE + g];
        const int* tile_e = (const int*)(ws + WS_TILE_E) + g * MAXTILE;
        if constexpr (sub == 0) { pg8::SchedMoe S{ntile, 8, G, c, tile_e, (const int*)(ws + WS_SLOT_TOK) + g * MAXSLOT}; EpiGU E{p.b_gu, (bf16*)(ws + WS_ACT)};
            pg8::gemm_phase(lds, (const bf16*)(ws + WS_H2), (const bf16*)(ws + WS_WB_GU), D, S, E); }
        else if constexpr (sub == 1) { pg8::SchedMoe S{ntile, 4, G, c, tile_e, nullptr}; EpiDN E{p.b_down, (const float*)(ws + WS_SLOT_P) + g * MAXSLOT, (bf16*)(ws + WS_YSLOT)};
            pg8::gemm_phase(lds, (const bf16*)(ws + WS_ACT), (const bf16*)(ws + WS_WB_DN), D, S, E); }
        else phase_combine(p, g);
    }
}

#ifndef PROBE_DUP_MASK
#define PROBE_DUP_MASK 0u
#endif
#if MK_FUSED
template <int PH>
__device__ __forceinline__ void run_from(const P& p, LAS unsigned char* lds, const XcdBarrier& bar) {
    if constexpr (PH < N_PHASES) { run_phase<PH>(p, lds);
        if constexpr ((PROBE_DUP_MASK >> PH) & 1u) { xcd_barrier(bar); run_phase<PH>(p, lds); }
        if constexpr (PH + 1 < N_PHASES) xcd_barrier(bar); run_from<PH + 1>(p, lds, bar); }
}
__global__ void __launch_bounds__(NTHREADS, 2) k_fused(P p) {
    extern __shared__ __attribute__((aligned(16))) unsigned char lds_raw[];
    LAS unsigned char* lds = (LAS unsigned char*)lds_raw;
    volatile LAS unsigned* misc = (volatile LAS unsigned*)(lds + 144 * 1024 - 64);
    if (threadIdx.x < 4) misc[threadIdx.x] = 0u;
    __syncthreads();
    XcdBarrier bar = xcd_barrier_post((unsigned*)(p.ws + WS_CTL) + CW_BAR, misc);
    run_from<0>(p, lds, bar);
}
#else
template <int PH>
__global__ void __launch_bounds__(NTHREADS, 2) k_phase(P p) {
    extern __shared__ __attribute__((aligned(16))) unsigned char lds_raw[];
    run_phase<PH>(p, (LAS unsigned char*)lds_raw);
}
template <int PH>
static void launch_all(const P& p, int grid, hipStream_t stream) {
    if constexpr (PH < N_PHASES) {
        static bool attr = false;
        if (!attr) { (void)hipFuncSetAttribute((const void*)k_phase<PH>, hipFuncAttributeMaxDynamicSharedMemorySize, LDS_BYTES); attr = true; }
        hipLaunchKernelGGL(k_phase<PH>, dim3(grid), dim3(NTHREADS), LDS_BYTES, stream, p);
        launch_all<PH + 1>(p, grid, stream);
    }
}
#endif

extern "C" void kernel_launch(void* const* d_in, const int* in_sizes, int n_in, void* d_out, int out_size, void* d_ws, size_t ws_size, hipStream_t stream) {
    static int grid = 0;
    if (grid == 0) {
        if (n_in != 30 || in_sizes[0] != T * D || out_size != T * D || ws_size < WS_END) { fprintf(stderr, "kernel_launch: unexpected shapes (n_in %d, in0 %d, out %d, ws %zu)\n", n_in, n_in > 0 ? in_sizes[0] : -1, out_size, ws_size); grid = -1; return; }
        int dev = 0, cus = 0;
        if (hipGetDevice(&dev) != hipSuccess || hipDeviceGetAttribute(&cus, hipDeviceAttributeMultiprocessorCount, dev) != hipSuccess) { grid = -1; return; }
#if MK_FUSED
        if (hipFuncSetAttribute((const void*)k_fused, hipFuncAttributeMaxDynamicSharedMemorySize, LDS_BYTES) != hipSuccess) { fprintf(stderr, "kernel_launch: hipFuncSetAttribute failed\n"); grid = -1; return; }
        int per_cu = 0;
        if (hipOccupancyMaxActiveBlocksPerMultiprocessor(&per_cu, (const void*)k_fused, NTHREADS, LDS_BYTES) != hipSuccess || per_cu < 1) fprintf(stderr, "kernel_launch: occupancy query reports %d\n", per_cu);
        (void)hipGetLastError();
#endif
        grid = cus;
    }
    if (grid < 0) return;
    (void)hipMemsetAsync((char*)d_ws + WS_CTL, 0, CTL_BYTES, stream);
    P p{};
    const float** pp = (const float**)&p;
    for (int i = 0; i < 30; ++i) pp[i] = (const float*)d_in[i];
    p.out = (float*)d_out; p.ws = (unsigned char*)d_ws;
#ifdef PROBE_SCAN_KIND
    p.probe = PROBE_SCAN_KIND;
#endif
#if MK_FUSED
    hipLaunchKernelGGL(k_fused, dim3(grid), dim3(NTHREADS), LDS_BYTES, stream, p);
#else
    launch_all<0>(p, grid, stream);
#endif
}
```

```cpp
#include <hip/hip_runtime.h>
#include <cstdio>
#include <cstdint>

#ifndef MK_FUSED
#define MK_FUSED 1
#endif
#ifndef FP8_G1
#define FP8_G1 1
#endif
#define G1_NF8 (FP8_G1 == 0 ? 0 : (FP8_G1 == 1 ? 21 : (FP8_G1 == 2 ? 12 : 20)))
#ifndef MOE_GATHER
#define MOE_GATHER 1
#endif
#ifndef FP8_G2
#define FP8_G2 1
#endif

#define GAS __attribute__((address_space(1)))
#define LAS __attribute__((address_space(3)))
typedef unsigned short bf16;
typedef unsigned v4u __attribute__((ext_vector_type(4)));
typedef unsigned v2u __attribute__((ext_vector_type(2)));
typedef float f32x4 __attribute__((ext_vector_type(4)));
typedef short bf16x8 __attribute__((ext_vector_type(8)));

constexpr int D = 1024, NB = 16, SEQ = 4096, T = NB * SEQ, CTXL = 256, TC = NB * CTXL, TT = T + TC;
constexpr int D_IN = 9280, N_S = 5376, N_G = 4096, NMOD = 6 * D;
constexpr int NE = 32, NG = 1, TG = T / NG, MAXSLOT = TG * 4 + NE * 256, MAXTILE = MAXSLOT / 256;
constexpr float EPS = 1e-6f;
constexpr int NTHREADS = 512, NWAVES = 8;
constexpr int LDS_BYTES = 147456;

constexpr size_t MiB = 1u << 20;
constexpr size_t WS_CTL = 0, CTL_BYTES = 1 * MiB;
constexpr size_t WS_MODV = 1 * MiB, WS_BT_S = 2 * MiB, WS_BT_G = 13 * MiB, WS_BT_OA = 21 * MiB, WS_BT_OB = 23 * MiB, WS_BT_O = 25 * MiB;
constexpr size_t WS_TOPI = 27 * MiB, WS_TOPP = 28 * MiB, WS_TOKSLOT = 29 * MiB, WS_SLOT_TOK = 30 * MiB, WS_SLOT_P = 32 * MiB, WS_TILE_E = 34 * MiB;
constexpr size_t WS_H8 = 880 * MiB, WS_BT_S8 = 976 * MiB, WS_BT_G8 = 984 * MiB;
constexpr size_t WS_H = 40 * MiB, WS_PB = 176 * MiB, WS_SMALL = 448 * MiB, WS_QKVA = 465 * MiB;
constexpr size_t WS_YA_IN = 240 * MiB, WS_YB_IN = 368 * MiB, WS_GATES = 496 * MiB, WS_Y = 752 * MiB;
constexpr size_t WS_X1B = 40 * MiB;
__host__ __device__ __forceinline__ constexpr int wb_dn_mib(int e) { return e < 28 ? 948 + e : 960 + e; }
constexpr int EARLY_GU = 15;
__host__ __device__ __forceinline__ constexpr int wb_gu_mib(int e) { return e < 8 ? 992 + 2 * e : (e < EARLY_GU ? 2 * e - 14 : 880 + 2 * (e - EARLY_GU)); }
constexpr size_t WS_H2 = 40 * MiB, WS_XG = 200 * MiB, WS_ACT = (NG == 1 ? 264 : 472) * MiB, WS_YSLOT = 608 * MiB, WS_END = 1008 * MiB;
static_assert(WS_QKVA + (size_t)TT * 3072 * 2 <= 873 * MiB && WS_SMALL + (size_t)TT * 64 * 4 <= WS_QKVA && WS_H + (size_t)TT * D * 2 <= WS_PB, "ws map");
static_assert(WS_XG + (size_t)T * D <= WS_ACT && WS_ACT + (size_t)MAXSLOT * D <= WS_YSLOT && WS_YSLOT + (size_t)MAXSLOT * D <= 880 * MiB && MOE_GATHER == 1 && (size_t)(wb_gu_mib(7) + 2) * MiB <= WS_END && wb_gu_mib(NE - 1) + 2 <= 948 && (EARLY_GU <= 8 || wb_gu_mib(EARLY_GU - 1) + 2 <= 21) && WS_H2 + (size_t)T * D <= WS_XG && WS_QKVA + (size_t)TT * 3072 * 2 <= 880 * MiB, "ws map 2");
constexpr int CW_BAR = 4096, CW_CNT = 8192, CW_CUR = 8192 + 256, CW_NTILE = 8192 + 512;

#define LDS_WAIT() asm volatile("s_waitcnt lgkmcnt(0)" ::: "memory")
#define VM_WAIT() asm volatile("s_waitcnt vmcnt(0)" ::: "memory")
__device__ __forceinline__ float bflo(unsigned u) { return __uint_as_float(u << 16); }
__device__ __forceinline__ float bfhi(unsigned u) { return __uint_as_float(u & 0xffff0000u); }
__device__ __forceinline__ unsigned pk2(float lo, float hi) { unsigned r; asm("v_cvt_pk_bf16_f32 %0, %1, %2" : "=v"(r) : "v"(lo), "v"(hi)); return r; }
__device__ __forceinline__ float wave_sum(float x) {
    x += __builtin_bit_cast(float, __builtin_amdgcn_update_dpp(0, __builtin_bit_cast(int, x), 0xB1, 0xF, 0xF, true));
    x += __builtin_bit_cast(float, __builtin_amdgcn_update_dpp(0, __builtin_bit_cast(int, x), 0x4E, 0xF, 0xF, true));
    x += __builtin_bit_cast(float, __builtin_amdgcn_update_dpp(0, __builtin_bit_cast(int, x), 0x141, 0xF, 0xF, true));
    x += __builtin_bit_cast(float, __builtin_amdgcn_update_dpp(0, __builtin_bit_cast(int, x), 0x140, 0xF, 0xF, true));
    { float a = x, b = x; asm volatile("s_nop 1\n\tv_permlane16_swap_b32 %0, %1" : "+v"(a), "+v"(b)); x = a + b; }
    { float a = x, b = x; asm volatile("s_nop 1\n\tv_permlane32_swap_b32 %0, %1" : "+v"(a), "+v"(b)); x = a + b; }
    return x;
}
__device__ __forceinline__ float row16_sum(float x) {
    x += __builtin_bit_cast(float, __builtin_amdgcn_update_dpp(0, __builtin_bit_cast(int, x), 0xB1, 0xF, 0xF, true));
    x += __builtin_bit_cast(float, __builtin_amdgcn_update_dpp(0, __builtin_bit_cast(int, x), 0x4E, 0xF, 0xF, true));
    x += __builtin_bit_cast(float, __builtin_amdgcn_update_dpp(0, __builtin_bit_cast(int, x), 0x141, 0xF, 0xF, true));
    x += __builtin_bit_cast(float, __builtin_amdgcn_update_dpp(0, __builtin_bit_cast(int, x), 0x140, 0xF, 0xF, true));
    return x;
}
__device__ __forceinline__ int lds_add(LAS int* p, int v) { return __hip_atomic_fetch_add(p, v, __ATOMIC_RELAXED, __HIP_MEMORY_SCOPE_WORKGROUP); }
__device__ __forceinline__ float sigmoidf_(float x) { return 1.0f / (1.0f + __expf(-x)); }
__device__ __forceinline__ float siluf_(float x) { return x / (1.0f + __expf(-x)); }
__device__ __forceinline__ float sigmoid_fast(float x) { return __builtin_amdgcn_rcpf(1.0f + __builtin_amdgcn_exp2f(-1.44269504f * x)); }
__device__ __forceinline__ float silu_fast(float x) { return x * __builtin_amdgcn_rcpf(1.0f + __builtin_amdgcn_exp2f(-1.44269504f * x)); }
__device__ __forceinline__ float rsqrtf_(float x) { return __builtin_amdgcn_rsqf(x); }
__device__ __forceinline__ float softplusf_(float x) { return fmaxf(x, 0.f) + 0.69314718f * __builtin_amdgcn_logf(1.0f + __builtin_amdgcn_exp2f(-1.44269504f * fabsf(x))); }
__device__ __forceinline__ void unpack8(const v4u w, float (&f)[8]) {
    f[0] = bflo(w.x); f[1] = bfhi(w.x); f[2] = bflo(w.y); f[3] = bfhi(w.y); f[4] = bflo(w.z); f[5] = bfhi(w.z); f[6] = bflo(w.w); f[7] = bfhi(w.w);
}
__device__ __forceinline__ v4u pack8(const float (&f)[8]) { v4u w; w.x = pk2(f[0], f[1]); w.y = pk2(f[2], f[3]); w.z = pk2(f[4], f[5]); w.w = pk2(f[6], f[7]); return w; }

__device__ __forceinline__ unsigned pk4f8(float a, float b, float c, float d) { int w = __builtin_amdgcn_cvt_pk_fp8_f32(a, b, 0, false); w = __builtin_amdgcn_cvt_pk_fp8_f32(c, d, w, true); return (unsigned)w; }
struct P {
    const float *x, *c, *ctx, *c_ctx, *w_mod, *b_mod, *norm_mix_g, *norm_ffn_g, *w_in, *conv_w, *a_log_f, *a_log_b, *dt_bias_f, *dt_bias_b, *gdn_norm_g,
        *gla_gate_w_f, *gla_gate_w_b, *gla_gate_b_f, *gla_gate_b_b, *gla_norm_g, *w_out_a, *w_out_b, *w_out, *w_router, *b_router, *w_gu, *b_gu, *w_down, *b_down, *final_norm_g;
    float* out; unsigned char* ws; int probe; int pad_;
};

typedef float f32x2_t __attribute__((ext_vector_type(2)));
namespace pg8 {
constexpr int BM = 256, BK = 64, HALF = 128, HTB = HALF * BK * 2, STAGE_BYTES = 8 * HTB, NXCD = 8, WGM = 8;
__host__ __device__ __forceinline__ int lds_byte(int r, int c) { const int m = r >> 4, fr = r & 15, ch = c >> 3; return m * 2048 + (fr >> 3) * 1024 + (8 * (fr & 7) + (ch ^ (fr & 6))) * 16; }
__host__ __device__ __forceinline__ void stage_rc(int b, int& R, int& C) { const int blk = b / 1024, sl = (b % 1024) / 16, r7 = sl >> 3; R = blk * 8 + r7; C = ((sl & 7) ^ (r7 & 6)) * 8; }
__host__ __device__ __forceinline__ int perm32(int rho) { const int n = rho >> 4, i = rho & 15; return 8 * (i >> 2) + 4 * n + (i & 3); }
struct Unit { int pm, pn, bt, e; };

__device__ __forceinline__ void order_map(int L, int nM, int nN, int& pm, int& pn) {
    const int nwg = nM * nN; int wgid = L;
    { const int q = nwg / NXCD, r = nwg % NXCD, xcd = wgid % NXCD, off = wgid / NXCD; wgid = (xcd < r ? xcd * (q + 1) : r * (q + 1) + (xcd - r) * q) + off; }
    const int nig = WGM * nN, gid = wgid / nig, fm = gid * WGM, gsz = (nM - fm) < WGM ? (nM - fm) : WGM;
    pm = fm + ((wgid % nig) % gsz); pn = (wgid % nig) / gsz;
}
struct SchedDense {
    int nM, nN, G, c, pn0 = 0;
    __device__ __forceinline__ bool next(int i, Unit& u) const { const long L = (long)i * G + c; if (L >= (long)nM * nN) return false; order_map((int)L, nM, nN, u.pm, u.pn); u.pn += pn0; u.bt = u.pn; u.e = 0; return true; }
    __device__ __forceinline__ unsigned arow(const Unit& u, int r) const { return (unsigned)(u.pm * BM + r); }
};
struct SchedMoeDense {
    int nM, nN, G, c; const int* tile_e; int dn;
    __device__ __forceinline__ bool next(int i, Unit& u) const { const long L = (long)i * G + c; if (L >= (long)nM * nN) return false; order_map((int)L, nM, nN, u.pm, u.pn); u.e = tile_e[u.pm]; u.bt = 4 * (dn ? wb_dn_mib(u.e) : wb_gu_mib(u.e)) + u.pn; return true; }
    __device__ __forceinline__ unsigned arow(const Unit& u, int r) const { return (unsigned)(u.pm * BM + r); }
};
struct SchedMoe {
    int nM, nN, G, c; const int* tile_e; const int* slot_tok; int dn;
    __device__ __forceinline__ bool next(int i, Unit& u) const { const long L = (long)i * G + c; if (L >= (long)nM * nN) return false; order_map((int)L, nM, nN, u.pm, u.pn); u.e = tile_e[u.pm]; u.bt = 4 * (dn ? wb_dn_mib(u.e) : wb_gu_mib(u.e)) + u.pn; return true; }
    __device__ __forceinline__ unsigned arow(const Unit& u, int r) const { if (slot_tok) { const int t = slot_tok[u.pm * BM + r]; return (unsigned)(t < 0 ? 0 : t); } return (unsigned)(u.pm * BM + r); }
};

typedef float f32x2_z __attribute__((ext_vector_type(2)));
typedef int i32x8 __attribute__((ext_vector_type(8)));
typedef float f32x8_t __attribute__((ext_vector_type(8)));
typedef short s16x16 __attribute__((ext_vector_type(16)));
typedef int i32x4 __attribute__((ext_vector_type(4)));
__device__ __forceinline__ i32x8 ld32(const LAS unsigned char* p) { const i32x4 a = *(const LAS i32x4*)p, b = *(const LAS i32x4*)(p + 16); return __builtin_shufflevector(a, b, 0, 1, 2, 3, 4, 5, 6, 7); }
#ifndef PROBE_GDUP
#define PROBE_GDUP 0
#endif
template <class Epi, class Sched, bool FP8 = false>
__device__ __forceinline__ void gemm_phase(LAS unsigned char* lds, const bf16* A, const bf16* Bt, const int K, const Sched& S, const Epi& E) {
    int tid = threadIdx.x; asm volatile("" : "+v"(tid));
    const int wid = __builtin_amdgcn_readfirstlane(tid >> 6), lane = tid & 63, wr = wid >> 2, wc = wid & 3, fr = lane & 15, fq = lane >> 4;
    const int nt = K / BK;
    int R0, C0; stage_rc(tid * 16, R0, C0);
    unsigned voffB[2];
#pragma unroll
    for (int i = 0; i < 2; ++i) { const int R = R0 + 64 * i; const int Rb = (R & ~31) + perm32(R & 31); voffB[i] = (unsigned)(Rb * K + C0) * 2u; }
    const unsigned rowb = (unsigned)K * 2u, cofs = (unsigned)C0 * 2u;
    const size_t kstep = (size_t)(BK * 2);
    const size_t hstep = (size_t)HALF * K * 2;
    const size_t tstep = 2 * hstep;
    const unsigned ldsw = (unsigned)wid * 1024u;
    const int aoff = lds_byte(wr * 64 + fr, fq * 8), boff = lds_byte(wc * 32 + fr, fq * 8), aoff1 = lds_byte(wr * 64 + fr, fq * 8 + 32), boff1 = lds_byte(wc * 32 + fr, fq * 8 + 32);
    const unsigned addrA = (unsigned)(size_t)lds + (unsigned)aoff, addrB = (unsigned)(size_t)lds + 65536u + (unsigned)boff, addrA1 = (unsigned)(size_t)lds + (unsigned)aoff1, addrB1 = (unsigned)(size_t)lds + 65536u + (unsigned)boff1; (void)addrA; (void)addrB; (void)addrA1; (void)addrB1;
#define PG8_SA(b, h) (((b) * 2 + (h)) * HTB)
#define PG8_SB(b, h) ((4 + (b) * 2 + (h)) * HTB)
#define PG8_STAGE(bufoff, gbase, voff) do { _Pragma("unroll") for (int _i = 0; _i < 2; ++_i) \
        __builtin_amdgcn_global_load_lds((const unsigned*)((const char*)(gbase) + (voff)[_i]), (LAS unsigned*)(lds + (bufoff) + ldsw + _i * 8192), 16, 0, 0); } while (0)
#define PG8_STAGE_A(bufoff, gbase, o0, o1) do { \
        __builtin_amdgcn_global_load_lds((const unsigned*)((const char*)(gbase) + (o0)), (LAS unsigned*)(lds + (bufoff) + ldsw), 16, 0, 0); \
        __builtin_amdgcn_global_load_lds((const unsigned*)((const char*)(gbase) + (o1)), (LAS unsigned*)(lds + (bufoff) + ldsw + 8192), 16, 0, 0); } while (0)
#define F8_RD(rlo, rhi, rfull, var, addr, off) asm volatile("ds_read_b128 " rlo ", %1 offset:%3\n\tds_read_b128 " rhi ", %2 offset:%3" : "={" rfull "}"(var) : "v"(addr), "v"(addr##1), "i"(off))
#define PG8_LDA(dst, b, h) do { if constexpr (FP8) { \
            F8_RD("v[192:195]", "v[196:199]", "v[192:199]", dst##8[0], addrA, PG8_SA(b, h)); F8_RD("v[200:203]", "v[204:207]", "v[200:207]", dst##8[1], addrA, PG8_SA(b, h) + 2048); \
            F8_RD("v[208:211]", "v[212:215]", "v[208:215]", dst##8[2], addrA, PG8_SA(b, h) + 4096); F8_RD("v[216:219]", "v[220:223]", "v[216:223]", dst##8[3], addrA, PG8_SA(b, h) + 6144); } \
        else { _Pragma("unroll") for (int m = 0; m < 4; ++m) _Pragma("unroll") for (int k = 0; k < 2; ++k) dst[m][k] = *(const LAS bf16x8*)(lds + PG8_SA(b, h) + (k ? aoff1 : aoff) + m * 2048); } } while (0)
#define PG8_LDB0(b, h) do { if constexpr (FP8) { F8_RD("v[224:227]", "v[228:231]", "v[224:231]", B08[0], addrB, PG8_SB(b, h) - 65536); F8_RD("v[232:235]", "v[236:239]", "v[232:239]", B08[1], addrB, PG8_SB(b, h) - 65536 + 2048); } \
        else { _Pragma("unroll") for (int n = 0; n < 2; ++n) _Pragma("unroll") for (int k = 0; k < 2; ++k) B0[n][k] = *(const LAS bf16x8*)(lds + PG8_SB(b, h) + (k ? boff1 : boff) + n * 2048); } } while (0)
#define PG8_LDB1(b, h) do { if constexpr (FP8) { F8_RD("v[240:243]", "v[244:247]", "v[240:247]", B18[0], addrB, PG8_SB(b, h) - 65536); F8_RD("v[248:251]", "v[252:255]", "v[248:255]", B18[1], addrB, PG8_SB(b, h) - 65536 + 2048); } \
        else { _Pragma("unroll") for (int n = 0; n < 2; ++n) _Pragma("unroll") for (int k = 0; k < 2; ++k) B1[n][k] = *(const LAS bf16x8*)(lds + PG8_SB(b, h) + (k ? boff1 : boff) + n * 2048); } } while (0)
#define PG8_LDB(dst, b, h) PG8_LD##dst(b, h)
#define PG8_LDB0_X 0
#define PG8_MMA(ai, bj, At, Bt_) do { if (PROBE_GDUP == 3 && !(ui & 1)) break; __builtin_amdgcn_s_setprio(1); \
        if constexpr (FP8) { _Pragma("unroll") for (int m = 0; m < 4; ++m) _Pragma("unroll") for (int n = 0; n < 2; ++n) \
            acc[ai][bj][m][n] = __builtin_amdgcn_mfma_scale_f32_16x16x128_f8f6f4(Bt_##8[n], At##8[m], acc[ai][bj][m][n], 0, 0, 0, 0x79797979, 0, 0x7f7f7f7f); } \
        else { _Pragma("unroll") for (int m = 0; m < 4; ++m) _Pragma("unroll") for (int n = 0; n < 2; ++n) _Pragma("unroll") for (int k = 0; k < 2; ++k) \
            acc[ai][bj][m][n] = __builtin_amdgcn_mfma_f32_16x16x32_bf16(Bt_[n][k], At[m][k], acc[ai][bj][m][n], 0, 0, 0); } \
        __builtin_amdgcn_s_setprio(0); } while (0)
#define PG8_WAIT_V(n) asm volatile("s_waitcnt vmcnt(" #n ")" ::: "memory")
#define PG8_WAIT_L(n) do { if constexpr (FP8) asm volatile("s_waitcnt lgkmcnt(" #n ")" : "+{v[192:199]}"(At8[0]), "+{v[200:207]}"(At8[1]), "+{v[208:215]}"(At8[2]), "+{v[216:223]}"(At8[3]), "+{v[224:231]}"(B08[0]), "+{v[232:239]}"(B08[1]), "+{v[240:247]}"(B18[0]), "+{v[248:255]}"(B18[1]) :: "memory"); \
        else asm volatile("s_waitcnt lgkmcnt(" #n ")" ::: "memory"); } while (0)
#define PG8_BAR __builtin_amdgcn_s_barrier()
#define PG8_SCHED __builtin_amdgcn_sched_barrier(0)
    Unit cur, nxt; int ui = 0;
    if (!S.next(0, cur)) return;
    f32x4 acc[2][2][4][2];
#pragma unroll
    for (int a = 0; a < 2; ++a)
#pragma unroll
        for (int b = 0; b < 2; ++b)
#pragma unroll
            for (int m = 0; m < 4; ++m)
#pragma unroll
                for (int n = 0; n < 2; ++n) acc[a][b][m][n] = (f32x4){0.f, 0.f, 0.f, 0.f};
    bf16x8 At[4][2], B0[2][2], B1[2][2]; i32x8 At8[4] = {}, B08[2] = {}, B18[2] = {};
    const char* Ab = (const char*)A;
    const char* cB = (const char*)Bt + (size_t)cur.bt * tstep;
    unsigned c00 = S.arow(cur, R0) * rowb + cofs, c01 = S.arow(cur, R0 + 64) * rowb + cofs, c10 = S.arow(cur, HALF + R0) * rowb + cofs, c11 = S.arow(cur, HALF + R0 + 64) * rowb + cofs;
    unsigned n00, n01, n10, n11;
    PG8_STAGE(PG8_SB(0, 0), cB, voffB); PG8_STAGE(PG8_SB(0, 1), cB + hstep, voffB); PG8_STAGE_A(PG8_SA(0, 0), Ab, c00, c01); PG8_STAGE_A(PG8_SA(0, 1), Ab, c10, c11);
    if (wr == 1) PG8_BAR;
    PG8_WAIT_V(2); PG8_BAR;
    PG8_STAGE(PG8_SB(1, 0), cB + kstep, voffB); PG8_STAGE_A(PG8_SA(1, 0), Ab + kstep, c00, c01); PG8_STAGE(PG8_SB(1, 1), cB + hstep + kstep, voffB);
    PG8_WAIT_V(6); PG8_BAR;
    for (;;) {
        const bool has_next = S.next((ui + 1) >> (PROBE_GDUP ? 1 : 0), nxt);
        const char* nB = has_next ? (const char*)Bt + (size_t)nxt.bt * tstep : cB;
        if (has_next) { n00 = S.arow(nxt, R0) * rowb + cofs; n01 = S.arow(nxt, R0 + 64) * rowb + cofs; n10 = S.arow(nxt, HALF + R0) * rowb + cofs; n11 = S.arow(nxt, HALF + R0 + 64) * rowb + cofs; }
        else { n00 = c00; n01 = c01; n10 = c10; n11 = c11; }
#pragma unroll 1
        for (int t = 0; t < nt; t += 2) {
            const bool last = (t == nt - 2);
            const char* a1 = Ab + (size_t)(t + 1) * kstep;
            const char* a2 = last ? Ab : Ab + (size_t)(t + 2) * kstep; const char* b2 = last ? nB : cB + (size_t)(t + 2) * kstep;
            const char* a3 = a2 + kstep; const char* b3 = b2 + kstep;
            const unsigned x00 = last ? n00 : c00, x01 = last ? n01 : c01, x10 = last ? n10 : c10, x11 = last ? n11 : c11;
            PG8_LDB(B0, 0, 0); PG8_LDB(B1, 0, 1); PG8_SCHED; PG8_LDA(At, 0, 0); PG8_STAGE_A(PG8_SA(1, 1), a1, c10, c11);
            PG8_WAIT_V(8); PG8_WAIT_L(0); PG8_BAR; PG8_MMA(0, 0, At, B0); PG8_MMA(0, 1, At, B1); PG8_BAR; PG8_SCHED;
            PG8_LDA(At, 0, 1); PG8_STAGE(PG8_SB(0, 0), b2, voffB); PG8_STAGE(PG8_SB(0, 1), b2 + hstep, voffB); PG8_STAGE_A(PG8_SA(0, 0), a2, x00, x01);
            PG8_WAIT_V(8); PG8_WAIT_L(0); PG8_BAR; PG8_MMA(1, 0, At, B0); PG8_MMA(1, 1, At, B1); PG8_BAR; PG8_SCHED;
            PG8_LDB(B0, 1, 0); PG8_LDB(B1, 1, 1); PG8_SCHED; PG8_LDA(At, 1, 0); PG8_STAGE_A(PG8_SA(0, 1), a2, x10, x11);
            PG8_WAIT_V(8); PG8_WAIT_L(0); PG8_BAR; PG8_MMA(0, 0, At, B0); PG8_MMA(0, 1, At, B1); PG8_BAR; PG8_SCHED;
            PG8_LDA(At, 1, 1); PG8_STAGE(PG8_SB(1, 0), b3, voffB); PG8_STAGE(PG8_SB(1, 1), b3 + hstep, voffB); PG8_STAGE_A(PG8_SA(1, 0), a3, x00, x01);
            PG8_WAIT_V(8); PG8_WAIT_L(0); PG8_BAR; PG8_MMA(1, 0, At, B0); PG8_MMA(1, 1, At, B1); PG8_BAR; PG8_SCHED;
        }
        if (wr == 0) PG8_BAR;
        if ((PROBE_GDUP != 1 && PROBE_GDUP != 3) || (ui & 1)) { int tz = threadIdx.x; asm volatile("" : "+v"(tz)); const int ln = tz & 63; E(acc, cur, wr, wc, ln & 15, ln >> 4); }
        if (!has_next) break;
#pragma unroll
        for (int a = 0; a < 2; ++a)
#pragma unroll
            for (int b = 0; b < 2; ++b)
#pragma unroll
                for (int m = 0; m < 4; ++m)
#pragma unroll
                    for (int n = 0; n < 2; ++n) { f32x2_z z0, z1; asm volatile("v_pk_mov_b32 %0, 0, 0\n\tv_pk_mov_b32 %1, 0, 0" : "=v"(z0), "=v"(z1)); acc[a][b][m][n] = (f32x4){z0.x, z0.y, z1.x, z1.y}; }
        cur = nxt; cB = nB; c00 = n00; c01 = n01; c10 = n10; c11 = n11; ++ui;
        if (wr == 1) PG8_BAR;
    }
    PG8_WAIT_V(0);
    PG8_BAR;
#undef PG8_SA
#undef PG8_SB
#undef PG8_STAGE
#undef PG8_STAGE_A
#undef PG8_LDA
#undef PG8_LDB
#undef PG8_LDB0
#undef PG8_LDB1
#undef F8_RD
#undef PG8_MMA
#undef PG8_WAIT_V
#undef PG8_WAIT_L
#undef PG8_BAR
#undef PG8_SCHED
}
}
typedef f32x4 Acc[2][2][4][2];

#define XB_TMO      128
#define XB_XCNT(j)  (256  + 64 * (j))
#define XB_XSUB(j)  (1280 + 64 * (j))
#define XB_XGEN(j)  (2304 + 64 * (j))
#define XB_TOP      3328
#define XB_TOPGEN   3392
#define XCD_BAR_WORDS 3456
#define XB_SPIN_CAP (1u << 22)
__device__ __forceinline__ unsigned xb_ld(unsigned* p)              { return __hip_atomic_load(p, __ATOMIC_RELAXED, __HIP_MEMORY_SCOPE_AGENT); }
__device__ __forceinline__ unsigned xb_add(unsigned* p, unsigned v) { return __hip_atomic_fetch_add(p, v, __ATOMIC_RELAXED, __HIP_MEMORY_SCOPE_AGENT); }
__device__ __forceinline__ unsigned xb_xcc_id() { return (unsigned)__builtin_amdgcn_s_getreg((3 << 11) | 20) & 0xFu; }
#define XB_SPIN(cond, bar) do { unsigned _sp = 0; while (cond) { __builtin_amdgcn_s_sleep(1); \
    if ((++_sp & 255u) == 0u) { if (xb_ld(&(bar)[XB_TMO])) break; if (_sp > XB_SPIN_CAP) { atomicAdd(&(bar)[XB_TMO], 1u); break; } } } } while (0)
struct XcdBarrier { unsigned* bar; unsigned x; volatile LAS unsigned* st; };
__device__ __forceinline__ XcdBarrier xcd_barrier_post(unsigned* bar, volatile LAS unsigned* st) {
    XcdBarrier b; b.bar = bar; b.x = xb_xcc_id(); b.st = st;
    if (threadIdx.x == 0) (void)xb_add(&bar[XB_XCNT(b.x)], 1u);
    return b;
}
__device__ __forceinline__ void xcd_barrier_complete(unsigned* bar, unsigned x, unsigned& nloc, unsigned& nx) {
    const unsigned G = gridDim.x * gridDim.y * gridDim.z;
    unsigned sum, cnt, mine, sp = 0u;
    for (;;) {
        sum = 0u; cnt = 0u; mine = 0u;
#pragma unroll
        for (unsigned j = 0; j < 16; ++j) { const unsigned c = xb_ld(&bar[XB_XCNT(j)]); sum += c; cnt += (c > 0u) ? 1u : 0u; mine = (j == x) ? c : mine; }
        if (sum == G) break;
        __builtin_amdgcn_s_sleep(1);
        if ((++sp & 255u) == 0u) { if (xb_ld(&bar[XB_TMO])) break; if (sp > XB_SPIN_CAP) { atomicAdd(&bar[XB_TMO], 1u); break; } }
    }
    nloc = mine > 0u ? mine : 1u; nx = cnt > 0u ? cnt : 1u;
}
__device__ __forceinline__ void xcd_barrier(const XcdBarrier& b) {
    asm volatile("s_waitcnt vmcnt(0)" ::: "memory");
    __syncthreads();
    if (threadIdx.x == 0) {
        unsigned* bar = b.bar;
        __builtin_amdgcn_s_waitcnt(0);
        unsigned nloc = b.st[0], nx = b.st[1];
        if (nloc == 0u) { xcd_barrier_complete(bar, b.x, nloc, nx); b.st[0] = nloc; b.st[1] = nx; }
        const unsigned old = xb_add(&bar[XB_XSUB(b.x)], 1u);
        const unsigned gen = old / nloc;
        if (old + 1u == (gen + 1u) * nloc) {
            __builtin_amdgcn_fence(__ATOMIC_RELEASE, "agent");
            asm volatile("s_waitcnt vmcnt(0)" ::: "memory");
            const unsigned og = xb_add(&bar[XB_TOP], 1u);
            const unsigned tg = og / nx;
            if (og + 1u == (tg + 1u) * nx) xb_add(&bar[XB_TOPGEN], 1u);
            else XB_SPIN(xb_ld(&bar[XB_TOPGEN]) == tg, bar);
            __builtin_amdgcn_fence(__ATOMIC_ACQUIRE, "agent");
            xb_add(&bar[XB_XGEN(b.x)], 1u);
            asm volatile("s_waitcnt vmcnt(0)" ::: "memory");
        } else {
            XB_SPIN(xb_ld(&bar[XB_XGEN(b.x)]) == gen, bar);
            __builtin_amdgcn_fence(__ATOMIC_ACQUIRE, "agent");
            asm volatile("s_waitcnt vmcnt(0)" ::: "memory");
        }
    }
    __syncthreads();
}

__device__ __forceinline__ void tr_item(const float* W, int ldw, int col0, bf16* WT, int dstrow0, int k0, LAS float* scr, int lane) {
#pragma unroll 8
    for (int i = 0; i < 32; ++i) { const int kk = 2 * i + (lane >> 5); scr[kk * 33 + (lane & 31)] = W[(size_t)(k0 + kk) * ldw + col0 + (lane & 31)]; }
    LDS_WAIT(); asm volatile("" ::: "memory");
    const int c = lane & 7;
#pragma unroll
    for (int j = 0; j < 4; ++j) { const int n = (lane >> 3) + 8 * j; const LAS float* s = scr + (8 * c) * 33 + n;
        v4u o; o.x = pk2(s[0 * 33], s[1 * 33]); o.y = pk2(s[2 * 33], s[3 * 33]); o.z = pk2(s[4 * 33], s[5 * 33]); o.w = pk2(s[6 * 33], s[7 * 33]);
        *(v4u*)(WT + (size_t)(dstrow0 + n) * D + k0 + 8 * c) = o; }
    LDS_WAIT(); asm volatile("" ::: "memory");
}
__device__ __forceinline__ void tr8_load(float (&t)[32], const float* W, int ldw, int col0, int k0, int lane) {
    const float* wp_ = W + (size_t)(k0 + (lane >> 5)) * ldw + col0 + (lane & 31);
#pragma unroll
    for (int i = 0; i < 32; ++i) t[i] = wp_[(size_t)(2 * i) * ldw];
}
__device__ __forceinline__ void tr8_finish(const float (&t)[32], unsigned char* WT, int dstrow0, int k0, LAS float* scr, int lane) {
#pragma unroll
    for (int i = 0; i < 32; ++i) scr[(2 * i + (lane >> 5)) * 33 + (lane & 31)] = t[i];
    LDS_WAIT(); asm volatile("" ::: "memory");
    const int n = lane >> 1, hf = lane & 1; const LAS float* sp = scr + (32 * hf) * 33 + n;
    v4u o[2];
#pragma unroll
    for (int c = 0; c < 2; ++c) { unsigned w[4];
#pragma unroll
        for (int j = 0; j < 4; ++j) { const LAS float* q4 = sp + (16 * c + 4 * j) * 33; w[j] = pk4f8(64.f * q4[0], 64.f * q4[33], 64.f * q4[66], 64.f * q4[99]); }
        o[c] = (v4u){w[0], w[1], w[2], w[3]}; }
    v4u* dst = (v4u*)(WT + (size_t)(dstrow0 + n) * D + k0 + 32 * hf);
    dst[0] = o[0]; dst[1] = o[1];
    LDS_WAIT(); asm volatile("" ::: "memory");
}
__device__ __forceinline__ void tr_item8(const float* W, int ldw, int col0, unsigned char* WT, int dstrow0, int k0, LAS float* scr, int lane) {
#pragma unroll 8
    for (int i = 0; i < 32; ++i) { const int kk = 2 * i + (lane >> 5); scr[kk * 33 + (lane & 31)] = W[(size_t)(k0 + kk) * ldw + col0 + (lane & 31)]; }
    LDS_WAIT(); asm volatile("" ::: "memory");
    const int n = lane >> 1, hf = lane & 1; const LAS float* sp = scr + (32 * hf) * 33 + n;
    v4u o[2];
#pragma unroll
    for (int c = 0; c < 2; ++c) { unsigned w[4];
#pragma unroll
        for (int j = 0; j < 4; ++j) { const LAS float* q4 = sp + (16 * c + 4 * j) * 33; w[j] = pk4f8(64.f * q4[0], 64.f * q4[33], 64.f * q4[66], 64.f * q4[99]); }
        o[c] = (v4u){w[0], w[1], w[2], w[3]}; }
    v4u* dst = (v4u*)(WT + (size_t)(dstrow0 + n) * D + k0 + 32 * hf);
    dst[0] = o[0]; dst[1] = o[1];
    LDS_WAIT(); asm volatile("" ::: "memory");
}
__device__ __forceinline__ void phase_prologue(const P& p, LAS unsigned char* lds) {
    const int tid = threadIdx.x, lane = tid & 63, wave = tid >> 6;
    LAS float* scr = (LAS float*)(lds + wave * 8448);
    const int gw = blockIdx.x * NWAVES + wave, NGW = gridDim.x * NWAVES;
    unsigned char* bt_s8 = p.ws + WS_BT_S8; unsigned char* bt_g8 = p.ws + WS_BT_G8;
    bf16* bt_s = (bf16*)(p.ws + WS_BT_S); bf16* bt_g = (bf16*)(p.ws + WS_BT_G);
    constexpr int I_S = 162 * 16, I_G = 128 * 16, I_O = 32 * 16;
    for (int it = gw; it < I_S + I_G + 3 * I_O; it += NGW) {
        int r = it;
        if (r < I_S) { const int nb = r >> 4, kb = r & 15; const int col0 = nb < 96 ? 32 * nb : (nb < 160 ? 4128 + 32 * (nb - 96) : (nb == 160 ? 4096 : 7200));
            if (nb < 8 * G1_NF8) tr_item8(p.w_in, D_IN, col0, bt_s8, 32 * nb, 64 * kb, scr, lane); else tr_item(p.w_in, D_IN, col0, bt_s, 32 * nb, 64 * kb, scr, lane); continue; } r -= I_S;
        if (r < I_G) { const int nb = r >> 4, kb = r & 15; const int col0 = nb < 32 ? 3072 + 32 * nb : (nb < 64 ? 6176 + 32 * (nb - 32) : 7232 + 32 * (nb - 64));
            if (FP8_G2) tr_item8(p.w_in, D_IN, col0, bt_g8, 32 * nb, 64 * kb, scr, lane); else tr_item(p.w_in, D_IN, col0, bt_g, 32 * nb, 64 * kb, scr, lane); continue; } r -= I_G;
        const int which = r / I_O; r -= which * I_O; const int nb = r >> 4, kb = r & 15;
        const float* W = which == 0 ? p.w_out_a : (which == 1 ? p.w_out_b : p.w_out);
        bf16* WT = (bf16*)(p.ws + (which == 0 ? WS_BT_OA : (which == 1 ? WS_BT_OB : WS_BT_O)));
        tr_item(W, D, 32 * nb, WT, 32 * nb, 64 * kb, scr, lane);
    }
    { const size_t n16 = (size_t)192 * D * (G1_NF8 == 21 ? 1 : 2) / 16; v4u* z = G1_NF8 == 21 ? (v4u*)(bt_s8 + (size_t)5184 * D) : (v4u*)(bt_s + (size_t)5184 * D);
      for (size_t i = (size_t)blockIdx.x * NTHREADS + tid; i < n16; i += (size_t)gridDim.x * NTHREADS) z[i] = (v4u){0u, 0u, 0u, 0u}; }
    __syncthreads();
    LAS float* sc = (LAS float*)lds;
    LAS float* red = (LAS float*)(lds + 17 * 1024 * 4);
    float* modv = (float*)(p.ws + WS_MODV);
    bool have = false;
    for (int u = blockIdx.x; u < NMOD / 64; u += gridDim.x) {
        if (!have) { for (int i = tid; i < 17 * 1024; i += NTHREADS) { const float v = i < 16 * 1024 ? p.c[i] : p.c_ctx[i - 16 * 1024]; sc[i] = siluf_(v); } have = true; __syncthreads(); }
        float acc[17];
#pragma unroll
        for (int b = 0; b < 17; ++b) acc[b] = 0.f;
        const int n = u * 64 + lane;
        for (int k = wave * 128; k < wave * 128 + 128; ++k) { const float wv = p.w_mod[(size_t)k * NMOD + n];
#pragma unroll
            for (int b = 0; b < 17; ++b) acc[b] += sc[b * 1024 + k] * wv; }
#pragma unroll
        for (int b = 0; b < 17; ++b) red[(wave * 17 + b) * 64 + lane] = acc[b];
        __syncthreads();
        for (int i = tid; i < 17 * 64; i += NTHREADS) { const int b = i >> 6, l = i & 63; float s = p.b_mod[u * 64 + l];
#pragma unroll
            for (int w = 0; w < 8; ++w) s += red[(w * 17 + b) * 64 + l];
            modv[b * NMOD + u * 64 + l] = s; }
        __syncthreads();
    }
}

__device__ __forceinline__ void phase_norm1(const P& p) {
    const int tid = threadIdx.x, lane = tid & 63, wave = tid >> 6;
    const int gw = blockIdx.x * NWAVES + wave, NGW = gridDim.x * NWAVES;
    const float* modv = (const float*)(p.ws + WS_MODV); bf16* h = (bf16*)(p.ws + WS_H);
    auto rowptr = [&](int r) -> const float* { return r < T ? p.x + (size_t)r * D : p.ctx + (size_t)(r - T) * D; };
    f32x4 nx[4];
    if (gw < TT) { const f32x4* xr = (const f32x4*)rowptr(gw) + lane;
#pragma unroll
        for (int j = 0; j < 4; ++j) nx[j] = xr[64 * j]; }
    for (int r = gw; r < TT; r += NGW) {
        const int b = r < T ? (r >> 12) : 16;
        f32x4 v[4]; float s = 0.f;
#pragma unroll
        for (int j = 0; j < 4; ++j) { v[j] = nx[j]; s += (v[j].x * v[j].x + v[j].y * v[j].y) + (v[j].z * v[j].z + v[j].w * v[j].w); }
        if (r + NGW < TT) { const f32x4* xr = (const f32x4*)rowptr(r + NGW) + lane;
#pragma unroll
            for (int j = 0; j < 4; ++j) nx[j] = xr[64 * j]; }
        const float rstd = rsqrtf_(wave_sum(s) * (1.f / D) + EPS);
        const f32x4* g = (const f32x4*)p.norm_mix_g + lane; const f32x4* sh = (const f32x4*)(modv + b * NMOD) + lane; const f32x4* scl = (const f32x4*)(modv + b * NMOD + D) + lane;
        unsigned* o8 = (unsigned*)(p.ws + WS_H8 + (size_t)r * D) + lane; v2u* o16 = (v2u*)(h + (size_t)r * D) + lane;
#pragma unroll
        for (int j = 0; j < 4; ++j) { const f32x4 gg = g[64 * j], s1 = sh[64 * j], s2 = scl[64 * j]; const f32x4 o = v[j] * rstd * gg * (1.0f + s2) + s1;
            if (FP8_G1 || FP8_G2) o8[64 * j] = pk4f8(o.x, o.y, o.z, o.w);
            if (!(FP8_G1 == 1 && FP8_G2)) { v2u w; w.x = pk2(o.x, o.y); w.y = pk2(o.z, o.w); o16[64 * j] = w; } }
    }
}

struct EpiG1 {
    bf16* qkva; bf16* pb; float* small;
    __device__ __forceinline__ void operator()(const Acc& acc, const pg8::Unit& u, int wr, int wc, int fr, int fq) const {
        const int row0 = u.pm * 256 + wr * 64 + fr, cb = wc * 32 + 8 * fq;
#pragma unroll
        for (int ai = 0; ai < 2; ++ai)
#pragma unroll
            for (int m = 0; m < 4; ++m) { const size_t row = (size_t)(row0 + ai * 128 + m * 16);
#pragma unroll
                for (int bj = 0; bj < 2; ++bj) { const int c = bj * 128 + cb; const f32x4 v0 = acc[ai][bj][m][0], v1 = acc[ai][bj][m][1];
                    if (u.pn < 20) { v4u w; w.x = pk2(v0[0], v0[1]); w.y = pk2(v0[2], v0[3]); w.z = pk2(v1[0], v1[1]); w.w = pk2(v1[2], v1[3]);
                        if (u.pn < 12) *(v4u*)(qkva + row * 3072 + u.pn * 256 + c) = w; else *(v4u*)(pb + row * 2048 + (u.pn - 12) * 256 + c) = w; }
                    else if (c < 64) { *(f32x4*)(small + row * 64 + c) = v0; *(f32x4*)(small + row * 64 + c + 4) = v1; } } }
    }
};
__device__ __forceinline__ f32x2_t sigmoid2(const f32x2_t x) { const f32x2_t t = x * -1.44269504f; const f32x2_t d = (f32x2_t){__builtin_amdgcn_exp2f(t.x), __builtin_amdgcn_exp2f(t.y)} + 1.0f; return (f32x2_t){__builtin_amdgcn_rcpf(d.x), __builtin_amdgcn_rcpf(d.y)}; }
__device__ __forceinline__ f32x2_t silu2(const f32x2_t x) { return x * sigmoid2(x); }
#define ACC_PAIR(a4, p) ((p) & 1 ? (f32x2_t){(a4).z, (a4).w} : (f32x2_t){(a4).x, (a4).y})
struct EpiG2 {
    const bf16* on; bf16* ya; bf16* yb; bf16* gates; const float* gla_g; LAS float* xch; const bf16* ob2;
    __device__ __forceinline__ void operator()(const Acc& acc, const pg8::Unit& u, int wr, int wc, int fr, int fq) const {
        const int row0 = u.pm * 256 + wr * 64 + fr, cb = wc * 32 + 8 * fq;
        if (u.pn >= 4 && u.pn < 8) {
#pragma unroll 2
            for (int rm = 0; rm < 8; ++rm) { const int rr = (rm >> 2) * 128 + (rm & 3) * 16; const size_t row = (size_t)(row0 + rr); float ss = 0.f;
#pragma unroll
                for (int bj = 0; bj < 2; ++bj) { float o[8], o2[8]; unpack8(*(const v4u*)(on + row * 2048 + u.pn * 256 + bj * 128 + cb), o); unpack8(*(const v4u*)(ob2 + row * 1024 + (u.pn - 4) * 256 + bj * 128 + cb), o2);
#pragma unroll
                    for (int j = 0; j < 8; ++j) { const float x = o[j] + o2[j]; ss += x * x; } }
                ss += __shfl_xor(ss, 16); ss += __shfl_xor(ss, 32);
                if (fq == 0) xch[(rr + wr * 64 + fr) * 4 + wc] = ss; }
            asm volatile("s_waitcnt lgkmcnt(0)" ::: "memory"); __builtin_amdgcn_s_barrier(); asm volatile("" ::: "memory");
#pragma unroll
            for (int bj = 0; bj < 2; ++bj) { float gg[8];
#pragma unroll
                for (int j = 0; j < 8; ++j) gg[j] = gla_g[bj * 128 + cb + j];
#pragma unroll
                for (int ai = 0; ai < 2; ++ai)
#pragma unroll
                    for (int m = 0; m < 4; ++m) { const size_t row = (size_t)(row0 + ai * 128 + m * 16);
                        const f32x4 ps = *(const LAS f32x4*)(xch + (ai * 128 + wr * 64 + m * 16 + fr) * 4);
                        const float rstd = rsqrtf_(((ps[0] + ps[1]) + (ps[2] + ps[3])) * (1.f / 256.f) + EPS);
                        float o[8], o2[8], v[8]; unpack8(*(const v4u*)(on + row * 2048 + u.pn * 256 + bj * 128 + cb), o); unpack8(*(const v4u*)(ob2 + row * 1024 + (u.pn - 4) * 256 + bj * 128 + cb), o2);
#pragma unroll
                        for (int pq = 0; pq < 4; ++pq) { const f32x2_t os = (f32x2_t){o[2 * pq], o[2 * pq + 1]} + (f32x2_t){o2[2 * pq], o2[2 * pq + 1]};
                            const f32x2_t r2 = os * rstd * (f32x2_t){gg[2 * pq], gg[2 * pq + 1]} * silu2(ACC_PAIR(acc[ai][bj][m][pq >> 1], pq)); v[2 * pq] = r2.x; v[2 * pq + 1] = r2.y; }
                        *(v4u*)(yb + row * 1024 + (u.pn - 4) * 256 + bj * 128 + cb) = pack8(v);
                        asm volatile("" ::: "memory"); } }
            return;
        }
        if (u.pn < 4) {
#pragma unroll
            for (int ai = 0; ai < 2; ++ai)
#pragma unroll
                for (int m = 0; m < 4; ++m) { const size_t row = (size_t)(row0 + ai * 128 + m * 16);
#pragma unroll
                    for (int bj = 0; bj < 2; ++bj) { const int c = bj * 128 + cb; float v[8], o[8];
                        unpack8(*(const v4u*)(on + row * 2048 + u.pn * 256 + c), o);
#pragma unroll
                        for (int pq = 0; pq < 4; ++pq) { const f32x2_t r2 = (f32x2_t){o[2 * pq], o[2 * pq + 1]} * silu2(ACC_PAIR(acc[ai][bj][m][pq >> 1], pq)); v[2 * pq] = r2.x; v[2 * pq + 1] = r2.y; }
                        *(v4u*)(ya + row * 1024 + u.pn * 256 + c) = pack8(v); } }
        } else {
#pragma unroll
            for (int ai = 0; ai < 2; ++ai)
#pragma unroll
                for (int m = 0; m < 4; ++m) { const size_t row = (size_t)(row0 + ai * 128 + m * 16);
#pragma unroll
                    for (int bj = 0; bj < 2; ++bj) { const int c = bj * 128 + cb; float v[8];
#pragma unroll
                        for (int pq = 0; pq < 4; ++pq) { const f32x2_t r2 = sigmoid2(ACC_PAIR(acc[ai][bj][m][pq >> 1], pq)); v[2 * pq] = r2.x; v[2 * pq + 1] = r2.y; }
                        asm volatile("s_nop 0" : "+v"(v[0]), "+v"(v[1]), "+v"(v[2]), "+v"(v[3]), "+v"(v[4]), "+v"(v[5]), "+v"(v[6]), "+v"(v[7]));
                        *(v4u*)(gates + row * 2048 + (u.pn - 8) * 256 + c) = pack8(v); } }
        }
    }
};
template <int WHICH> struct EpiG34 {
    const bf16* gates; bf16* y;
    __device__ __forceinline__ void operator()(const Acc& acc, const pg8::Unit& u, int wr, int wc, int fr, int fq) const {
        const int row0 = u.pm * 256 + wr * 64 + fr, cb = wc * 32 + 8 * fq;
#pragma unroll
        for (int ai = 0; ai < 2; ++ai)
#pragma unroll
            for (int m = 0; m < 4; ++m) { const size_t row = (size_t)(row0 + ai * 128 + m * 16);
#pragma unroll
                for (int bj = 0; bj < 2; ++bj) { const int c = u.pn * 256 + bj * 128 + cb; float v[8], g[8];
#pragma unroll
                    for (int j = 0; j < 4; ++j) { v[j] = acc[ai][bj][m][0][j]; v[4 + j] = acc[ai][bj][m][1][j]; }
                    unpack8(*(const v4u*)(gates + row * 2048 + WHICH * 1024 + c), g);
                    if (WHICH == 0) {
#pragma unroll
                        for (int j = 0; j < 8; ++j) v[j] = g[j] * v[j];
                    } else { float o[8]; unpack8(*(const v4u*)(y + row * 1024 + c), o);
#pragma unroll
                        for (int j = 0; j < 8; ++j) v[j] = o[j] + g[j] * v[j]; }
                    *(v4u*)(y + row * 1024 + c) = pack8(v); } }
    }
};
__device__ __forceinline__ f32x4 ldx4(const v2u w) { return (f32x4){bflo(w.x), bfhi(w.x), bflo(w.y), bfhi(w.y)}; }
struct EpiG5 {
    const float* x; const float* modv; bf16* x1b;
    __device__ __forceinline__ void operator()(const Acc& acc, const pg8::Unit& u, int wr, int wc, int fr, int fq) const {
        const int row0 = u.pm * 256 + wr * 64 + fr, cb = wc * 32 + 8 * fq;
        const float* g1 = modv + (u.pm >> 4) * NMOD + 2 * D;
#pragma unroll
        for (int ai = 0; ai < 2; ++ai)
#pragma unroll
            for (int m = 0; m < 4; ++m) { const size_t row = (size_t)(row0 + ai * 128 + m * 16);
#pragma unroll
                for (int bj = 0; bj < 2; ++bj) { const int c = u.pn * 256 + bj * 128 + cb; float v[8];
#pragma unroll
                    for (int n = 0; n < 2; ++n) { const f32x4 xv = *(const f32x4*)(x + row * D + c + 4 * n), gv = *(const f32x4*)(g1 + c + 4 * n); const f32x4 o = xv + gv * acc[ai][bj][m][n];
                        v[4 * n] = o.x; v[4 * n + 1] = o.y; v[4 * n + 2] = o.z; v[4 * n + 3] = o.w; }
                    *(v4u*)(x1b + row * D + c) = pack8(v); } }
    }
};
struct EpiGU {
    const float* b_gu; bf16* act;
    __device__ __forceinline__ void operator()(const Acc& acc, const pg8::Unit& u, int wr, int wc, int fr, int fq) const {
        const int row0 = u.pm * 256 + wr * 64 + fr, cb = wc * 32 + 8 * fq; const int e = u.e;
        const float* bg = b_gu + (size_t)e * 2048 + u.pn * 128 + cb; const float* bl = bg + 1024;
        f32x2_t bgv[4], blv[4];
#pragma unroll
        for (int j = 0; j < 4; ++j) { bgv[j] = (f32x2_t){bg[2 * j], bg[2 * j + 1]}; blv[j] = (f32x2_t){bl[2 * j] + 1.0f, bl[2 * j + 1] + 1.0f}; }
#pragma unroll
        for (int ai = 0; ai < 2; ++ai)
#pragma unroll
            for (int m = 0; m < 4; ++m) { const size_t row = (size_t)(row0 + ai * 128 + m * 16); f32x2_t v[4];
#pragma unroll
                for (int j = 0; j < 4; ++j) { const f32x4 ag = acc[ai][0][m][j >> 1], al = acc[ai][1][m][j >> 1];
                    f32x2_t gl = (j & 1 ? (f32x2_t){ag.z, ag.w} : (f32x2_t){ag.x, ag.y}) + bgv[j]; f32x2_t ln = (j & 1 ? (f32x2_t){al.z, al.w} : (f32x2_t){al.x, al.y}) + blv[j];
                    gl = (f32x2_t){fminf(gl.x, 7.0f), fminf(gl.y, 7.0f)}; ln = (f32x2_t){__builtin_amdgcn_fmed3f(ln.x, -6.0f, 8.0f), __builtin_amdgcn_fmed3f(ln.y, -6.0f, 8.0f)};
                    const f32x2_t t = gl * (-1.702f * 1.44269504f); f32x2_t d = (f32x2_t){__builtin_amdgcn_exp2f(t.x), __builtin_amdgcn_exp2f(t.y)} + 1.0f;
                    const f32x2_t r = (f32x2_t){__builtin_amdgcn_rcpf(d.x), __builtin_amdgcn_rcpf(d.y)};
                    v[j] = gl * r * ln; }
                v2u w8; w8.x = pk4f8(v[0].x, v[0].y, v[1].x, v[1].y); w8.y = pk4f8(v[2].x, v[2].y, v[3].x, v[3].y);
                *(v2u*)((unsigned char*)act + row * 1024 + u.pn * 128 + cb) = w8; }
    }
};
struct EpiDN {
    const float* b_down; const float* slot_p; bf16* ys;
    __device__ __forceinline__ void operator()(const Acc& acc, const pg8::Unit& u, int wr, int wc, int fr, int fq) const {
        const int row0 = u.pm * 256 + wr * 64 + fr, cb = wc * 32 + 8 * fq; const int e = u.e;
#pragma unroll
        for (int bj = 0; bj < 2; ++bj) { const int c = u.pn * 256 + bj * 128 + cb; float bv[8];
#pragma unroll
            for (int j = 0; j < 8; ++j) bv[j] = b_down[(size_t)e * 1024 + c + j];
#pragma unroll
            for (int ai = 0; ai < 2; ++ai)
#pragma unroll
                for (int m = 0; m < 4; ++m) { const size_t row = (size_t)(row0 + ai * 128 + m * 16); const float pr = 16.0f * slot_p[row]; float v[8];
#pragma unroll
                    for (int pq = 0; pq < 4; ++pq) { const f32x2_t r2 = (ACC_PAIR(acc[ai][bj][m][pq >> 1], pq) + (f32x2_t){bv[2 * pq], bv[2 * pq + 1]}) * pr; v[2 * pq] = r2.x; v[2 * pq + 1] = r2.y; }
                    v2u w8; w8.x = pk4f8(v[0], v[1], v[2], v[3]); w8.y = pk4f8(v[4], v[5], v[6], v[7]);
                    *(v2u*)((unsigned char*)ys + row * 1024 + c) = w8; } }
    }
};

template <int CG>
__device__ __forceinline__ void conv_unit(const P& p, LAS unsigned char* lds, const int b, const int chan0, const bool donorm) {
    constexpr int NCOL = 512 / CG, NPOS = 64 / NCOL, CTXN = 256 / NCOL, SLOT = CG * 32, CSLOT = CG * 16, RB = 66 * SLOT;
    const int tid = threadIdx.x;
    bf16* qkva = (bf16*)(p.ws + WS_QKVA);
    LAS unsigned char* rowbuf = lds;
    LAS unsigned char* cbuf = lds;
    const int cg = tid % CG, c0 = tid / CG;
    float w[9][8];
#pragma unroll
    for (int k = 0; k < 9; ++k)
#pragma unroll
        for (int e = 0; e < 8; ++e) w[k][e] = p.conv_w[k * 3072 + chan0 + cg * 8 + e];
    __syncthreads();
    if (tid < 2 * CG) { const int r = tid; *(LAS v4u*)(cbuf + ((r >= CG) ? 257 : 0) * CSLOT + (r % CG) * 16) = (v4u){0u, 0u, 0u, 0u}; }
    { bf16* base = qkva + (size_t)(T + b * CTXL) * 3072 + chan0 + cg * 8;
#pragma unroll
      for (int jj = 0; jj < CTXN; ++jj) { const int t = c0 + NCOL * jj; *(LAS v4u*)(cbuf + (t + 1) * CSLOT + cg * 16) = *(const v4u*)(base + (size_t)t * 3072); }
      __syncthreads();
#pragma unroll
      for (int jj = 0; jj < CTXN; ++jj) { const int t = c0 + NCOL * jj; float a[8];
#pragma unroll
          for (int e = 0; e < 8; ++e) a[e] = 0.f;
#pragma unroll
          for (int kw = 0; kw < 3; ++kw) { float f[8]; unpack8(*(const LAS v4u*)(cbuf + (t + kw) * CSLOT + cg * 16), f);
#pragma unroll
              for (int e = 0; e < 8; ++e) a[e] += f[e] * w[3 + kw][e]; }
          float ss = 0.f;
#pragma unroll
          for (int e = 0; e < 8; ++e) { a[e] = silu_fast(a[e]); ss += a[e] * a[e]; }
          if (CG == 16 && donorm) { ss = row16_sum(ss); const float sc = rsqrtf_(ss + EPS);
#pragma unroll
              for (int e = 0; e < 8; ++e) a[e] *= sc; }
          *(v4u*)(base + (size_t)t * 3072) = pack8(a); }
    }
    __syncthreads();
    if (tid < 6 * CG * 2) { const int bi = tid / (4 * CG), r = tid % (4 * CG); *(LAS f32x4*)(rowbuf + bi * RB + ((r >= 2 * CG) ? 65 : 0) * SLOT + (r % (2 * CG)) * 16) = (f32x4){0.f, 0.f, 0.f, 0.f}; }
    bf16* base = qkva + (size_t)(b * SEQ) * 3072 + chan0 + cg * 8;
#define CONV_PUT(rr_, c_, w_) do { float f_[8]; unpack8((w_), f_); LAS f32x4* d_ = (LAS f32x4*)(rowbuf + ((rr_) % 3) * RB + ((c_) + 1) * SLOT + cg * 32); \
        d_[0] = (f32x4){f_[0], f_[1], f_[2], f_[3]}; d_[1] = (f32x4){f_[4], f_[5], f_[6], f_[7]}; } while (0)
#pragma unroll
    for (int rr = 0; rr < 2; ++rr)
#pragma unroll
        for (int jj = 0; jj < NPOS; ++jj) { const int c = c0 + NCOL * jj; const v4u wv = *(const v4u*)(base + (size_t)(rr * 64 + c) * 3072); CONV_PUT(rr, c, wv); }
    __syncthreads();
    for (int r = 0; r < 64; ++r) {
        v4u pre[NPOS];
        if (r + 2 < 64) {
#pragma unroll
            for (int jj = 0; jj < NPOS; ++jj) pre[jj] = *(const v4u*)(base + (size_t)((r + 2) * 64 + c0 + NCOL * jj) * 3072);
        }
#pragma unroll
        for (int jj = 0; jj < NPOS; ++jj) { const int c = c0 + NCOL * jj; float a[8];
#pragma unroll
            for (int e = 0; e < 8; ++e) a[e] = 0.f;
#pragma unroll
            for (int kh = 0; kh < 3; ++kh) { const int rr = r + kh - 1; if (rr < 0 || rr > 63) continue; const LAS unsigned char* rb = rowbuf + (rr % 3) * RB;
#pragma unroll
                for (int kw = 0; kw < 3; ++kw) { const f32x4 f0 = *(const LAS f32x4*)(rb + (c + kw) * SLOT + cg * 32), f1 = *(const LAS f32x4*)(rb + (c + kw) * SLOT + cg * 32 + 16);
#pragma unroll
                    for (int e = 0; e < 4; ++e) { a[e] += f0[e] * w[kh * 3 + kw][e]; a[4 + e] += f1[e] * w[kh * 3 + kw][4 + e]; } } }
            float ss = 0.f;
#pragma unroll
            for (int e = 0; e < 8; ++e) { a[e] = silu_fast(a[e]); ss += a[e] * a[e]; }
            if (CG == 16 && donorm) { ss = row16_sum(ss); const float sc = rsqrtf_(ss + EPS);
#pragma unroll
                for (int e = 0; e < 8; ++e) a[e] *= sc; }
            *(v4u*)(base + (size_t)(r * 64 + c) * 3072) = pack8(a); }
        __syncthreads();
        if (r + 2 < 64) {
#pragma unroll
            for (int jj = 0; jj < NPOS; ++jj) CONV_PUT(r + 2, c0 + NCOL * jj, pre[jj]);
        }
        __syncthreads();
    }
#undef CONV_PUT
}
__device__ __forceinline__ void phase_conv(const P& p, LAS unsigned char* lds) {
    for (int u = blockIdx.x; u < NB * 16; u += gridDim.x) conv_unit<16>(p, lds, u >> 4, (u & 15) * 128, true);
    for (int u = blockIdx.x; u < NB * 16; u += gridDim.x) conv_unit<8>(p, lds, u >> 4, 2048 + (u & 15) * 64, false);
}

template <bool GLA>
__device__ __forceinline__ void scan_unit(const P& p, LAS unsigned char* lds, int b, int h, int vh) {
    const int tid = threadIdx.x, j = tid >> 2, part = tid & 3;
    LAS float* qf = (LAS float*)lds; LAS float* kf = qf + 32 * 144; LAS float* af = kf + 32 * 144; LAS float* vf = af + 32 * 144; LAS float* ob = vf + 32 * 128;
    LAS float* sa = ob + 32 * 128; LAS float* sb = sa + 32;
    const bf16* qkva = (const bf16*)(p.ws + WS_QKVA); const bf16* pbuf = (const bf16*)(p.ws + WS_PB); const float* small = (const float*)(p.ws + WS_SMALL);
    bf16* on = (bf16*)p.out;
    const int lt = tid >> 4, piece = tid & 15;
    const float scale = 0.08838834764831845f;
    for (int dir = 0; dir < 2; ++dir) {
        float S[32];
#pragma unroll
        for (int i = 0; i < 32; ++i) S[i] = 0.f;
        float wcol[16]; float gbias = 0.f, alog = 0.f, dtb = 0.f;
        if (GLA) { const float* gw = dir ? p.gla_gate_w_b : p.gla_gate_w_f; const int i = tid & 127;
#pragma unroll
            for (int r = 0; r < 16; ++r) wcol[r] = gw[r * 512 + h * 128 + i];
            gbias = (dir ? p.gla_gate_b_b : p.gla_gate_b_f)[h * 128 + i]; }
        else { alog = __expf((dir ? p.a_log_b : p.a_log_f)[h]); dtb = (dir ? p.dt_bias_b : p.dt_bias_f)[h]; }
        for (int s = 0; s < 136; ++s) {
            const bool is_ctx = s < 8;
            const int sci = is_ctx ? (dir ? 7 - s : s) : (dir ? 127 - (s - 8) : s - 8);
            const size_t row0 = is_ctx ? (size_t)(T + b * CTXL + sci * 32) : (size_t)(b * SEQ + sci * 32);
            __syncthreads();
            { v4u qw, kw, vw;
              if (GLA) { const bf16* r = pbuf + (row0 + lt) * 2048; qw = *(const v4u*)(r + h * 128 + piece * 8); kw = *(const v4u*)(r + 512 + h * 128 + piece * 8); vw = *(const v4u*)(r + 1024 + h * 256 + vh * 128 + piece * 8); }
              else { const bf16* r = qkva + (row0 + lt) * 3072; qw = *(const v4u*)(r + h * 128 + piece * 8); kw = *(const v4u*)(r + 1024 + h * 128 + piece * 8); vw = *(const v4u*)(r + 2048 + h * 128 + piece * 8); }
              float f[8]; const int o = lt * 144 + (piece >> 2) * 36 + (piece & 3) * 8;
              unpack8(qw, f);
#pragma unroll
              for (int e = 0; e < 8; ++e) qf[o + e] = f[e] * scale;
              unpack8(kw, f);
#pragma unroll
              for (int e = 0; e < 8; ++e) kf[o + e] = f[e];
              unpack8(vw, f);
#pragma unroll
              for (int e = 0; e < 8; ++e) vf[lt * 128 + piece * 8 + e] = f[e]; }
            if (GLA) { const int i = tid & 127, tq = tid >> 7;
#pragma unroll
                for (int tt = 0; tt < 8; ++tt) { const int t = tq * 8 + tt; const float* z = small + (row0 + t) * 64 + 32 + dir * 16; float u = gbias;
#pragma unroll
                    for (int r = 0; r < 16; ++r) u += z[r] * wcol[r];
                    const float ls = fminf(u, 0.f) - log1pf(__expf(-fabsf(u)));
                    af[t * 144 + (i >> 5) * 36 + (i & 31)] = __expf(ls * (1.0f / 16.0f)); } }
            else if (tid < 32) { const float* sm = small + (row0 + tid) * 64; sb[tid] = sigmoidf_(sm[dir * 8 + h]); sa[tid] = __expf(-alog * softplusf_(sm[16 + dir * 8 + h] + dtb)); }
            __syncthreads();
            for (int tt = 0; tt < 32; ++tt) { const int t = dir ? 31 - tt : tt;
                const LAS float* kp = kf + t * 144 + part * 36; const LAS float* qp = qf + t * 144 + part * 36;
                float kk[32], qq[32];
#pragma unroll
                for (int i = 0; i < 32; i += 4) { const f32x4 a = *(const LAS f32x4*)(kp + i); kk[i] = a.x; kk[i + 1] = a.y; kk[i + 2] = a.z; kk[i + 3] = a.w;
                    const f32x4 q4 = *(const LAS f32x4*)(qp + i); qq[i] = q4.x; qq[i + 1] = q4.y; qq[i + 2] = q4.z; qq[i + 3] = q4.w; }
                const float vj = vf[t * 128 + j];
                float os = 0.f;
                if (GLA) { const LAS float* ap = af + t * 144 + part * 36;
#pragma unroll
                    for (int i = 0; i < 32; i += 4) { const f32x4 a = *(const LAS f32x4*)(ap + i);
                        S[i] = a.x * S[i] + kk[i] * vj; S[i + 1] = a.y * S[i + 1] + kk[i + 1] * vj; S[i + 2] = a.z * S[i + 2] + kk[i + 2] * vj; S[i + 3] = a.w * S[i + 3] + kk[i + 3] * vj; }
                } else { const float a = sa[t], be = sb[t]; float ks = 0.f;
#pragma unroll
                    for (int i = 0; i < 32; ++i) ks += kk[i] * S[i];
                    ks += __shfl_xor(ks, 1); ks += __shfl_xor(ks, 2);
                    const float vn = be * (vj - a * ks);
#pragma unroll
                    for (int i = 0; i < 32; ++i) S[i] = a * S[i] + kk[i] * vn; }
                if (!is_ctx) {
#pragma unroll
                    for (int i = 0; i < 32; ++i) os += qq[i] * S[i];
                    os += __shfl_xor(os, 1); os += __shfl_xor(os, 2);
                    if (part == 0) ob[t * 128 + j] = os; }
            }
            if (!is_ctx) { __syncthreads();
                bf16* dst = on + (row0 + lt) * 2048 + (GLA ? 1024 + h * 256 + vh * 128 : h * 128) + piece * 8; float f[8];
#pragma unroll
                for (int e = 0; e < 8; ++e) f[e] = ob[lt * 128 + piece * 8 + e];
                if (dir) { float g[8]; unpack8(*(const v4u*)dst, g);
#pragma unroll
                    for (int e = 0; e < 8; ++e) f[e] += g[e]; }
                *(v4u*)dst = pack8(f); }
        }
    }
}

typedef short s16x4 __attribute__((ext_vector_type(4)));
typedef __bf16 bf16x2_t __attribute__((ext_vector_type(2)));
#define MF16(a, b, c) __builtin_amdgcn_mfma_f32_16x16x16bf16_1k((a), (b), (c), 0, 0, 0)
#define MF32(a, b, c) __builtin_amdgcn_mfma_f32_16x16x32_bf16((a), (b), (c), 0, 0, 0)
__device__ __forceinline__ unsigned pk2c(float lo, float hi) { const f32x2_t v = {lo, hi}; return __builtin_bit_cast(unsigned, __builtin_convertvector(v, bf16x2_t)); }
__device__ __forceinline__ s16x4 cvt4(const f32x4 v) { v2u p; p.x = pk2c(v[0], v[1]); p.y = pk2c(v[2], v[3]); return __builtin_bit_cast(s16x4, p); }
__device__ __forceinline__ bf16x8 cat8(const s16x4 a, const s16x4 b) { return __builtin_shufflevector(a, b, 0, 1, 2, 3, 4, 5, 6, 7); }
__device__ __forceinline__ bf16x8 ldfrag(const LAS unsigned char* img, int row, int strideB, int s, int q) {
    const LAS unsigned char* p = img + row * strideB + (32 * s + 4 * q) * 2;
    unsigned a2 = (unsigned)(size_t)p + 32u; asm volatile("" : "+v"(a2));
    return cat8(*(const LAS s16x4*)p, *(const LAS s16x4*)(size_t)a2);
}
__device__ __forceinline__ v4u pack8c(const float (&f)[8]) { v4u w; w.x = pk2c(f[0], f[1]); w.y = pk2c(f[2], f[3]); w.z = pk2c(f[4], f[5]); w.w = pk2c(f[6], f[7]); return w; }
constexpr int CS_KS = 272, CS_TS = 144;
constexpr int L_K = 0, L_Q = 17408, L_V = 34816, L_KT = 52224, L_O = 70656, L_AOFF = 88064, L_TD = 91136, L_ATT = 93184, L_SC = 98304;
constexpr float QSCALE = 0.08838834764831845f;
__device__ __forceinline__ int tri_idx(int bi, int bj) { return bi * (bi + 1) / 2 + bj; }
__device__ __forceinline__ int off_idx(int bi, int bj) { return bi * (bi - 1) / 2 + bj; }

__device__ __forceinline__ void build_kt_plain(LAS unsigned char* lds, int tid) {
    const int a = tid & 127, seg = tid >> 7;
#pragma unroll
    for (int mm = 0; mm < 4; ++mm) { unsigned short v[4];
#pragma unroll
        for (int e = 0; e < 4; ++e) v[e] = *(const LAS unsigned short*)(lds + L_K + (16 * seg + 4 * mm + e) * CS_KS + a * 2);
        v2u w; w.x = (unsigned)v[0] | ((unsigned)v[1] << 16); w.y = (unsigned)v[2] | ((unsigned)v[3] << 16);
        *(LAS v2u*)(lds + L_KT + a * CS_TS + (16 * seg + 4 * mm) * 2) = w; }
}

__device__ __forceinline__ float wave_scan_incl(float x) {
#define SCAN_DPP_(ctrl, rmask) x += __builtin_bit_cast(float, __builtin_amdgcn_update_dpp(0, __builtin_bit_cast(int, x), (ctrl), (rmask), 0xF, false))
    SCAN_DPP_(0x111, 0xF); SCAN_DPP_(0x112, 0xF); SCAN_DPP_(0x114, 0xF); SCAN_DPP_(0x118, 0xF); SCAN_DPP_(0x142, 0xA); SCAN_DPP_(0x143, 0xC);
#undef SCAN_DPP_
    return x;
}
constexpr int GP_KS = 288, GP_TS = 160;
constexpr int GP_K = 0, GP_Q = 18432, GP_V = 36864, GP_KT = 54272, GP_O = 74752, GP_AOFF = 92160, GP_TD = 95232, GP_ATT = 97280, GP_SC = 102400;
__device__ __forceinline__ bf16x8 ldf16(const LAS unsigned char* img, int row, int strideB, int s, int q) { return *(const LAS bf16x8*)(img + row * strideB + (32 * s + 8 * q) * 2); }
__device__ __forceinline__ void gdn_build_kt(LAS unsigned char* lds, int tid) {
    const int a = tid & 127, seg = tid >> 7;
    const int pa = 32 * (a >> 5) + 8 * ((a >> 2) & 3) + 4 * ((a >> 4) & 1) + (a & 3);
#pragma unroll
    for (int mm = 0; mm < 4; ++mm) { unsigned short v[4];
#pragma unroll
        for (int e = 0; e < 4; ++e) v[e] = *(const LAS unsigned short*)(lds + GP_K + (16 * seg + 4 * mm + e) * GP_KS + pa * 2);
        v2u w; w.x = (unsigned)v[0] | ((unsigned)v[1] << 16); w.y = (unsigned)v[2] | ((unsigned)v[3] << 16);
        *(LAS v2u*)(lds + GP_KT + a * GP_TS + (32 * (seg >> 1) + 8 * mm + 4 * (seg & 1)) * 2) = w; }
}

__device__ __forceinline__ void gdn_unit(const P& p, LAS unsigned char* lds, const int b, const int h) {
    const int wave = __builtin_amdgcn_readfirstlane(threadIdx.x >> 6);
    const int c0 = wave * 16;
    const bf16* qkva = (const bf16*)(p.ws + WS_QKVA); const float* small = (const float*)(p.ws + WS_SMALL); bf16* on = (bf16*)p.out;
    LAS float* sc0 = (LAS float*)(lds + GP_SC); LAS float* gnl = sc0 + 320;
    __syncthreads();
    if (threadIdx.x < 128) gnl[threadIdx.x] = p.gdn_norm_g[threadIdx.x];
    for (int dir = 0; dir < 2; ++dir) {
        f32x4 S[8];
#pragma unroll
        for (int u = 0; u < 8; ++u) S[u] = (f32x4){0.f, 0.f, 0.f, 0.f};
        const float alog = __expf((dir ? p.a_log_b : p.a_log_f)[h]), dtb = (dir ? p.dt_bias_b : p.dt_bias_f)[h];
        v4u pq[2], pk[2], pv[2]; float pgb = 0.f, pga = 0.f;
#define LANE_VARS int tz_ = threadIdx.x; asm volatile("" : "+v"(tz_)); const int tid = tz_, lane = tz_ & 63, r = lane & 15, q = lane >> 4, lt = tz_ >> 4, piece = tz_ & 15; (void)tid; (void)r; (void)q; (void)lt; (void)piece;
#define GDN_ROW0(s_) (((s_) < 4) ? (size_t)(T + b * CTXL + (dir ? 3 - (s_) : (s_)) * 64) : (size_t)(b * SEQ + (dir ? 63 - ((s_) - 4) : (s_) - 4) * 64))
#define GDN_PREFETCH(s_) do { const size_t r0_ = GDN_ROW0(s_); \
            _Pragma("unroll") for (int jj = 0; jj < 2; ++jj) { const int pp = lt + 32 * jj; const bf16* rp = qkva + (r0_ + (dir ? 63 - pp : pp)) * 3072 + h * 128 + piece * 8; \
                pq[jj] = *(const v4u*)rp; pk[jj] = *(const v4u*)(rp + 1024); pv[jj] = *(const v4u*)(rp + 2048); } \
            if (wave == 0) { const float* sm = small + (r0_ + (dir ? 63 - lane : lane)) * 64; pgb = sm[dir * 8 + h]; pga = sm[16 + dir * 8 + h]; } } while (0)
#define GDN_FLUSH(s_) do { const size_t fr0_ = GDN_ROW0(s_); \
            _Pragma("unroll") for (int jj = 0; jj < 2; ++jj) { const int pp = lt + 32 * jj; float f[8]; unpack8(*(const LAS v4u*)(lds + GP_O + pp * CS_KS + piece * 16), f); \
                bf16* dst = on + (fr0_ + (dir ? 63 - pp : pp)) * 2048 + h * 128 + piece * 8; \
                if (dir) { float g[8]; unpack8(fwdv[jj], g); float ss = 0.f; \
                    _Pragma("unroll") for (int e = 0; e < 8; ++e) { f[e] += g[e]; ss += f[e] * f[e]; } \
                    ss = row16_sum(ss); \
                    const float rstd = rsqrtf_(ss * (1.f / 128.f) + EPS); \
                    const f32x4 g0 = *(const LAS f32x4*)(gnl + piece * 8), g1 = *(const LAS f32x4*)(gnl + piece * 8 + 4); \
                    _Pragma("unroll") for (int e = 0; e < 4; ++e) { f[e] *= rstd * g0[e]; f[4 + e] *= rstd * g1[e]; } } \
                *(v4u*)dst = pack8c(f); } } while (0)
        v4u fwdv[2] = {};
#define GDN_STAGE1(s_) do { LAS float* scn_ = sc0 + (((s_) & 1) << 9); \
            if (wave == 0) { const float be = sigmoid_fast(pgb); const float G = wave_scan_incl(-alog * softplusf_(pga + dtb)); \
                const float G63 = __builtin_bit_cast(float, __builtin_amdgcn_readlane(__builtin_bit_cast(int, G), 63)); \
                scn_[lane] = be; scn_[64 + lane] = G; scn_[128 + lane] = __expf(G); scn_[192 + lane] = __expf(G63 - G); if (lane == 0) scn_[256] = __expf(G63); } \
            _Pragma("unroll") for (int jj = 0; jj < 2; ++jj) { const int pp = lt + 32 * jj; \
                const int po_ = 64 * (piece >> 2) + 32 * (piece & 1) + 8 * ((piece >> 1) & 1);     \
                LAS unsigned char* kr_ = lds + GP_K + pp * GP_KS + po_; LAS unsigned char* qr_ = lds + GP_Q + pp * GP_KS + po_; \
                *(LAS v2u*)kr_ = (v2u){pk[jj].x, pk[jj].y}; *(LAS v2u*)(kr_ + 16) = (v2u){pk[jj].z, pk[jj].w}; *(LAS v2u*)qr_ = (v2u){pq[jj].x, pq[jj].y}; *(LAS v2u*)(qr_ + 16) = (v2u){pq[jj].z, pq[jj].w}; \
                *(LAS v4u*)(lds + GP_V + pp * CS_KS + piece * 16) = pv[jj]; } } while (0)
        { LANE_VARS GDN_PREFETCH(0); __syncthreads(); GDN_STAGE1(0); GDN_PREFETCH(1); }
        for (int s = 0; s < 68; ++s) {
            LANE_VARS
            const bool is_ctx = s < 4;
            const size_t row0 = GDN_ROW0(s);
            LAS float* scb = sc0 + ((s & 1) << 9); LAS float* scG = scb + 64; LAS float* sceG = scb + 128; LAS float* scdK = scb + 192; LAS float* scl = scb + 256;
            __syncthreads();
            if (s > 4) GDN_FLUSH(s - 1);
            if (dir && !is_ctx) {
#pragma unroll
                for (int jj = 0; jj < 2; ++jj) fwdv[jj] = *(const v4u*)(on + (row0 + (63 - (lt + 32 * jj))) * 2048 + h * 128 + piece * 8); }
            gdn_build_kt(lds, tid);
            if (wave < 4) {
                const int bb = wave; f32x4 kk = (f32x4){0.f, 0.f, 0.f, 0.f}, qk = (f32x4){0.f, 0.f, 0.f, 0.f};
#pragma unroll
                for (int ks = 0; ks < 4; ++ks) { const bf16x8 kf = ldf16(lds + GP_K, 16 * bb + r, GP_KS, ks, q); const bf16x8 qf = ldf16(lds + GP_Q, 16 * bb + r, GP_KS, ks, q);
                    kk = MF32(kf, kf, kk); qk = MF32(kf, qf, qk); }
                const float Gr = scG[16 * bb + r], br = scb[16 * bb + r];
                const f32x4 Ge = *(const LAS f32x4*)(scG + 16 * bb + 4 * q), be4 = *(const LAS f32x4*)(scb + 16 * bb + 4 * q);
                f32x4 A, At, att;
#pragma unroll
                for (int e = 0; e < 4; ++e) { const int ie = 4 * q + e; const float dlo = __expf(fminf(Ge[e] - Gr, 0.f)), dhi = __expf(fminf(Gr - Ge[e], 0.f));
                    A[e] = (r < ie) ? be4[e] * kk[e] * dlo : 0.f;
                    At[e] = (ie < r) ? br * kk[e] * dhi : 0.f;
                    att[e] = (ie <= r) ? QSCALE * qk[e] * dhi : 0.f; }
                *(LAS s16x4*)(lds + GP_ATT + tri_idx(bb, bb) * 512 + lane * 8) = cvt4(att);
                const f32x4 Z = (f32x4){0.f, 0.f, 0.f, 0.f};
                f32x4 Rt;
#pragma unroll
                for (int e = 0; e < 4; ++e) Rt[e] = ((4 * q + e) == r ? 1.f : 0.f) - At[e];
                f32x4 Pm = MF16(cvt4(At), cvt4(A), Z), Pt = MF16(cvt4(A), cvt4(At), Z);
                Rt = MF16(cvt4(Pm), cvt4(Rt), Rt);
                f32x4 P2 = MF16(cvt4(Pt), cvt4(Pm), Z), Pt2 = MF16(cvt4(Pm), cvt4(Pt), Z);
                Rt = MF16(cvt4(P2), cvt4(Rt), Rt);
                f32x4 P4 = MF16(cvt4(Pt2), cvt4(P2), Z);
                Rt = MF16(cvt4(P4), cvt4(Rt), Rt);
                *(LAS s16x4*)(lds + GP_TD + bb * 512 + lane * 8) = cvt4(Rt);
            } else {
#pragma unroll
                for (int uu = 0; uu < 3; ++uu) { const int un = (wave - 4) + 4 * uu; const int pr = un % 6; const bool isqk = un >= 6;
                    const int bi = pr == 0 ? 1 : (pr < 3 ? 2 : 3), bj = pr == 0 ? 0 : (pr < 3 ? pr - 1 : pr - 3);
                    f32x4 d = (f32x4){0.f, 0.f, 0.f, 0.f};
                    const LAS unsigned char* bimg = lds + (isqk ? GP_Q : GP_K);
#pragma unroll
                    for (int ks = 0; ks < 4; ++ks) d = MF32(ldf16(lds + GP_K, 16 * bj + r, GP_KS, ks, q), ldf16(bimg, 16 * bi + r, GP_KS, ks, q), d);
                    const float Gi = scG[16 * bi + r], bi_ = scb[16 * bi + r]; const f32x4 Gj = *(const LAS f32x4*)(scG + 16 * bj + 4 * q);
                    const float f = isqk ? QSCALE : -bi_;
#pragma unroll
                    for (int e = 0; e < 4; ++e) d[e] = f * d[e] * __expf(fminf(Gi - Gj[e], 0.f));
                    *(LAS s16x4*)(lds + (isqk ? GP_ATT + tri_idx(bi, bj) * 512 : GP_AOFF + off_idx(bi, bj) * 512) + lane * 8) = cvt4(d); }
            }
            bf16x8 Sb[4];
#pragma unroll
            for (int ks = 0; ks < 4; ++ks) Sb[ks] = cat8(cvt4(S[2 * ks]), cvt4(S[2 * ks + 1]));
            bf16x8 fa[8];
#define LD8(img, t0) do { _Pragma("unroll") for (int t_ = 0; t_ < 2; ++t_) _Pragma("unroll") for (int ks_ = 0; ks_ < 4; ++ks_) fa[t_ * 4 + ks_] = ldf16(lds + (img), 16 * ((t0) + t_) + r, GP_KS, ks_, q); } while (0)
#define LD8T(u0) do { _Pragma("unroll") for (int u_ = 0; u_ < 4; ++u_) { fa[2 * u_] = ldf16(lds + GP_KT, 16 * ((u0) + u_) + r, GP_TS, 0, q); fa[2 * u_ + 1] = ldf16(lds + GP_KT, 16 * ((u0) + u_) + r, GP_TS, 1, q); } } while (0)
#define GDN_XS(dst, t0) do { _Pragma("unroll") for (int t = 0; t < 2; ++t) { f32x4 X = (f32x4){0.f, 0.f, 0.f, 0.f}; \
                _Pragma("unroll") for (int ks = 0; ks < 4; ++ks) X = MF32(fa[t * 4 + ks], Sb[ks], X); \
                dst[(t0) + t] = X; } } while (0)
            f32x4 vn[4], oq[4];
            LD8(GP_K, 0); GDN_XS(vn, 0);
            LD8(GP_K, 2); GDN_XS(vn, 2);
            if (!is_ctx) { LD8(GP_Q, 0); GDN_XS(oq, 0); LD8(GP_Q, 2); GDN_XS(oq, 2); }
            else {
#pragma unroll
                for (int t = 0; t < 4; ++t) oq[t] = (f32x4){0.f, 0.f, 0.f, 0.f}; }
#undef GDN_XS
#pragma unroll
            for (int t = 0; t < 4; ++t) { const f32x4 be4 = *(const LAS f32x4*)(scb + 16 * t + 4 * q), eg4 = *(const LAS f32x4*)(sceG + 16 * t + 4 * q);
#pragma unroll
                for (int e = 0; e < 4; ++e) { const float v = bflo((unsigned)*(const LAS unsigned short*)(lds + GP_V + (16 * t + 4 * q + e) * CS_KS + (c0 + r) * 2));
                    vn[t][e] = be4[e] * (v - eg4[e] * vn[t][e]); } }
            __syncthreads();
            LD8T(0);
            { s16x4 td[4], ao[6];
#pragma unroll
              for (int i = 0; i < 4; ++i) td[i] = *(const LAS s16x4*)(lds + GP_TD + i * 512 + lane * 8);
#pragma unroll
              for (int i = 0; i < 6; ++i) ao[i] = *(const LAS s16x4*)(lds + GP_AOFF + i * 512 + lane * 8);
              vn[0] = MF16(td[0], cvt4(vn[0]), ((f32x4){0.f, 0.f, 0.f, 0.f}));
#pragma unroll
              for (int bi = 1; bi < 4; ++bi) { f32x4 a = vn[bi];
#pragma unroll
                  for (int bj = 0; bj < bi; ++bj) a = MF16(ao[off_idx(bi, bj)], cvt4(vn[bj]), a);
                  vn[bi] = MF16(td[bi], cvt4(a), ((f32x4){0.f, 0.f, 0.f, 0.f})); } }
            if (!is_ctx) {
                s16x4 vc[4];
#pragma unroll
                for (int t = 0; t < 4; ++t) vc[t] = cvt4(vn[t]);
#pragma unroll
                for (int t = 0; t < 4; ++t) { f32x4 a = oq[t]; const f32x4 eg4 = *(const LAS f32x4*)(sceG + 16 * t + 4 * q);
#pragma unroll
                    for (int e = 0; e < 4; ++e) a[e] *= QSCALE * eg4[e];
#pragma unroll
                    for (int tj = 0; tj <= t; ++tj) a = MF16(*(const LAS s16x4*)(lds + GP_ATT + tri_idx(t, tj) * 512 + lane * 8), vc[tj], a);
#pragma unroll
                    for (int e = 0; e < 4; ++e) *(LAS unsigned short*)(lds + GP_O + (16 * t + 4 * q + e) * CS_KS + (c0 + r) * 2) = (unsigned short)(pk2c(a[e], 0.f) & 0xffffu); }
            }
            if (s + 1 < 68) { GDN_STAGE1(s + 1); if (s + 2 < 68) GDN_PREFETCH(s + 2); }
            { const float egl = scl[0]; s16x4 vd[4];
#pragma unroll
              for (int t = 0; t < 4; ++t) { const f32x4 dk4 = *(const LAS f32x4*)(scdK + 16 * t + 4 * q); vd[t] = cvt4(vn[t] * dk4); }
              const bf16x8 vb0 = cat8(vd[0], vd[1]), vb1 = cat8(vd[2], vd[3]);
#pragma unroll
              for (int u = 0; u < 4; ++u) { f32x4 a = S[u] * egl; a = MF32(fa[2 * u], vb0, a); a = MF32(fa[2 * u + 1], vb1, a); S[u] = a; }
              LD8T(4);
#pragma unroll
              for (int u = 0; u < 4; ++u) { f32x4 a = S[4 + u] * egl; a = MF32(fa[2 * u], vb0, a); a = MF32(fa[2 * u + 1], vb1, a); S[4 + u] = a; } }
        }
        { LANE_VARS __syncthreads(); GDN_FLUSH(67); }
#undef GDN_FLUSH
#undef GDN_STAGE1
#undef GDN_PREFETCH
#undef GDN_ROW0
    }
}

constexpr int GL_V = 34816, GL_VS = 528, GL_KT = 68608, GL_ATT = 87040, GL_G = 92160, GL_SC = 125952;
constexpr size_t WS_OB2 = 40 * MiB;
__device__ __forceinline__ void gla_unit(const P& p, LAS unsigned char* lds, const int b, const int h, const int dir) {
    const int wave = __builtin_amdgcn_readfirstlane(threadIdx.x >> 6);
    const bf16* pbuf = (const bf16*)(p.ws + WS_PB); const float* small = (const float*)(p.ws + WS_SMALL);
    bf16* outb = dir ? (bf16*)(p.ws + WS_OB2) + h * 256 : (bf16*)p.out + 1024 + h * 256; const int opitch = dir ? 1024 : 2048;
    LAS float* gl = (LAS float*)(lds + GL_SC);
    LAS unsigned char* zb = lds + GL_SC + 512;
    LAS unsigned char* wb = lds + GL_SC + 2560;
    LAS float* gbias = (LAS float*)(lds + GL_SC + 6656);
    {
        f32x4 S[2][8];
#pragma unroll
        for (int ct = 0; ct < 2; ++ct)
#pragma unroll
            for (int u = 0; u < 8; ++u) S[ct][u] = (f32x4){0.f, 0.f, 0.f, 0.f};
        __syncthreads();
        { const float* gw = dir ? p.gla_gate_w_b : p.gla_gate_w_f; const float* gbp = dir ? p.gla_gate_b_b : p.gla_gate_b_f;
          for (int i = threadIdx.x; i < 2048; i += NTHREADS) { const int dim = i >> 4, k = i & 15; *(LAS unsigned short*)(wb + i * 2) = (unsigned short)(pk2c(gw[k * 512 + h * 128 + dim], 0.f) & 0xffffu); }
          if (threadIdx.x < 128) gbias[threadIdx.x] = gbp[h * 128 + threadIdx.x]; }
        v4u pq[2], pk[2], pv[2][2]; float pz[2];
#define LANE_VARS int tz_ = threadIdx.x; asm volatile("" : "+v"(tz_)); const int tid = tz_, lane = tz_ & 63, r = lane & 15, q = lane >> 4, lt = tz_ >> 4, piece = tz_ & 15; (void)tid; (void)r; (void)q; (void)lt; (void)piece;
#define GLA_ROW0(s_) (((s_) < 4) ? (size_t)(T + b * CTXL + (dir ? 3 - (s_) : (s_)) * 64) : (size_t)(b * SEQ + (dir ? 63 - ((s_) - 4) : (s_) - 4) * 64))
#define GLA_PREFETCH(s_) do { const size_t r0_ = GLA_ROW0(s_); \
            _Pragma("unroll") for (int jj = 0; jj < 2; ++jj) { const int pp = lt + 32 * jj; const bf16* rp = pbuf + (r0_ + (dir ? 63 - pp : pp)) * 2048; \
                pq[jj] = *(const v4u*)(rp + h * 128 + piece * 8); pk[jj] = *(const v4u*)(rp + 512 + h * 128 + piece * 8); \
                pv[jj][0] = *(const v4u*)(rp + 1024 + h * 256 + piece * 8); pv[jj][1] = *(const v4u*)(rp + 1024 + h * 256 + 128 + piece * 8); \
                pz[jj] = small[(r0_ + (dir ? 63 - pp : pp)) * 64 + 32 + dir * 16 + piece]; } } while (0)
        { LANE_VARS GLA_PREFETCH(0); }
        for (int s = 0; s < 68; ++s) {
            LANE_VARS
            const bool is_ctx = s < 4;
            const size_t row0 = GLA_ROW0(s);
            __syncthreads();
#pragma unroll
            for (int jj = 0; jj < 2; ++jj) { const int pp = lt + 32 * jj;
                *(LAS v4u*)(lds + L_K + pp * CS_KS + piece * 16) = pk[jj];
                *(LAS v4u*)(lds + GL_V + pp * GL_VS + piece * 16) = pv[jj][0]; *(LAS v4u*)(lds + GL_V + pp * GL_VS + 256 + piece * 16) = pv[jj][1];
                *(LAS unsigned short*)(zb + (pp * 16 + piece) * 2) = (unsigned short)(pk2c(pz[jj], 0.f) & 0xffffu); }
            __syncthreads();
            { const int c0 = wave * 16;
              const s16x4 wfr = *(const LAS s16x4*)(wb + (c0 + r) * 32 + q * 8); const float bia = gbias[c0 + r];
              s16x4 lgb[4];
#pragma unroll
              for (int t = 0; t < 4; ++t) { f32x4 u = MF16(*(const LAS s16x4*)(zb + (16 * t + r) * 32 + q * 8), wfr, ((f32x4){0.f, 0.f, 0.f, 0.f}));
#pragma unroll
                  for (int e = 0; e < 4; ++e) { const float x = u[e] + bia; u[e] = (fminf(x, 0.f) - 0.69314718f * __builtin_amdgcn_logf(1.0f + __builtin_amdgcn_exp2f(-1.44269504f * fabsf(x)))) * (1.0f / 16.0f); }
                  lgb[t] = cvt4(u); }
              s16x4 ltri, lone;
              { v2u a, o1; const unsigned one = 0x3f80u;
                a.x = ((4 * q + 0 <= r) ? one : 0u) | (((4 * q + 1 <= r) ? one : 0u) << 16); a.y = ((4 * q + 2 <= r) ? one : 0u) | (((4 * q + 3 <= r) ? one : 0u) << 16);
                o1.x = one | (one << 16); o1.y = o1.x; ltri = __builtin_bit_cast(s16x4, a); lone = __builtin_bit_cast(s16x4, o1); }
              f32x4 gc[4];
#pragma unroll
              for (int ti = 0; ti < 4; ++ti) { f32x4 a = (f32x4){0.f, 0.f, 0.f, 0.f};
#pragma unroll
                  for (int tj = 0; tj <= ti; ++tj) a = MF16(tj == ti ? ltri : lone, lgb[tj], a);
                  gc[ti] = a; }
              const float tot = __shfl(gc[3][3], 48 + r);
              if (q == 0) gl[c0 + r] = __expf(tot);
#pragma unroll
              for (int t = 0; t < 4; ++t) { float kd[4];
#pragma unroll
                  for (int e = 0; e < 4; ++e) { *(LAS float*)(lds + GL_G + (16 * t + 4 * q + e) * GL_VS + (c0 + r) * 4) = gc[t][e];
                      const float kv = bflo((unsigned)*(const LAS unsigned short*)(lds + L_K + (16 * t + 4 * q + e) * CS_KS + (c0 + r) * 2));
                      kd[e] = kv * __expf(tot - gc[t][e]); }
                  v2u w; w.x = pk2c(kd[0], kd[1]); w.y = pk2c(kd[2], kd[3]);
                  *(LAS v2u*)(lds + GL_KT + (c0 + r) * CS_TS + (16 * t + 4 * q) * 2) = w; } }
            __syncthreads();
#pragma unroll
            for (int jj = 0; jj < 2; ++jj) { const int pp = lt + 32 * jj;
                const f32x4 g0 = *(const LAS f32x4*)(lds + GL_G + pp * GL_VS + piece * 32), g1 = *(const LAS f32x4*)(lds + GL_G + pp * GL_VS + piece * 32 + 16);
                float qf[8], kf[8]; unpack8(pq[jj], qf); unpack8(pk[jj], kf);
#pragma unroll
                for (int e = 0; e < 4; ++e) { qf[e] *= QSCALE * __expf(g0[e]); kf[e] *= __expf(fminf(-g0[e], 80.f)); qf[4 + e] *= QSCALE * __expf(g1[e]); kf[4 + e] *= __expf(fminf(-g1[e], 80.f)); }
                *(LAS v4u*)(lds + L_Q + pp * CS_KS + piece * 16) = pack8c(qf); *(LAS v4u*)(lds + L_K + pp * CS_KS + piece * 16) = pack8c(kf); }
            if (s + 1 < 68) GLA_PREFETCH(s + 1);
            __syncthreads();
            if (!is_ctx) {
#pragma unroll
                for (int uu = 0; uu < 2; ++uu) { const int un = wave + 8 * uu; if (un < 10) {
                    const int bi = un < 1 ? 0 : (un < 3 ? 1 : (un < 6 ? 2 : 3)), bj = un - bi * (bi + 1) / 2;
                    bf16x8 fk[4], fq[4];
#pragma unroll
                    for (int ks = 0; ks < 4; ++ks) { fk[ks] = ldfrag(lds + L_K, 16 * bj + r, CS_KS, ks, q); fq[ks] = ldfrag(lds + L_Q, 16 * bi + r, CS_KS, ks, q); }
                    f32x4 d = (f32x4){0.f, 0.f, 0.f, 0.f};
#pragma unroll
                    for (int ks = 0; ks < 4; ++ks) d = MF32(fk[ks], fq[ks], d);
                    if (bi == bj) {
#pragma unroll
                        for (int e = 0; e < 4; ++e) d[e] = ((4 * q + e) <= r) ? d[e] : 0.f; }
                    *(LAS s16x4*)(lds + GL_ATT + un * 512 + lane * 8) = cvt4(d); } }
                __syncthreads();
            }
#define GLD8(img, t0) do { _Pragma("unroll") for (int t_ = 0; t_ < 2; ++t_) _Pragma("unroll") for (int ks_ = 0; ks_ < 4; ++ks_) fa[t_ * 4 + ks_] = ldfrag(lds + (img), 16 * ((t0) + t_) + r, CS_KS, ks_, q); } while (0)
#define GLD8T(u0) do { _Pragma("unroll") for (int u_ = 0; u_ < 4; ++u_) { fa[2 * u_] = ldfrag(lds + GL_KT, 16 * ((u0) + u_) + r, CS_TS, 0, q); fa[2 * u_ + 1] = ldfrag(lds + GL_KT, 16 * ((u0) + u_) + r, CS_TS, 1, q); } } while (0)
            { const int cc0 = wave * 16;
              bf16x8 fa[8];
              if (!is_ctx) GLD8(L_Q, 0); else GLD8T(0);
              s16x4 vt[2][4];
#pragma unroll
              for (int ct = 0; ct < 2; ++ct)
#pragma unroll
                  for (int t = 0; t < 4; ++t) { unsigned short v[4];
#pragma unroll
                      for (int e = 0; e < 4; ++e) v[e] = *(const LAS unsigned short*)(lds + GL_V + (16 * t + 4 * q + e) * GL_VS + (ct * 128 + cc0 + r) * 2);
                      v2u w; w.x = (unsigned)v[0] | ((unsigned)v[1] << 16); w.y = (unsigned)v[2] | ((unsigned)v[3] << 16); vt[ct][t] = __builtin_bit_cast(s16x4, w); }
              if (!is_ctx) {
                  f32x4 o[2][4];
                  { bf16x8 Sb[2][4];
#pragma unroll
                    for (int ct = 0; ct < 2; ++ct)
#pragma unroll
                        for (int ks = 0; ks < 4; ++ks) Sb[ct][ks] = cat8(cvt4(S[ct][2 * ks]), cvt4(S[ct][2 * ks + 1]));
#pragma unroll
                    for (int ct = 0; ct < 2; ++ct)
#pragma unroll
                        for (int t = 0; t < 2; ++t) { f32x4 a = (f32x4){0.f, 0.f, 0.f, 0.f};
#pragma unroll
                            for (int ks = 0; ks < 4; ++ks) a = MF32(fa[t * 4 + ks], Sb[ct][ks], a);
                            o[ct][t] = a; }
                    GLD8(L_Q, 2);
#pragma unroll
                    for (int ct = 0; ct < 2; ++ct)
#pragma unroll
                        for (int t = 0; t < 2; ++t) { f32x4 a = (f32x4){0.f, 0.f, 0.f, 0.f};
#pragma unroll
                            for (int ks = 0; ks < 4; ++ks) a = MF32(fa[t * 4 + ks], Sb[ct][ks], a);
                            o[ct][2 + t] = a; } }
                  GLD8T(0);
#pragma unroll
                  for (int t = 0; t < 4; ++t) { s16x4 at[4];
#pragma unroll
                      for (int tj = 0; tj <= t; ++tj) at[tj] = *(const LAS s16x4*)(lds + GL_ATT + tri_idx(t, tj) * 512 + lane * 8);
#pragma unroll
                      for (int ct = 0; ct < 2; ++ct) { f32x4 a = o[ct][t];
#pragma unroll
                          for (int tj = 0; tj <= t; ++tj) a = MF16(at[tj], vt[ct][tj], a);
#pragma unroll
                          for (int e = 0; e < 4; ++e) *(LAS unsigned short*)(lds + GL_G + (16 * t + 4 * q + e) * GL_VS + (ct * 128 + cc0 + r) * 2) = (unsigned short)(pk2c(a[e], 0.f) & 0xffffu); } }
              }
              { bf16x8 vb0[2], vb1[2];
#pragma unroll
                for (int ct = 0; ct < 2; ++ct) { vb0[ct] = cat8(vt[ct][0], vt[ct][1]); vb1[ct] = cat8(vt[ct][2], vt[ct][3]); }
#pragma unroll
                for (int u = 0; u < 4; ++u) { const f32x4 g4 = *(const LAS f32x4*)(gl + 16 * u + 4 * q);
#pragma unroll
                    for (int ct = 0; ct < 2; ++ct) { f32x4 a = S[ct][u] * g4; a = MF32(fa[2 * u], vb0[ct], a); a = MF32(fa[2 * u + 1], vb1[ct], a); S[ct][u] = a; } }
                GLD8T(4);
#pragma unroll
                for (int u = 0; u < 4; ++u) { const f32x4 g4 = *(const LAS f32x4*)(gl + 16 * (4 + u) + 4 * q);
#pragma unroll
                    for (int ct = 0; ct < 2; ++ct) { f32x4 a = S[ct][4 + u] * g4; a = MF32(fa[2 * u], vb0[ct], a); a = MF32(fa[2 * u + 1], vb1[ct], a); S[ct][4 + u] = a; } } }
            }
#undef GLD8
#undef GLD8T
            if (!is_ctx) {
                __syncthreads();
#pragma unroll
                for (int jj = 0; jj < 2; ++jj) { const int pp = lt + 32 * jj; bf16* dst = outb + (row0 + (dir ? 63 - pp : pp)) * opitch + piece * 8;
                    *(v4u*)dst = *(const LAS v4u*)(lds + GL_G + pp * GL_VS + piece * 16); *(v4u*)(dst + 128) = *(const LAS v4u*)(lds + GL_G + pp * GL_VS + 256 + piece * 16); }
            }
        }
#undef GLA_PREFETCH
#undef GLA_ROW0
#undef LANE_VARS
    }
}
#ifndef SCAN_ORACLE
#define SCAN_ORACLE 0
#endif

__device__ __forceinline__ void phase_wconv(const P& p, LAS unsigned char* lds, const int which, const int worker, const int nworkers);
__device__ __forceinline__ void phase_scan(const P& p, LAS unsigned char* lds) {
  const int nrep = p.probe ? 2 : 1;
  for (int rep = 0; rep < nrep; ++rep) {
    const int kinds = rep ? p.probe : 3;
    for (int u = blockIdx.x; u < 256; u += gridDim.x) {
        if (!((kinds >> (u & 1)) & 1)) continue;
#if SCAN_ORACLE
        if (u < 128) scan_unit<false>(p, lds, u >> 3, u & 7, 0);
        else { const int v = u - 128; scan_unit<true>(p, lds, v >> 3, (v >> 1) & 3, v & 1); }
#else
#ifndef GLA_ORACLE
#define GLA_ORACLE 0
#endif
#if !defined(TEST_NO_GDN)
        if ((u & 1) == 0) { const int v = u >> 1; gdn_unit(p, lds, v >> 3, v & 7); }
#else
        if ((u & 1) == 0) {}
#endif
#if defined(TEST_NO_GLA)
        else {}
#elif GLA_ORACLE
        else { const int v = u >> 1; scan_unit<true>(p, lds, v >> 3, (v >> 1) & 3, v & 1); }
#else
        else { const int v = u >> 1; gla_unit(p, lds, v >> 3, (v >> 1) & 3, v & 1); }
#endif
#endif
        __syncthreads();
    }
    __syncthreads();
  }
  { const int nw = (int)gridDim.x >> 1;
    if (nw == 0) phase_wconv(p, lds, 0, 0, 1);
    else if (blockIdx.x & 1) phase_wconv(p, lds, 0, (int)blockIdx.x >> 1, nw); }
}

__device__ __forceinline__ void phase_onorm(const P& p) {
    const int tid = threadIdx.x, lane = tid & 63, wave = tid >> 6;
    const int gw = blockIdx.x * NWAVES + wave, NGW = gridDim.x * NWAVES;
    bf16* on = (bf16*)p.out;
#if SCAN_ORACLE
    const float* gp = lane < 32 ? p.gdn_norm_g + (lane & 3) * 32 : p.gla_norm_g + ((lane - 32) & 7) * 32;
    float g[32];
#pragma unroll
    for (int i = 0; i < 32; ++i) g[i] = gp[i];
    for (int r = gw; r < T; r += NGW) {
        v4u* ptr = (v4u*)(on + (size_t)r * 2048 + lane * 32); float f[32]; float ss = 0.f;
#pragma unroll
        for (int q = 0; q < 4; ++q) { float t8[8]; unpack8(ptr[q], t8);
#pragma unroll
            for (int e = 0; e < 8; ++e) { f[q * 8 + e] = t8[e]; ss += t8[e] * t8[e]; } }
        ss += __shfl_xor(ss, 1); ss += __shfl_xor(ss, 2);
        const float s4 = __shfl_xor(ss, 4);
        const float rstd = lane < 32 ? rsqrtf_(ss * (1.f / 128.f) + EPS) : rsqrtf_((ss + s4) * (1.f / 256.f) + EPS);
#pragma unroll
        for (int q = 0; q < 4; ++q) { float t8[8];
#pragma unroll
            for (int e = 0; e < 8; ++e) t8[e] = f[q * 8 + e] * rstd * g[q * 8 + e];
            ptr[q] = pack8(t8); }
    }
#else
    float g[16];
#pragma unroll
    for (int i = 0; i < 16; ++i) g[i] = p.gla_norm_g[(lane & 15) * 16 + i];
    const bf16* ob2 = (const bf16*)(p.ws + WS_OB2);
    v4u nxt[4];
    if (gw < T) { const v4u* pp = (const v4u*)(on + (size_t)gw * 2048 + 1024 + lane * 16); const v4u* pb = (const v4u*)(ob2 + (size_t)gw * 1024 + lane * 16); nxt[0] = pp[0]; nxt[1] = pp[1]; nxt[2] = pb[0]; nxt[3] = pb[1]; }
    for (int r = gw; r < T; r += NGW) {
        v4u* ptr = (v4u*)(on + (size_t)r * 2048 + 1024 + lane * 16); float f[16]; float ss = 0.f;
        const v4u cur[4] = {nxt[0], nxt[1], nxt[2], nxt[3]};
        if (r + NGW < T) { const v4u* pp = (const v4u*)(on + (size_t)(r + NGW) * 2048 + 1024 + lane * 16); const v4u* pb = (const v4u*)(ob2 + (size_t)(r + NGW) * 1024 + lane * 16); nxt[0] = pp[0]; nxt[1] = pp[1]; nxt[2] = pb[0]; nxt[3] = pb[1]; }
#pragma unroll
        for (int q = 0; q < 2; ++q) { float t8[8], u8[8]; unpack8(cur[q], t8); unpack8(cur[2 + q], u8);
#pragma unroll
            for (int e = 0; e < 8; ++e) { const float x = t8[e] + u8[e]; f[q * 8 + e] = x; ss += x * x; } }
        ss = row16_sum(ss);
        const float rstd = rsqrtf_(ss * (1.f / 256.f) + EPS);
#pragma unroll
        for (int q = 0; q < 2; ++q) { float t8[8];
#pragma unroll
            for (int e = 0; e < 8; ++e) t8[e] = f[q * 8 + e] * rstd * g[q * 8 + e];
            ptr[q] = pack8(t8); }
    }
#endif
}

__device__ __forceinline__ void phase_wconv(const P& p, LAS unsigned char* lds, const int which, const int worker, const int nworkers) {
    const int tid = threadIdx.x, lane = tid & 63, wave = tid >> 6;
    LAS float* scr = (LAS float*)(lds + wave * 8448);
    const int gw = worker * NWAVES + wave, NGW = nworkers * NWAVES;
    constexpr int I_GUE = EARLY_GU * 64 * 16, I_GUL = (NE - EARLY_GU) * 64 * 16, I_DN = NE * 32 * 16;
    const int I_GUH = which ? I_GUL : I_GUE; const int nit = which ? I_GUL : I_GUE + I_DN;
#define WC_ITEM(it_, W_, ld_, c0_, dst_, dr_, k0_) do { if ((it_) < I_GUH) { const int e_ = ((it_) >> 10) + (which ? EARLY_GU : 0), r_ = (it_) & 1023, nb_ = r_ & 63;     \
            W_ = p.w_gu + (size_t)e_ * D * 2048; ld_ = 2048; c0_ = 32 * nb_; dst_ = p.ws + (size_t)wb_gu_mib(e_) * MiB; k0_ = 64 * (r_ >> 6); \
            dr_ = nb_ < 32 ? (nb_ >> 2) * 256 + (nb_ & 3) * 32 : ((nb_ - 32) >> 2) * 256 + 128 + ((nb_ - 32) & 3) * 32; } \
        else { const int r2_ = (it_) - I_GUH, e_ = r2_ >> 9, r_ = r2_ & 511, nb_ = r_ & 31; \
            W_ = p.w_down + (size_t)e_ * D * D; ld_ = D; c0_ = 32 * nb_; dst_ = p.ws + (size_t)wb_dn_mib(e_) * MiB; k0_ = 64 * (r_ >> 5); dr_ = 32 * nb_; } } while (0)
    float tn[32];
    const float* W; int ld, c0, dr, k0; unsigned char* dst;
    if (gw < nit) { WC_ITEM(gw, W, ld, c0, dst, dr, k0); tr8_load(tn, W, ld, c0, k0, lane); }
    for (int it = gw; it < nit; it += NGW) {
        float t[32];
#pragma unroll
        for (int i = 0; i < 32; ++i) t[i] = tn[i];
        unsigned char* cdst = dst; const int cdr = dr, ck0 = k0;
        if (it + NGW < nit) { WC_ITEM(it + NGW, W, ld, c0, dst, dr, k0); tr8_load(tn, W, ld, c0, k0, lane); }
        tr8_finish(t, cdst, cdr, ck0, scr, lane);
    }
#undef WC_ITEM
}

#define DPPF(x, ctrl) __builtin_bit_cast(float, __builtin_amdgcn_update_dpp(0, __builtin_bit_cast(int, (x)), (ctrl), 0xF, 0xF, true))
#define DPPI(x, ctrl) __builtin_amdgcn_update_dpp(0, (x), (ctrl), 0xF, 0xF, true)
#define AMAX_STEP(bv, bi, ctrl) { const float ov = DPPF(bv, ctrl); const int oi = DPPI(bi, ctrl); \
    const bool tk = (ov > bv) || (ov == bv && oi < bi); bv = tk ? ov : bv; bi = tk ? oi : bi; }
__device__ __forceinline__ void phase_ffnprep(const P& p, LAS unsigned char* lds) {
    const int tid = threadIdx.x, lane = tid & 63, wave = tid >> 6;
    LAS float* wp = (LAS float*)lds;
    LAS float* part = (LAS float*)(lds + 131584);
    LAS float* cb = (LAS float*)(lds + 132608);
    LAS float* rs = (LAS float*)(lds + 132736);
    LAS int* lcnt = (LAS int*)(lds + 133760);
    const float* modv = (const float*)(p.ws + WS_MODV); unsigned char* h2 = MOE_GATHER ? p.ws + WS_XG : (unsigned char*)p.out; const bf16* x1b = (const bf16*)(p.ws + WS_X1B);
    int* topi = (int*)(p.ws + WS_TOPI); float* topp = (float*)(p.ws + WS_TOPP);
    { int* st = (int*)(p.ws + WS_SLOT_TOK); float* sp = (float*)(p.ws + WS_SLOT_P);
      for (int i = blockIdx.x * NTHREADS + tid; i < NG * MAXSLOT; i += gridDim.x * NTHREADS) { st[i] = -1; sp[i] = 0.f; } }
    for (int r0 = blockIdx.x * 256; r0 < T; r0 += gridDim.x * 256) {
        const int b = r0 >> 12;
        const float* shp = modv + b * NMOD + 3 * D; const float* scp = modv + b * NMOD + 4 * D;
        __syncthreads();
        { float ca0 = 0.f, ca1 = 0.f, ca2 = 0.f, ca3 = 0.f; const int e4 = tid & 7;
#pragma unroll 4
          for (int it = 0; it < 16; ++it) { const int i4 = tid + NTHREADS * it, k = i4 >> 3;
              const f32x4 wv = ((const f32x4*)p.w_router)[i4]; const float gk = p.norm_ffn_g[k] * (1.0f + scp[k]), sk = shp[k];
              wp[(4 * e4 + 0) * 1028 + k] = wv.x * gk; wp[(4 * e4 + 1) * 1028 + k] = wv.y * gk;
              wp[(4 * e4 + 2) * 1028 + k] = wv.z * gk; wp[(4 * e4 + 3) * 1028 + k] = wv.w * gk;
              ca0 += sk * wv.x; ca1 += sk * wv.y; ca2 += sk * wv.z; ca3 += sk * wv.w; }
#pragma unroll
          for (int m = 8; m < 64; m <<= 1) { ca0 += __shfl_xor(ca0, m); ca1 += __shfl_xor(ca1, m); ca2 += __shfl_xor(ca2, m); ca3 += __shfl_xor(ca3, m); }
          if (lane < 8) { part[wave * 32 + 4 * lane + 0] = ca0; part[wave * 32 + 4 * lane + 1] = ca1; part[wave * 32 + 4 * lane + 2] = ca2; part[wave * 32 + 4 * lane + 3] = ca3; } }
        if (tid < NG * 32) lcnt[tid] = 0;
        __syncthreads();
        if (tid < 32) { float s = p.b_router[tid];
#pragma unroll
            for (int w = 0; w < 8; ++w) s += part[w * 32 + tid];
            cb[tid] = s; }
        const int rw = r0 + 32 * wave;
        { f32x4 gs[4], s1[4];
#pragma unroll
          for (int j = 0; j < 4; ++j) { const f32x4 gg = ((const f32x4*)p.norm_ffn_g)[lane + 64 * j], s2 = ((const f32x4*)scp)[lane + 64 * j];
              gs[j] = gg * (1.0f + s2); s1[j] = ((const f32x4*)shp)[lane + 64 * j]; }
          f32x4 nx[4];
          { const v2u* xr = (const v2u*)(x1b + (size_t)rw * D) + lane;
#pragma unroll
            for (int j = 0; j < 4; ++j) nx[j] = ldx4(xr[64 * j]); }
          for (int t = 0; t < 32; ++t) {
              const int r = rw + t;
              f32x4 v[4]; float s = 0.f;
#pragma unroll
              for (int j = 0; j < 4; ++j) { v[j] = nx[j]; s += (v[j].x * v[j].x + v[j].y * v[j].y) + (v[j].z * v[j].z + v[j].w * v[j].w); }
              if (t + 1 < 32) { const v2u* xr = (const v2u*)(x1b + (size_t)(r + 1) * D) + lane;
#pragma unroll
                  for (int j = 0; j < 4; ++j) nx[j] = ldx4(xr[64 * j]); }
              const float rstd = rsqrtf_(wave_sum(s) * (1.f / D) + EPS);
              if (lane == 0) rs[32 * wave + t] = rstd;
              unsigned* o8 = (unsigned*)(h2 + (size_t)r * D) + lane;
#pragma unroll
              for (int j = 0; j < 4; ++j) { v[j] = v[j] * rstd * gs[j] + s1[j]; o8[64 * j] = pk4f8(v[j].x, v[j].y, v[j].z, v[j].w); }
          } }
        __syncthreads();
        const int n = lane & 15, q = lane >> 4;
#pragma unroll 1
        for (int tt = 0; tt < 2; ++tt) {
            const int tb = rw + 16 * tt;
            const v4u* xr = (const v4u*)(x1b + (size_t)(tb + n) * D) + q;
            const LAS float* w0 = wp + n * 1028 + 8 * q; const LAS float* w1 = w0 + 16 * 1028;
            f32x4 acc0 = {0.f, 0.f, 0.f, 0.f}, acc1 = {0.f, 0.f, 0.f, 0.f};
            v4u xa[8], xb[8];
#pragma unroll
            for (int i = 0; i < 8; ++i) xa[i] = xr[4 * i];
#define FFN_MF(xf, wa, wb) acc0 = __builtin_amdgcn_mfma_f32_16x16x4f32((xf), (wa), acc0, 0, 0, 0); acc1 = __builtin_amdgcn_mfma_f32_16x16x4f32((xf), (wb), acc1, 0, 0, 0);
#define FFN_GRP(X, g) _Pragma("unroll") for (int i = 0; i < 8; ++i) { const int sp_ = 8 * (g) + i; \
                const f32x4 wv0a = *(const LAS f32x4*)(w0 + 32 * sp_), wv0b = *(const LAS f32x4*)(w0 + 32 * sp_ + 4), wv1a = *(const LAS f32x4*)(w1 + 32 * sp_), wv1b = *(const LAS f32x4*)(w1 + 32 * sp_ + 4); \
                FFN_MF(bflo(X[i].x), wv0a.x, wv1a.x) FFN_MF(bfhi(X[i].x), wv0a.y, wv1a.y) FFN_MF(bflo(X[i].y), wv0a.z, wv1a.z) FFN_MF(bfhi(X[i].y), wv0a.w, wv1a.w) \
                FFN_MF(bflo(X[i].z), wv0b.x, wv1b.x) FFN_MF(bfhi(X[i].z), wv0b.y, wv1b.y) FFN_MF(bflo(X[i].w), wv0b.z, wv1b.z) FFN_MF(bfhi(X[i].w), wv0b.w, wv1b.w) }
#pragma unroll 1
            for (int g = 0; g < 4; g += 2) {
#pragma unroll
                for (int i = 0; i < 8; ++i) xb[i] = xr[4 * (8 * (g + 1) + i)];
                FFN_GRP(xa, g)
                if (g + 2 < 4) {
#pragma unroll
                    for (int i = 0; i < 8; ++i) xa[i] = xr[4 * (8 * (g + 2) + i)]; }
                FFN_GRP(xb, g + 1)
            }
#undef FFN_MF
            const float c0 = cb[n], c1 = cb[16 + n];
            float v0[4], v1[4];
#pragma unroll
            for (int j = 0; j < 4; ++j) { const float rsd = rs[32 * wave + 16 * tt + 4 * q + j]; v0[j] = acc0[j] * rsd + c0; v1[j] = acc1[j] * rsd + c1; }
#pragma unroll
            for (int j = 0; j < 4; ++j) {
                int sel[4]; float val[4];
#pragma unroll
                for (int k = 0; k < 4; ++k) {
                    float bv; int bi;
                    if (v1[j] > v0[j]) { bv = v1[j]; bi = 16 + n; } else { bv = v0[j]; bi = n; }
                    AMAX_STEP(bv, bi, 0xB1) AMAX_STEP(bv, bi, 0x4E) AMAX_STEP(bv, bi, 0x141) AMAX_STEP(bv, bi, 0x140)
                    sel[k] = bi; val[k] = bv;
                    v0[j] = (bi == n) ? -3.0e38f : v0[j]; v1[j] = (bi == 16 + n) ? -3.0e38f : v1[j];
                }
                float pe[4], ps = 0.f;
#pragma unroll
                for (int k = 0; k < 4; ++k) { pe[k] = __expf(val[k] - val[0]); ps += pe[k]; }
                if (n < 4) { const int r = tb + 4 * q + j;
                    const int e = n == 0 ? sel[0] : (n == 1 ? sel[1] : (n == 2 ? sel[2] : sel[3])); const float pv = (n == 0 ? pe[0] : (n == 1 ? pe[1] : (n == 2 ? pe[2] : pe[3]))) / ps;
                    topi[r * 4 + n] = e; topp[r * 4 + n] = pv; lds_add(&lcnt[(r / TG) * 32 + e], 1); }
            }
        }
        __syncthreads();
        if (tid < NG * 32) { const int v = lcnt[tid]; if (v) atomicAdd((int*)(p.ws + WS_CTL) + CW_CNT + tid, v); }
    }
}

__device__ __forceinline__ void phase_route(const P& p, LAS unsigned char* lds) {
    const int tid = threadIdx.x;
    LAS int* seg = (LAS int*)lds;
    LAS int* lcnt = seg + 64; LAS int* gb = lcnt + 32;
    int* ctl = (int*)(p.ws + WS_CTL);
    int* tile_e = (int*)(p.ws + WS_TILE_E);
    if (tid < 64) {
        const int c = __hip_atomic_load(ctl + CW_CNT + tid, __ATOMIC_RELAXED, __HIP_MEMORY_SCOPE_AGENT); const int padded = (c + 255) & ~255;
        int incl = padded;
#pragma unroll
        for (int d = 1; d < 32; d <<= 1) { const int t = __shfl_up(incl, d, 32); if ((tid & 31) >= d) incl += t; }
        const int start = incl - padded; seg[tid] = start;
        if (blockIdx.x == 0) { for (int t = start >> 8; t < (start + padded) >> 8; ++t) tile_e[(tid >> 5) * MAXTILE + t] = tid & 31;
            if ((tid & 31) == 31) ctl[CW_NTILE + (tid >> 5)] = incl >> 8; }
    }
    __syncthreads();
    const int* topi = (const int*)(p.ws + WS_TOPI); const float* topp = (const float*)(p.ws + WS_TOPP);
    int* slot_tok = (int*)(p.ws + WS_SLOT_TOK); float* slot_p = (float*)(p.ws + WS_SLOT_P); int* tokslot = (int*)(p.ws + WS_TOKSLOT);
    for (int base = blockIdx.x * 256; base < T; base += gridDim.x * 256) {
        const int g = base / TG;
        if (tid < 32) lcnt[tid] = 0;
        __syncthreads();
        int e2[2], lp[2];
#pragma unroll
        for (int jj = 0; jj < 2; ++jj) { const int i = tid + 512 * jj; e2[jj] = topi[base * 4 + i]; lp[jj] = lds_add(&lcnt[e2[jj]], 1); }
        __syncthreads();
        if (tid < 32) gb[tid] = lcnt[tid] ? atomicAdd(ctl + CW_CUR + g * 32 + tid, lcnt[tid]) : 0;
        __syncthreads();
#pragma unroll
        for (int jj = 0; jj < 2; ++jj) { const int i = tid + 512 * jj; const int slot = seg[g * 32 + e2[jj]] + gb[e2[jj]] + lp[jj];
            slot_tok[g * MAXSLOT + slot] = base + (i >> 2); slot_p[g * MAXSLOT + slot] = topp[base * 4 + i]; tokslot[base * 4 + i] = slot; }
        __syncthreads();
        if (!MOE_GATHER) { const int wave = tid >> 6, lane = tid & 63; const unsigned char* h2 = (const unsigned char*)p.out; unsigned char* xg = p.ws + WS_XG + (size_t)g * MAXSLOT * D;
          for (int i0 = wave * 128; i0 < wave * 128 + 128; i0 += 8) { int sl[8]; v4u rw[8];
#pragma unroll
              for (int j = 0; j < 8; ++j) sl[j] = tokslot[base * 4 + i0 + j];
#pragma unroll
              for (int j = 0; j < 8; ++j) rw[j] = *(const v4u*)(h2 + (size_t)(base + ((i0 + j) >> 2)) * D + lane * 16);
#pragma unroll
              for (int j = 0; j < 8; ++j) *(v4u*)(xg + (size_t)sl[j] * D + lane * 16) = rw[j]; } }
        __syncthreads();
    }
}

__device__ __forceinline__ void phase_combine(const P& p, int g) {
    const int tid = threadIdx.x, lane = tid & 63, wave = tid >> 6;
    const int gw = blockIdx.x * NWAVES + wave, NGW = gridDim.x * NWAVES;
    const float* modv = (const float*)(p.ws + WS_MODV); const bf16* ys = (const bf16*)(p.ws + WS_YSLOT); const int* tokslot = (const int*)(p.ws + WS_TOKSLOT); const bf16* x1b = (const bf16*)(p.ws + WS_X1B);
    const int rbeg = g * TG + gw, rend = (g + 1) * TG;
    int sl2[4] = {0, 0, 0, 0}; f32x4 nx[4]; unsigned nyw[4][4];
#define CMB_LDY(dst, sl) _Pragma("unroll") for (int k = 0; k < 4; ++k) { const unsigned* yr_ = (const unsigned*)((const unsigned char*)ys + (size_t)(sl)[k] * D) + lane; \
        _Pragma("unroll") for (int j = 0; j < 4; ++j) dst[k][j] = yr_[64 * j]; }
    if (rbeg < rend) { int sl[4];
#pragma unroll
        for (int k = 0; k < 4; ++k) sl[k] = tokslot[rbeg * 4 + k];
        if (rbeg + NGW < rend) {
#pragma unroll
            for (int k = 0; k < 4; ++k) sl2[k] = tokslot[(rbeg + NGW) * 4 + k]; }
        const v2u* xr0 = (const v2u*)(x1b + (size_t)rbeg * D) + lane;
#pragma unroll
        for (int j = 0; j < 4; ++j) nx[j] = ldx4(xr0[64 * j]);
        CMB_LDY(nyw, sl) }
    for (int r = rbeg; r < rend; r += NGW) {
        const int b = r >> 12;
        f32x4* xr = (f32x4*)(p.out + (size_t)r * D) + lane;
        const f32x4* g2 = (const f32x4*)(modv + b * NMOD + 5 * D) + lane;
        unsigned yw[4][4]; f32x4 xc[4];
#pragma unroll
        for (int k = 0; k < 4; ++k)
#pragma unroll
            for (int j = 0; j < 4; ++j) yw[k][j] = nyw[k][j];
#pragma unroll
        for (int j = 0; j < 4; ++j) xc[j] = nx[j];
        if (r + NGW < rend) { int sl[4];
#pragma unroll
            for (int k = 0; k < 4; ++k) sl[k] = sl2[k];
            if (r + 2 * NGW < rend) {
#pragma unroll
                for (int k = 0; k < 4; ++k) sl2[k] = tokslot[(r + 2 * NGW) * 4 + k]; }
            const v2u* xn = (const v2u*)(x1b + (size_t)(r + NGW) * D) + lane;
#pragma unroll
            for (int j = 0; j < 4; ++j) nx[j] = ldx4(xn[64 * j]);
            CMB_LDY(nyw, sl) }
        f32x4 y[4];
#pragma unroll
        for (int j = 0; j < 4; ++j) y[j] = (f32x4){0.f, 0.f, 0.f, 0.f};
#pragma unroll
        for (int k = 0; k < 4; ++k)
#pragma unroll
            for (int j = 0; j < 4; ++j) { const int w = (int)yw[k][j]; y[j].x += __builtin_amdgcn_cvt_f32_fp8(w, 0); y[j].y += __builtin_amdgcn_cvt_f32_fp8(w, 1); y[j].z += __builtin_amdgcn_cvt_f32_fp8(w, 2); y[j].w += __builtin_amdgcn_cvt_f32_fp8(w, 3); }
        f32x4 v[4]; float s = 0.f;
#pragma unroll
        for (int j = 0; j < 4; ++j) { v[j] = xc[j] + (0.0625f * g2[64 * j]) * y[j]; s += (v[j].x * v[j].x + v[j].y * v[j].y) + (v[j].z * v[j].z + v[j].w * v[j].w); }
        const float rstd = rsqrtf_(wave_sum(s) * (1.f / D) + EPS);
        const f32x4* fg = (const f32x4*)p.final_norm_g + lane;
#pragma unroll
        for (int j = 0; j < 4; ++j) xr[64 * j] = v[j] * rstd * fg[64 * j];
    }
#undef CMB_LDY
}

constexpr int N_PHASES = 11 + 2 * NG;
template <int PH>
__device__ __forceinline__ void run_phase(const P& p, LAS unsigned char* lds) {
    const int G = gridDim.x, c = blockIdx.x;
    unsigned char* ws = p.ws;
    if constexpr (PH == 0) phase_prologue(p, lds);
    else if constexpr (PH == 1) phase_norm1(p);
    else if constexpr (PH == 2) { EpiG1 E{(bf16*)(ws + WS_QKVA), (bf16*)(ws + WS_PB), (float*)(ws + WS_SMALL)};
        if constexpr (G1_NF8 > 0) { pg8::SchedDense S8{TT / 256, G1_NF8, G, c}; pg8::gemm_phase<EpiG1, pg8::SchedDense, true>(lds, (const bf16*)(ws + WS_H8), (const bf16*)(ws + WS_BT_S8), D / 2, S8, E); }
        if constexpr (G1_NF8 < N_S / 256) { pg8::SchedDense S{TT / 256, N_S / 256 - G1_NF8, G, c, G1_NF8}; pg8::gemm_phase(lds, (const bf16*)(ws + WS_H), (const bf16*)(ws + WS_BT_S), D, S, E); } }
    else if constexpr (PH == 3) phase_conv(p, lds);
    else if constexpr (PH == 4) phase_scan(p, lds);
    else if constexpr (PH == 5) { pg8::SchedDense S{T / 256, N_G / 256, G, c}; EpiG2 E{(const bf16*)p.out, (bf16*)(ws + WS_YA_IN), (bf16*)(ws + WS_YB_IN), (bf16*)(ws + WS_GATES), p.gla_norm_g, (LAS float*)(lds + 131072), (const bf16*)(ws + WS_OB2)};
        if constexpr (FP8_G2) pg8::gemm_phase<EpiG2, pg8::SchedDense, true>(lds, (const bf16*)(ws + WS_H8), (const bf16*)(ws + WS_BT_G8), D / 2, S, E);
        else pg8::gemm_phase(lds, (const bf16*)(ws + WS_H), (const bf16*)(ws + WS_BT_G), D, S, E); }
    else if constexpr (PH == 6) { phase_wconv(p, lds, 1, blockIdx.x, gridDim.x); __syncthreads();
        pg8::SchedDense S{T / 256, 4, G, c};
        { EpiG34<0> E{(const bf16*)(ws + WS_GATES), (bf16*)(ws + WS_Y)}; pg8::gemm_phase(lds, (const bf16*)(ws + WS_YA_IN), (const bf16*)(ws + WS_BT_OA), D, S, E); }
        asm volatile("s_waitcnt vmcnt(0)" ::: "memory"); __syncthreads();
        { EpiG34<1> E{(const bf16*)(ws + WS_GATES), (bf16*)(ws + WS_Y)}; pg8::gemm_phase(lds, (const bf16*)(ws + WS_YB_IN), (const bf16*)(ws + WS_BT_OB), D, S, E); } }
    else if constexpr (PH == 7) { pg8::SchedDense S{T / 256, 4, G, c}; EpiG5 E{p.x, (const float*)(ws + WS_MODV), (bf16*)(ws + WS_X1B)};
        pg8::gemm_phase(lds, (const bf16*)(ws + WS_Y), (const bf16*)(ws + WS_BT_O), D, S, E); }
    else if constexpr (PH == 8) phase_ffnprep(p, lds);
    else if constexpr (PH == 9) phase_route(p, lds);
    else if constexpr (PH == 10 + 2 * NG) phase_combine(p, NG - 1);
    else {
        constexpr int g = (PH - 10) / 2, sub = (PH - 10) % 2;
        const int ntile = ((const int*)(ws + WS_CTL))[CW_NTILE + g];
        const int* tile_e = (const int*)(ws + WS_TILE_E) + g * MAXTILE;
        if constexpr (sub == 0) { EpiGU E{p.b_gu, (bf16*)(ws + WS_ACT)};
            if constexpr (MOE_GATHER) { pg8::SchedMoe S{ntile, 8, G, c, tile_e, (const int*)(ws + WS_SLOT_TOK) + g * MAXSLOT, 0};
                pg8::gemm_phase<EpiGU, pg8::SchedMoe, true>(lds, (const bf16*)(ws + WS_XG), (const bf16*)ws, D / 2, S, E); }
            else { pg8::SchedMoeDense S{ntile, 8, G, c, tile_e, 0};
                pg8::gemm_phase<EpiGU, pg8::SchedMoeDense, true>(lds, (const bf16*)(ws + WS_XG + (size_t)g * MAXSLOT * D), (const bf16*)ws, D / 2, S, E); }
            if constexpr (g > 0) phase_combine(p, g - 1); }
        else { pg8::SchedMoeDense S{ntile, 4, G, c, tile_e, 1}; EpiDN E{p.b_down, (const float*)(ws + WS_SLOT_P) + g * MAXSLOT, (bf16*)(ws + WS_YSLOT)};
            pg8::gemm_phase<EpiDN, pg8::SchedMoeDense, true>(lds, (const bf16*)(ws + WS_ACT), (const bf16*)ws, D / 2, S, E); }
    }
}

#ifndef PROBE_DUP_MASK
#define PROBE_DUP_MASK 0u
#endif
#if MK_FUSED
template <int PH>
__device__ __forceinline__ void run_from(const P& p, LAS unsigned char* lds, const XcdBarrier& bar) {
    if constexpr (PH < N_PHASES) { run_phase<PH>(p, lds);
        if constexpr ((PROBE_DUP_MASK >> PH) & 1u) { xcd_barrier(bar); run_phase<PH>(p, lds); }
        if constexpr (PH + 1 < N_PHASES) xcd_barrier(bar); run_from<PH + 1>(p, lds, bar); }
}
__global__ void __launch_bounds__(NTHREADS, 2) k_fused(P p) {
    extern __shared__ __attribute__((aligned(16))) unsigned char lds_raw[];
    LAS unsigned char* lds = (LAS unsigned char*)lds_raw;
    volatile LAS unsigned* misc = (volatile LAS unsigned*)(lds + 144 * 1024 - 64);
    if (threadIdx.x < 4) misc[threadIdx.x] = 0u;
    __syncthreads();
    XcdBarrier bar = xcd_barrier_post((unsigned*)(p.ws + WS_CTL) + CW_BAR, misc);
    run_from<0>(p, lds, bar);
}
#else
template <int PH>
__global__ void __launch_bounds__(NTHREADS, 2) k_phase(P p) {
    extern __shared__ __attribute__((aligned(16))) unsigned char lds_raw[];
    run_phase<PH>(p, (LAS unsigned char*)lds_raw);
}
template <int PH>
static void launch_all(const P& p, int grid, hipStream_t stream) {
    if constexpr (PH < N_PHASES) {
        static bool attr = false;
        if (!attr) { (void)hipFuncSetAttribute((const void*)k_phase<PH>, hipFuncAttributeMaxDynamicSharedMemorySize, LDS_BYTES); attr = true; }
        hipLaunchKernelGGL(k_phase<PH>, dim3(grid), dim3(NTHREADS), LDS_BYTES, stream, p);
        launch_all<PH + 1>(p, grid, stream);
    }
}
#endif

extern "C" void kernel_launch(void* const* d_in, const int* in_sizes, int n_in, void* d_out, int out_size, void* d_ws, size_t ws_size, hipStream_t stream) {
    static int grid = 0;
    if (grid == 0) {
        if (n_in != 30 || in_sizes[0] != T * D || out_size != T * D || ws_size < WS_END) { fprintf(stderr, "kernel_launch: unexpected shapes (n_in %d, in0 %d, out %d, ws %zu)\n", n_in, n_in > 0 ? in_sizes[0] : -1, out_size, ws_size); grid = -1; return; }
        int dev = 0, cus = 0;
        if (hipGetDevice(&dev) != hipSuccess || hipDeviceGetAttribute(&cus, hipDeviceAttributeMultiprocessorCount, dev) != hipSuccess) { grid = -1; return; }
#if MK_FUSED
        if (hipFuncSetAttribute((const void*)k_fused, hipFuncAttributeMaxDynamicSharedMemorySize, LDS_BYTES) != hipSuccess) { fprintf(stderr, "kernel_launch: hipFuncSetAttribute failed\n"); grid = -1; return; }
        int per_cu = 0;
        if (hipOccupancyMaxActiveBlocksPerMultiprocessor(&per_cu, (const void*)k_fused, NTHREADS, LDS_BYTES) != hipSuccess || per_cu < 1) fprintf(stderr, "kernel_launch: occupancy query reports %d\n", per_cu);
        (void)hipGetLastError();
#endif
        grid = cus;
    }
    if (grid < 0) return;
    (void)hipMemsetAsync((char*)d_ws + WS_CTL, 0, CTL_BYTES, stream);
    P p{};
    const float** pp = (const float**)&p;
    for (int i = 0; i < 30; ++i) pp[i] = (const float*)d_in[i];
    p.out = (float*)d_out; p.ws = (unsigned char*)d_ws;
#ifdef PROBE_SCAN_KIND
    p.probe = PROBE_SCAN_KIND;
#endif
#if MK_FUSED
    hipLaunchKernelGGL(k_fused, dim3(grid), dim3(NTHREADS), LDS_BYTES, stream, p);
#else
    launch_all<0>(p, grid, stream);
#endif
}
```

```cpp
#include <hip/hip_runtime.h>
#include <cstdio>
#include <cstdint>

#ifndef MK_FUSED
#define MK_FUSED 1
#endif
#ifndef FP8_G1
#define FP8_G1 1
#endif
#define G1_NF8 (FP8_G1 == 0 ? 0 : (FP8_G1 == 1 ? 21 : (FP8_G1 == 2 ? 12 : 20)))
#ifndef MOE_GATHER
#define MOE_GATHER 1
#endif
#ifndef FP8_G2
#define FP8_G2 1
#endif

#define GAS __attribute__((address_space(1)))
#define LAS __attribute__((address_space(3)))
typedef unsigned short bf16;
typedef unsigned v4u __attribute__((ext_vector_type(4)));
typedef unsigned v2u __attribute__((ext_vector_type(2)));
typedef float f32x4 __attribute__((ext_vector_type(4)));
typedef short bf16x8 __attribute__((ext_vector_type(8)));

constexpr int D = 1024, NB = 16, SEQ = 4096, T = NB * SEQ, CTXL = 256, TC = NB * CTXL, TT = T + TC;
constexpr int D_IN = 9280, N_S = 5376, N_G = 4096, NMOD = 6 * D;
constexpr int NE = 32, NG = 1, TG = T / NG, MAXSLOT = TG * 4 + NE * 256, MAXTILE = MAXSLOT / 256;
constexpr float EPS = 1e-6f;
constexpr int NTHREADS = 512, NWAVES = 8;
constexpr int LDS_BYTES = 147456;

constexpr size_t MiB = 1u << 20;
constexpr size_t WS_CTL = 0, CTL_BYTES = 1 * MiB;
constexpr size_t WS_MODV = 1 * MiB, WS_BT_S = 2 * MiB, WS_BT_G = 13 * MiB, WS_BT_OA = 21 * MiB, WS_BT_OB = 23 * MiB, WS_BT_O = 25 * MiB;
constexpr size_t WS_TOPI = 27 * MiB, WS_TOPP = 28 * MiB, WS_TOKSLOT = 29 * MiB, WS_SLOT_TOK = 30 * MiB, WS_SLOT_P = 32 * MiB, WS_TILE_E = 34 * MiB;
constexpr size_t WS_H8 = 880 * MiB, WS_BT_S8 = 976 * MiB, WS_BT_G8 = 984 * MiB;
constexpr size_t WS_H = 40 * MiB, WS_PB = 176 * MiB, WS_SMALL = 448 * MiB, WS_QKVA = 465 * MiB;
constexpr size_t WS_YA_IN = 240 * MiB, WS_YB_IN = 368 * MiB, WS_GATES = 496 * MiB, WS_Y = 752 * MiB;
constexpr size_t WS_X1B = 40 * MiB;
__host__ __device__ __forceinline__ constexpr int wb_dn_mib(int e) { return e < 28 ? 948 + e : 960 + e; }
constexpr int EARLY_GU = 15;
__host__ __device__ __forceinline__ constexpr int wb_gu_mib(int e) { return e < 8 ? 992 + 2 * e : (e < EARLY_GU ? 2 * e - 14 : 880 + 2 * (e - EARLY_GU)); }
constexpr size_t WS_H2 = 40 * MiB, WS_XG = 200 * MiB, WS_ACT = (NG == 1 ? 264 : 472) * MiB, WS_YSLOT = 608 * MiB, WS_END = 1008 * MiB;
static_assert(WS_QKVA + (size_t)TT * 3072 * 2 <= 873 * MiB && WS_SMALL + (size_t)TT * 64 * 4 <= WS_QKVA && WS_H + (size_t)TT * D * 2 <= WS_PB, "ws map");
static_assert(WS_XG + (size_t)T * D <= WS_ACT && WS_ACT + (size_t)MAXSLOT * D <= WS_YSLOT && WS_YSLOT + (size_t)MAXSLOT * D <= 880 * MiB && MOE_GATHER == 1 && (size_t)(wb_gu_mib(7) + 2) * MiB <= WS_END && wb_gu_mib(NE - 1) + 2 <= 948 && (EARLY_GU <= 8 || wb_gu_mib(EARLY_GU - 1) + 2 <= 21) && WS_H2 + (size_t)T * D <= WS_XG && WS_QKVA + (size_t)TT * 3072 * 2 <= 880 * MiB, "ws map 2");
constexpr int CW_BAR = 4096, CW_CNT = 8192, CW_CUR = 8192 + 256, CW_NTILE = 8192 + 512;

#define LDS_WAIT() asm volatile("s_waitcnt lgkmcnt(0)" ::: "memory")
#define VM_WAIT() asm volatile("s_waitcnt vmcnt(0)" ::: "memory")
__device__ __forceinline__ float bflo(unsigned u) { return __uint_as_float(u << 16); }
__device__ __forceinline__ float bfhi(unsigned u) { return __uint_as_float(u & 0xffff0000u); }
__device__ __forceinline__ unsigned pk2(float lo, float hi) { unsigned r; asm("v_cvt_pk_bf16_f32 %0, %1, %2" : "=v"(r) : "v"(lo), "v"(hi)); return r; }
__device__ __forceinline__ float wave_sum(float x) {
    x += __builtin_bit_cast(float, __builtin_amdgcn_update_dpp(0, __builtin_bit_cast(int, x), 0xB1, 0xF, 0xF, true));
    x += __builtin_bit_cast(float, __builtin_amdgcn_update_dpp(0, __builtin_bit_cast(int, x), 0x4E, 0xF, 0xF, true));
    x += __builtin_bit_cast(float, __builtin_amdgcn_update_dpp(0, __builtin_bit_cast(int, x), 0x141, 0xF, 0xF, true));
    x += __builtin_bit_cast(float, __builtin_amdgcn_update_dpp(0, __builtin_bit_cast(int, x), 0x140, 0xF, 0xF, true));
    { float a = x, b = x; asm volatile("s_nop 1\n\tv_permlane16_swap_b32 %0, %1" : "+v"(a), "+v"(b)); x = a + b; }
    { float a = x, b = x; asm volatile("s_nop 1\n\tv_permlane32_swap_b32 %0, %1" : "+v"(a), "+v"(b)); x = a + b; }
    return x;
}
__device__ __forceinline__ float row16_sum(float x) {
    x += __builtin_bit_cast(float, __builtin_amdgcn_update_dpp(0, __builtin_bit_cast(int, x), 0xB1, 0xF, 0xF, true));
    x += __builtin_bit_cast(float, __builtin_amdgcn_update_dpp(0, __builtin_bit_cast(int, x), 0x4E, 0xF, 0xF, true));
    x += __builtin_bit_cast(float, __builtin_amdgcn_update_dpp(0, __builtin_bit_cast(int, x), 0x141, 0xF, 0xF, true));
    x += __builtin_bit_cast(float, __builtin_amdgcn_update_dpp(0, __builtin_bit_cast(int, x), 0x140, 0xF, 0xF, true));
    return x;
}
__device__ __forceinline__ int lds_add(LAS int* p, int v) { return __hip_atomic_fetch_add(p, v, __ATOMIC_RELAXED, __HIP_MEMORY_SCOPE_WORKGROUP); }
__device__ __forceinline__ float sigmoidf_(float x) { return 1.0f / (1.0f + __expf(-x)); }
__device__ __forceinline__ float siluf_(float x) { return x / (1.0f + __expf(-x)); }
__device__ __forceinline__ float sigmoid_fast(float x) { return __builtin_amdgcn_rcpf(1.0f + __builtin_amdgcn_exp2f(-1.44269504f * x)); }
__device__ __forceinline__ float silu_fast(float x) { return x * __builtin_amdgcn_rcpf(1.0f + __builtin_amdgcn_exp2f(-1.44269504f * x)); }
__device__ __forceinline__ float rsqrtf_(float x) { return __builtin_amdgcn_rsqf(x); }
__device__ __forceinline__ float softplusf_(float x) { return fmaxf(x, 0.f) + 0.69314718f * __builtin_amdgcn_logf(1.0f + __builtin_amdgcn_exp2f(-1.44269504f * fabsf(x))); }
__device__ __forceinline__ void unpack8(const v4u w, float (&f)[8]) {
    f[0] = bflo(w.x); f[1] = bfhi(w.x); f[2] = bflo(w.y); f[3] = bfhi(w.y); f[4] = bflo(w.z); f[5] = bfhi(w.z); f[6] = bflo(w.w); f[7] = bfhi(w.w);
}
__device__ __forceinline__ v4u pack8(const float (&f)[8]) { v4u w; w.x = pk2(f[0], f[1]); w.y = pk2(f[2], f[3]); w.z = pk2(f[4], f[5]); w.w = pk2(f[6], f[7]); return w; }

__device__ __forceinline__ unsigned pk4f8(float a, float b, float c, float d) { int w = __builtin_amdgcn_cvt_pk_fp8_f32(a, b, 0, false); w = __builtin_amdgcn_cvt_pk_fp8_f32(c, d, w, true); return (unsigned)w; }
struct P {
    const float *x, *c, *ctx, *c_ctx, *w_mod, *b_mod, *norm_mix_g, *norm_ffn_g, *w_in, *conv_w, *a_log_f, *a_log_b, *dt_bias_f, *dt_bias_b, *gdn_norm_g,
        *gla_gate_w_f, *gla_gate_w_b, *gla_gate_b_f, *gla_gate_b_b, *gla_norm_g, *w_out_a, *w_out_b, *w_out, *w_router, *b_router, *w_gu, *b_gu, *w_down, *b_down, *final_norm_g;
    float* out; unsigned char* ws; int probe; int pad_;
};

typedef float f32x2_t __attribute__((ext_vector_type(2)));
namespace pg8 {
constexpr int BM = 256, BK = 64, HALF = 128, HTB = HALF * BK * 2, STAGE_BYTES = 8 * HTB, NXCD = 8, WGM = 8;
__host__ __device__ __forceinline__ int lds_byte(int r, int c) { const int m = r >> 4, fr = r & 15, ch = c >> 3; return m * 2048 + (fr >> 3) * 1024 + (8 * (fr & 7) + (ch ^ (fr & 6))) * 16; }
__host__ __device__ __forceinline__ void stage_rc(int b, int& R, int& C) { const int blk = b / 1024, sl = (b % 1024) / 16, r7 = sl >> 3; R = blk * 8 + r7; C = ((sl & 7) ^ (r7 & 6)) * 8; }
__host__ __device__ __forceinline__ int perm32(int rho) { const int n = rho >> 4, i = rho & 15; return 8 * (i >> 2) + 4 * n + (i & 3); }
struct Unit { int pm, pn, bt, e; };

__device__ __forceinline__ void order_map(int L, int nM, int nN, int& pm, int& pn) {
    const int nwg = nM * nN; int wgid = L;
    { const int q = nwg / NXCD, r = nwg % NXCD, xcd = wgid % NXCD, off = wgid / NXCD; wgid = (xcd < r ? xcd * (q + 1) : r * (q + 1) + (xcd - r) * q) + off; }
    const int nig = WGM * nN, gid = wgid / nig, fm = gid * WGM, gsz = (nM - fm) < WGM ? (nM - fm) : WGM;
    pm = fm + ((wgid % nig) % gsz); pn = (wgid % nig) / gsz;
}
struct SchedDense {
    int nM, nN, G, c, pn0 = 0;
    __device__ __forceinline__ bool next(int i, Unit& u) const { const long L = (long)i * G + c; if (L >= (long)nM * nN) return false; order_map((int)L, nM, nN, u.pm, u.pn); u.pn += pn0; u.bt = u.pn; u.e = 0; return true; }
    __device__ __forceinline__ unsigned arow(const Unit& u, int r) const { return (unsigned)(u.pm * BM + r); }
};
struct SchedMoeDense {
    int nM, nN, G, c; const int* tile_e; int dn;
    __device__ __forceinline__ bool next(int i, Unit& u) const { const long L = (long)i * G + c; if (L >= (long)nM * nN) return false; order_map((int)L, nM, nN, u.pm, u.pn); u.e = tile_e[u.pm]; u.bt = 4 * (dn ? wb_dn_mib(u.e) : wb_gu_mib(u.e)) + u.pn; return true; }
    __device__ __forceinline__ unsigned arow(const Unit& u, int r) const { return (unsigned)(u.pm * BM + r); }
};
struct SchedMoe {
    int nM, nN, G, c; const int* tile_e; const int* slot_tok; int dn;
    __device__ __forceinline__ bool next(int i, Unit& u) const { const long L = (long)i * G + c; if (L >= (long)nM * nN) return false; order_map((int)L, nM, nN, u.pm, u.pn); u.e = tile_e[u.pm]; u.bt = 4 * (dn ? wb_dn_mib(u.e) : wb_gu_mib(u.e)) + u.pn; return true; }
    __device__ __forceinline__ unsigned arow(const Unit& u, int r) const { if (slot_tok) { const int t = slot_tok[u.pm * BM + r]; return (unsigned)(t < 0 ? 0 : t); } return (unsigned)(u.pm * BM + r); }
};

typedef float f32x2_z __attribute__((ext_vector_type(2)));
typedef int i32x8 __attribute__((ext_vector_type(8)));
typedef float f32x8_t __attribute__((ext_vector_type(8)));
typedef short s16x16 __attribute__((ext_vector_type(16)));
typedef int i32x4 __attribute__((ext_vector_type(4)));
__device__ __forceinline__ i32x8 ld32(const LAS unsigned char* p) { const i32x4 a = *(const LAS i32x4*)p, b = *(const LAS i32x4*)(p + 16); return __builtin_shufflevector(a, b, 0, 1, 2, 3, 4, 5, 6, 7); }
#ifndef PROBE_GDUP
#define PROBE_GDUP 0
#endif
template <class Epi, class Sched, bool FP8 = false>
__device__ __forceinline__ void gemm_phase(LAS unsigned char* lds, const bf16* A, const bf16* Bt, const int K, const Sched& S, const Epi& E) {
    int tid = threadIdx.x; asm volatile("" : "+v"(tid));
    const int wid = __builtin_amdgcn_readfirstlane(tid >> 6), lane = tid & 63, wr = wid >> 2, wc = wid & 3, fr = lane & 15, fq = lane >> 4;
    const int nt = K / BK;
    int R0, C0; stage_rc(tid * 16, R0, C0);
    unsigned voffB[2];
#pragma unroll
    for (int i = 0; i < 2; ++i) { const int R = R0 + 64 * i; const int Rb = (R & ~31) + perm32(R & 31); voffB[i] = (unsigned)(Rb * K + C0) * 2u; }
    const unsigned rowb = (unsigned)K * 2u, cofs = (unsigned)C0 * 2u;
    const size_t kstep = (size_t)(BK * 2);
    const size_t hstep = (size_t)HALF * K * 2;
    const size_t tstep = 2 * hstep;
    const unsigned ldsw = (unsigned)wid * 1024u;
    const int aoff = lds_byte(wr * 64 + fr, fq * 8), boff = lds_byte(wc * 32 + fr, fq * 8), aoff1 = lds_byte(wr * 64 + fr, fq * 8 + 32), boff1 = lds_byte(wc * 32 + fr, fq * 8 + 32);
    const unsigned addrA = (unsigned)(size_t)lds + (unsigned)aoff, addrB = (unsigned)(size_t)lds + 65536u + (unsigned)boff, addrA1 = (unsigned)(size_t)lds + (unsigned)aoff1, addrB1 = (unsigned)(size_t)lds + 65536u + (unsigned)boff1; (void)addrA; (void)addrB; (void)addrA1; (void)addrB1;
#define PG8_SA(b, h) (((b) * 2 + (h)) * HTB)
#define PG8_SB(b, h) ((4 + (b) * 2 + (h)) * HTB)
#define PG8_STAGE(bufoff, gbase, voff) do { _Pragma("unroll") for (int _i = 0; _i < 2; ++_i) \
        __builtin_amdgcn_global_load_lds((const unsigned*)((const char*)(gbase) + (voff)[_i]), (LAS unsigned*)(lds + (bufoff) + ldsw + _i * 8192), 16, 0, 0); } while (0)
#define PG8_STAGE_A(bufoff, gbase, o0, o1) do { \
        __builtin_amdgcn_global_load_lds((const unsigned*)((const char*)(gbase) + (o0)), (LAS unsigned*)(lds + (bufoff) + ldsw), 16, 0, 0); \
        __builtin_amdgcn_global_load_lds((const unsigned*)((const char*)(gbase) + (o1)), (LAS unsigned*)(lds + (bufoff) + ldsw + 8192), 16, 0, 0); } while (0)
#define F8_RD(rlo, rhi, rfull, var, addr, off) asm volatile("ds_read_b128 " rlo ", %1 offset:%3\n\tds_read_b128 " rhi ", %2 offset:%3" : "={" rfull "}"(var) : "v"(addr), "v"(addr##1), "i"(off))
#define PG8_LDA(dst, b, h) do { if constexpr (FP8) { \
            F8_RD("v[192:195]", "v[196:199]", "v[192:199]", dst##8[0], addrA, PG8_SA(b, h)); F8_RD("v[200:203]", "v[204:207]", "v[200:207]", dst##8[1], addrA, PG8_SA(b, h) + 2048); \
            F8_RD("v[208:211]", "v[212:215]", "v[208:215]", dst##8[2], addrA, PG8_SA(b, h) + 4096); F8_RD("v[216:219]", "v[220:223]", "v[216:223]", dst##8[3], addrA, PG8_SA(b, h) + 6144); } \
        else { _Pragma("unroll") for (int m = 0; m < 4; ++m) _Pragma("unroll") for (int k = 0; k < 2; ++k) dst[m][k] = *(const LAS bf16x8*)(lds + PG8_SA(b, h) + (k ? aoff1 : aoff) + m * 2048); } } while (0)
#define PG8_LDB0(b, h) do { if constexpr (FP8) { F8_RD("v[224:227]", "v[228:231]", "v[224:231]", B08[0], addrB, PG8_SB(b, h) - 65536); F8_RD("v[232:235]", "v[236:239]", "v[232:239]", B08[1], addrB, PG8_SB(b, h) - 65536 + 2048); } \
        else { _Pragma("unroll") for (int n = 0; n < 2; ++n) _Pragma("unroll") for (int k = 0; k < 2; ++k) B0[n][k] = *(const LAS bf16x8*)(lds + PG8_SB(b, h) + (k ? boff1 : boff) + n * 2048); } } while (0)
#define PG8_LDB1(b, h) do { if constexpr (FP8) { F8_RD("v[240:243]", "v[244:247]", "v[240:247]", B18[0], addrB, PG8_SB(b, h) - 65536); F8_RD("v[248:251]", "v[252:255]", "v[248:255]", B18[1], addrB, PG8_SB(b, h) - 65536 + 2048); } \
        else { _Pragma("unroll") for (int n = 0; n < 2; ++n) _Pragma("unroll") for (int k = 0; k < 2; ++k) B1[n][k] = *(const LAS bf16x8*)(lds + PG8_SB(b, h) + (k ? boff1 : boff) + n * 2048); } } while (0)
#define PG8_LDB(dst, b, h) PG8_LD##dst(b, h)
#define PG8_LDB0_X 0
#define PG8_MMA(ai, bj, At, Bt_) do { if (PROBE_GDUP == 3 && !(ui & 1)) break; __builtin_amdgcn_s_setprio(1); \
        if constexpr (FP8) { _Pragma("unroll") for (int m = 0; m < 4; ++m) _Pragma("unroll") for (int n = 0; n < 2; ++n) \
            acc[ai][bj][m][n] = __builtin_amdgcn_mfma_scale_f32_16x16x128_f8f6f4(Bt_##8[n], At##8[m], acc[ai][bj][m][n], 0, 0, 0, 0x79797979, 0, 0x7f7f7f7f); } \
        else { _Pragma("unroll") for (int m = 0; m < 4; ++m) _Pragma("unroll") for (int n = 0; n < 2; ++n) _Pragma("unroll") for (int k = 0; k < 2; ++k) \
            acc[ai][bj][m][n] = __builtin_amdgcn_mfma_f32_16x16x32_bf16(Bt_[n][k], At[m][k], acc[ai][bj][m][n], 0, 0, 0); } \
        __builtin_amdgcn_s_setprio(0); } while (0)
#define PG8_WAIT_V(n) asm volatile("s_waitcnt vmcnt(" #n ")" ::: "memory")
#define PG8_WAIT_L(n) do { if constexpr (FP8) asm volatile("s_waitcnt lgkmcnt(" #n ")" : "+{v[192:199]}"(At8[0]), "+{v[200:207]}"(At8[1]), "+{v[208:215]}"(At8[2]), "+{v[216:223]}"(At8[3]), "+{v[224:231]}"(B08[0]), "+{v[232:239]}"(B08[1]), "+{v[240:247]}"(B18[0]), "+{v[248:255]}"(B18[1]) :: "memory"); \
        else asm volatile("s_waitcnt lgkmcnt(" #n ")" ::: "memory"); } while (0)
#define PG8_BAR __builtin_amdgcn_s_barrier()
#define PG8_SCHED __builtin_amdgcn_sched_barrier(0)
    Unit cur, nxt; int ui = 0;
    if (!S.next(0, cur)) return;
    f32x4 acc[2][2][4][2];
#pragma unroll
    for (int a = 0; a < 2; ++a)
#pragma unroll
        for (int b = 0; b < 2; ++b)
#pragma unroll
            for (int m = 0; m < 4; ++m)
#pragma unroll
                for (int n = 0; n < 2; ++n) acc[a][b][m][n] = (f32x4){0.f, 0.f, 0.f, 0.f};
    bf16x8 At[4][2], B0[2][2], B1[2][2]; i32x8 At8[4] = {}, B08[2] = {}, B18[2] = {};
    const char* Ab = (const char*)A;
    const char* cB = (const char*)Bt + (size_t)cur.bt * tstep;
    unsigned c00 = S.arow(cur, R0) * rowb + cofs, c01 = S.arow(cur, R0 + 64) * rowb + cofs, c10 = S.arow(cur, HALF + R0) * rowb + cofs, c11 = S.arow(cur, HALF + R0 + 64) * rowb + cofs;
    unsigned n00, n01, n10, n11;
    PG8_STAGE(PG8_SB(0, 0), cB, voffB); PG8_STAGE(PG8_SB(0, 1), cB + hstep, voffB); PG8_STAGE_A(PG8_SA(0, 0), Ab, c00, c01); PG8_STAGE_A(PG8_SA(0, 1), Ab, c10, c11);
    if (wr == 1) PG8_BAR;
    PG8_WAIT_V(2); PG8_BAR;
    PG8_STAGE(PG8_SB(1, 0), cB + kstep, voffB); PG8_STAGE_A(PG8_SA(1, 0), Ab + kstep, c00, c01); PG8_STAGE(PG8_SB(1, 1), cB + hstep + kstep, voffB);
    PG8_WAIT_V(6); PG8_BAR;
    for (;;) {
        const bool has_next = S.next((ui + 1) >> (PROBE_GDUP ? 1 : 0), nxt);
        const char* nB = has_next ? (const char*)Bt + (size_t)nxt.bt * tstep : cB;
        if (has_next) { n00 = S.arow(nxt, R0) * rowb + cofs; n01 = S.arow(nxt, R0 + 64) * rowb + cofs; n10 = S.arow(nxt, HALF + R0) * rowb + cofs; n11 = S.arow(nxt, HALF + R0 + 64) * rowb + cofs; }
        else { n00 = c00; n01 = c01; n10 = c10; n11 = c11; }
#pragma unroll 1
        for (int t = 0; t < nt; t += 2) {
            const bool last = (t == nt - 2);
            const char* a1 = Ab + (size_t)(t + 1) * kstep;
            const char* a2 = last ? Ab : Ab + (size_t)(t + 2) * kstep; const char* b2 = last ? nB : cB + (size_t)(t + 2) * kstep;
            const char* a3 = a2 + kstep; const char* b3 = b2 + kstep;
            const unsigned x00 = last ? n00 : c00, x01 = last ? n01 : c01, x10 = last ? n10 : c10, x11 = last ? n11 : c11;
            PG8_LDB(B0, 0, 0); PG8_LDB(B1, 0, 1); PG8_SCHED; PG8_LDA(At, 0, 0); PG8_STAGE_A(PG8_SA(1, 1), a1, c10, c11);
            PG8_WAIT_V(8); PG8_WAIT_L(0); PG8_BAR; PG8_MMA(0, 0, At, B0); PG8_MMA(0, 1, At, B1); PG8_BAR; PG8_SCHED;
            PG8_LDA(At, 0, 1); PG8_STAGE(PG8_SB(0, 0), b2, voffB); PG8_STAGE(PG8_SB(0, 1), b2 + hstep, voffB); PG8_STAGE_A(PG8_SA(0, 0), a2, x00, x01);
            PG8_WAIT_V(8); PG8_WAIT_L(0); PG8_BAR; PG8_MMA(1, 0, At, B0); PG8_MMA(1, 1, At, B1); PG8_BAR; PG8_SCHED;
            PG8_LDB(B0, 1, 0); PG8_LDB(B1, 1, 1); PG8_SCHED; PG8_LDA(At, 1, 0); PG8_STAGE_A(PG8_SA(0, 1), a2, x10, x11);
            PG8_WAIT_V(8); PG8_WAIT_L(0); PG8_BAR; PG8_MMA(0, 0, At, B0); PG8_MMA(0, 1, At, B1); PG8_BAR; PG8_SCHED;
            PG8_LDA(At, 1, 1); PG8_STAGE(PG8_SB(1, 0), b3, voffB); PG8_STAGE(PG8_SB(1, 1), b3 + hstep, voffB); PG8_STAGE_A(PG8_SA(1, 0), a3, x00, x01);
            PG8_WAIT_V(8); PG8_WAIT_L(0); PG8_BAR; PG8_MMA(1, 0, At, B0); PG8_MMA(1, 1, At, B1); PG8_BAR; PG8_SCHED;
        }
        if (wr == 0) PG8_BAR;
        if ((PROBE_GDUP != 1 && PROBE_GDUP != 3) || (ui & 1)) { int tz = threadIdx.x; asm volatile("" : "+v"(tz)); const int ln = tz & 63; E(acc, cur, wr, wc, ln & 15, ln >> 4); }
        if (!has_next) break;
#pragma unroll
        for (int a = 0; a < 2; ++a)
#pragma unroll
            for (int b = 0; b < 2; ++b)
#pragma unroll
                for (int m = 0; m < 4; ++m)
#pragma unroll
                    for (int n = 0; n < 2; ++n) { f32x2_z z0, z1; asm volatile("v_pk_mov_b32 %0, 0, 0\n\tv_pk_mov_b32 %1, 0, 0" : "=v"(z0), "=v"(z1)); acc[a][b][m][n] = (f32x4){z0.x, z0.y, z1.x, z1.y}; }
        cur = nxt; cB = nB; c00 = n00; c01 = n01; c10 = n10; c11 = n11; ++ui;
        if (wr == 1) PG8_BAR;
    }
    PG8_WAIT_V(0);
    PG8_BAR;
#undef PG8_SA
#undef PG8_SB
#undef PG8_STAGE
#undef PG8_STAGE_A
#undef PG8_LDA
#undef PG8_LDB
#undef PG8_LDB0
#undef PG8_LDB1
#undef F8_RD
#undef PG8_MMA
#undef PG8_WAIT_V
#undef PG8_WAIT_L
#undef PG8_BAR
#undef PG8_SCHED
}
}
typedef f32x4 Acc[2][2][4][2];

#define XB_TMO      128
#define XB_XCNT(j)  (256  + 64 * (j))
#define XB_XSUB(j)  (1280 + 64 * (j))
#define XB_XGEN(j)  (2304 + 64 * (j))
#define XB_TOP      3328
#define XB_TOPGEN   3392
#define XCD_BAR_WORDS 3456
#define XB_SPIN_CAP (1u << 22)
__device__ __forceinline__ unsigned xb_ld(unsigned* p)              { return __hip_atomic_load(p, __ATOMIC_RELAXED, __HIP_MEMORY_SCOPE_AGENT); }
__device__ __forceinline__ unsigned xb_add(unsigned* p, unsigned v) { return __hip_atomic_fetch_add(p, v, __ATOMIC_RELAXED, __HIP_MEMORY_SCOPE_AGENT); }
__device__ __forceinline__ unsigned xb_xcc_id() { return (unsigned)__builtin_amdgcn_s_getreg((3 << 11) | 20) & 0xFu; }
#define XB_SPIN(cond, bar) do { unsigned _sp = 0; while (cond) { __builtin_amdgcn_s_sleep(1); \
    if ((++_sp & 255u) == 0u) { if (xb_ld(&(bar)[XB_TMO])) break; if (_sp > XB_SPIN_CAP) { atomicAdd(&(bar)[XB_TMO], 1u); break; } } } } while (0)
struct XcdBarrier { unsigned* bar; unsigned x; volatile LAS unsigned* st; };
__device__ __forceinline__ XcdBarrier xcd_barrier_post(unsigned* bar, volatile LAS unsigned* st) {
    XcdBarrier b; b.bar = bar; b.x = xb_xcc_id(); b.st = st;
    if (threadIdx.x == 0) (void)xb_add(&bar[XB_XCNT(b.x)], 1u);
    return b;
}
__device__ __forceinline__ void xcd_barrier_complete(unsigned* bar, unsigned x, unsigned& nloc, unsigned& nx) {
    const unsigned G = gridDim.x * gridDim.y * gridDim.z;
    unsigned sum, cnt, mine, sp = 0u;
    for (;;) {
        sum = 0u; cnt = 0u; mine = 0u;
#pragma unroll
        for (unsigned j = 0; j < 16; ++j) { const unsigned c = xb_ld(&bar[XB_XCNT(j)]); sum += c; cnt += (c > 0u) ? 1u : 0u; mine = (j == x) ? c : mine; }
        if (sum == G) break;
        __builtin_amdgcn_s_sleep(1);
        if ((++sp & 255u) == 0u) { if (xb_ld(&bar[XB_TMO])) break; if (sp > XB_SPIN_CAP) { atomicAdd(&bar[XB_TMO], 1u); break; } }
    }
    nloc = mine > 0u ? mine : 1u; nx = cnt > 0u ? cnt : 1u;
}
__device__ __forceinline__ void xcd_barrier(const XcdBarrier& b) {
    asm volatile("s_waitcnt vmcnt(0)" ::: "memory");
    __syncthreads();
    if (threadIdx.x == 0) {
        unsigned* bar = b.bar;
        __builtin_amdgcn_s_waitcnt(0);
        unsigned nloc = b.st[0], nx = b.st[1];
        if (nloc == 0u) { xcd_barrier_complete(bar, b.x, nloc, nx); b.st[0] = nloc; b.st[1] = nx; }
        const unsigned old = xb_add(&bar[XB_XSUB(b.x)], 1u);
        const unsigned gen = old / nloc;
        if (old + 1u == (gen + 1u) * nloc) {
            __builtin_amdgcn_fence(__ATOMIC_RELEASE, "agent");
            asm volatile("s_waitcnt vmcnt(0)" ::: "memory");
            const unsigned og = xb_add(&bar[XB_TOP], 1u);
            const unsigned tg = og / nx;
            if (og + 1u == (tg + 1u) * nx) xb_add(&bar[XB_TOPGEN], 1u);
            else XB_SPIN(xb_ld(&bar[XB_TOPGEN]) == tg, bar);
            __builtin_amdgcn_fence(__ATOMIC_ACQUIRE, "agent");
            xb_add(&bar[XB_XGEN(b.x)], 1u);
            asm volatile("s_waitcnt vmcnt(0)" ::: "memory");
        } else {
            XB_SPIN(xb_ld(&bar[XB_XGEN(b.x)]) == gen, bar);
            __builtin_amdgcn_fence(__ATOMIC_ACQUIRE, "agent");
            asm volatile("s_waitcnt vmcnt(0)" ::: "memory");
        }
    }
    __syncthreads();
}

__device__ __forceinline__ void tr_item(const float* W, int ldw, int col0, bf16* WT, int dstrow0, int k0, LAS float* scr, int lane) {
#pragma unroll 8
    for (int i = 0; i < 32; ++i) { const int kk = 2 * i + (lane >> 5); scr[kk * 33 + (lane & 31)] = W[(size_t)(k0 + kk) * ldw + col0 + (lane & 31)]; }
    LDS_WAIT(); asm volatile("" ::: "memory");
    const int c = lane & 7;
#pragma unroll
    for (int j = 0; j < 4; ++j) { const int n = (lane >> 3) + 8 * j; const LAS float* s = scr + (8 * c) * 33 + n;
        v4u o; o.x = pk2(s[0 * 33], s[1 * 33]); o.y = pk2(s[2 * 33], s[3 * 33]); o.z = pk2(s[4 * 33], s[5 * 33]); o.w = pk2(s[6 * 33], s[7 * 33]);
        *(v4u*)(WT + (size_t)(dstrow0 + n) * D + k0 + 8 * c) = o; }
    LDS_WAIT(); asm volatile("" ::: "memory");
}
__device__ __forceinline__ void tr8_load(float (&t)[32], const float* W, int ldw, int col0, int k0, int lane) {
    const float* wp_ = W + (size_t)(k0 + (lane >> 5)) * ldw + col0 + (lane & 31);
#pragma unroll
    for (int i = 0; i < 32; ++i) t[i] = wp_[(size_t)(2 * i) * ldw];
}
__device__ __forceinline__ void tr8_finish(const float (&t)[32], unsigned char* WT, int dstrow0, int k0, LAS float* scr, int lane) {
#pragma unroll
    for (int i = 0; i < 32; ++i) scr[(2 * i + (lane >> 5)) * 33 + (lane & 31)] = t[i];
    LDS_WAIT(); asm volatile("" ::: "memory");
    const int n = lane >> 1, hf = lane & 1; const LAS float* sp = scr + (32 * hf) * 33 + n;
    v4u o[2];
#pragma unroll
    for (int c = 0; c < 2; ++c) { unsigned w[4];
#pragma unroll
        for (int j = 0; j < 4; ++j) { const LAS float* q4 = sp + (16 * c + 4 * j) * 33; w[j] = pk4f8(64.f * q4[0], 64.f * q4[33], 64.f * q4[66], 64.f * q4[99]); }
        o[c] = (v4u){w[0], w[1], w[2], w[3]}; }
    v4u* dst = (v4u*)(WT + (size_t)(dstrow0 + n) * D + k0 + 32 * hf);
    dst[0] = o[0]; dst[1] = o[1];
    LDS_WAIT(); asm volatile("" ::: "memory");
}
__device__ __forceinline__ void tr_item8(const float* W, int ldw, int col0, unsigned char* WT, int dstrow0, int k0, LAS float* scr, int lane) {
#pragma unroll 8
    for (int i = 0; i < 32; ++i) { const int kk = 2 * i + (lane >> 5); scr[kk * 33 + (lane & 31)] = W[(size_t)(k0 + kk) * ldw + col0 + (lane & 31)]; }
    LDS_WAIT(); asm volatile("" ::: "memory");
    const int n = lane >> 1, hf = lane & 1; const LAS float* sp = scr + (32 * hf) * 33 + n;
    v4u o[2];
#pragma unroll
    for (int c = 0; c < 2; ++c) { unsigned w[4];
#pragma unroll
        for (int j = 0; j < 4; ++j) { const LAS float* q4 = sp + (16 * c + 4 * j) * 33; w[j] = pk4f8(64.f * q4[0], 64.f * q4[33], 64.f * q4[66], 64.f * q4[99]); }
        o[c] = (v4u){w[0], w[1], w[2], w[3]}; }
    v4u* dst = (v4u*)(WT + (size_t)(dstrow0 + n) * D + k0 + 32 * hf);
    dst[0] = o[0]; dst[1] = o[1];
    LDS_WAIT(); asm volatile("" ::: "memory");
}
__device__ __forceinline__ void phase_prologue(const P& p, LAS unsigned char* lds) {
    const int tid = threadIdx.x, lane = tid & 63, wave = tid >> 6;
    LAS float* scr = (LAS float*)(lds + wave * 8448);
    const int gw = blockIdx.x * NWAVES + wave, NGW = gridDim.x * NWAVES;
    unsigned char* bt_s8 = p.ws + WS_BT_S8; unsigned char* bt_g8 = p.ws + WS_BT_G8;
    bf16* bt_s = (bf16*)(p.ws + WS_BT_S); bf16* bt_g = (bf16*)(p.ws + WS_BT_G);
    constexpr int I_S = 162 * 16, I_G = 128 * 16, I_O = 32 * 16;
    for (int it = gw; it < I_S + I_G + 3 * I_O; it += NGW) {
        int r = it;
        if (r < I_S) { const int nb = r >> 4, kb = r & 15; const int col0 = nb < 96 ? 32 * nb : (nb < 160 ? 4128 + 32 * (nb - 96) : (nb == 160 ? 4096 : 7200));
            if (nb < 8 * G1_NF8) tr_item8(p.w_in, D_IN, col0, bt_s8, 32 * nb, 64 * kb, scr, lane); else tr_item(p.w_in, D_IN, col0, bt_s, 32 * nb, 64 * kb, scr, lane); continue; } r -= I_S;
        if (r < I_G) { const int nb = r >> 4, kb = r & 15; const int col0 = nb < 32 ? 3072 + 32 * nb : (nb < 64 ? 6176 + 32 * (nb - 32) : 7232 + 32 * (nb - 64));
            if (FP8_G2) tr_item8(p.w_in, D_IN, col0, bt_g8, 32 * nb, 64 * kb, scr, lane); else tr_item(p.w_in, D_IN, col0, bt_g, 32 * nb, 64 * kb, scr, lane); continue; } r -= I_G;
        const int which = r / I_O; r -= which * I_O; const int nb = r >> 4, kb = r & 15;
        const float* W = which == 0 ? p.w_out_a : (which == 1 ? p.w_out_b : p.w_out);
        bf16* WT = (bf16*)(p.ws + (which == 0 ? WS_BT_OA : (which == 1 ? WS_BT_OB : WS_BT_O)));
        tr_item(W, D, 32 * nb, WT, 32 * nb, 64 * kb, scr, lane);
    }
    { const size_t n16 = (size_t)192 * D * (G1_NF8 == 21 ? 1 : 2) / 16; v4u* z = G1_NF8 == 21 ? (v4u*)(bt_s8 + (size_t)5184 * D) : (v4u*)(bt_s + (size_t)5184 * D);
      for (size_t i = (size_t)blockIdx.x * NTHREADS + tid; i < n16; i += (size_t)gridDim.x * NTHREADS) z[i] = (v4u){0u, 0u, 0u, 0u}; }
    __syncthreads();
    LAS float* sc = (LAS float*)lds;
    LAS float* red = (LAS float*)(lds + 17 * 1024 * 4);
    float* modv = (float*)(p.ws + WS_MODV);
    bool have = false;
    for (int u = blockIdx.x; u < NMOD / 64; u += gridDim.x) {
        if (!have) { for (int i = tid; i < 17 * 1024; i += NTHREADS) { const float v = i < 16 * 1024 ? p.c[i] : p.c_ctx[i - 16 * 1024]; sc[i] = siluf_(v); } have = true; __syncthreads(); }
        float acc[17];
#pragma unroll
        for (int b = 0; b < 17; ++b) acc[b] = 0.f;
        const int n = u * 64 + lane;
        for (int k = wave * 128; k < wave * 128 + 128; ++k) { const float wv = p.w_mod[(size_t)k * NMOD + n];
#pragma unroll
            for (int b = 0; b < 17; ++b) acc[b] += sc[b * 1024 + k] * wv; }
#pragma unroll
        for (int b = 0; b < 17; ++b) red[(wave * 17 + b) * 64 + lane] = acc[b];
        __syncthreads();
        for (int i = tid; i < 17 * 64; i += NTHREADS) { const int b = i >> 6, l = i & 63; float s = p.b_mod[u * 64 + l];
#pragma unroll
            for (int w = 0; w < 8; ++w) s += red[(w * 17 + b) * 64 + l];
            modv[b * NMOD + u * 64 + l] = s; }
        __syncthreads();
    }
}

__device__ __forceinline__ void phase_norm1(const P& p) {
    const int tid = threadIdx.x, lane = tid & 63, wave = tid >> 6;
    const int gw = blockIdx.x * NWAVES + wave, NGW = gridDim.x * NWAVES;
    const float* modv = (const float*)(p.ws + WS_MODV); bf16* h = (bf16*)(p.ws + WS_H);
    auto rowptr = [&](int r) -> const float* { return r < T ? p.x + (size_t)r * D : p.ctx + (size_t)(r - T) * D; };
    f32x4 nx[4];
    if (gw < TT) { const f32x4* xr = (const f32x4*)rowptr(gw) + lane;
#pragma unroll
        for (int j = 0; j < 4; ++j) nx[j] = xr[64 * j]; }
    for (int r = gw; r < TT; r += NGW) {
        const int b = r < T ? (r >> 12) : 16;
        f32x4 v[4]; float s = 0.f;
#pragma unroll
        for (int j = 0; j < 4; ++j) { v[j] = nx[j]; s += (v[j].x * v[j].x + v[j].y * v[j].y) + (v[j].z * v[j].z + v[j].w * v[j].w); }
        if (r + NGW < TT) { const f32x4* xr = (const f32x4*)rowptr(r + NGW) + lane;
#pragma unroll
            for (int j = 0; j < 4; ++j) nx[j] = xr[64 * j]; }
        const float rstd = rsqrtf_(wave_sum(s) * (1.f / D) + EPS);
        const f32x4* g = (const f32x4*)p.norm_mix_g + lane; const f32x4* sh = (const f32x4*)(modv + b * NMOD) + lane; const f32x4* scl = (const f32x4*)(modv + b * NMOD + D) + lane;
        unsigned* o8 = (unsigned*)(p.ws + WS_H8 + (size_t)r * D) + lane; v2u* o16 = (v2u*)(h + (size_t)r * D) + lane;
#pragma unroll
        for (int j = 0; j < 4; ++j) { const f32x4 gg = g[64 * j], s1 = sh[64 * j], s2 = scl[64 * j]; const f32x4 o = v[j] * rstd * gg * (1.0f + s2) + s1;
            if (FP8_G1 || FP8_G2) o8[64 * j] = pk4f8(o.x, o.y, o.z, o.w);
            if (!(FP8_G1 == 1 && FP8_G2)) { v2u w; w.x = pk2(o.x, o.y); w.y = pk2(o.z, o.w); o16[64 * j] = w; } }
    }
}

struct EpiG1 {
    bf16* qkva; bf16* pb; float* small;
    __device__ __forceinline__ void operator()(const Acc& acc, const pg8::Unit& u, int wr, int wc, int fr, int fq) const {
        const int row0 = u.pm * 256 + wr * 64 + fr, cb = wc * 32 + 8 * fq;
#pragma unroll
        for (int ai = 0; ai < 2; ++ai)
#pragma unroll
            for (int m = 0; m < 4; ++m) { const size_t row = (size_t)(row0 + ai * 128 + m * 16);
#pragma unroll
                for (int bj = 0; bj < 2; ++bj) { const int c = bj * 128 + cb; const f32x4 v0 = acc[ai][bj][m][0], v1 = acc[ai][bj][m][1];
                    if (u.pn < 20) { v4u w; w.x = pk2(v0[0], v0[1]); w.y = pk2(v0[2], v0[3]); w.z = pk2(v1[0], v1[1]); w.w = pk2(v1[2], v1[3]);
                        if (u.pn < 12) *(v4u*)(qkva + row * 3072 + u.pn * 256 + c) = w; else *(v4u*)(pb + row * 2048 + (u.pn - 12) * 256 + c) = w; }
                    else if (c < 64) { *(f32x4*)(small + row * 64 + c) = v0; *(f32x4*)(small + row * 64 + c + 4) = v1; } } }
    }
};
__device__ __forceinline__ f32x2_t sigmoid2(const f32x2_t x) { const f32x2_t t = x * -1.44269504f; const f32x2_t d = (f32x2_t){__builtin_amdgcn_exp2f(t.x), __builtin_amdgcn_exp2f(t.y)} + 1.0f; return (f32x2_t){__builtin_amdgcn_rcpf(d.x), __builtin_amdgcn_rcpf(d.y)}; }
__device__ __forceinline__ f32x2_t silu2(const f32x2_t x) { return x * sigmoid2(x); }
#define ACC_PAIR(a4, p) ((p) & 1 ? (f32x2_t){(a4).z, (a4).w} : (f32x2_t){(a4).x, (a4).y})
struct EpiG2 {
    const bf16* on; bf16* ya; bf16* yb; bf16* gates; const float* gla_g; LAS float* xch; const bf16* ob2;
    __device__ __forceinline__ void operator()(const Acc& acc, const pg8::Unit& u, int wr, int wc, int fr, int fq) const {
        const int row0 = u.pm * 256 + wr * 64 + fr, cb = wc * 32 + 8 * fq;
        if (u.pn >= 4 && u.pn < 8) {
#pragma unroll 2
            for (int rm = 0; rm < 8; ++rm) { const int rr = (rm >> 2) * 128 + (rm & 3) * 16; const size_t row = (size_t)(row0 + rr); float ss = 0.f;
#pragma unroll
                for (int bj = 0; bj < 2; ++bj) { float o[8], o2[8]; unpack8(*(const v4u*)(on + row * 2048 + u.pn * 256 + bj * 128 + cb), o); unpack8(*(const v4u*)(ob2 + row * 1024 + (u.pn - 4) * 256 + bj * 128 + cb), o2);
#pragma unroll
                    for (int j = 0; j < 8; ++j) { const float x = o[j] + o2[j]; ss += x * x; } }
                ss += __shfl_xor(ss, 16); ss += __shfl_xor(ss, 32);
                if (fq == 0) xch[(rr + wr * 64 + fr) * 4 + wc] = ss; }
            asm volatile("s_waitcnt lgkmcnt(0)" ::: "memory"); __builtin_amdgcn_s_barrier(); asm volatile("" ::: "memory");
#pragma unroll
            for (int bj = 0; bj < 2; ++bj) { float gg[8];
#pragma unroll
                for (int j = 0; j < 8; ++j) gg[j] = gla_g[bj * 128 + cb + j];
#pragma unroll
                for (int ai = 0; ai < 2; ++ai)
#pragma unroll
                    for (int m = 0; m < 4; ++m) { const size_t row = (size_t)(row0 + ai * 128 + m * 16);
                        const f32x4 ps = *(const LAS f32x4*)(xch + (ai * 128 + wr * 64 + m * 16 + fr) * 4);
                        const float rstd = rsqrtf_(((ps[0] + ps[1]) + (ps[2] + ps[3])) * (1.f / 256.f) + EPS);
                        float o[8], o2[8], v[8]; unpack8(*(const v4u*)(on + row * 2048 + u.pn * 256 + bj * 128 + cb), o); unpack8(*(const v4u*)(ob2 + row * 1024 + (u.pn - 4) * 256 + bj * 128 + cb), o2);
#pragma unroll
                        for (int pq = 0; pq < 4; ++pq) { const f32x2_t os = (f32x2_t){o[2 * pq], o[2 * pq + 1]} + (f32x2_t){o2[2 * pq], o2[2 * pq + 1]};
                            const f32x2_t r2 = os * rstd * (f32x2_t){gg[2 * pq], gg[2 * pq + 1]} * silu2(ACC_PAIR(acc[ai][bj][m][pq >> 1], pq)); v[2 * pq] = r2.x; v[2 * pq + 1] = r2.y; }
                        *(v4u*)(yb + row * 1024 + (u.pn - 4) * 256 + bj * 128 + cb) = pack8(v);
                        asm volatile("" ::: "memory"); } }
            return;
        }
        if (u.pn < 4) {
#pragma unroll
            for (int ai = 0; ai < 2; ++ai)
#pragma unroll
                for (int m = 0; m < 4; ++m) { const size_t row = (size_t)(row0 + ai * 128 + m * 16);
#pragma unroll
                    for (int bj = 0; bj < 2; ++bj) { const int c = bj * 128 + cb; float v[8], o[8];
                        unpack8(*(const v4u*)(on + row * 2048 + u.pn * 256 + c), o);
#pragma unroll
                        for (int pq = 0; pq < 4; ++pq) { const f32x2_t r2 = (f32x2_t){o[2 * pq], o[2 * pq + 1]} * silu2(ACC_PAIR(acc[ai][bj][m][pq >> 1], pq)); v[2 * pq] = r2.x; v[2 * pq + 1] = r2.y; }
                        *(v4u*)(ya + row * 1024 + u.pn * 256 + c) = pack8(v); } }
        } else {
#pragma unroll
            for (int ai = 0; ai < 2; ++ai)
#pragma unroll
                for (int m = 0; m < 4; ++m) { const size_t row = (size_t)(row0 + ai * 128 + m * 16);
#pragma unroll
                    for (int bj = 0; bj < 2; ++bj) { const int c = bj * 128 + cb; float v[8];
#pragma unroll
                        for (int pq = 0; pq < 4; ++pq) { const f32x2_t r2 = sigmoid2(ACC_PAIR(acc[ai][bj][m][pq >> 1], pq)); v[2 * pq] = r2.x; v[2 * pq + 1] = r2.y; }
                        asm volatile("s_nop 0" : "+v"(v[0]), "+v"(v[1]), "+v"(v[2]), "+v"(v[3]), "+v"(v[4]), "+v"(v[5]), "+v"(v[6]), "+v"(v[7]));
                        *(v4u*)(gates + row * 2048 + (u.pn - 8) * 256 + c) = pack8(v); } }
        }
    }
};
template <int WHICH> struct EpiG34 {
    const bf16* gates; bf16* y;
    __device__ __forceinline__ void operator()(const Acc& acc, const pg8::Unit& u, int wr, int wc, int fr, int fq) const {
        const int row0 = u.pm * 256 + wr * 64 + fr, cb = wc * 32 + 8 * fq;
#pragma unroll
        for (int ai = 0; ai < 2; ++ai)
#pragma unroll
            for (int m = 0; m < 4; ++m) { const size_t row = (size_t)(row0 + ai * 128 + m * 16);
#pragma unroll
                for (int bj = 0; bj < 2; ++bj) { const int c = u.pn * 256 + bj * 128 + cb; float v[8], g[8];
#pragma unroll
                    for (int j = 0; j < 4; ++j) { v[j] = acc[ai][bj][m][0][j]; v[4 + j] = acc[ai][bj][m][1][j]; }
                    unpack8(*(const v4u*)(gates + row * 2048 + WHICH * 1024 + c), g);
                    if (WHICH == 0) {
#pragma unroll
                        for (int j = 0; j < 8; ++j) v[j] = g[j] * v[j];
                    } else { float o[8]; unpack8(*(const v4u*)(y + row * 1024 + c), o);
#pragma unroll
                        for (int j = 0; j < 8; ++j) v[j] = o[j] + g[j] * v[j]; }
                    *(v4u*)(y + row * 1024 + c) = pack8(v); } }
    }
};
__device__ __forceinline__ f32x4 ldx4(const v2u w) { return (f32x4){bflo(w.x), bfhi(w.x), bflo(w.y), bfhi(w.y)}; }
struct EpiG5 {
    const float* x; const float* modv; bf16* x1b;
    __device__ __forceinline__ void operator()(const Acc& acc, const pg8::Unit& u, int wr, int wc, int fr, int fq) const {
        const int row0 = u.pm * 256 + wr * 64 + fr, cb = wc * 32 + 8 * fq;
        const float* g1 = modv + (u.pm >> 4) * NMOD + 2 * D;
#pragma unroll
        for (int ai = 0; ai < 2; ++ai)
#pragma unroll
            for (int m = 0; m < 4; ++m) { const size_t row = (size_t)(row0 + ai * 128 + m * 16);
#pragma unroll
                for (int bj = 0; bj < 2; ++bj) { const int c = u.pn * 256 + bj * 128 + cb; float v[8];
#pragma unroll
                    for (int n = 0; n < 2; ++n) { const f32x4 xv = *(const f32x4*)(x + row * D + c + 4 * n), gv = *(const f32x4*)(g1 + c + 4 * n); const f32x4 o = xv + gv * acc[ai][bj][m][n];
                        v[4 * n] = o.x; v[4 * n + 1] = o.y; v[4 * n + 2] = o.z; v[4 * n + 3] = o.w; }
                    *(v4u*)(x1b + row * D + c) = pack8(v); } }
    }
};
struct EpiGU {
    const float* b_gu; bf16* act;
    __device__ __forceinline__ void operator()(const Acc& acc, const pg8::Unit& u, int wr, int wc, int fr, int fq) const {
        const int row0 = u.pm * 256 + wr * 64 + fr, cb = wc * 32 + 8 * fq; const int e = u.e;
        const float* bg = b_gu + (size_t)e * 2048 + u.pn * 128 + cb; const float* bl = bg + 1024;
        f32x2_t bgv[4], blv[4];
#pragma unroll
        for (int j = 0; j < 4; ++j) { bgv[j] = (f32x2_t){bg[2 * j], bg[2 * j + 1]}; blv[j] = (f32x2_t){bl[2 * j] + 1.0f, bl[2 * j + 1] + 1.0f}; }
#pragma unroll
        for (int ai = 0; ai < 2; ++ai)
#pragma unroll
            for (int m = 0; m < 4; ++m) { const size_t row = (size_t)(row0 + ai * 128 + m * 16); f32x2_t v[4];
#pragma unroll
                for (int j = 0; j < 4; ++j) { const f32x4 ag = acc[ai][0][m][j >> 1], al = acc[ai][1][m][j >> 1];
                    f32x2_t gl = (j & 1 ? (f32x2_t){ag.z, ag.w} : (f32x2_t){ag.x, ag.y}) + bgv[j]; f32x2_t ln = (j & 1 ? (f32x2_t){al.z, al.w} : (f32x2_t){al.x, al.y}) + blv[j];
                    gl = (f32x2_t){fminf(gl.x, 7.0f), fminf(gl.y, 7.0f)}; ln = (f32x2_t){__builtin_amdgcn_fmed3f(ln.x, -6.0f, 8.0f), __builtin_amdgcn_fmed3f(ln.y, -6.0f, 8.0f)};
                    const f32x2_t t = gl * (-1.702f * 1.44269504f); f32x2_t d = (f32x2_t){__builtin_amdgcn_exp2f(t.x), __builtin_amdgcn_exp2f(t.y)} + 1.0f;
                    const f32x2_t r = (f32x2_t){__builtin_amdgcn_rcpf(d.x), __builtin_amdgcn_rcpf(d.y)};
                    v[j] = gl * r * ln; }
                v2u w8; w8.x = pk4f8(v[0].x, v[0].y, v[1].x, v[1].y); w8.y = pk4f8(v[2].x, v[2].y, v[3].x, v[3].y);
                *(v2u*)((unsigned char*)act + row * 1024 + u.pn * 128 + cb) = w8; }
    }
};
struct EpiDN {
    const float* b_down; const float* slot_p; bf16* ys;
    __device__ __forceinline__ void operator()(const Acc& acc, const pg8::Unit& u, int wr, int wc, int fr, int fq) const {
        const int row0 = u.pm * 256 + wr * 64 + fr, cb = wc * 32 + 8 * fq; const int e = u.e;
#pragma unroll
        for (int bj = 0; bj < 2; ++bj) { const int c = u.pn * 256 + bj * 128 + cb; float bv[8];
#pragma unroll
            for (int j = 0; j < 8; ++j) bv[j] = b_down[(size_t)e * 1024 + c + j];
#pragma unroll
            for (int ai = 0; ai < 2; ++ai)
#pragma unroll
                for (int m = 0; m < 4; ++m) { const size_t row = (size_t)(row0 + ai * 128 + m * 16); const float pr = 16.0f * slot_p[row]; float v[8];
#pragma unroll
                    for (int pq = 0; pq < 4; ++pq) { const f32x2_t r2 = (ACC_PAIR(acc[ai][bj][m][pq >> 1], pq) + (f32x2_t){bv[2 * pq], bv[2 * pq + 1]}) * pr; v[2 * pq] = r2.x; v[2 * pq + 1] = r2.y; }
                    v2u w8; w8.x = pk4f8(v[0], v[1], v[2], v[3]); w8.y = pk4f8(v[4], v[5], v[6], v[7]);
                    *(v2u*)((unsigned char*)ys + row * 1024 + c) = w8; } }
    }
};

template <int CG>
__device__ __forceinline__ void conv_unit(const P& p, LAS unsigned char* lds, const int b, const int chan0, const bool donorm) {
    constexpr int NCOL = 512 / CG, NPOS = 64 / NCOL, CTXN = 256 / NCOL, SLOT = CG * 32, CSLOT = CG * 16, RB = 66 * SLOT;
    const int tid = threadIdx.x;
    bf16* qkva = (bf16*)(p.ws + WS_QKVA);
    LAS unsigned char* rowbuf = lds;
    LAS unsigned char* cbuf = lds;
    const int cg = tid % CG, c0 = tid / CG;
    float w[9][8];
#pragma unroll
    for (int k = 0; k < 9; ++k)
#pragma unroll
        for (int e = 0; e < 8; ++e) w[k][e] = p.conv_w[k * 3072 + chan0 + cg * 8 + e];
    __syncthreads();
    if (tid < 2 * CG) { const int r = tid; *(LAS v4u*)(cbuf + ((r >= CG) ? 257 : 0) * CSLOT + (r % CG) * 16) = (v4u){0u, 0u, 0u, 0u}; }
    { bf16* base = qkva + (size_t)(T + b * CTXL) * 3072 + chan0 + cg * 8;
#pragma unroll
      for (int jj = 0; jj < CTXN; ++jj) { const int t = c0 + NCOL * jj; *(LAS v4u*)(cbuf + (t + 1) * CSLOT + cg * 16) = *(const v4u*)(base + (size_t)t * 3072); }
      __syncthreads();
#pragma unroll
      for (int jj = 0; jj < CTXN; ++jj) { const int t = c0 + NCOL * jj; float a[8];
#pragma unroll
          for (int e = 0; e < 8; ++e) a[e] = 0.f;
#pragma unroll
          for (int kw = 0; kw < 3; ++kw) { float f[8]; unpack8(*(const LAS v4u*)(cbuf + (t + kw) * CSLOT + cg * 16), f);
#pragma unroll
              for (int e = 0; e < 8; ++e) a[e] += f[e] * w[3 + kw][e]; }
          float ss = 0.f;
#pragma unroll
          for (int e = 0; e < 8; ++e) { a[e] = silu_fast(a[e]); ss += a[e] * a[e]; }
          if (CG == 16 && donorm) { ss = row16_sum(ss); const float sc = rsqrtf_(ss + EPS);
#pragma unroll
              for (int e = 0; e < 8; ++e) a[e] *= sc; }
          *(v4u*)(base + (size_t)t * 3072) = pack8(a); }
    }
    __syncthreads();
    if (tid < 6 * CG * 2) { const int bi = tid / (4 * CG), r = tid % (4 * CG); *(LAS f32x4*)(rowbuf + bi * RB + ((r >= 2 * CG) ? 65 : 0) * SLOT + (r % (2 * CG)) * 16) = (f32x4){0.f, 0.f, 0.f, 0.f}; }
    bf16* base = qkva + (size_t)(b * SEQ) * 3072 + chan0 + cg * 8;
#define CONV_PUT(rr_, c_, w_) do { float f_[8]; unpack8((w_), f_); LAS f32x4* d_ = (LAS f32x4*)(rowbuf + ((rr_) % 3) * RB + ((c_) + 1) * SLOT + cg * 32); \
        d_[0] = (f32x4){f_[0], f_[1], f_[2], f_[3]}; d_[1] = (f32x4){f_[4], f_[5], f_[6], f_[7]}; } while (0)
#pragma unroll
    for (int rr = 0; rr < 2; ++rr)
#pragma unroll
        for (int jj = 0; jj < NPOS; ++jj) { const int c = c0 + NCOL * jj; const v4u wv = *(const v4u*)(base + (size_t)(rr * 64 + c) * 3072); CONV_PUT(rr, c, wv); }
    __syncthreads();
    for (int r = 0; r < 64; ++r) {
        v4u pre[NPOS];
        if (r + 2 < 64) {
#pragma unroll
            for (int jj = 0; jj < NPOS; ++jj) pre[jj] = *(const v4u*)(base + (size_t)((r + 2) * 64 + c0 + NCOL * jj) * 3072);
        }
#pragma unroll
        for (int jj = 0; jj < NPOS; ++jj) { const int c = c0 + NCOL * jj; float a[8];
#pragma unroll
            for (int e = 0; e < 8; ++e) a[e] = 0.f;
#pragma unroll
            for (int kh = 0; kh < 3; ++kh) { const int rr = r + kh - 1; if (rr < 0 || rr > 63) continue; const LAS unsigned char* rb = rowbuf + (rr % 3) * RB;
#pragma unroll
                for (int kw = 0; kw < 3; ++kw) { const f32x4 f0 = *(const LAS f32x4*)(rb + (c + kw) * SLOT + cg * 32), f1 = *(const LAS f32x4*)(rb + (c + kw) * SLOT + cg * 32 + 16);
#pragma unroll
                    for (int e = 0; e < 4; ++e) { a[e] += f0[e] * w[kh * 3 + kw][e]; a[4 + e] += f1[e] * w[kh * 3 + kw][4 + e]; } } }
            float ss = 0.f;
#pragma unroll
            for (int e = 0; e < 8; ++e) { a[e] = silu_fast(a[e]); ss += a[e] * a[e]; }
            if (CG == 16 && donorm) { ss = row16_sum(ss); const float sc = rsqrtf_(ss + EPS);
#pragma unroll
                for (int e = 0; e < 8; ++e) a[e] *= sc; }
            *(v4u*)(base + (size_t)(r * 64 + c) * 3072) = pack8(a); }
        __syncthreads();
        if (r + 2 < 64) {
#pragma unroll
            for (int jj = 0; jj < NPOS; ++jj) CONV_PUT(r + 2, c0 + NCOL * jj, pre[jj]);
        }
        __syncthreads();
    }
#undef CONV_PUT
}
__device__ __forceinline__ void phase_conv(const P& p, LAS unsigned char* lds) {
    for (int u = blockIdx.x; u < NB * 16; u += gridDim.x) conv_unit<16>(p, lds, u >> 4, (u & 15) * 128, true);
    for (int u = blockIdx.x; u < NB * 16; u += gridDim.x) conv_unit<8>(p, lds, u >> 4, 2048 + (u & 15) * 64, false);
}

template <bool GLA>
__device__ __forceinline__ void scan_unit(const P& p, LAS unsigned char* lds, int b, int h, int vh) {
    const int tid = threadIdx.x, j = tid >> 2, part = tid & 3;
    LAS float* qf = (LAS float*)lds; LAS float* kf = qf + 32 * 144; LAS float* af = kf + 32 * 144; LAS float* vf = af + 32 * 144; LAS float* ob = vf + 32 * 128;
    LAS float* sa = ob + 32 * 128; LAS float* sb = sa + 32;
    const bf16* qkva = (const bf16*)(p.ws + WS_QKVA); const bf16* pbuf = (const bf16*)(p.ws + WS_PB); const float* small = (const float*)(p.ws + WS_SMALL);
    bf16* on = (bf16*)p.out;
    const int lt = tid >> 4, piece = tid & 15;
    const float scale = 0.08838834764831845f;
    for (int dir = 0; dir < 2; ++dir) {
        float S[32];
#pragma unroll
        for (int i = 0; i < 32; ++i) S[i] = 0.f;
        float wcol[16]; float gbias = 0.f, alog = 0.f, dtb = 0.f;
        if (GLA) { const float* gw = dir ? p.gla_gate_w_b : p.gla_gate_w_f; const int i = tid & 127;
#pragma unroll
            for (int r = 0; r < 16; ++r) wcol[r] = gw[r * 512 + h * 128 + i];
            gbias = (dir ? p.gla_gate_b_b : p.gla_gate_b_f)[h * 128 + i]; }
        else { alog = __expf((dir ? p.a_log_b : p.a_log_f)[h]); dtb = (dir ? p.dt_bias_b : p.dt_bias_f)[h]; }
        for (int s = 0; s < 136; ++s) {
            const bool is_ctx = s < 8;
            const int sci = is_ctx ? (dir ? 7 - s : s) : (dir ? 127 - (s - 8) : s - 8);
            const size_t row0 = is_ctx ? (size_t)(T + b * CTXL + sci * 32) : (size_t)(b * SEQ + sci * 32);
            __syncthreads();
            { v4u qw, kw, vw;
              if (GLA) { const bf16* r = pbuf + (row0 + lt) * 2048; qw = *(const v4u*)(r + h * 128 + piece * 8); kw = *(const v4u*)(r + 512 + h * 128 + piece * 8); vw = *(const v4u*)(r + 1024 + h * 256 + vh * 128 + piece * 8); }
              else { const bf16* r = qkva + (row0 + lt) * 3072; qw = *(const v4u*)(r + h * 128 + piece * 8); kw = *(const v4u*)(r + 1024 + h * 128 + piece * 8); vw = *(const v4u*)(r + 2048 + h * 128 + piece * 8); }
              float f[8]; const int o = lt * 144 + (piece >> 2) * 36 + (piece & 3) * 8;
              unpack8(qw, f);
#pragma unroll
              for (int e = 0; e < 8; ++e) qf[o + e] = f[e] * scale;
              unpack8(kw, f);
#pragma unroll
              for (int e = 0; e < 8; ++e) kf[o + e] = f[e];
              unpack8(vw, f);
#pragma unroll
              for (int e = 0; e < 8; ++e) vf[lt * 128 + piece * 8 + e] = f[e]; }
            if (GLA) { const int i = tid & 127, tq = tid >> 7;
#pragma unroll
                for (int tt = 0; tt < 8; ++tt) { const int t = tq * 8 + tt; const float* z = small + (row0 + t) * 64 + 32 + dir * 16; float u = gbias;
#pragma unroll
                    for (int r = 0; r < 16; ++r) u += z[r] * wcol[r];
                    const float ls = fminf(u, 0.f) - log1pf(__expf(-fabsf(u)));
                    af[t * 144 + (i >> 5) * 36 + (i & 31)] = __expf(ls * (1.0f / 16.0f)); } }
            else if (tid < 32) { const float* sm = small + (row0 + tid) * 64; sb[tid] = sigmoidf_(sm[dir * 8 + h]); sa[tid] = __expf(-alog * softplusf_(sm[16 + dir * 8 + h] + dtb)); }
            __syncthreads();
            for (int tt = 0; tt < 32; ++tt) { const int t = dir ? 31 - tt : tt;
                const LAS float* kp = kf + t * 144 + part * 36; const LAS float* qp = qf + t * 144 + part * 36;
                float kk[32], qq[32];
#pragma unroll
                for (int i = 0; i < 32; i += 4) { const f32x4 a = *(const LAS f32x4*)(kp + i); kk[i] = a.x; kk[i + 1] = a.y; kk[i + 2] = a.z; kk[i + 3] = a.w;
                    const f32x4 q4 = *(const LAS f32x4*)(qp + i); qq[i] = q4.x; qq[i + 1] = q4.y; qq[i + 2] = q4.z; qq[i + 3] = q4.w; }
                const float vj = vf[t * 128 + j];
                float os = 0.f;
                if (GLA) { const LAS float* ap = af + t * 144 + part * 36;
#pragma unroll
                    for (int i = 0; i < 32; i += 4) { const f32x4 a = *(const LAS f32x4*)(ap + i);
                        S[i] = a.x * S[i] + kk[i] * vj; S[i + 1] = a.y * S[i + 1] + kk[i + 1] * vj; S[i + 2] = a.z * S[i + 2] + kk[i + 2] * vj; S[i + 3] = a.w * S[i + 3] + kk[i + 3] * vj; }
                } else { const float a = sa[t], be = sb[t]; float ks = 0.f;
#pragma unroll
                    for (int i = 0; i < 32; ++i) ks += kk[i] * S[i];
                    ks += __shfl_xor(ks, 1); ks += __shfl_xor(ks, 2);
                    const float vn = be * (vj - a * ks);
#pragma unroll
                    for (int i = 0; i < 32; ++i) S[i] = a * S[i] + kk[i] * vn; }
                if (!is_ctx) {
#pragma unroll
                    for (int i = 0; i < 32; ++i) os += qq[i] * S[i];
                    os += __shfl_xor(os, 1); os += __shfl_xor(os, 2);
                    if (part == 0) ob[t * 128 + j] = os; }
            }
            if (!is_ctx) { __syncthreads();
                bf16* dst = on + (row0 + lt) * 2048 + (GLA ? 1024 + h * 256 + vh * 128 : h * 128) + piece * 8; float f[8];
#pragma unroll
                for (int e = 0; e < 8; ++e) f[e] = ob[lt * 128 + piece * 8 + e];
                if (dir) { float g[8]; unpack8(*(const v4u*)dst, g);
#pragma unroll
                    for (int e = 0; e < 8; ++e) f[e] += g[e]; }
                *(v4u*)dst = pack8(f); }
        }
    }
}

typedef short s16x4 __attribute__((ext_vector_type(4)));
typedef __bf16 bf16x2_t __attribute__((ext_vector_type(2)));
#define MF16(a, b, c) __builtin_amdgcn_mfma_f32_16x16x16bf16_1k((a), (b), (c), 0, 0, 0)
#define MF32(a, b, c) __builtin_amdgcn_mfma_f32_16x16x32_bf16((a), (b), (c), 0, 0, 0)
__device__ __forceinline__ unsigned pk2c(float lo, float hi) { const f32x2_t v = {lo, hi}; return __builtin_bit_cast(unsigned, __builtin_convertvector(v, bf16x2_t)); }
__device__ __forceinline__ s16x4 cvt4(const f32x4 v) { v2u p; p.x = pk2c(v[0], v[1]); p.y = pk2c(v[2], v[3]); return __builtin_bit_cast(s16x4, p); }
__device__ __forceinline__ bf16x8 cat8(const s16x4 a, const s16x4 b) { return __builtin_shufflevector(a, b, 0, 1, 2, 3, 4, 5, 6, 7); }
__device__ __forceinline__ bf16x8 ldfrag(const LAS unsigned char* img, int row, int strideB, int s, int q) {
    const LAS unsigned char* p = img + row * strideB + (32 * s + 4 * q) * 2;
    unsigned a2 = (unsigned)(size_t)p + 32u; asm volatile("" : "+v"(a2));
    return cat8(*(const LAS s16x4*)p, *(const LAS s16x4*)(size_t)a2);
}
__device__ __forceinline__ v4u pack8c(const float (&f)[8]) { v4u w; w.x = pk2c(f[0], f[1]); w.y = pk2c(f[2], f[3]); w.z = pk2c(f[4], f[5]); w.w = pk2c(f[6], f[7]); return w; }
constexpr int CS_KS = 272, CS_TS = 144;
constexpr int L_K = 0, L_Q = 17408, L_V = 34816, L_KT = 52224, L_O = 70656, L_AOFF = 88064, L_TD = 91136, L_ATT = 93184, L_SC = 98304;
constexpr float QSCALE = 0.08838834764831845f;
__device__ __forceinline__ int tri_idx(int bi, int bj) { return bi * (bi + 1) / 2 + bj; }
__device__ __forceinline__ int off_idx(int bi, int bj) { return bi * (bi - 1) / 2 + bj; }

__device__ __forceinline__ void build_kt_plain(LAS unsigned char* lds, int tid) {
    const int a = tid & 127, seg = tid >> 7;
#pragma unroll
    for (int mm = 0; mm < 4; ++mm) { unsigned short v[4];
#pragma unroll
        for (int e = 0; e < 4; ++e) v[e] = *(const LAS unsigned short*)(lds + L_K + (16 * seg + 4 * mm + e) * CS_KS + a * 2);
        v2u w; w.x = (unsigned)v[0] | ((unsigned)v[1] << 16); w.y = (unsigned)v[2] | ((unsigned)v[3] << 16);
        *(LAS v2u*)(lds + L_KT + a * CS_TS + (16 * seg + 4 * mm) * 2) = w; }
}

__device__ __forceinline__ float wave_scan_incl(float x) {
#define SCAN_DPP_(ctrl, rmask) x += __builtin_bit_cast(float, __builtin_amdgcn_update_dpp(0, __builtin_bit_cast(int, x), (ctrl), (rmask), 0xF, false))
    SCAN_DPP_(0x111, 0xF); SCAN_DPP_(0x112, 0xF); SCAN_DPP_(0x114, 0xF); SCAN_DPP_(0x118, 0xF); SCAN_DPP_(0x142, 0xA); SCAN_DPP_(0x143, 0xC);
#undef SCAN_DPP_
    return x;
}
constexpr int GP_KS = 288, GP_TS = 160;
constexpr int GP_K = 0, GP_Q = 18432, GP_V = 36864, GP_KT = 54272, GP_O = 74752, GP_AOFF = 92160, GP_TD = 95232, GP_ATT = 97280, GP_SC = 102400;
__device__ __forceinline__ bf16x8 ldf16(const LAS unsigned char* img, int row, int strideB, int s, int q) { return *(const LAS bf16x8*)(img + row * strideB + (32 * s + 8 * q) * 2); }
__device__ __forceinline__ void gdn_build_kt(LAS unsigned char* lds, int tid) {
    const int a = tid & 127, seg = tid >> 7;
    const int pa = 32 * (a >> 5) + 8 * ((a >> 2) & 3) + 4 * ((a >> 4) & 1) + (a & 3);
#pragma unroll
    for (int mm = 0; mm < 4; ++mm) { unsigned short v[4];
#pragma unroll
        for (int e = 0; e < 4; ++e) v[e] = *(const LAS unsigned short*)(lds + GP_K + (16 * seg + 4 * mm + e) * GP_KS + pa * 2);
        v2u w; w.x = (unsigned)v[0] | ((unsigned)v[1] << 16); w.y = (unsigned)v[2] | ((unsigned)v[3] << 16);
        *(LAS v2u*)(lds + GP_KT + a * GP_TS + (32 * (seg >> 1) + 8 * mm + 4 * (seg & 1)) * 2) = w; }
}

__device__ __forceinline__ void gdn_unit(const P& p, LAS unsigned char* lds, const int b, const int h) {
    const int wave = __builtin_amdgcn_readfirstlane(threadIdx.x >> 6);
    const int c0 = wave * 16;
    const bf16* qkva = (const bf16*)(p.ws + WS_QKVA); const float* small = (const float*)(p.ws + WS_SMALL); bf16* on = (bf16*)p.out;
    LAS float* sc0 = (LAS float*)(lds + GP_SC); LAS float* gnl = sc0 + 320;
    __syncthreads();
    if (threadIdx.x < 128) gnl[threadIdx.x] = p.gdn_norm_g[threadIdx.x];
    for (int dir = 0; dir < 2; ++dir) {
        f32x4 S[8];
#pragma unroll
        for (int u = 0; u < 8; ++u) S[u] = (f32x4){0.f, 0.f, 0.f, 0.f};
        const float alog = __expf((dir ? p.a_log_b : p.a_log_f)[h]), dtb = (dir ? p.dt_bias_b : p.dt_bias_f)[h];
        v4u pq[2], pk[2], pv[2]; float pgb = 0.f, pga = 0.f;
#define LANE_VARS int tz_ = threadIdx.x; asm volatile("" : "+v"(tz_)); const int tid = tz_, lane = tz_ & 63, r = lane & 15, q = lane >> 4, lt = tz_ >> 4, piece = tz_ & 15; (void)tid; (void)r; (void)q; (void)lt; (void)piece;
#define GDN_ROW0(s_) (((s_) < 4) ? (size_t)(T + b * CTXL + (dir ? 3 - (s_) : (s_)) * 64) : (size_t)(b * SEQ + (dir ? 63 - ((s_) - 4) : (s_) - 4) * 64))
#define GDN_PREFETCH(s_) do { const size_t r0_ = GDN_ROW0(s_); \
            _Pragma("unroll") for (int jj = 0; jj < 2; ++jj) { const int pp = lt + 32 * jj; const bf16* rp = qkva + (r0_ + (dir ? 63 - pp : pp)) * 3072 + h * 128 + piece * 8; \
                pq[jj] = *(const v4u*)rp; pk[jj] = *(const v4u*)(rp + 1024); pv[jj] = *(const v4u*)(rp + 2048); } \
            if (wave == 0) { const float* sm = small + (r0_ + (dir ? 63 - lane : lane)) * 64; pgb = sm[dir * 8 + h]; pga = sm[16 + dir * 8 + h]; } } while (0)
#define GDN_FLUSH(s_) do { const size_t fr0_ = GDN_ROW0(s_); \
            _Pragma("unroll") for (int jj = 0; jj < 2; ++jj) { const int pp = lt + 32 * jj; float f[8]; unpack8(*(const LAS v4u*)(lds + GP_O + pp * CS_KS + piece * 16), f); \
                bf16* dst = on + (fr0_ + (dir ? 63 - pp : pp)) * 2048 + h * 128 + piece * 8; \
                if (dir) { float g[8]; unpack8(fwdv[jj], g); float ss = 0.f; \
                    _Pragma("unroll") for (int e = 0; e < 8; ++e) { f[e] += g[e]; ss += f[e] * f[e]; } \
                    ss = row16_sum(ss); \
                    const float rstd = rsqrtf_(ss * (1.f / 128.f) + EPS); \
                    const f32x4 g0 = *(const LAS f32x4*)(gnl + piece * 8), g1 = *(const LAS f32x4*)(gnl + piece * 8 + 4); \
                    _Pragma("unroll") for (int e = 0; e < 4; ++e) { f[e] *= rstd * g0[e]; f[4 + e] *= rstd * g1[e]; } } \
                *(v4u*)dst = pack8c(f); } } while (0)
        v4u fwdv[2] = {};
#define GDN_STAGE1(s_) do { LAS float* scn_ = sc0 + (((s_) & 1) << 9); \
            if (wave == 0) { const float be = sigmoid_fast(pgb); const float G = wave_scan_incl(-alog * softplusf_(pga + dtb)); \
                const float G63 = __builtin_bit_cast(float, __builtin_amdgcn_readlane(__builtin_bit_cast(int, G), 63)); \
                scn_[lane] = be; scn_[64 + lane] = G; scn_[128 + lane] = __expf(G); scn_[192 + lane] = __expf(G63 - G); if (lane == 0) scn_[256] = __expf(G63); } \
            _Pragma("unroll") for (int jj = 0; jj < 2; ++jj) { const int pp = lt + 32 * jj; \
                const int po_ = 64 * (piece >> 2) + 32 * (piece & 1) + 8 * ((piece >> 1) & 1);     \
                LAS unsigned char* kr_ = lds + GP_K + pp * GP_KS + po_; LAS unsigned char* qr_ = lds + GP_Q + pp * GP_KS + po_; \
                *(LAS v2u*)kr_ = (v2u){pk[jj].x, pk[jj].y}; *(LAS v2u*)(kr_ + 16) = (v2u){pk[jj].z, pk[jj].w}; *(LAS v2u*)qr_ = (v2u){pq[jj].x, pq[jj].y}; *(LAS v2u*)(qr_ + 16) = (v2u){pq[jj].z, pq[jj].w}; \
                *(LAS v4u*)(lds + GP_V + pp * CS_KS + piece * 16) = pv[jj]; } } while (0)
        { LANE_VARS GDN_PREFETCH(0); __syncthreads(); GDN_STAGE1(0); GDN_PREFETCH(1); }
        for (int s = 0; s < 68; ++s) {
            LANE_VARS
            const bool is_ctx = s < 4;
            const size_t row0 = GDN_ROW0(s);
            LAS float* scb = sc0 + ((s & 1) << 9); LAS float* scG = scb + 64; LAS float* sceG = scb + 128; LAS float* scdK = scb + 192; LAS float* scl = scb + 256;
            __syncthreads();
            if (s > 4) GDN_FLUSH(s - 1);
            if (dir && !is_ctx) {
#pragma unroll
                for (int jj = 0; jj < 2; ++jj) fwdv[jj] = *(const v4u*)(on + (row0 + (63 - (lt + 32 * jj))) * 2048 + h * 128 + piece * 8); }
            gdn_build_kt(lds, tid);
            if (wave < 4) {
                const int bb = wave; f32x4 kk = (f32x4){0.f, 0.f, 0.f, 0.f}, qk = (f32x4){0.f, 0.f, 0.f, 0.f};
#pragma unroll
                for (int ks = 0; ks < 4; ++ks) { const bf16x8 kf = ldf16(lds + GP_K, 16 * bb + r, GP_KS, ks, q); const bf16x8 qf = ldf16(lds + GP_Q, 16 * bb + r, GP_KS, ks, q);
                    kk = MF32(kf, kf, kk); qk = MF32(kf, qf, qk); }
                const float Gr = scG[16 * bb + r], br = scb[16 * bb + r];
                const f32x4 Ge = *(const LAS f32x4*)(scG + 16 * bb + 4 * q), be4 = *(const LAS f32x4*)(scb + 16 * bb + 4 * q);
                f32x4 A, At, att;
#pragma unroll
                for (int e = 0; e < 4; ++e) { const int ie = 4 * q + e; const float dlo = __expf(fminf(Ge[e] - Gr, 0.f)), dhi = __expf(fminf(Gr - Ge[e], 0.f));
                    A[e] = (r < ie) ? be4[e] * kk[e] * dlo : 0.f;
                    At[e] = (ie < r) ? br * kk[e] * dhi : 0.f;
                    att[e] = (ie <= r) ? QSCALE * qk[e] * dhi : 0.f; }
                *(LAS s16x4*)(lds + GP_ATT + tri_idx(bb, bb) * 512 + lane * 8) = cvt4(att);
                const f32x4 Z = (f32x4){0.f, 0.f, 0.f, 0.f};
                f32x4 Rt;
#pragma unroll
                for (int e = 0; e < 4; ++e) Rt[e] = ((4 * q + e) == r ? 1.f : 0.f) - At[e];
                f32x4 Pm = MF16(cvt4(At), cvt4(A), Z), Pt = MF16(cvt4(A), cvt4(At), Z);
                Rt = MF16(cvt4(Pm), cvt4(Rt), Rt);
                f32x4 P2 = MF16(cvt4(Pt), cvt4(Pm), Z), Pt2 = MF16(cvt4(Pm), cvt4(Pt), Z);
                Rt = MF16(cvt4(P2), cvt4(Rt), Rt);
                f32x4 P4 = MF16(cvt4(Pt2), cvt4(P2), Z);
                Rt = MF16(cvt4(P4), cvt4(Rt), Rt);
                *(LAS s16x4*)(lds + GP_TD + bb * 512 + lane * 8) = cvt4(Rt);
            } else {
#pragma unroll
                for (int uu = 0; uu < 3; ++uu) { const int un = (wave - 4) + 4 * uu; const int pr = un % 6; const bool isqk = un >= 6;
                    const int bi = pr == 0 ? 1 : (pr < 3 ? 2 : 3), bj = pr == 0 ? 0 : (pr < 3 ? pr - 1 : pr - 3);
                    f32x4 d = (f32x4){0.f, 0.f, 0.f, 0.f};
                    const LAS unsigned char* bimg = lds + (isqk ? GP_Q : GP_K);
#pragma unroll
                    for (int ks = 0; ks < 4; ++ks) d = MF32(ldf16(lds + GP_K, 16 * bj + r, GP_KS, ks, q), ldf16(bimg, 16 * bi + r, GP_KS, ks, q), d);
                    const float Gi = scG[16 * bi + r], bi_ = scb[16 * bi + r]; const f32x4 Gj = *(const LAS f32x4*)(scG + 16 * bj + 4 * q);
                    const float f = isqk ? QSCALE : -bi_;
#pragma unroll
                    for (int e = 0; e < 4; ++e) d[e] = f * d[e] * __expf(fminf(Gi - Gj[e], 0.f));
                    *(LAS s16x4*)(lds + (isqk ? GP_ATT + tri_idx(bi, bj) * 512 : GP_AOFF + off_idx(bi, bj) * 512) + lane * 8) = cvt4(d); }
            }
            bf16x8 Sb[4];
#pragma unroll
            for (int ks = 0; ks < 4; ++ks) Sb[ks] = cat8(cvt4(S[2 * ks]), cvt4(S[2 * ks + 1]));
            bf16x8 fa[8];
#define LD8(img, t0) do { _Pragma("unroll") for (int t_ = 0; t_ < 2; ++t_) _Pragma("unroll") for (int ks_ = 0; ks_ < 4; ++ks_) fa[t_ * 4 + ks_] = ldf16(lds + (img), 16 * ((t0) + t_) + r, GP_KS, ks_, q); } while (0)
#define LD8T(u0) do { _Pragma("unroll") for (int u_ = 0; u_ < 4; ++u_) { fa[2 * u_] = ldf16(lds + GP_KT, 16 * ((u0) + u_) + r, GP_TS, 0, q); fa[2 * u_ + 1] = ldf16(lds + GP_KT, 16 * ((u0) + u_) + r, GP_TS, 1, q); } } while (0)
#define GDN_XS(dst, t0) do { _Pragma("unroll") for (int t = 0; t < 2; ++t) { f32x4 X = (f32x4){0.f, 0.f, 0.f, 0.f}; \
                _Pragma("unroll") for (int ks = 0; ks < 4; ++ks) X = MF32(fa[t * 4 + ks], Sb[ks], X); \
                dst[(t0) + t] = X; } } while (0)
            f32x4 vn[4], oq[4];
            LD8(GP_K, 0); GDN_XS(vn, 0);
            LD8(GP_K, 2); GDN_XS(vn, 2);
            if (!is_ctx) { LD8(GP_Q, 0); GDN_XS(oq, 0); LD8(GP_Q, 2); GDN_XS(oq, 2); }
            else {
#pragma unroll
                for (int t = 0; t < 4; ++t) oq[t] = (f32x4){0.f, 0.f, 0.f, 0.f}; }
#undef GDN_XS
#pragma unroll
            for (int t = 0; t < 4; ++t) { const f32x4 be4 = *(const LAS f32x4*)(scb + 16 * t + 4 * q), eg4 = *(const LAS f32x4*)(sceG + 16 * t + 4 * q);
#pragma unroll
                for (int e = 0; e < 4; ++e) { const float v = bflo((unsigned)*(const LAS unsigned short*)(lds + GP_V + (16 * t + 4 * q + e) * CS_KS + (c0 + r) * 2));
                    vn[t][e] = be4[e] * (v - eg4[e] * vn[t][e]); } }
            __syncthreads();
            if (wave >= 4 && s + 1 < 68) { GDN_STAGE1(s + 1); if (s + 2 < 68) GDN_PREFETCH(s + 2); }
            LD8T(0);
            { s16x4 td[4], ao[6];
#pragma unroll
              for (int i = 0; i < 4; ++i) td[i] = *(const LAS s16x4*)(lds + GP_TD + i * 512 + lane * 8);
#pragma unroll
              for (int i = 0; i < 6; ++i) ao[i] = *(const LAS s16x4*)(lds + GP_AOFF + i * 512 + lane * 8);
              vn[0] = MF16(td[0], cvt4(vn[0]), ((f32x4){0.f, 0.f, 0.f, 0.f}));
#pragma unroll
              for (int bi = 1; bi < 4; ++bi) { f32x4 a = vn[bi];
#pragma unroll
                  for (int bj = 0; bj < bi; ++bj) a = MF16(ao[off_idx(bi, bj)], cvt4(vn[bj]), a);
                  vn[bi] = MF16(td[bi], cvt4(a), ((f32x4){0.f, 0.f, 0.f, 0.f})); } }
            if (!is_ctx) {
                s16x4 vc[4];
#pragma unroll
                for (int t = 0; t < 4; ++t) vc[t] = cvt4(vn[t]);
#pragma unroll
                for (int t = 0; t < 4; ++t) { f32x4 a = oq[t]; const f32x4 eg4 = *(const LAS f32x4*)(sceG + 16 * t + 4 * q);
#pragma unroll
                    for (int e = 0; e < 4; ++e) a[e] *= QSCALE * eg4[e];
#pragma unroll
                    for (int tj = 0; tj <= t; ++tj) a = MF16(*(const LAS s16x4*)(lds + GP_ATT + tri_idx(t, tj) * 512 + lane * 8), vc[tj], a);
#pragma unroll
                    for (int e = 0; e < 4; ++e) *(LAS unsigned short*)(lds + GP_O + (16 * t + 4 * q + e) * CS_KS + (c0 + r) * 2) = (unsigned short)(pk2c(a[e], 0.f) & 0xffffu); }
            }
            if (wave < 4 && s + 1 < 68) { GDN_STAGE1(s + 1); if (s + 2 < 68) GDN_PREFETCH(s + 2); }
            { const float egl = scl[0]; s16x4 vd[4];
#pragma unroll
              for (int t = 0; t < 4; ++t) { const f32x4 dk4 = *(const LAS f32x4*)(scdK + 16 * t + 4 * q); vd[t] = cvt4(vn[t] * dk4); }
              const bf16x8 vb0 = cat8(vd[0], vd[1]), vb1 = cat8(vd[2], vd[3]);
#pragma unroll
              for (int u = 0; u < 4; ++u) { f32x4 a = S[u] * egl; a = MF32(fa[2 * u], vb0, a); a = MF32(fa[2 * u + 1], vb1, a); S[u] = a; }
              LD8T(4);
#pragma unroll
              for (int u = 0; u < 4; ++u) { f32x4 a = S[4 + u] * egl; a = MF32(fa[2 * u], vb0, a); a = MF32(fa[2 * u + 1], vb1, a); S[4 + u] = a; } }
        }
        { LANE_VARS __syncthreads(); GDN_FLUSH(67); }
#undef GDN_FLUSH
#undef GDN_STAGE1
#undef GDN_PREFETCH
#undef GDN_ROW0
    }
}

constexpr int GL_V = 34816, GL_VS = 528, GL_KT = 68608, GL_ATT = 87040, GL_G = 92160, GL_SC = 125952;
constexpr size_t WS_OB2 = 40 * MiB;
__device__ __forceinline__ void gla_unit(const P& p, LAS unsigned char* lds, const int b, const int h, const int dir) {
    const int wave = __builtin_amdgcn_readfirstlane(threadIdx.x >> 6);
    const bf16* pbuf = (const bf16*)(p.ws + WS_PB); const float* small = (const float*)(p.ws + WS_SMALL);
    bf16* outb = dir ? (bf16*)(p.ws + WS_OB2) + h * 256 : (bf16*)p.out + 1024 + h * 256; const int opitch = dir ? 1024 : 2048;
    LAS float* gl = (LAS float*)(lds + GL_SC);
    LAS unsigned char* zb = lds + GL_SC + 512;
    LAS unsigned char* wb = lds + GL_SC + 2560;
    LAS float* gbias = (LAS float*)(lds + GL_SC + 6656);
    {
        f32x4 S[2][8];
#pragma unroll
        for (int ct = 0; ct < 2; ++ct)
#pragma unroll
            for (int u = 0; u < 8; ++u) S[ct][u] = (f32x4){0.f, 0.f, 0.f, 0.f};
        __syncthreads();
        { const float* gw = dir ? p.gla_gate_w_b : p.gla_gate_w_f; const float* gbp = dir ? p.gla_gate_b_b : p.gla_gate_b_f;
          for (int i = threadIdx.x; i < 2048; i += NTHREADS) { const int dim = i >> 4, k = i & 15; *(LAS unsigned short*)(wb + i * 2) = (unsigned short)(pk2c(gw[k * 512 + h * 128 + dim], 0.f) & 0xffffu); }
          if (threadIdx.x < 128) gbias[threadIdx.x] = gbp[h * 128 + threadIdx.x]; }
        v4u pq[2], pk[2], pv[2][2]; float pz[2];
#define LANE_VARS int tz_ = threadIdx.x; asm volatile("" : "+v"(tz_)); const int tid = tz_, lane = tz_ & 63, r = lane & 15, q = lane >> 4, lt = tz_ >> 4, piece = tz_ & 15; (void)tid; (void)r; (void)q; (void)lt; (void)piece;
#define GLA_ROW0(s_) (((s_) < 4) ? (size_t)(T + b * CTXL + (dir ? 3 - (s_) : (s_)) * 64) : (size_t)(b * SEQ + (dir ? 63 - ((s_) - 4) : (s_) - 4) * 64))
#define GLA_PREFETCH(s_) do { const size_t r0_ = GLA_ROW0(s_); \
            _Pragma("unroll") for (int jj = 0; jj < 2; ++jj) { const int pp = lt + 32 * jj; const bf16* rp = pbuf + (r0_ + (dir ? 63 - pp : pp)) * 2048; \
                pq[jj] = *(const v4u*)(rp + h * 128 + piece * 8); pk[jj] = *(const v4u*)(rp + 512 + h * 128 + piece * 8); \
                pv[jj][0] = *(const v4u*)(rp + 1024 + h * 256 + piece * 8); pv[jj][1] = *(const v4u*)(rp + 1024 + h * 256 + 128 + piece * 8); \
                pz[jj] = small[(r0_ + (dir ? 63 - pp : pp)) * 64 + 32 + dir * 16 + piece]; } } while (0)
        { LANE_VARS GLA_PREFETCH(0); }
        for (int s = 0; s < 68; ++s) {
            LANE_VARS
            const bool is_ctx = s < 4;
            const size_t row0 = GLA_ROW0(s);
            __syncthreads();
#pragma unroll
            for (int jj = 0; jj < 2; ++jj) { const int pp = lt + 32 * jj;
                *(LAS v4u*)(lds + L_K + pp * CS_KS + piece * 16) = pk[jj];
                *(LAS v4u*)(lds + GL_V + pp * GL_VS + piece * 16) = pv[jj][0]; *(LAS v4u*)(lds + GL_V + pp * GL_VS + 256 + piece * 16) = pv[jj][1];
                *(LAS unsigned short*)(zb + (pp * 16 + piece) * 2) = (unsigned short)(pk2c(pz[jj], 0.f) & 0xffffu); }
            __syncthreads();
            { const int c0 = wave * 16;
              const s16x4 wfr = *(const LAS s16x4*)(wb + (c0 + r) * 32 + q * 8); const float bia = gbias[c0 + r];
              s16x4 lgb[4];
#pragma unroll
              for (int t = 0; t < 4; ++t) { f32x4 u = MF16(*(const LAS s16x4*)(zb + (16 * t + r) * 32 + q * 8), wfr, ((f32x4){0.f, 0.f, 0.f, 0.f}));
#pragma unroll
                  for (int e = 0; e < 4; ++e) { const float x = u[e] + bia; u[e] = (fminf(x, 0.f) - 0.69314718f * __builtin_amdgcn_logf(1.0f + __builtin_amdgcn_exp2f(-1.44269504f * fabsf(x)))) * (1.0f / 16.0f); }
                  lgb[t] = cvt4(u); }
              s16x4 ltri, lone;
              { v2u a, o1; const unsigned one = 0x3f80u;
                a.x = ((4 * q + 0 <= r) ? one : 0u) | (((4 * q + 1 <= r) ? one : 0u) << 16); a.y = ((4 * q + 2 <= r) ? one : 0u) | (((4 * q + 3 <= r) ? one : 0u) << 16);
                o1.x = one | (one << 16); o1.y = o1.x; ltri = __builtin_bit_cast(s16x4, a); lone = __builtin_bit_cast(s16x4, o1); }
              f32x4 gc[4];
#pragma unroll
              for (int ti = 0; ti < 4; ++ti) { f32x4 a = (f32x4){0.f, 0.f, 0.f, 0.f};
#pragma unroll
                  for (int tj = 0; tj <= ti; ++tj) a = MF16(tj == ti ? ltri : lone, lgb[tj], a);
                  gc[ti] = a; }
              const float tot = __shfl(gc[3][3], 48 + r);
              if (q == 0) gl[c0 + r] = __expf(tot);
#pragma unroll
              for (int t = 0; t < 4; ++t) { float kd[4];
#pragma unroll
                  for (int e = 0; e < 4; ++e) { *(LAS float*)(lds + GL_G + (16 * t + 4 * q + e) * GL_VS + (c0 + r) * 4) = gc[t][e];
                      const float kv = bflo((unsigned)*(const LAS unsigned short*)(lds + L_K + (16 * t + 4 * q + e) * CS_KS + (c0 + r) * 2));
                      kd[e] = kv * __expf(tot - gc[t][e]); }
                  v2u w; w.x = pk2c(kd[0], kd[1]); w.y = pk2c(kd[2], kd[3]);
                  *(LAS v2u*)(lds + GL_KT + (c0 + r) * CS_TS + (16 * t + 4 * q) * 2) = w; } }
            __syncthreads();
#pragma unroll
            for (int jj = 0; jj < 2; ++jj) { const int pp = lt + 32 * jj;
                const f32x4 g0 = *(const LAS f32x4*)(lds + GL_G + pp * GL_VS + piece * 32), g1 = *(const LAS f32x4*)(lds + GL_G + pp * GL_VS + piece * 32 + 16);
                float qf[8], kf[8]; unpack8(pq[jj], qf); unpack8(pk[jj], kf);
#pragma unroll
                for (int e = 0; e < 4; ++e) { qf[e] *= QSCALE * __expf(g0[e]); kf[e] *= __expf(fminf(-g0[e], 80.f)); qf[4 + e] *= QSCALE * __expf(g1[e]); kf[4 + e] *= __expf(fminf(-g1[e], 80.f)); }
                *(LAS v4u*)(lds + L_Q + pp * CS_KS + piece * 16) = pack8c(qf); *(LAS v4u*)(lds + L_K + pp * CS_KS + piece * 16) = pack8c(kf); }
            if (s + 1 < 68) GLA_PREFETCH(s + 1);
            __syncthreads();
            if (!is_ctx) {
#pragma unroll
                for (int uu = 0; uu < 2; ++uu) { const int un = wave + 8 * uu; if (un < 10) {
                    const int bi = un < 1 ? 0 : (un < 3 ? 1 : (un < 6 ? 2 : 3)), bj = un - bi * (bi + 1) / 2;
                    bf16x8 fk[4], fq[4];
#pragma unroll
                    for (int ks = 0; ks < 4; ++ks) { fk[ks] = ldfrag(lds + L_K, 16 * bj + r, CS_KS, ks, q); fq[ks] = ldfrag(lds + L_Q, 16 * bi + r, CS_KS, ks, q); }
                    f32x4 d = (f32x4){0.f, 0.f, 0.f, 0.f};
#pragma unroll
                    for (int ks = 0; ks < 4; ++ks) d = MF32(fk[ks], fq[ks], d);
                    if (bi == bj) {
#pragma unroll
                        for (int e = 0; e < 4; ++e) d[e] = ((4 * q + e) <= r) ? d[e] : 0.f; }
                    *(LAS s16x4*)(lds + GL_ATT + un * 512 + lane * 8) = cvt4(d); } }
                __syncthreads();
            }
#define GLD8(img, t0) do { _Pragma("unroll") for (int t_ = 0; t_ < 2; ++t_) _Pragma("unroll") for (int ks_ = 0; ks_ < 4; ++ks_) fa[t_ * 4 + ks_] = ldfrag(lds + (img), 16 * ((t0) + t_) + r, CS_KS, ks_, q); } while (0)
#define GLD8T(u0) do { _Pragma("unroll") for (int u_ = 0; u_ < 4; ++u_) { fa[2 * u_] = ldfrag(lds + GL_KT, 16 * ((u0) + u_) + r, CS_TS, 0, q); fa[2 * u_ + 1] = ldfrag(lds + GL_KT, 16 * ((u0) + u_) + r, CS_TS, 1, q); } } while (0)
            { const int cc0 = wave * 16;
              bf16x8 fa[8];
              if (!is_ctx) GLD8(L_Q, 0); else GLD8T(0);
              s16x4 vt[2][4];
#pragma unroll
              for (int ct = 0; ct < 2; ++ct)
#pragma unroll
                  for (int t = 0; t < 4; ++t) { unsigned short v[4];
#pragma unroll
                      for (int e = 0; e < 4; ++e) v[e] = *(const LAS unsigned short*)(lds + GL_V + (16 * t + 4 * q + e) * GL_VS + (ct * 128 + cc0 + r) * 2);
                      v2u w; w.x = (unsigned)v[0] | ((unsigned)v[1] << 16); w.y = (unsigned)v[2] | ((unsigned)v[3] << 16); vt[ct][t] = __builtin_bit_cast(s16x4, w); }
              if (!is_ctx) {
                  f32x4 o[2][4];
                  { bf16x8 Sb[2][4];
#pragma unroll
                    for (int ct = 0; ct < 2; ++ct)
#pragma unroll
                        for (int ks = 0; ks < 4; ++ks) Sb[ct][ks] = cat8(cvt4(S[ct][2 * ks]), cvt4(S[ct][2 * ks + 1]));
#pragma unroll
                    for (int ct = 0; ct < 2; ++ct)
#pragma unroll
                        for (int t = 0; t < 2; ++t) { f32x4 a = (f32x4){0.f, 0.f, 0.f, 0.f};
#pragma unroll
                            for (int ks = 0; ks < 4; ++ks) a = MF32(fa[t * 4 + ks], Sb[ct][ks], a);
                            o[ct][t] = a; }
                    GLD8(L_Q, 2);
#pragma unroll
                    for (int ct = 0; ct < 2; ++ct)
#pragma unroll
                        for (int t = 0; t < 2; ++t) { f32x4 a = (f32x4){0.f, 0.f, 0.f, 0.f};
#pragma unroll
                            for (int ks = 0; ks < 4; ++ks) a = MF32(fa[t * 4 + ks], Sb[ct][ks], a);
                            o[ct][2 + t] = a; } }
                  GLD8T(0);
#pragma unroll
                  for (int t = 0; t < 4; ++t) { s16x4 at[4];
#pragma unroll
                      for (int tj = 0; tj <= t; ++tj) at[tj] = *(const LAS s16x4*)(lds + GL_ATT + tri_idx(t, tj) * 512 + lane * 8);
#pragma unroll
                      for (int ct = 0; ct < 2; ++ct) { f32x4 a = o[ct][t];
#pragma unroll
                          for (int tj = 0; tj <= t; ++tj) a = MF16(at[tj], vt[ct][tj], a);
#pragma unroll
                          for (int e = 0; e < 4; ++e) *(LAS unsigned short*)(lds + GL_G + (16 * t + 4 * q + e) * GL_VS + (ct * 128 + cc0 + r) * 2) = (unsigned short)(pk2c(a[e], 0.f) & 0xffffu); } }
              }
              { bf16x8 vb0[2], vb1[2];
#pragma unroll
                for (int ct = 0; ct < 2; ++ct) { vb0[ct] = cat8(vt[ct][0], vt[ct][1]); vb1[ct] = cat8(vt[ct][2], vt[ct][3]); }
#pragma unroll
                for (int u = 0; u < 4; ++u) { const f32x4 g4 = *(const LAS f32x4*)(gl + 16 * u + 4 * q);
#pragma unroll
                    for (int ct = 0; ct < 2; ++ct) { f32x4 a = S[ct][u] * g4; a = MF32(fa[2 * u], vb0[ct], a); a = MF32(fa[2 * u + 1], vb1[ct], a); S[ct][u] = a; } }
                GLD8T(4);
#pragma unroll
                for (int u = 0; u < 4; ++u) { const f32x4 g4 = *(const LAS f32x4*)(gl + 16 * (4 + u) + 4 * q);
#pragma unroll
                    for (int ct = 0; ct < 2; ++ct) { f32x4 a = S[ct][4 + u] * g4; a = MF32(fa[2 * u], vb0[ct], a); a = MF32(fa[2 * u + 1], vb1[ct], a); S[ct][4 + u] = a; } } }
            }
#undef GLD8
#undef GLD8T
            if (!is_ctx) {
                __syncthreads();
#pragma unroll
                for (int jj = 0; jj < 2; ++jj) { const int pp = lt + 32 * jj; bf16* dst = outb + (row0 + (dir ? 63 - pp : pp)) * opitch + piece * 8;
                    *(v4u*)dst = *(const LAS v4u*)(lds + GL_G + pp * GL_VS + piece * 16); *(v4u*)(dst + 128) = *(const LAS v4u*)(lds + GL_G + pp * GL_VS + 256 + piece * 16); }
            }
        }
#undef GLA_PREFETCH
#undef GLA_ROW0
#undef LANE_VARS
    }
}
#ifndef SCAN_ORACLE
#define SCAN_ORACLE 0
#endif

__device__ __forceinline__ void phase_wconv(const P& p, LAS unsigned char* lds, const int which, const int worker, const int nworkers);
__device__ __forceinline__ void phase_scan(const P& p, LAS unsigned char* lds) {
  const int nrep = p.probe ? 2 : 1;
  for (int rep = 0; rep < nrep; ++rep) {
    const int kinds = rep ? p.probe : 3;
    for (int u = blockIdx.x; u < 256; u += gridDim.x) {
        if (!((kinds >> (u & 1)) & 1)) continue;
#if SCAN_ORACLE
        if (u < 128) scan_unit<false>(p, lds, u >> 3, u & 7, 0);
        else { const int v = u - 128; scan_unit<true>(p, lds, v >> 3, (v >> 1) & 3, v & 1); }
#else
#ifndef GLA_ORACLE
#define GLA_ORACLE 0
#endif
#if !defined(TEST_NO_GDN)
        if ((u & 1) == 0) { const int v = u >> 1; gdn_unit(p, lds, v >> 3, v & 7); }
#else
        if ((u & 1) == 0) {}
#endif
#if defined(TEST_NO_GLA)
        else {}
#elif GLA_ORACLE
        else { const int v = u >> 1; scan_unit<true>(p, lds, v >> 3, (v >> 1) & 3, v & 1); }
#else
        else { const int v = u >> 1; gla_unit(p, lds, v >> 3, (v >> 1) & 3, v & 1); }
#endif
#endif
        __syncthreads();
    }
    __syncthreads();
  }
  { const int nw = (int)gridDim.x >> 1;
    if (nw == 0) phase_wconv(p, lds, 0, 0, 1);
    else if (blockIdx.x & 1) phase_wconv(p, lds, 0, (int)blockIdx.x >> 1, nw); }
}

__device__ __forceinline__ void phase_onorm(const P& p) {
    const int tid = threadIdx.x, lane = tid & 63, wave = tid >> 6;
    const int gw = blockIdx.x * NWAVES + wave, NGW = gridDim.x * NWAVES;
    bf16* on = (bf16*)p.out;
#if SCAN_ORACLE
    const float* gp = lane < 32 ? p.gdn_norm_g + (lane & 3) * 32 : p.gla_norm_g + ((lane - 32) & 7) * 32;
    float g[32];
#pragma unroll
    for (int i = 0; i < 32; ++i) g[i] = gp[i];
    for (int r = gw; r < T; r += NGW) {
        v4u* ptr = (v4u*)(on + (size_t)r * 2048 + lane * 32); float f[32]; float ss = 0.f;
#pragma unroll
        for (int q = 0; q < 4; ++q) { float t8[8]; unpack8(ptr[q], t8);
#pragma unroll
            for (int e = 0; e < 8; ++e) { f[q * 8 + e] = t8[e]; ss += t8[e] * t8[e]; } }
        ss += __shfl_xor(ss, 1); ss += __shfl_xor(ss, 2);
        const float s4 = __shfl_xor(ss, 4);
        const float rstd = lane < 32 ? rsqrtf_(ss * (1.f / 128.f) + EPS) : rsqrtf_((ss + s4) * (1.f / 256.f) + EPS);
#pragma unroll
        for (int q = 0; q < 4; ++q) { float t8[8];
#pragma unroll
            for (int e = 0; e < 8; ++e) t8[e] = f[q * 8 + e] * rstd * g[q * 8 + e];
            ptr[q] = pack8(t8); }
    }
#else
    float g[16];
#pragma unroll
    for (int i = 0; i < 16; ++i) g[i] = p.gla_norm_g[(lane & 15) * 16 + i];
    const bf16* ob2 = (const bf16*)(p.ws + WS_OB2);
    v4u nxt[4];
    if (gw < T) { const v4u* pp = (const v4u*)(on + (size_t)gw * 2048 + 1024 + lane * 16); const v4u* pb = (const v4u*)(ob2 + (size_t)gw * 1024 + lane * 16); nxt[0] = pp[0]; nxt[1] = pp[1]; nxt[2] = pb[0]; nxt[3] = pb[1]; }
    for (int r = gw; r < T; r += NGW) {
        v4u* ptr = (v4u*)(on + (size_t)r * 2048 + 1024 + lane * 16); float f[16]; float ss = 0.f;
        const v4u cur[4] = {nxt[0], nxt[1], nxt[2], nxt[3]};
        if (r + NGW < T) { const v4u* pp = (const v4u*)(on + (size_t)(r + NGW) * 2048 + 1024 + lane * 16); const v4u* pb = (const v4u*)(ob2 + (size_t)(r + NGW) * 1024 + lane * 16); nxt[0] = pp[0]; nxt[1] = pp[1]; nxt[2] = pb[0]; nxt[3] = pb[1]; }
#pragma unroll
        for (int q = 0; q < 2; ++q) { float t8[8], u8[8]; unpack8(cur[q], t8); unpack8(cur[2 + q], u8);
#pragma unroll
            for (int e = 0; e < 8; ++e) { const float x = t8[e] + u8[e]; f[q * 8 + e] = x; ss += x * x; } }
        ss = row16_sum(ss);
        const float rstd = rsqrtf_(ss * (1.f / 256.f) + EPS);
#pragma unroll
        for (int q = 0; q < 2; ++q) { float t8[8];
#pragma unroll
            for (int e = 0; e < 8; ++e) t8[e] = f[q * 8 + e] * rstd * g[q * 8 + e];
            ptr[q] = pack8(t8); }
    }
#endif
}

__device__ __forceinline__ void phase_wconv(const P& p, LAS unsigned char* lds, const int which, const int worker, const int nworkers) {
    const int tid = threadIdx.x, lane = tid & 63, wave = tid >> 6;
    LAS float* scr = (LAS float*)(lds + wave * 8448);
    const int gw = worker * NWAVES + wave, NGW = nworkers * NWAVES;
    constexpr int I_GUE = EARLY_GU * 64 * 16, I_GUL = (NE - EARLY_GU) * 64 * 16, I_DN = NE * 32 * 16;
    const int I_GUH = which ? I_GUL : I_GUE; const int nit = which ? I_GUL : I_GUE + I_DN;
#define WC_ITEM(it_, W_, ld_, c0_, dst_, dr_, k0_) do { if ((it_) < I_GUH) { const int e_ = ((it_) >> 10) + (which ? EARLY_GU : 0), r_ = (it_) & 1023, nb_ = r_ & 63;     \
            W_ = p.w_gu + (size_t)e_ * D * 2048; ld_ = 2048; c0_ = 32 * nb_; dst_ = p.ws + (size_t)wb_gu_mib(e_) * MiB; k0_ = 64 * (r_ >> 6); \
            dr_ = nb_ < 32 ? (nb_ >> 2) * 256 + (nb_ & 3) * 32 : ((nb_ - 32) >> 2) * 256 + 128 + ((nb_ - 32) & 3) * 32; } \
        else { const int r2_ = (it_) - I_GUH, e_ = r2_ >> 9, r_ = r2_ & 511, nb_ = r_ & 31; \
            W_ = p.w_down + (size_t)e_ * D * D; ld_ = D; c0_ = 32 * nb_; dst_ = p.ws + (size_t)wb_dn_mib(e_) * MiB; k0_ = 64 * (r_ >> 5); dr_ = 32 * nb_; } } while (0)
    float tn[32];
    const float* W; int ld, c0, dr, k0; unsigned char* dst;
    if (gw < nit) { WC_ITEM(gw, W, ld, c0, dst, dr, k0); tr8_load(tn, W, ld, c0, k0, lane); }
    for (int it = gw; it < nit; it += NGW) {
        float t[32];
#pragma unroll
        for (int i = 0; i < 32; ++i) t[i] = tn[i];
        unsigned char* cdst = dst; const int cdr = dr, ck0 = k0;
        if (it + NGW < nit) { WC_ITEM(it + NGW, W, ld, c0, dst, dr, k0); tr8_load(tn, W, ld, c0, k0, lane); }
        tr8_finish(t, cdst, cdr, ck0, scr, lane);
    }
#undef WC_ITEM
}

#define DPPF(x, ctrl) __builtin_bit_cast(float, __builtin_amdgcn_update_dpp(0, __builtin_bit_cast(int, (x)), (ctrl), 0xF, 0xF, true))
#define DPPI(x, ctrl) __builtin_amdgcn_update_dpp(0, (x), (ctrl), 0xF, 0xF, true)
#define AMAX_STEP(bv, bi, ctrl) { const float ov = DPPF(bv, ctrl); const int oi = DPPI(bi, ctrl); \
    const bool tk = (ov > bv) || (ov == bv && oi < bi); bv = tk ? ov : bv; bi = tk ? oi : bi; }
__device__ __forceinline__ void phase_ffnprep(const P& p, LAS unsigned char* lds) {
    const int tid = threadIdx.x, lane = tid & 63, wave = tid >> 6;
    LAS float* wp = (LAS float*)lds;
    LAS float* part = (LAS float*)(lds + 131584);
    LAS float* cb = (LAS float*)(lds + 132608);
    LAS float* rs = (LAS float*)(lds + 132736);
    LAS int* lcnt = (LAS int*)(lds + 133760);
    const float* modv = (const float*)(p.ws + WS_MODV); unsigned char* h2 = MOE_GATHER ? p.ws + WS_XG : (unsigned char*)p.out; const bf16* x1b = (const bf16*)(p.ws + WS_X1B);
    int* topi = (int*)(p.ws + WS_TOPI); float* topp = (float*)(p.ws + WS_TOPP);
    { int* st = (int*)(p.ws + WS_SLOT_TOK); float* sp = (float*)(p.ws + WS_SLOT_P);
      for (int i = blockIdx.x * NTHREADS + tid; i < NG * MAXSLOT; i += gridDim.x * NTHREADS) { st[i] = -1; sp[i] = 0.f; } }
    for (int r0 = blockIdx.x * 256; r0 < T; r0 += gridDim.x * 256) {
        const int b = r0 >> 12;
        const float* shp = modv + b * NMOD + 3 * D; const float* scp = modv + b * NMOD + 4 * D;
        __syncthreads();
        { float ca0 = 0.f, ca1 = 0.f, ca2 = 0.f, ca3 = 0.f; const int e4 = tid & 7;
#pragma unroll 4
          for (int it = 0; it < 16; ++it) { const int i4 = tid + NTHREADS * it, k = i4 >> 3;
              const f32x4 wv = ((const f32x4*)p.w_router)[i4]; const float gk = p.norm_ffn_g[k] * (1.0f + scp[k]), sk = shp[k];
              wp[(4 * e4 + 0) * 1028 + k] = wv.x * gk; wp[(4 * e4 + 1) * 1028 + k] = wv.y * gk;
              wp[(4 * e4 + 2) * 1028 + k] = wv.z * gk; wp[(4 * e4 + 3) * 1028 + k] = wv.w * gk;
              ca0 += sk * wv.x; ca1 += sk * wv.y; ca2 += sk * wv.z; ca3 += sk * wv.w; }
#pragma unroll
          for (int m = 8; m < 64; m <<= 1) { ca0 += __shfl_xor(ca0, m); ca1 += __shfl_xor(ca1, m); ca2 += __shfl_xor(ca2, m); ca3 += __shfl_xor(ca3, m); }
          if (lane < 8) { part[wave * 32 + 4 * lane + 0] = ca0; part[wave * 32 + 4 * lane + 1] = ca1; part[wave * 32 + 4 * lane + 2] = ca2; part[wave * 32 + 4 * lane + 3] = ca3; } }
        if (tid < NG * 32) lcnt[tid] = 0;
        __syncthreads();
        if (tid < 32) { float s = p.b_router[tid];
#pragma unroll
            for (int w = 0; w < 8; ++w) s += part[w * 32 + tid];
            cb[tid] = s; }
        const int rw = r0 + 32 * wave;
        { f32x4 gs[4], s1[4];
#pragma unroll
          for (int j = 0; j < 4; ++j) { const f32x4 gg = ((const f32x4*)p.norm_ffn_g)[lane + 64 * j], s2 = ((const f32x4*)scp)[lane + 64 * j];
              gs[j] = gg * (1.0f + s2); s1[j] = ((const f32x4*)shp)[lane + 64 * j]; }
          f32x4 nx[4];
          { const v2u* xr = (const v2u*)(x1b + (size_t)rw * D) + lane;
#pragma unroll
            for (int j = 0; j < 4; ++j) nx[j] = ldx4(xr[64 * j]); }
          for (int t = 0; t < 32; ++t) {
              const int r = rw + t;
              f32x4 v[4]; float s = 0.f;
#pragma unroll
              for (int j = 0; j < 4; ++j) { v[j] = nx[j]; s += (v[j].x * v[j].x + v[j].y * v[j].y) + (v[j].z * v[j].z + v[j].w * v[j].w); }
              if (t + 1 < 32) { const v2u* xr = (const v2u*)(x1b + (size_t)(r + 1) * D) + lane;
#pragma unroll
                  for (int j = 0; j < 4; ++j) nx[j] = ldx4(xr[64 * j]); }
              const float rstd = rsqrtf_(wave_sum(s) * (1.f / D) + EPS);
              if (lane == 0) rs[32 * wave + t] = rstd;
              unsigned* o8 = (unsigned*)(h2 + (size_t)r * D) + lane;
#pragma unroll
              for (int j = 0; j < 4; ++j) { v[j] = v[j] * rstd * gs[j] + s1[j]; o8[64 * j] = pk4f8(v[j].x, v[j].y, v[j].z, v[j].w); }
          } }
        __syncthreads();
        const int n = lane & 15, q = lane >> 4;
#pragma unroll 1
        for (int tt = 0; tt < 2; ++tt) {
            const int tb = rw + 16 * tt;
            const v4u* xr = (const v4u*)(x1b + (size_t)(tb + n) * D) + q;
            const LAS float* w0 = wp + n * 1028 + 8 * q; const LAS float* w1 = w0 + 16 * 1028;
            f32x4 acc0 = {0.f, 0.f, 0.f, 0.f}, acc1 = {0.f, 0.f, 0.f, 0.f};
            v4u xa[8], xb[8];
#pragma unroll
            for (int i = 0; i < 8; ++i) xa[i] = xr[4 * i];
#define FFN_MF(xf, wa, wb) acc0 = __builtin_amdgcn_mfma_f32_16x16x4f32((xf), (wa), acc0, 0, 0, 0); acc1 = __builtin_amdgcn_mfma_f32_16x16x4f32((xf), (wb), acc1, 0, 0, 0);
#define FFN_GRP(X, g) _Pragma("unroll") for (int i = 0; i < 8; ++i) { const int sp_ = 8 * (g) + i; \
                const f32x4 wv0a = *(const LAS f32x4*)(w0 + 32 * sp_), wv0b = *(const LAS f32x4*)(w0 + 32 * sp_ + 4), wv1a = *(const LAS f32x4*)(w1 + 32 * sp_), wv1b = *(const LAS f32x4*)(w1 + 32 * sp_ + 4); \
                FFN_MF(bflo(X[i].x), wv0a.x, wv1a.x) FFN_MF(bfhi(X[i].x), wv0a.y, wv1a.y) FFN_MF(bflo(X[i].y), wv0a.z, wv1a.z) FFN_MF(bfhi(X[i].y), wv0a.w, wv1a.w) \
                FFN_MF(bflo(X[i].z), wv0b.x, wv1b.x) FFN_MF(bfhi(X[i].z), wv0b.y, wv1b.y) FFN_MF(bflo(X[i].w), wv0b.z, wv1b.z) FFN_MF(bfhi(X[i].w), wv0b.w, wv1b.w) }
#pragma unroll 1
            for (int g = 0; g < 4; g += 2) {
#pragma unroll
                for (int i = 0; i < 8; ++i) xb[i] = xr[4 * (8 * (g + 1) + i)];
                FFN_GRP(xa, g)
                if (g + 2 < 4) {
#pragma unroll
                    for (int i = 0; i < 8; ++i) xa[i] = xr[4 * (8 * (g + 2) + i)]; }
                FFN_GRP(xb, g + 1)
            }
#undef FFN_MF
            const float c0 = cb[n], c1 = cb[16 + n];
            float v0[4], v1[4];
#pragma unroll
            for (int j = 0; j < 4; ++j) { const float rsd = rs[32 * wave + 16 * tt + 4 * q + j]; v0[j] = acc0[j] * rsd + c0; v1[j] = acc1[j] * rsd + c1; }
#pragma unroll
            for (int j = 0; j < 4; ++j) {
                int sel[4]; float val[4];
#pragma unroll
                for (int k = 0; k < 4; ++k) {
                    float bv; int bi;
                    if (v1[j] > v0[j]) { bv = v1[j]; bi = 16 + n; } else { bv = v0[j]; bi = n; }
                    AMAX_STEP(bv, bi, 0xB1) AMAX_STEP(bv, bi, 0x4E) AMAX_STEP(bv, bi, 0x141) AMAX_STEP(bv, bi, 0x140)
                    sel[k] = bi; val[k] = bv;
                    v0[j] = (bi == n) ? -3.0e38f : v0[j]; v1[j] = (bi == 16 + n) ? -3.0e38f : v1[j];
                }
                float pe[4], ps = 0.f;
#pragma unroll
                for (int k = 0; k < 4; ++k) { pe[k] = __expf(val[k] - val[0]); ps += pe[k]; }
                if (n < 4) { const int r = tb + 4 * q + j;
                    const int e = n == 0 ? sel[0] : (n == 1 ? sel[1] : (n == 2 ? sel[2] : sel[3])); const float pv = (n == 0 ? pe[0] : (n == 1 ? pe[1] : (n == 2 ? pe[2] : pe[3]))) / ps;
                    topi[r * 4 + n] = e; topp[r * 4 + n] = pv; lds_add(&lcnt[(r / TG) * 32 + e], 1); }
            }
        }
        __syncthreads();
        if (tid < NG * 32) { const int v = lcnt[tid]; if (v) atomicAdd((int*)(p.ws + WS_CTL) + CW_CNT + tid, v); }
    }
}

__device__ __forceinline__ void phase_route(const P& p, LAS unsigned char* lds) {
    const int tid = threadIdx.x;
    LAS int* seg = (LAS int*)lds;
    LAS int* lcnt = seg + 64; LAS int* gb = lcnt + 32;
    int* ctl = (int*)(p.ws + WS_CTL);
    int* tile_e = (int*)(p.ws + WS_TILE_E);
    if (tid < 64) {
        const int c = __hip_atomic_load(ctl + CW_CNT + tid, __ATOMIC_RELAXED, __HIP_MEMORY_SCOPE_AGENT); const int padded = (c + 255) & ~255;
        int incl = padded;
#pragma unroll
        for (int d = 1; d < 32; d <<= 1) { const int t = __shfl_up(incl, d, 32); if ((tid & 31) >= d) incl += t; }
        const int start = incl - padded; seg[tid] = start;
        if (blockIdx.x == 0) { for (int t = start >> 8; t < (start + padded) >> 8; ++t) tile_e[(tid >> 5) * MAXTILE + t] = tid & 31;
            if ((tid & 31) == 31) ctl[CW_NTILE + (tid >> 5)] = incl >> 8; }
    }
    __syncthreads();
    const int* topi = (const int*)(p.ws + WS_TOPI); const float* topp = (const float*)(p.ws + WS_TOPP);
    int* slot_tok = (int*)(p.ws + WS_SLOT_TOK); float* slot_p = (float*)(p.ws + WS_SLOT_P); int* tokslot = (int*)(p.ws + WS_TOKSLOT);
    for (int base = blockIdx.x * 256; base < T; base += gridDim.x * 256) {
        const int g = base / TG;
        if (tid < 32) lcnt[tid] = 0;
        __syncthreads();
        int e2[2], lp[2];
#pragma unroll
        for (int jj = 0; jj < 2; ++jj) { const int i = tid + 512 * jj; e2[jj] = topi[base * 4 + i]; lp[jj] = lds_add(&lcnt[e2[jj]], 1); }
        __syncthreads();
        if (tid < 32) gb[tid] = lcnt[tid] ? atomicAdd(ctl + CW_CUR + g * 32 + tid, lcnt[tid]) : 0;
        __syncthreads();
#pragma unroll
        for (int jj = 0; jj < 2; ++jj) { const int i = tid + 512 * jj; const int slot = seg[g * 32 + e2[jj]] + gb[e2[jj]] + lp[jj];
            slot_tok[g * MAXSLOT + slot] = base + (i >> 2); slot_p[g * MAXSLOT + slot] = topp[base * 4 + i]; tokslot[base * 4 + i] = slot; }
        __syncthreads();
        if (!MOE_GATHER) { const int wave = tid >> 6, lane = tid & 63; const unsigned char* h2 = (const unsigned char*)p.out; unsigned char* xg = p.ws + WS_XG + (size_t)g * MAXSLOT * D;
          for (int i0 = wave * 128; i0 < wave * 128 + 128; i0 += 8) { int sl[8]; v4u rw[8];
#pragma unroll
              for (int j = 0; j < 8; ++j) sl[j] = tokslot[base * 4 + i0 + j];
#pragma unroll
              for (int j = 0; j < 8; ++j) rw[j] = *(const v4u*)(h2 + (size_t)(base + ((i0 + j) >> 2)) * D + lane * 16);
#pragma unroll
              for (int j = 0; j < 8; ++j) *(v4u*)(xg + (size_t)sl[j] * D + lane * 16) = rw[j]; } }
        __syncthreads();
    }
}

__device__ __forceinline__ void phase_combine(const P& p, int g) {
    const int tid = threadIdx.x, lane = tid & 63, wave = tid >> 6;
    const int gw = blockIdx.x * NWAVES + wave, NGW = gridDim.x * NWAVES;
    const float* modv = (const float*)(p.ws + WS_MODV); const bf16* ys = (const bf16*)(p.ws + WS_YSLOT); const int* tokslot = (const int*)(p.ws + WS_TOKSLOT); const bf16* x1b = (const bf16*)(p.ws + WS_X1B);
    int nsl[4]; f32x4 nx[4];
    { const int r0 = g * TG + gw; if (r0 < (g + 1) * TG) { const v2u* xr0 = (const v2u*)(x1b + (size_t)r0 * D) + lane;
#pragma unroll
        for (int k = 0; k < 4; ++k) nsl[k] = tokslot[r0 * 4 + k];
#pragma unroll
        for (int j = 0; j < 4; ++j) nx[j] = ldx4(xr0[64 * j]); } }
    for (int r = g * TG + gw; r < (g + 1) * TG; r += NGW) {
        const int b = r >> 12;
        f32x4* xr = (f32x4*)(p.out + (size_t)r * D) + lane;
        const f32x4* g2 = (const f32x4*)(modv + b * NMOD + 5 * D) + lane;
        unsigned yw[4][4];
#pragma unroll
        for (int k = 0; k < 4; ++k) { const unsigned* yr = (const unsigned*)((const unsigned char*)ys + (size_t)nsl[k] * D) + lane;
#pragma unroll
            for (int j = 0; j < 4; ++j) yw[k][j] = yr[64 * j]; }
        f32x4 xc[4];
#pragma unroll
        for (int j = 0; j < 4; ++j) xc[j] = nx[j];
        if (r + NGW < (g + 1) * TG) { const v2u* xn = (const v2u*)(x1b + (size_t)(r + NGW) * D) + lane;
#pragma unroll
            for (int k = 0; k < 4; ++k) nsl[k] = tokslot[(r + NGW) * 4 + k];
#pragma unroll
            for (int j = 0; j < 4; ++j) nx[j] = ldx4(xn[64 * j]); }
        f32x4 y[4];
#pragma unroll
        for (int j = 0; j < 4; ++j) y[j] = (f32x4){0.f, 0.f, 0.f, 0.f};
#pragma unroll
        for (int k = 0; k < 4; ++k)
#pragma unroll
            for (int j = 0; j < 4; ++j) { const int w = (int)yw[k][j]; y[j].x += __builtin_amdgcn_cvt_f32_fp8(w, 0); y[j].y += __builtin_amdgcn_cvt_f32_fp8(w, 1); y[j].z += __builtin_amdgcn_cvt_f32_fp8(w, 2); y[j].w += __builtin_amdgcn_cvt_f32_fp8(w, 3); }
        f32x4 v[4]; float s = 0.f;
#pragma unroll
        for (int j = 0; j < 4; ++j) { v[j] = xc[j] + (0.0625f * g2[64 * j]) * y[j]; s += (v[j].x * v[j].x + v[j].y * v[j].y) + (v[j].z * v[j].z + v[j].w * v[j].w); }
        const float rstd = rsqrtf_(wave_sum(s) * (1.f / D) + EPS);
        const f32x4* fg = (const f32x4*)p.final_norm_g + lane;
#pragma unroll
        for (int j = 0; j < 4; ++j) xr[64 * j] = v[j] * rstd * fg[64 * j];
    }
}

constexpr int N_PHASES = 11 + 2 * NG;
template <int PH>
__device__ __forceinline__ void run_phase(const P& p, LAS unsigned char* lds) {
    const int G = gridDim.x, c = blockIdx.x;
    unsigned char* ws = p.ws;
    if constexpr (PH == 0) phase_prologue(p, lds);
    else if constexpr (PH == 1) phase_norm1(p);
    else if constexpr (PH == 2) { EpiG1 E{(bf16*)(ws + WS_QKVA), (bf16*)(ws + WS_PB), (float*)(ws + WS_SMALL)};
        if constexpr (G1_NF8 > 0) { pg8::SchedDense S8{TT / 256, G1_NF8, G, c}; pg8::gemm_phase<EpiG1, pg8::SchedDense, true>(lds, (const bf16*)(ws + WS_H8), (const bf16*)(ws + WS_BT_S8), D / 2, S8, E); }
        if constexpr (G1_NF8 < N_S / 256) { pg8::SchedDense S{TT / 256, N_S / 256 - G1_NF8, G, c, G1_NF8}; pg8::gemm_phase(lds, (const bf16*)(ws + WS_H), (const bf16*)(ws + WS_BT_S), D, S, E); } }
    else if constexpr (PH == 3) phase_conv(p, lds);
    else if constexpr (PH == 4) phase_scan(p, lds);
    else if constexpr (PH == 5) { pg8::SchedDense S{T / 256, N_G / 256, G, c}; EpiG2 E{(const bf16*)p.out, (bf16*)(ws + WS_YA_IN), (bf16*)(ws + WS_YB_IN), (bf16*)(ws + WS_GATES), p.gla_norm_g, (LAS float*)(lds + 131072), (const bf16*)(ws + WS_OB2)};
        if constexpr (FP8_G2) pg8::gemm_phase<EpiG2, pg8::SchedDense, true>(lds, (const bf16*)(ws + WS_H8), (const bf16*)(ws + WS_BT_G8), D / 2, S, E);
        else pg8::gemm_phase(lds, (const bf16*)(ws + WS_H), (const bf16*)(ws + WS_BT_G), D, S, E); }
    else if constexpr (PH == 6) { phase_wconv(p, lds, 1, blockIdx.x, gridDim.x); __syncthreads();
        pg8::SchedDense S{T / 256, 4, G, c};
        { EpiG34<0> E{(const bf16*)(ws + WS_GATES), (bf16*)(ws + WS_Y)}; pg8::gemm_phase(lds, (const bf16*)(ws + WS_YA_IN), (const bf16*)(ws + WS_BT_OA), D, S, E); }
        asm volatile("s_waitcnt vmcnt(0)" ::: "memory"); __syncthreads();
        { EpiG34<1> E{(const bf16*)(ws + WS_GATES), (bf16*)(ws + WS_Y)}; pg8::gemm_phase(lds, (const bf16*)(ws + WS_YB_IN), (const bf16*)(ws + WS_BT_OB), D, S, E); } }
    else if constexpr (PH == 7) { pg8::SchedDense S{T / 256, 4, G, c}; EpiG5 E{p.x, (const float*)(ws + WS_MODV), (bf16*)(ws + WS_X1B)};
        pg8::gemm_phase(lds, (const bf16*)(ws + WS_Y), (const bf16*)(ws + WS_BT_O), D, S, E); }
    else if constexpr (PH == 8) phase_ffnprep(p, lds);
    else if constexpr (PH == 9) phase_route(p, lds);
    else if constexpr (PH == 10 + 2 * NG) phase_combine(p, NG - 1);
    else {
        constexpr int g = (PH - 10) / 2, sub = (PH - 10) % 2;
        const int ntile = ((const int*)(ws + WS_CTL))[CW_NTILE + g];
        const int* tile_e = (const int*)(ws + WS_TILE_E) + g * MAXTILE;
        if constexpr (sub == 0) { EpiGU E{p.b_gu, (bf16*)(ws + WS_ACT)};
            if constexpr (MOE_GATHER) { pg8::SchedMoe S{ntile, 8, G, c, tile_e, (const int*)(ws + WS_SLOT_TOK) + g * MAXSLOT, 0};
                pg8::gemm_phase<EpiGU, pg8::SchedMoe, true>(lds, (const bf16*)(ws + WS_XG), (const bf16*)ws, D / 2, S, E); }
            else { pg8::SchedMoeDense S{ntile, 8, G, c, tile_e, 0};
                pg8::gemm_phase<EpiGU, pg8::SchedMoeDense, true>(lds, (const bf16*)(ws + WS_XG + (size_t)g * MAXSLOT * D), (const bf16*)ws, D / 2, S, E); }
            if constexpr (g > 0) phase_combine(p, g - 1); }
        else { pg8::SchedMoeDense S{ntile, 4, G, c, tile_e, 1}; EpiDN E{p.b_down, (const float*)(ws + WS_SLOT_P) + g * MAXSLOT, (bf16*)(ws + WS_YSLOT)};
            pg8::gemm_phase<EpiDN, pg8::SchedMoeDense, true>(lds, (const bf16*)(ws + WS_ACT), (const bf16*)ws, D / 2, S, E); }
    }
}

#ifndef PROBE_DUP_MASK
#define PROBE_DUP_MASK 0u
#endif
#if MK_FUSED
template <int PH>
__device__ __forceinline__ void run_from(const P& p, LAS unsigned char* lds, const XcdBarrier& bar) {
    if constexpr (PH < N_PHASES) { run_phase<PH>(p, lds);
        if constexpr ((PROBE_DUP_MASK >> PH) & 1u) { xcd_barrier(bar); run_phase<PH>(p, lds); }
        if constexpr (PH + 1 < N_PHASES) xcd_barrier(bar); run_from<PH + 1>(p, lds, bar); }
}
__global__ void __launch_bounds__(NTHREADS, 2) k_fused(P p) {
    extern __shared__ __attribute__((aligned(16))) unsigned char lds_raw[];
    LAS unsigned char* lds = (LAS unsigned char*)lds_raw;
    volatile LAS unsigned* misc = (volatile LAS unsigned*)(lds + 144 * 1024 - 64);
    if (threadIdx.x < 4) misc[threadIdx.x] = 0u;
    __syncthreads();
    XcdBarrier bar = xcd_barrier_post((unsigned*)(p.ws + WS_CTL) + CW_BAR, misc);
    run_from<0>(p, lds, bar);
}
#else
template <int PH>
__global__ void __launch_bounds__(NTHREADS, 2) k_phase(P p) {
    extern __shared__ __attribute__((aligned(16))) unsigned char lds_raw[];
    run_phase<PH>(p, (LAS unsigned char*)lds_raw);
}
template <int PH>
static void launch_all(const P& p, int grid, hipStream_t stream) {
    if constexpr (PH < N_PHASES) {
        static bool attr = false;
        if (!attr) { (void)hipFuncSetAttribute((const void*)k_phase<PH>, hipFuncAttributeMaxDynamicSharedMemorySize, LDS_BYTES); attr = true; }
        hipLaunchKernelGGL(k_phase<PH>, dim3(grid), dim3(NTHREADS), LDS_BYTES, stream, p);
        launch_all<PH + 1>(p, grid, stream);
    }
}
#endif

extern "C" void kernel_launch(void* const* d_in, const int* in_sizes, int n_in, void* d_out, int out_size, void* d_ws, size_t ws_size, hipStream_t stream) {
    static int grid = 0;
    if (grid == 0) {
        if (n_in != 30 || in_sizes[0] != T * D || out_size != T * D || ws_size < WS_END) { fprintf(stderr, "kernel_launch: unexpected shapes (n_in %d, in0 %d, out %d, ws %zu)\n", n_in, n_in > 0 ? in_sizes[0] : -1, out_size, ws_size); grid = -1; return; }
        int dev = 0, cus = 0;
        if (hipGetDevice(&dev) != hipSuccess || hipDeviceGetAttribute(&cus, hipDeviceAttributeMultiprocessorCount, dev) != hipSuccess) { grid = -1; return; }
#if MK_FUSED
        if (hipFuncSetAttribute((const void*)k_fused, hipFuncAttributeMaxDynamicSharedMemorySize, LDS_BYTES) != hipSuccess) { fprintf(stderr, "kernel_launch: hipFuncSetAttribute failed\n"); grid = -1; return; }
        int per_cu = 0;
        if (hipOccupancyMaxActiveBlocksPerMultiprocessor(&per_cu, (const void*)k_fused, NTHREADS, LDS_BYTES) != hipSuccess || per_cu < 1) fprintf(stderr, "kernel_launch: occupancy query reports %d\n", per_cu);
        (void)hipGetLastError();
#endif
        grid = cus;
    }
    if (grid < 0) return;
    (void)hipMemsetAsync((char*)d_ws + WS_CTL, 0, CTL_BYTES, stream);
    P p{};
    const float** pp = (const float**)&p;
    for (int i = 0; i < 30; ++i) pp[i] = (const float*)d_in[i];
    p.out = (float*)d_out; p.ws = (unsigned char*)d_ws;
#ifdef PROBE_SCAN_KIND
    p.probe = PROBE_SCAN_KIND;
#endif
#if MK_FUSED
    hipLaunchKernelGGL(k_fused, dim3(grid), dim3(NTHREADS), LDS_BYTES, stream, p);
#else
    launch_all<0>(p, grid, stream);
#endif
}
```

```cpp
#include <hip/hip_runtime.h>
#include <cstdio>
#include <cstdint>

#ifndef MK_FUSED
#define MK_FUSED 1
#endif
#ifndef FP8_G1
#define FP8_G1 1
#endif
#define G1_NF8 (FP8_G1 == 0 ? 0 : (FP8_G1 == 1 ? 21 : (FP8_G1 == 2 ? 12 : 20)))
#ifndef MOE_GATHER
#define MOE_GATHER 1
#endif
#ifndef FP8_G2
#define FP8_G2 1
#endif

#define GAS __attribute__((address_space(1)))
#define LAS __attribute__((address_space(3)))
typedef unsigned short bf16;
typedef unsigned v4u __attribute__((ext_vector_type(4)));
typedef unsigned v2u __attribute__((ext_vector_type(2)));
typedef float f32x4 __attribute__((ext_vector_type(4)));
typedef short bf16x8 __attribute__((ext_vector_type(8)));

constexpr int D = 1024, NB = 16, SEQ = 4096, T = NB * SEQ, CTXL = 256, TC = NB * CTXL, TT = T + TC;
constexpr int D_IN = 9280, N_S = 5376, N_G = 4096, NMOD = 6 * D;
constexpr int NE = 32, NG = 1, TG = T / NG, MAXSLOT = TG * 4 + NE * 256, MAXTILE = MAXSLOT / 256;
constexpr float EPS = 1e-6f;
constexpr int NTHREADS = 512, NWAVES = 8;
constexpr int LDS_BYTES = 147456;

constexpr size_t MiB = 1u << 20;
constexpr size_t WS_CTL = 0, CTL_BYTES = 1 * MiB;
constexpr size_t WS_MODV = 1 * MiB, WS_BT_S = 2 * MiB, WS_BT_G = 13 * MiB, WS_BT_OA = 21 * MiB, WS_BT_OB = 23 * MiB, WS_BT_O = 25 * MiB;
constexpr size_t WS_TOPI = 27 * MiB, WS_TOPP = 28 * MiB, WS_TOKSLOT = 29 * MiB, WS_SLOT_TOK = 30 * MiB, WS_SLOT_P = 32 * MiB, WS_TILE_E = 34 * MiB;
constexpr size_t WS_H8 = 880 * MiB, WS_BT_S8 = 976 * MiB, WS_BT_G8 = 984 * MiB;
constexpr size_t WS_H = 40 * MiB, WS_PB = 176 * MiB, WS_SMALL = 448 * MiB, WS_QKVA = 465 * MiB;
constexpr size_t WS_YA_IN = 240 * MiB, WS_YB_IN = 368 * MiB, WS_GATES = 496 * MiB, WS_Y = 752 * MiB;
constexpr size_t WS_X1B = 40 * MiB;
__host__ __device__ __forceinline__ constexpr int wb_dn_mib(int e) { return e < 28 ? 948 + e : 960 + e; }
constexpr int EARLY_GU = 15;
__host__ __device__ __forceinline__ constexpr int wb_gu_mib(int e) { return e < 8 ? 992 + 2 * e : (e < EARLY_GU ? 2 * e - 14 : 880 + 2 * (e - EARLY_GU)); }
constexpr size_t WS_H2 = 40 * MiB, WS_XG = 200 * MiB, WS_ACT = (NG == 1 ? 264 : 472) * MiB, WS_YSLOT = 608 * MiB, WS_END = 1008 * MiB;
static_assert(WS_QKVA + (size_t)TT * 3072 * 2 <= 873 * MiB && WS_SMALL + (size_t)TT * 64 * 4 <= WS_QKVA && WS_H + (size_t)TT * D * 2 <= WS_PB, "ws map");
static_assert(WS_XG + (size_t)T * D <= WS_ACT && WS_ACT + (size_t)MAXSLOT * D <= WS_YSLOT && WS_YSLOT + (size_t)MAXSLOT * D <= 880 * MiB && MOE_GATHER == 1 && (size_t)(wb_gu_mib(7) + 2) * MiB <= WS_END && wb_gu_mib(NE - 1) + 2 <= 948 && (EARLY_GU <= 8 || wb_gu_mib(EARLY_GU - 1) + 2 <= 21) && WS_H2 + (size_t)T * D <= WS_XG && WS_QKVA + (size_t)TT * 3072 * 2 <= 880 * MiB, "ws map 2");
constexpr int CW_BAR = 4096, CW_CNT = 8192, CW_CUR = 8192 + 256, CW_NTILE = 8192 + 512;

#define LDS_WAIT() asm volatile("s_waitcnt lgkmcnt(0)" ::: "memory")
#define VM_WAIT() asm volatile("s_waitcnt vmcnt(0)" ::: "memory")
__device__ __forceinline__ float bflo(unsigned u) { return __uint_as_float(u << 16); }
__device__ __forceinline__ float bfhi(unsigned u) { return __uint_as_float(u & 0xffff0000u); }
__device__ __forceinline__ unsigned pk2(float lo, float hi) { unsigned r; asm("v_cvt_pk_bf16_f32 %0, %1, %2" : "=v"(r) : "v"(lo), "v"(hi)); return r; }
__device__ __forceinline__ float wave_sum(float x) {
    x += __builtin_bit_cast(float, __builtin_amdgcn_update_dpp(0, __builtin_bit_cast(int, x), 0xB1, 0xF, 0xF, true));
    x += __builtin_bit_cast(float, __builtin_amdgcn_update_dpp(0, __builtin_bit_cast(int, x), 0x4E, 0xF, 0xF, true));
    x += __builtin_bit_cast(float, __builtin_amdgcn_update_dpp(0, __builtin_bit_cast(int, x), 0x141, 0xF, 0xF, true));
    x += __builtin_bit_cast(float, __builtin_amdgcn_update_dpp(0, __builtin_bit_cast(int, x), 0x140, 0xF, 0xF, true));
    { float a = x, b = x; asm volatile("s_nop 1\n\tv_permlane16_swap_b32 %0, %1" : "+v"(a), "+v"(b)); x = a + b; }
    { float a = x, b = x; asm volatile("s_nop 1\n\tv_permlane32_swap_b32 %0, %1" : "+v"(a), "+v"(b)); x = a + b; }
    return x;
}
__device__ __forceinline__ float row16_sum(float x) {
    x += __builtin_bit_cast(float, __builtin_amdgcn_update_dpp(0, __builtin_bit_cast(int, x), 0xB1, 0xF, 0xF, true));
    x += __builtin_bit_cast(float, __builtin_amdgcn_update_dpp(0, __builtin_bit_cast(int, x), 0x4E, 0xF, 0xF, true));
    x += __builtin_bit_cast(float, __builtin_amdgcn_update_dpp(0, __builtin_bit_cast(int, x), 0x141, 0xF, 0xF, true));
    x += __builtin_bit_cast(float, __builtin_amdgcn_update_dpp(0, __builtin_bit_cast(int, x), 0x140, 0xF, 0xF, true));
    return x;
}
__device__ __forceinline__ int lds_add(LAS int* p, int v) { return __hip_atomic_fetch_add(p, v, __ATOMIC_RELAXED, __HIP_MEMORY_SCOPE_WORKGROUP); }
__device__ __forceinline__ float sigmoidf_(float x) { return 1.0f / (1.0f + __expf(-x)); }
__device__ __forceinline__ float siluf_(float x) { return x / (1.0f + __expf(-x)); }
__device__ __forceinline__ float sigmoid_fast(float x) { return __builtin_amdgcn_rcpf(1.0f + __builtin_amdgcn_exp2f(-1.44269504f * x)); }
__device__ __forceinline__ float silu_fast(float x) { return x * __builtin_amdgcn_rcpf(1.0f + __builtin_amdgcn_exp2f(-1.44269504f * x)); }
__device__ __forceinline__ float rsqrtf_(float x) { return __builtin_amdgcn_rsqf(x); }
__device__ __forceinline__ float softplusf_(float x) { return fmaxf(x, 0.f) + 0.69314718f * __builtin_amdgcn_logf(1.0f + __builtin_amdgcn_exp2f(-1.44269504f * fabsf(x))); }
__device__ __forceinline__ void unpack8(const v4u w, float (&f)[8]) {
    f[0] = bflo(w.x); f[1] = bfhi(w.x); f[2] = bflo(w.y); f[3] = bfhi(w.y); f[4] = bflo(w.z); f[5] = bfhi(w.z); f[6] = bflo(w.w); f[7] = bfhi(w.w);
}
__device__ __forceinline__ v4u pack8(const float (&f)[8]) { v4u w; w.x = pk2(f[0], f[1]); w.y = pk2(f[2], f[3]); w.z = pk2(f[4], f[5]); w.w = pk2(f[6], f[7]); return w; }

__device__ __forceinline__ unsigned pk4f8(float a, float b, float c, float d) { int w = __builtin_amdgcn_cvt_pk_fp8_f32(a, b, 0, false); w = __builtin_amdgcn_cvt_pk_fp8_f32(c, d, w, true); return (unsigned)w; }
struct P {
    const float *x, *c, *ctx, *c_ctx, *w_mod, *b_mod, *norm_mix_g, *norm_ffn_g, *w_in, *conv_w, *a_log_f, *a_log_b, *dt_bias_f, *dt_bias_b, *gdn_norm_g,
        *gla_gate_w_f, *gla_gate_w_b, *gla_gate_b_f, *gla_gate_b_b, *gla_norm_g, *w_out_a, *w_out_b, *w_out, *w_router, *b_router, *w_gu, *b_gu, *w_down, *b_down, *final_norm_g;
    float* out; unsigned char* ws; int probe; int pad_;
};

typedef float f32x2_t __attribute__((ext_vector_type(2)));
namespace pg8 {
constexpr int BM = 256, BK = 64, HALF = 128, HTB = HALF * BK * 2, STAGE_BYTES = 8 * HTB, NXCD = 8, WGM = 8;
__host__ __device__ __forceinline__ int lds_byte(int r, int c) { const int m = r >> 4, fr = r & 15, ch = c >> 3; return m * 2048 + (fr >> 3) * 1024 + (8 * (fr & 7) + (ch ^ (fr & 6))) * 16; }
__host__ __device__ __forceinline__ void stage_rc(int b, int& R, int& C) { const int blk = b / 1024, sl = (b % 1024) / 16, r7 = sl >> 3; R = blk * 8 + r7; C = ((sl & 7) ^ (r7 & 6)) * 8; }
__host__ __device__ __forceinline__ int perm32(int rho) { const int n = rho >> 4, i = rho & 15; return 8 * (i >> 2) + 4 * n + (i & 3); }
struct Unit { int pm, pn, bt, e; };

__device__ __forceinline__ void order_map(int L, int nM, int nN, int& pm, int& pn) {
    const int nwg = nM * nN; int wgid = L;
    { const int q = nwg / NXCD, r = nwg % NXCD, xcd = wgid % NXCD, off = wgid / NXCD; wgid = (xcd < r ? xcd * (q + 1) : r * (q + 1) + (xcd - r) * q) + off; }
    const int nig = WGM * nN, gid = wgid / nig, fm = gid * WGM, gsz = (nM - fm) < WGM ? (nM - fm) : WGM;
    pm = fm + ((wgid % nig) % gsz); pn = (wgid % nig) / gsz;
}
struct SchedDense {
    int nM, nN, G, c, pn0 = 0;
    __device__ __forceinline__ bool next(int i, Unit& u) const { const long L = (long)i * G + c; if (L >= (long)nM * nN) return false; order_map((int)L, nM, nN, u.pm, u.pn); u.pn += pn0; u.bt = u.pn; u.e = 0; return true; }
    __device__ __forceinline__ unsigned arow(const Unit& u, int r) const { return (unsigned)(u.pm * BM + r); }
};
struct SchedMoeDense {
    int nM, nN, G, c; const int* tile_e; int dn;
    __device__ __forceinline__ bool next(int i, Unit& u) const { const long L = (long)i * G + c; if (L >= (long)nM * nN) return false; order_map((int)L, nM, nN, u.pm, u.pn); u.e = tile_e[u.pm]; u.bt = 4 * (dn ? wb_dn_mib(u.e) : wb_gu_mib(u.e)) + u.pn; return true; }
    __device__ __forceinline__ unsigned arow(const Unit& u, int r) const { return (unsigned)(u.pm * BM + r); }
};
struct SchedMoe {
    int nM, nN, G, c; const int* tile_e; const int* slot_tok; int dn;
    __device__ __forceinline__ bool next(int i, Unit& u) const { const long L = (long)i * G + c; if (L >= (long)nM * nN) return false; order_map((int)L, nM, nN, u.pm, u.pn); u.e = tile_e[u.pm]; u.bt = 4 * (dn ? wb_dn_mib(u.e) : wb_gu_mib(u.e)) + u.pn; return true; }
    __device__ __forceinline__ unsigned arow(const Unit& u, int r) const { if (slot_tok) { const int t = slot_tok[u.pm * BM + r]; return (unsigned)(t < 0 ? 0 : t); } return (unsigned)(u.pm * BM + r); }
};

typedef float f32x2_z __attribute__((ext_vector_type(2)));
typedef int i32x8 __attribute__((ext_vector_type(8)));
typedef float f32x8_t __attribute__((ext_vector_type(8)));
typedef short s16x16 __attribute__((ext_vector_type(16)));
typedef int i32x4 __attribute__((ext_vector_type(4)));
__device__ __forceinline__ i32x8 ld32(const LAS unsigned char* p) { const i32x4 a = *(const LAS i32x4*)p, b = *(const LAS i32x4*)(p + 16); return __builtin_shufflevector(a, b, 0, 1, 2, 3, 4, 5, 6, 7); }
#ifndef PROBE_GDUP
#define PROBE_GDUP 0
#endif
template <class Epi, class Sched, bool FP8 = false>
__device__ __forceinline__ void gemm_phase(LAS unsigned char* lds, const bf16* A, const bf16* Bt, const int K, const Sched& S, const Epi& E) {
    int tid = threadIdx.x; asm volatile("" : "+v"(tid));
    const int wid = __builtin_amdgcn_readfirstlane(tid >> 6), lane = tid & 63, wr = wid >> 2, wc = wid & 3, fr = lane & 15, fq = lane >> 4;
    const int nt = K / BK;
    int R0, C0; stage_rc(tid * 16, R0, C0);
    unsigned voffB[2];
#pragma unroll
    for (int i = 0; i < 2; ++i) { const int R = R0 + 64 * i; const int Rb = (R & ~31) + perm32(R & 31); voffB[i] = (unsigned)(Rb * K + C0) * 2u; }
    const unsigned rowb = (unsigned)K * 2u, cofs = (unsigned)C0 * 2u;
    const size_t kstep = (size_t)(BK * 2);
    const size_t hstep = (size_t)HALF * K * 2;
    const size_t tstep = 2 * hstep;
    const unsigned ldsw = (unsigned)wid * 1024u;
    const int aoff = lds_byte(wr * 64 + fr, fq * 8), boff = lds_byte(wc * 32 + fr, fq * 8), aoff1 = lds_byte(wr * 64 + fr, fq * 8 + 32), boff1 = lds_byte(wc * 32 + fr, fq * 8 + 32);
    const unsigned addrA = (unsigned)(size_t)lds + (unsigned)aoff, addrB = (unsigned)(size_t)lds + 65536u + (unsigned)boff, addrA1 = (unsigned)(size_t)lds + (unsigned)aoff1, addrB1 = (unsigned)(size_t)lds + 65536u + (unsigned)boff1; (void)addrA; (void)addrB; (void)addrA1; (void)addrB1;
#define PG8_SA(b, h) (((b) * 2 + (h)) * HTB)
#define PG8_SB(b, h) ((4 + (b) * 2 + (h)) * HTB)
#define PG8_STAGE(bufoff, gbase, voff) do { _Pragma("unroll") for (int _i = 0; _i < 2; ++_i) \
        __builtin_amdgcn_global_load_lds((const unsigned*)((const char*)(gbase) + (voff)[_i]), (LAS unsigned*)(lds + (bufoff) + ldsw + _i * 8192), 16, 0, 0); } while (0)
#define PG8_STAGE_A(bufoff, gbase, o0, o1) do { \
        __builtin_amdgcn_global_load_lds((const unsigned*)((const char*)(gbase) + (o0)), (LAS unsigned*)(lds + (bufoff) + ldsw), 16, 0, 0); \
        __builtin_amdgcn_global_load_lds((const unsigned*)((const char*)(gbase) + (o1)), (LAS unsigned*)(lds + (bufoff) + ldsw + 8192), 16, 0, 0); } while (0)
#define F8_RD(rlo, rhi, rfull, var, addr, off) asm volatile("ds_read_b128 " rlo ", %1 offset:%3\n\tds_read_b128 " rhi ", %2 offset:%3" : "={" rfull "}"(var) : "v"(addr), "v"(addr##1), "i"(off))
#define PG8_LDA(dst, b, h) do { if constexpr (FP8) { \
            F8_RD("v[192:195]", "v[196:199]", "v[192:199]", dst##8[0], addrA, PG8_SA(b, h)); F8_RD("v[200:203]", "v[204:207]", "v[200:207]", dst##8[1], addrA, PG8_SA(b, h) + 2048); \
            F8_RD("v[208:211]", "v[212:215]", "v[208:215]", dst##8[2], addrA, PG8_SA(b, h) + 4096); F8_RD("v[216:219]", "v[220:223]", "v[216:223]", dst##8[3], addrA, PG8_SA(b, h) + 6144); } \
        else { _Pragma("unroll") for (int m = 0; m < 4; ++m) _Pragma("unroll") for (int k = 0; k < 2; ++k) dst[m][k] = *(const LAS bf16x8*)(lds + PG8_SA(b, h) + (k ? aoff1 : aoff) + m * 2048); } } while (0)
#define PG8_LDB0(b, h) do { if constexpr (FP8) { F8_RD("v[224:227]", "v[228:231]", "v[224:231]", B08[0], addrB, PG8_SB(b, h) - 65536); F8_RD("v[232:235]", "v[236:239]", "v[232:239]", B08[1], addrB, PG8_SB(b, h) - 65536 + 2048); } \
        else { _Pragma("unroll") for (int n = 0; n < 2; ++n) _Pragma("unroll") for (int k = 0; k < 2; ++k) B0[n][k] = *(const LAS bf16x8*)(lds + PG8_SB(b, h) + (k ? boff1 : boff) + n * 2048); } } while (0)
#define PG8_LDB1(b, h) do { if constexpr (FP8) { F8_RD("v[240:243]", "v[244:247]", "v[240:247]", B18[0], addrB, PG8_SB(b, h) - 65536); F8_RD("v[248:251]", "v[252:255]", "v[248:255]", B18[1], addrB, PG8_SB(b, h) - 65536 + 2048); } \
        else { _Pragma("unroll") for (int n = 0; n < 2; ++n) _Pragma("unroll") for (int k = 0; k < 2; ++k) B1[n][k] = *(const LAS bf16x8*)(lds + PG8_SB(b, h) + (k ? boff1 : boff) + n * 2048); } } while (0)
#define PG8_LDB(dst, b, h) PG8_LD##dst(b, h)
#define PG8_LDB0_X 0
#define PG8_MMA(ai, bj, At, Bt_) do { if (PROBE_GDUP == 3 && !(ui & 1)) break; __builtin_amdgcn_s_setprio(1); \
        if constexpr (FP8) { _Pragma("unroll") for (int m = 0; m < 4; ++m) _Pragma("unroll") for (int n = 0; n < 2; ++n) \
            acc[ai][bj][m][n] = __builtin_amdgcn_mfma_scale_f32_16x16x128_f8f6f4(Bt_##8[n], At##8[m], acc[ai][bj][m][n], 0, 0, 0, 0x79797979, 0, 0x7f7f7f7f); } \
        else { _Pragma("unroll") for (int m = 0; m < 4; ++m) _Pragma("unroll") for (int n = 0; n < 2; ++n) _Pragma("unroll") for (int k = 0; k < 2; ++k) \
            acc[ai][bj][m][n] = __builtin_amdgcn_mfma_f32_16x16x32_bf16(Bt_[n][k], At[m][k], acc[ai][bj][m][n], 0, 0, 0); } \
        __builtin_amdgcn_s_setprio(0); } while (0)
#define PG8_WAIT_V(n) asm volatile("s_waitcnt vmcnt(" #n ")" ::: "memory")
#define PG8_WAIT_L(n) do { if constexpr (FP8) asm volatile("s_waitcnt lgkmcnt(" #n ")" : "+{v[192:199]}"(At8[0]), "+{v[200:207]}"(At8[1]), "+{v[208:215]}"(At8[2]), "+{v[216:223]}"(At8[3]), "+{v[224:231]}"(B08[0]), "+{v[232:239]}"(B08[1]), "+{v[240:247]}"(B18[0]), "+{v[248:255]}"(B18[1]) :: "memory"); \
        else asm volatile("s_waitcnt lgkmcnt(" #n ")" ::: "memory"); } while (0)
#define PG8_BAR __builtin_amdgcn_s_barrier()
#define PG8_SCHED __builtin_amdgcn_sched_barrier(0)
    Unit cur, nxt; int ui = 0;
    if (!S.next(0, cur)) return;
    f32x4 acc[2][2][4][2];
#pragma unroll
    for (int a = 0; a < 2; ++a)
#pragma unroll
        for (int b = 0; b < 2; ++b)
#pragma unroll
            for (int m = 0; m < 4; ++m)
#pragma unroll
                for (int n = 0; n < 2; ++n) acc[a][b][m][n] = (f32x4){0.f, 0.f, 0.f, 0.f};
    bf16x8 At[4][2], B0[2][2], B1[2][2]; i32x8 At8[4] = {}, B08[2] = {}, B18[2] = {};
    const char* Ab = (const char*)A;
    const char* cB = (const char*)Bt + (size_t)cur.bt * tstep;
    unsigned c00 = S.arow(cur, R0) * rowb + cofs, c01 = S.arow(cur, R0 + 64) * rowb + cofs, c10 = S.arow(cur, HALF + R0) * rowb + cofs, c11 = S.arow(cur, HALF + R0 + 64) * rowb + cofs;
    unsigned n00, n01, n10, n11;
    PG8_STAGE(PG8_SB(0, 0), cB, voffB); PG8_STAGE(PG8_SB(0, 1), cB + hstep, voffB); PG8_STAGE_A(PG8_SA(0, 0), Ab, c00, c01); PG8_STAGE_A(PG8_SA(0, 1), Ab, c10, c11);
    if (wr == 1) PG8_BAR;
    PG8_WAIT_V(2); PG8_BAR;
    PG8_STAGE(PG8_SB(1, 0), cB + kstep, voffB); PG8_STAGE_A(PG8_SA(1, 0), Ab + kstep, c00, c01); PG8_STAGE(PG8_SB(1, 1), cB + hstep + kstep, voffB);
    PG8_WAIT_V(6); PG8_BAR;
    for (;;) {
        const bool has_next = S.next((ui + 1) >> (PROBE_GDUP ? 1 : 0), nxt);
        const char* nB = has_next ? (const char*)Bt + (size_t)nxt.bt * tstep : cB;
        if (has_next) { n00 = S.arow(nxt, R0) * rowb + cofs; n01 = S.arow(nxt, R0 + 64) * rowb + cofs; n10 = S.arow(nxt, HALF + R0) * rowb + cofs; n11 = S.arow(nxt, HALF + R0 + 64) * rowb + cofs; }
        else { n00 = c00; n01 = c01; n10 = c10; n11 = c11; }
#pragma unroll 1
        for (int t = 0; t < nt; t += 2) {
            const bool last = (t == nt - 2);
            const char* a1 = Ab + (size_t)(t + 1) * kstep;
            const char* a2 = last ? Ab : Ab + (size_t)(t + 2) * kstep; const char* b2 = last ? nB : cB + (size_t)(t + 2) * kstep;
            const char* a3 = a2 + kstep; const char* b3 = b2 + kstep;
            const unsigned x00 = last ? n00 : c00, x01 = last ? n01 : c01, x10 = last ? n10 : c10, x11 = last ? n11 : c11;
            PG8_LDB(B0, 0, 0); PG8_LDB(B1, 0, 1); PG8_SCHED; PG8_LDA(At, 0, 0); PG8_STAGE_A(PG8_SA(1, 1), a1, c10, c11);
            PG8_WAIT_V(8); PG8_WAIT_L(0); PG8_BAR; PG8_MMA(0, 0, At, B0); PG8_MMA(0, 1, At, B1); PG8_BAR; PG8_SCHED;
            PG8_LDA(At, 0, 1); PG8_STAGE(PG8_SB(0, 0), b2, voffB); PG8_STAGE(PG8_SB(0, 1), b2 + hstep, voffB); PG8_STAGE_A(PG8_SA(0, 0), a2, x00, x01);
            PG8_WAIT_V(8); PG8_WAIT_L(0); PG8_BAR; PG8_MMA(1, 0, At, B0); PG8_MMA(1, 1, At, B1); PG8_BAR; PG8_SCHED;
            PG8_LDB(B0, 1, 0); PG8_LDB(B1, 1, 1); PG8_SCHED; PG8_LDA(At, 1, 0); PG8_STAGE_A(PG8_SA(0, 1), a2, x10, x11);
            PG8_WAIT_V(8); PG8_WAIT_L(0); PG8_BAR; PG8_MMA(0, 0, At, B0); PG8_MMA(0, 1, At, B1); PG8_BAR; PG8_SCHED;
            PG8_LDA(At, 1, 1); PG8_STAGE(PG8_SB(1, 0), b3, voffB); PG8_STAGE(PG8_SB(1, 1), b3 + hstep, voffB); PG8_STAGE_A(PG8_SA(1, 0), a3, x00, x01);
            PG8_WAIT_V(8); PG8_WAIT_L(0); PG8_BAR; PG8_MMA(1, 0, At, B0); PG8_MMA(1, 1, At, B1); PG8_BAR; PG8_SCHED;
        }
        if (wr == 0) PG8_BAR;
        if ((PROBE_GDUP != 1 && PROBE_GDUP != 3) || (ui & 1)) { int tz = threadIdx.x; asm volatile("" : "+v"(tz)); const int ln = tz & 63; E(acc, cur, wr, wc, ln & 15, ln >> 4); }
        if (!has_next) break;
#pragma unroll
        for (int a = 0; a < 2; ++a)
#pragma unroll
            for (int b = 0; b < 2; ++b)
#pragma unroll
                for (int m = 0; m < 4; ++m)
#pragma unroll
                    for (int n = 0; n < 2; ++n) { f32x2_z z0, z1; asm volatile("v_pk_mov_b32 %0, 0, 0\n\tv_pk_mov_b32 %1, 0, 0" : "=v"(z0), "=v"(z1)); acc[a][b][m][n] = (f32x4){z0.x, z0.y, z1.x, z1.y}; }
        cur = nxt; cB = nB; c00 = n00; c01 = n01; c10 = n10; c11 = n11; ++ui;
        if (wr == 1) PG8_BAR;
    }
    PG8_WAIT_V(0);
    PG8_BAR;
#undef PG8_SA
#undef PG8_SB
#undef PG8_STAGE
#undef PG8_STAGE_A
#undef PG8_LDA
#undef PG8_LDB
#undef PG8_LDB0
#undef PG8_LDB1
#undef F8_RD
#undef PG8_MMA
#undef PG8_WAIT_V
#undef PG8_WAIT_L
#undef PG8_BAR
#undef PG8_SCHED
}
}
typedef f32x4 Acc[2][2][4][2];

#define XB_TMO      128
#define XB_XCNT(j)  (256  + 64 * (j))
#define XB_XSUB(j)  (1280 + 64 * (j))
#define XB_XGEN(j)  (2304 + 64 * (j))
#define XB_TOP      3328
#define XB_TOPGEN   3392
#define XCD_BAR_WORDS 3456
#define XB_SPIN_CAP (1u << 22)
__device__ __forceinline__ unsigned xb_ld(unsigned* p)              { return __hip_atomic_load(p, __ATOMIC_RELAXED, __HIP_MEMORY_SCOPE_AGENT); }
__device__ __forceinline__ unsigned xb_add(unsigned* p, unsigned v) { return __hip_atomic_fetch_add(p, v, __ATOMIC_RELAXED, __HIP_MEMORY_SCOPE_AGENT); }
__device__ __forceinline__ unsigned xb_xcc_id() { return (unsigned)__builtin_amdgcn_s_getreg((3 << 11) | 20) & 0xFu; }
#define XB_SPIN(cond, bar) do { unsigned _sp = 0; while (cond) { __builtin_amdgcn_s_sleep(1); \
    if ((++_sp & 255u) == 0u) { if (xb_ld(&(bar)[XB_TMO])) break; if (_sp > XB_SPIN_CAP) { atomicAdd(&(bar)[XB_TMO], 1u); break; } } } } while (0)
struct XcdBarrier { unsigned* bar; unsigned x; volatile LAS unsigned* st; };
__device__ __forceinline__ XcdBarrier xcd_barrier_post(unsigned* bar, volatile LAS unsigned* st) {
    XcdBarrier b; b.bar = bar; b.x = xb_xcc_id(); b.st = st;
    if (threadIdx.x == 0) (void)xb_add(&bar[XB_XCNT(b.x)], 1u);
    return b;
}
__device__ __forceinline__ void xcd_barrier_complete(unsigned* bar, unsigned x, unsigned& nloc, unsigned& nx) {
    const unsigned G = gridDim.x * gridDim.y * gridDim.z;
    unsigned sum, cnt, mine, sp = 0u;
    for (;;) {
        sum = 0u; cnt = 0u; mine = 0u;
#pragma unroll
        for (unsigned j = 0; j < 16; ++j) { const unsigned c = xb_ld(&bar[XB_XCNT(j)]); sum += c; cnt += (c > 0u) ? 1u : 0u; mine = (j == x) ? c : mine; }
        if (sum == G) break;
        __builtin_amdgcn_s_sleep(1);
        if ((++sp & 255u) == 0u) { if (xb_ld(&bar[XB_TMO])) break; if (sp > XB_SPIN_CAP) { atomicAdd(&bar[XB_TMO], 1u); break; } }
    }
    nloc = mine > 0u ? mine : 1u; nx = cnt > 0u ? cnt : 1u;
}
__device__ __forceinline__ void xcd_barrier(const XcdBarrier& b) {
    asm volatile("s_waitcnt vmcnt(0)" ::: "memory");
    __syncthreads();
    if (threadIdx.x == 0) {
        unsigned* bar = b.bar;
        __builtin_amdgcn_s_waitcnt(0);
        unsigned nloc = b.st[0], nx = b.st[1];
        if (nloc == 0u) { xcd_barrier_complete(bar, b.x, nloc, nx); b.st[0] = nloc; b.st[1] = nx; }
        const unsigned old = xb_add(&bar[XB_XSUB(b.x)], 1u);
        const unsigned gen = old / nloc;
        if (old + 1u == (gen + 1u) * nloc) {
            __builtin_amdgcn_fence(__ATOMIC_RELEASE, "agent");
            asm volatile("s_waitcnt vmcnt(0)" ::: "memory");
            const unsigned og = xb_add(&bar[XB_TOP], 1u);
            const unsigned tg = og / nx;
            if (og + 1u == (tg + 1u) * nx) xb_add(&bar[XB_TOPGEN], 1u);
            else XB_SPIN(xb_ld(&bar[XB_TOPGEN]) == tg, bar);
            __builtin_amdgcn_fence(__ATOMIC_ACQUIRE, "agent");
            xb_add(&bar[XB_XGEN(b.x)], 1u);
            asm volatile("s_waitcnt vmcnt(0)" ::: "memory");
        } else {
            XB_SPIN(xb_ld(&bar[XB_XGEN(b.x)]) == gen, bar);
            __builtin_amdgcn_fence(__ATOMIC_ACQUIRE, "agent");
            asm volatile("s_waitcnt vmcnt(0)" ::: "memory");
        }
    }
    __syncthreads();
}

__device__ __forceinline__ void tr_item(const float* W, int ldw, int col0, bf16* WT, int dstrow0, int k0, LAS float* scr, int lane) {
#pragma unroll 8
    for (int i = 0; i < 32; ++i) { const int kk = 2 * i + (lane >> 5); scr[kk * 33 + (lane & 31)] = W[(size_t)(k0 + kk) * ldw + col0 + (lane & 31)]; }
    LDS_WAIT(); asm volatile("" ::: "memory");
    const int c = lane & 7;
#pragma unroll
    for (int j = 0; j < 4; ++j) { const int n = (lane >> 3) + 8 * j; const LAS float* s = scr + (8 * c) * 33 + n;
        v4u o; o.x = pk2(s[0 * 33], s[1 * 33]); o.y = pk2(s[2 * 33], s[3 * 33]); o.z = pk2(s[4 * 33], s[5 * 33]); o.w = pk2(s[6 * 33], s[7 * 33]);
        *(v4u*)(WT + (size_t)(dstrow0 + n) * D + k0 + 8 * c) = o; }
    LDS_WAIT(); asm volatile("" ::: "memory");
}
__device__ __forceinline__ void tr8_load(float (&t)[32], const float* W, int ldw, int col0, int k0, int lane) {
    const float* wp_ = W + (size_t)(k0 + (lane >> 5)) * ldw + col0 + (lane & 31);
#pragma unroll
    for (int i = 0; i < 32; ++i) t[i] = wp_[(size_t)(2 * i) * ldw];
}
__device__ __forceinline__ void tr8_finish(const float (&t)[32], unsigned char* WT, int dstrow0, int k0, LAS float* scr, int lane) {
#pragma unroll
    for (int i = 0; i < 32; ++i) scr[(2 * i + (lane >> 5)) * 33 + (lane & 31)] = t[i];
    LDS_WAIT(); asm volatile("" ::: "memory");
    const int n = lane >> 1, hf = lane & 1; const LAS float* sp = scr + (32 * hf) * 33 + n;
    v4u o[2];
#pragma unroll
    for (int c = 0; c < 2; ++c) { unsigned w[4];
#pragma unroll
        for (int j = 0; j < 4; ++j) { const LAS float* q4 = sp + (16 * c + 4 * j) * 33; w[j] = pk4f8(64.f * q4[0], 64.f * q4[33], 64.f * q4[66], 64.f * q4[99]); }
        o[c] = (v4u){w[0], w[1], w[2], w[3]}; }
    v4u* dst = (v4u*)(WT + (size_t)(dstrow0 + n) * D + k0 + 32 * hf);
    dst[0] = o[0]; dst[1] = o[1];
    LDS_WAIT(); asm volatile("" ::: "memory");
}
__device__ __forceinline__ void tr_item8(const float* W, int ldw, int col0, unsigned char* WT, int dstrow0, int k0, LAS float* scr, int lane) {
#pragma unroll 8
    for (int i = 0; i < 32; ++i) { const int kk = 2 * i + (lane >> 5); scr[kk * 33 + (lane & 31)] = W[(size_t)(k0 + kk) * ldw + col0 + (lane & 31)]; }
    LDS_WAIT(); asm volatile("" ::: "memory");
    const int n = lane >> 1, hf = lane & 1; const LAS float* sp = scr + (32 * hf) * 33 + n;
    v4u o[2];
#pragma unroll
    for (int c = 0; c < 2; ++c) { unsigned w[4];
#pragma unroll
        for (int j = 0; j < 4; ++j) { const LAS float* q4 = sp + (16 * c + 4 * j) * 33; w[j] = pk4f8(64.f * q4[0], 64.f * q4[33], 64.f * q4[66], 64.f * q4[99]); }
        o[c] = (v4u){w[0], w[1], w[2], w[3]}; }
    v4u* dst = (v4u*)(WT + (size_t)(dstrow0 + n) * D + k0 + 32 * hf);
    dst[0] = o[0]; dst[1] = o[1];
    LDS_WAIT(); asm volatile("" ::: "memory");
}
__device__ __forceinline__ void phase_prologue(const P& p, LAS unsigned char* lds) {
    const int tid = threadIdx.x, lane = tid & 63, wave = tid >> 6;
    LAS float* scr = (LAS float*)(lds + wave * 8448);
    const int gw = blockIdx.x * NWAVES + wave, NGW = gridDim.x * NWAVES;
    unsigned char* bt_s8 = p.ws + WS_BT_S8; unsigned char* bt_g8 = p.ws + WS_BT_G8;
    bf16* bt_s = (bf16*)(p.ws + WS_BT_S); bf16* bt_g = (bf16*)(p.ws + WS_BT_G);
    constexpr int I_S = 162 * 16, I_G = 128 * 16, I_O = 32 * 16;
    for (int it = gw; it < I_S + I_G + 3 * I_O; it += NGW) {
        int r = it;
        if (r < I_S) { const int nb = r >> 4, kb = r & 15; const int col0 = nb < 96 ? 32 * nb : (nb < 160 ? 4128 + 32 * (nb - 96) : (nb == 160 ? 4096 : 7200));
            if (nb < 8 * G1_NF8) tr_item8(p.w_in, D_IN, col0, bt_s8, 32 * nb, 64 * kb, scr, lane); else tr_item(p.w_in, D_IN, col0, bt_s, 32 * nb, 64 * kb, scr, lane); continue; } r -= I_S;
        if (r < I_G) { const int nb = r >> 4, kb = r & 15; const int col0 = nb < 32 ? 3072 + 32 * nb : (nb < 64 ? 6176 + 32 * (nb - 32) : 7232 + 32 * (nb - 64));
            if (FP8_G2) tr_item8(p.w_in, D_IN, col0, bt_g8, 32 * nb, 64 * kb, scr, lane); else tr_item(p.w_in, D_IN, col0, bt_g, 32 * nb, 64 * kb, scr, lane); continue; } r -= I_G;
        const int which = r / I_O; r -= which * I_O; const int nb = r >> 4, kb = r & 15;
        const float* W = which == 0 ? p.w_out_a : (which == 1 ? p.w_out_b : p.w_out);
        bf16* WT = (bf16*)(p.ws + (which == 0 ? WS_BT_OA : (which == 1 ? WS_BT_OB : WS_BT_O)));
        tr_item(W, D, 32 * nb, WT, 32 * nb, 64 * kb, scr, lane);
    }
    { const size_t n16 = (size_t)192 * D * (G1_NF8 == 21 ? 1 : 2) / 16; v4u* z = G1_NF8 == 21 ? (v4u*)(bt_s8 + (size_t)5184 * D) : (v4u*)(bt_s + (size_t)5184 * D);
      for (size_t i = (size_t)blockIdx.x * NTHREADS + tid; i < n16; i += (size_t)gridDim.x * NTHREADS) z[i] = (v4u){0u, 0u, 0u, 0u}; }
    __syncthreads();
    LAS float* sc = (LAS float*)lds;
    LAS float* red = (LAS float*)(lds + 17 * 1024 * 4);
    float* modv = (float*)(p.ws + WS_MODV);
    bool have = false;
    for (int u = blockIdx.x; u < NMOD / 64; u += gridDim.x) {
        if (!have) { for (int i = tid; i < 17 * 1024; i += NTHREADS) { const float v = i < 16 * 1024 ? p.c[i] : p.c_ctx[i - 16 * 1024]; sc[i] = siluf_(v); } have = true; __syncthreads(); }
        float acc[17];
#pragma unroll
        for (int b = 0; b < 17; ++b) acc[b] = 0.f;
        const int n = u * 64 + lane;
        for (int k = wave * 128; k < wave * 128 + 128; ++k) { const float wv = p.w_mod[(size_t)k * NMOD + n];
#pragma unroll
            for (int b = 0; b < 17; ++b) acc[b] += sc[b * 1024 + k] * wv; }
#pragma unroll
        for (int b = 0; b < 17; ++b) red[(wave * 17 + b) * 64 + lane] = acc[b];
        __syncthreads();
        for (int i = tid; i < 17 * 64; i += NTHREADS) { const int b = i >> 6, l = i & 63; float s = p.b_mod[u * 64 + l];
#pragma unroll
            for (int w = 0; w < 8; ++w) s += red[(w * 17 + b) * 64 + l];
            modv[b * NMOD + u * 64 + l] = s; }
        __syncthreads();
    }
}

__device__ __forceinline__ void phase_norm1(const P& p) {
    const int tid = threadIdx.x, lane = tid & 63, wave = tid >> 6;
    const int gw = blockIdx.x * NWAVES + wave, NGW = gridDim.x * NWAVES;
    const float* modv = (const float*)(p.ws + WS_MODV); bf16* h = (bf16*)(p.ws + WS_H);
    auto rowptr = [&](int r) -> const float* { return r < T ? p.x + (size_t)r * D : p.ctx + (size_t)(r - T) * D; };
    f32x4 nx[4];
    if (gw < TT) { const f32x4* xr = (const f32x4*)rowptr(gw) + lane;
#pragma unroll
        for (int j = 0; j < 4; ++j) nx[j] = xr[64 * j]; }
    for (int r = gw; r < TT; r += NGW) {
        const int b = r < T ? (r >> 12) : 16;
        f32x4 v[4]; float s = 0.f;
#pragma unroll
        for (int j = 0; j < 4; ++j) { v[j] = nx[j]; s += (v[j].x * v[j].x + v[j].y * v[j].y) + (v[j].z * v[j].z + v[j].w * v[j].w); }
        if (r + NGW < TT) { const f32x4* xr = (const f32x4*)rowptr(r + NGW) + lane;
#pragma unroll
            for (int j = 0; j < 4; ++j) nx[j] = xr[64 * j]; }
        const float rstd = rsqrtf_(wave_sum(s) * (1.f / D) + EPS);
        const f32x4* g = (const f32x4*)p.norm_mix_g + lane; const f32x4* sh = (const f32x4*)(modv + b * NMOD) + lane; const f32x4* scl = (const f32x4*)(modv + b * NMOD + D) + lane;
        unsigned* o8 = (unsigned*)(p.ws + WS_H8 + (size_t)r * D) + lane; v2u* o16 = (v2u*)(h + (size_t)r * D) + lane;
#pragma unroll
        for (int j = 0; j < 4; ++j) { const f32x4 gg = g[64 * j], s1 = sh[64 * j], s2 = scl[64 * j]; const f32x4 o = v[j] * rstd * gg * (1.0f + s2) + s1;
            if (FP8_G1 || FP8_G2) o8[64 * j] = pk4f8(o.x, o.y, o.z, o.w);
            if (!(FP8_G1 == 1 && FP8_G2)) { v2u w; w.x = pk2(o.x, o.y); w.y = pk2(o.z, o.w); o16[64 * j] = w; } }
    }
}

struct EpiG1 {
    bf16* qkva; bf16* pb; float* small;
    __device__ __forceinline__ void operator()(const Acc& acc, const pg8::Unit& u, int wr, int wc, int fr, int fq) const {
        const int row0 = u.pm * 256 + wr * 64 + fr, cb = wc * 32 + 8 * fq;
#pragma unroll
        for (int ai = 0; ai < 2; ++ai)
#pragma unroll
            for (int m = 0; m < 4; ++m) { const size_t row = (size_t)(row0 + ai * 128 + m * 16);
#pragma unroll
                for (int bj = 0; bj < 2; ++bj) { const int c = bj * 128 + cb; const f32x4 v0 = acc[ai][bj][m][0], v1 = acc[ai][bj][m][1];
                    if (u.pn < 20) { v4u w; w.x = pk2(v0[0], v0[1]); w.y = pk2(v0[2], v0[3]); w.z = pk2(v1[0], v1[1]); w.w = pk2(v1[2], v1[3]);
                        if (u.pn < 12) *(v4u*)(qkva + row * 3072 + u.pn * 256 + c) = w; else *(v4u*)(pb + row * 2048 + (u.pn - 12) * 256 + c) = w; }
                    else if (c < 64) { *(f32x4*)(small + row * 64 + c) = v0; *(f32x4*)(small + row * 64 + c + 4) = v1; } } }
    }
};
__device__ __forceinline__ f32x2_t sigmoid2(const f32x2_t x) { const f32x2_t t = x * -1.44269504f; const f32x2_t d = (f32x2_t){__builtin_amdgcn_exp2f(t.x), __builtin_amdgcn_exp2f(t.y)} + 1.0f; return (f32x2_t){__builtin_amdgcn_rcpf(d.x), __builtin_amdgcn_rcpf(d.y)}; }
__device__ __forceinline__ f32x2_t silu2(const f32x2_t x) { return x * sigmoid2(x); }
#define ACC_PAIR(a4, p) ((p) & 1 ? (f32x2_t){(a4).z, (a4).w} : (f32x2_t){(a4).x, (a4).y})
struct EpiG2 {
    const bf16* on; bf16* ya; bf16* yb; bf16* gates; const float* gla_g; LAS float* xch; const bf16* ob2;
    __device__ __forceinline__ void operator()(const Acc& acc, const pg8::Unit& u, int wr, int wc, int fr, int fq) const {
        const int row0 = u.pm * 256 + wr * 64 + fr, cb = wc * 32 + 8 * fq;
        if (u.pn >= 4 && u.pn < 8) {
#pragma unroll 2
            for (int rm = 0; rm < 8; ++rm) { const int rr = (rm >> 2) * 128 + (rm & 3) * 16; const size_t row = (size_t)(row0 + rr); float ss = 0.f;
#pragma unroll
                for (int bj = 0; bj < 2; ++bj) { float o[8], o2[8]; unpack8(*(const v4u*)(on + row * 2048 + u.pn * 256 + bj * 128 + cb), o); unpack8(*(const v4u*)(ob2 + row * 1024 + (u.pn - 4) * 256 + bj * 128 + cb), o2);
#pragma unroll
                    for (int j = 0; j < 8; ++j) { const float x = o[j] + o2[j]; ss += x * x; } }
                ss += __shfl_xor(ss, 16); ss += __shfl_xor(ss, 32);
                if (fq == 0) xch[(rr + wr * 64 + fr) * 4 + wc] = ss; }
            asm volatile("s_waitcnt lgkmcnt(0)" ::: "memory"); __builtin_amdgcn_s_barrier(); asm volatile("" ::: "memory");
#pragma unroll
            for (int bj = 0; bj < 2; ++bj) { float gg[8];
#pragma unroll
                for (int j = 0; j < 8; ++j) gg[j] = gla_g[bj * 128 + cb + j];
#pragma unroll
                for (int ai = 0; ai < 2; ++ai)
#pragma unroll
                    for (int m = 0; m < 4; ++m) { const size_t row = (size_t)(row0 + ai * 128 + m * 16);
                        const f32x4 ps = *(const LAS f32x4*)(xch + (ai * 128 + wr * 64 + m * 16 + fr) * 4);
                        const float rstd = rsqrtf_(((ps[0] + ps[1]) + (ps[2] + ps[3])) * (1.f / 256.f) + EPS);
                        float o[8], o2[8], v[8]; unpack8(*(const v4u*)(on + row * 2048 + u.pn * 256 + bj * 128 + cb), o); unpack8(*(const v4u*)(ob2 + row * 1024 + (u.pn - 4) * 256 + bj * 128 + cb), o2);
#pragma unroll
                        for (int pq = 0; pq < 4; ++pq) { const f32x2_t os = (f32x2_t){o[2 * pq], o[2 * pq + 1]} + (f32x2_t){o2[2 * pq], o2[2 * pq + 1]};
                            const f32x2_t r2 = os * rstd * (f32x2_t){gg[2 * pq], gg[2 * pq + 1]} * silu2(ACC_PAIR(acc[ai][bj][m][pq >> 1], pq)); v[2 * pq] = r2.x; v[2 * pq + 1] = r2.y; }
                        *(v4u*)(yb + row * 1024 + (u.pn - 4) * 256 + bj * 128 + cb) = pack8(v);
                        asm volatile("" ::: "memory"); } }
            return;
        }
        if (u.pn < 4) {
#pragma unroll
            for (int ai = 0; ai < 2; ++ai)
#pragma unroll
                for (int m = 0; m < 4; ++m) { const size_t row = (size_t)(row0 + ai * 128 + m * 16);
#pragma unroll
                    for (int bj = 0; bj < 2; ++bj) { const int c = bj * 128 + cb; float v[8], o[8];
                        unpack8(*(const v4u*)(on + row * 2048 + u.pn * 256 + c), o);
#pragma unroll
                        for (int pq = 0; pq < 4; ++pq) { const f32x2_t r2 = (f32x2_t){o[2 * pq], o[2 * pq + 1]} * silu2(ACC_PAIR(acc[ai][bj][m][pq >> 1], pq)); v[2 * pq] = r2.x; v[2 * pq + 1] = r2.y; }
                        *(v4u*)(ya + row * 1024 + u.pn * 256 + c) = pack8(v); } }
        } else {
#pragma unroll
            for (int ai = 0; ai < 2; ++ai)
#pragma unroll
                for (int m = 0; m < 4; ++m) { const size_t row = (size_t)(row0 + ai * 128 + m * 16);
#pragma unroll
                    for (int bj = 0; bj < 2; ++bj) { const int c = bj * 128 + cb; float v[8];
#pragma unroll
                        for (int pq = 0; pq < 4; ++pq) { const f32x2_t r2 = sigmoid2(ACC_PAIR(acc[ai][bj][m][pq >> 1], pq)); v[2 * pq] = r2.x; v[2 * pq + 1] = r2.y; }
                        asm volatile("s_nop 0" : "+v"(v[0]), "+v"(v[1]), "+v"(v[2]), "+v"(v[3]), "+v"(v[4]), "+v"(v[5]), "+v"(v[6]), "+v"(v[7]));
                        *(v4u*)(gates + row * 2048 + (u.pn - 8) * 256 + c) = pack8(v); } }
        }
    }
};
template <int WHICH> struct EpiG34 {
    const bf16* gates; bf16* y;
    __device__ __forceinline__ void operator()(const Acc& acc, const pg8::Unit& u, int wr, int wc, int fr, int fq) const {
        const int row0 = u.pm * 256 + wr * 64 + fr, cb = wc * 32 + 8 * fq;
#pragma unroll
        for (int ai = 0; ai < 2; ++ai)
#pragma unroll
            for (int m = 0; m < 4; ++m) { const size_t row = (size_t)(row0 + ai * 128 + m * 16);
#pragma unroll
                for (int bj = 0; bj < 2; ++bj) { const int c = u.pn * 256 + bj * 128 + cb; float v[8], g[8];
#pragma unroll
                    for (int j = 0; j < 4; ++j) { v[j] = acc[ai][bj][m][0][j]; v[4 + j] = acc[ai][bj][m][1][j]; }
                    unpack8(*(const v4u*)(gates + row * 2048 + WHICH * 1024 + c), g);
                    if (WHICH == 0) {
#pragma unroll
                        for (int j = 0; j < 8; ++j) v[j] = g[j] * v[j];
                    } else { float o[8]; unpack8(*(const v4u*)(y + row * 1024 + c), o);
#pragma unroll
                        for (int j = 0; j < 8; ++j) v[j] = o[j] + g[j] * v[j]; }
                    *(v4u*)(y + row * 1024 + c) = pack8(v); } }
    }
};
__device__ __forceinline__ f32x4 ldx4(const v2u w) { return (f32x4){bflo(w.x), bfhi(w.x), bflo(w.y), bfhi(w.y)}; }
struct EpiG5 {
    const float* x; const float* modv; bf16* x1b;
    __device__ __forceinline__ void operator()(const Acc& acc, const pg8::Unit& u, int wr, int wc, int fr, int fq) const {
        const int row0 = u.pm * 256 + wr * 64 + fr, cb = wc * 32 + 8 * fq;
        const float* g1 = modv + (u.pm >> 4) * NMOD + 2 * D;
#pragma unroll
        for (int ai = 0; ai < 2; ++ai)
#pragma unroll
            for (int m = 0; m < 4; ++m) { const size_t row = (size_t)(row0 + ai * 128 + m * 16);
#pragma unroll
                for (int bj = 0; bj < 2; ++bj) { const int c = u.pn * 256 + bj * 128 + cb; float v[8];
#pragma unroll
                    for (int n = 0; n < 2; ++n) { const f32x4 xv = *(const f32x4*)(x + row * D + c + 4 * n), gv = *(const f32x4*)(g1 + c + 4 * n); const f32x4 o = xv + gv * acc[ai][bj][m][n];
                        v[4 * n] = o.x; v[4 * n + 1] = o.y; v[4 * n + 2] = o.z; v[4 * n + 3] = o.w; }
                    *(v4u*)(x1b + row * D + c) = pack8(v); } }
    }
};
struct EpiGU {
    const float* b_gu; bf16* act;
    __device__ __forceinline__ void operator()(const Acc& acc, const pg8::Unit& u, int wr, int wc, int fr, int fq) const {
        const int row0 = u.pm * 256 + wr * 64 + fr, cb = wc * 32 + 8 * fq; const int e = u.e;
        const float* bg = b_gu + (size_t)e * 2048 + u.pn * 128 + cb; const float* bl = bg + 1024;
        f32x2_t bgv[4], blv[4];
#pragma unroll
        for (int j = 0; j < 4; ++j) { bgv[j] = (f32x2_t){bg[2 * j], bg[2 * j + 1]}; blv[j] = (f32x2_t){bl[2 * j] + 1.0f, bl[2 * j + 1] + 1.0f}; }
#pragma unroll
        for (int ai = 0; ai < 2; ++ai)
#pragma unroll
            for (int m = 0; m < 4; ++m) { const size_t row = (size_t)(row0 + ai * 128 + m * 16); f32x2_t v[4];
#pragma unroll
                for (int j = 0; j < 4; ++j) { const f32x4 ag = acc[ai][0][m][j >> 1], al = acc[ai][1][m][j >> 1];
                    f32x2_t gl = (j & 1 ? (f32x2_t){ag.z, ag.w} : (f32x2_t){ag.x, ag.y}) + bgv[j]; f32x2_t ln = (j & 1 ? (f32x2_t){al.z, al.w} : (f32x2_t){al.x, al.y}) + blv[j];
                    gl = (f32x2_t){fminf(gl.x, 7.0f), fminf(gl.y, 7.0f)}; ln = (f32x2_t){__builtin_amdgcn_fmed3f(ln.x, -6.0f, 8.0f), __builtin_amdgcn_fmed3f(ln.y, -6.0f, 8.0f)};
                    const f32x2_t t = gl * (-1.702f * 1.44269504f); f32x2_t d = (f32x2_t){__builtin_amdgcn_exp2f(t.x), __builtin_amdgcn_exp2f(t.y)} + 1.0f;
                    const f32x2_t r = (f32x2_t){__builtin_amdgcn_rcpf(d.x), __builtin_amdgcn_rcpf(d.y)};
                    v[j] = gl * r * ln; }
                v2u w8; w8.x = pk4f8(v[0].x, v[0].y, v[1].x, v[1].y); w8.y = pk4f8(v[2].x, v[2].y, v[3].x, v[3].y);
                *(v2u*)((unsigned char*)act + row * 1024 + u.pn * 128 + cb) = w8; }
    }
};
struct EpiDN {
    const float* b_down; const float* slot_p; bf16* ys;
    __device__ __forceinline__ void operator()(const Acc& acc, const pg8::Unit& u, int wr, int wc, int fr, int fq) const {
        const int row0 = u.pm * 256 + wr * 64 + fr, cb = wc * 32 + 8 * fq; const int e = u.e;
#pragma unroll
        for (int bj = 0; bj < 2; ++bj) { const int c = u.pn * 256 + bj * 128 + cb; float bv[8];
#pragma unroll
            for (int j = 0; j < 8; ++j) bv[j] = b_down[(size_t)e * 1024 + c + j];
#pragma unroll
            for (int ai = 0; ai < 2; ++ai)
#pragma unroll
                for (int m = 0; m < 4; ++m) { const size_t row = (size_t)(row0 + ai * 128 + m * 16); const float pr = 16.0f * slot_p[row]; float v[8];
#pragma unroll
                    for (int pq = 0; pq < 4; ++pq) { const f32x2_t r2 = (ACC_PAIR(acc[ai][bj][m][pq >> 1], pq) + (f32x2_t){bv[2 * pq], bv[2 * pq + 1]}) * pr; v[2 * pq] = r2.x; v[2 * pq + 1] = r2.y; }
                    v2u w8; w8.x = pk4f8(v[0], v[1], v[2], v[3]); w8.y = pk4f8(v[4], v[5], v[6], v[7]);
                    *(v2u*)((unsigned char*)ys + row * 1024 + c) = w8; } }
    }
};

template <int CG>
__device__ __forceinline__ void conv_unit(const P& p, LAS unsigned char* lds, const int b, const int chan0, const bool donorm) {
    constexpr int NCOL = 512 / CG, NPOS = 64 / NCOL, CTXN = 256 / NCOL, SLOT = CG * 32, CSLOT = CG * 16, RB = 66 * SLOT;
    const int tid = threadIdx.x;
    bf16* qkva = (bf16*)(p.ws + WS_QKVA);
    LAS unsigned char* rowbuf = lds;
    LAS unsigned char* cbuf = lds;
    const int cg = tid % CG, c0 = tid / CG;
    float w[9][8];
#pragma unroll
    for (int k = 0; k < 9; ++k)
#pragma unroll
        for (int e = 0; e < 8; ++e) w[k][e] = p.conv_w[k * 3072 + chan0 + cg * 8 + e];
    __syncthreads();
    if (tid < 2 * CG) { const int r = tid; *(LAS v4u*)(cbuf + ((r >= CG) ? 257 : 0) * CSLOT + (r % CG) * 16) = (v4u){0u, 0u, 0u, 0u}; }
    { bf16* base = qkva + (size_t)(T + b * CTXL) * 3072 + chan0 + cg * 8;
#pragma unroll
      for (int jj = 0; jj < CTXN; ++jj) { const int t = c0 + NCOL * jj; *(LAS v4u*)(cbuf + (t + 1) * CSLOT + cg * 16) = *(const v4u*)(base + (size_t)t * 3072); }
      __syncthreads();
#pragma unroll
      for (int jj = 0; jj < CTXN; ++jj) { const int t = c0 + NCOL * jj; float a[8];
#pragma unroll
          for (int e = 0; e < 8; ++e) a[e] = 0.f;
#pragma unroll
          for (int kw = 0; kw < 3; ++kw) { float f[8]; unpack8(*(const LAS v4u*)(cbuf + (t + kw) * CSLOT + cg * 16), f);
#pragma unroll
              for (int e = 0; e < 8; ++e) a[e] += f[e] * w[3 + kw][e]; }
          float ss = 0.f;
#pragma unroll
          for (int e = 0; e < 8; ++e) { a[e] = silu_fast(a[e]); ss += a[e] * a[e]; }
          if (CG == 16 && donorm) { ss = row16_sum(ss); const float sc = rsqrtf_(ss + EPS);
#pragma unroll
              for (int e = 0; e < 8; ++e) a[e] *= sc; }
          *(v4u*)(base + (size_t)t * 3072) = pack8(a); }
    }
    __syncthreads();
    if (tid < 6 * CG * 2) { const int bi = tid / (4 * CG), r = tid % (4 * CG); *(LAS f32x4*)(rowbuf + bi * RB + ((r >= 2 * CG) ? 65 : 0) * SLOT + (r % (2 * CG)) * 16) = (f32x4){0.f, 0.f, 0.f, 0.f}; }
    bf16* base = qkva + (size_t)(b * SEQ) * 3072 + chan0 + cg * 8;
#define CONV_PUT(rr_, c_, w_) do { float f_[8]; unpack8((w_), f_); LAS f32x4* d_ = (LAS f32x4*)(rowbuf + ((rr_) % 3) * RB + ((c_) + 1) * SLOT + cg * 32); \
        d_[0] = (f32x4){f_[0], f_[1], f_[2], f_[3]}; d_[1] = (f32x4){f_[4], f_[5], f_[6], f_[7]}; } while (0)
#pragma unroll
    for (int rr = 0; rr < 2; ++rr)
#pragma unroll
        for (int jj = 0; jj < NPOS; ++jj) { const int c = c0 + NCOL * jj; const v4u wv = *(const v4u*)(base + (size_t)(rr * 64 + c) * 3072); CONV_PUT(rr, c, wv); }
    __syncthreads();
    const bool late = (tid >> 6) >= 4;
    float ap[NPOS][8];
#define CONV_SUMS(A_) _Pragma("unroll") for (int jj = 0; jj < NPOS; ++jj) { const int c = c0 + NCOL * jj; \
            _Pragma("unroll") for (int e = 0; e < 8; ++e) A_[jj][e] = 0.f; \
            _Pragma("unroll") for (int kh = 0; kh < 3; ++kh) { const int rr = r + kh - 1; if (rr < 0 || rr > 63) continue; const LAS unsigned char* rb = rowbuf + (rr % 3) * RB; \
                _Pragma("unroll") for (int kw = 0; kw < 3; ++kw) { const f32x4 f0 = *(const LAS f32x4*)(rb + (c + kw) * SLOT + cg * 32), f1 = *(const LAS f32x4*)(rb + (c + kw) * SLOT + cg * 32 + 16); \
                    _Pragma("unroll") for (int e = 0; e < 4; ++e) { A_[jj][e] += f0[e] * w[kh * 3 + kw][e]; A_[jj][4 + e] += f1[e] * w[kh * 3 + kw][4 + e]; } } } }
#define CONV_FIN(A_, r_) _Pragma("unroll") for (int jj = 0; jj < NPOS; ++jj) { const int c = c0 + NCOL * jj; float a[8]; float ss = 0.f; \
            _Pragma("unroll") for (int e = 0; e < 8; ++e) { a[e] = silu_fast(A_[jj][e]); ss += a[e] * a[e]; } \
            if (CG == 16 && donorm) { ss = row16_sum(ss); const float sc = rsqrtf_(ss + EPS); _Pragma("unroll") for (int e = 0; e < 8; ++e) a[e] *= sc; } \
            *(v4u*)(base + (size_t)((r_) * 64 + c) * 3072) = pack8(a); }
    for (int r = 0; r < 64; ++r) {
        v4u pre[NPOS];
        if (r + 2 < 64) {
#pragma unroll
            for (int jj = 0; jj < NPOS; ++jj) pre[jj] = *(const v4u*)(base + (size_t)((r + 2) * 64 + c0 + NCOL * jj) * 3072);
        }
        if (!late) { float an[NPOS][8]; CONV_SUMS(an) CONV_FIN(an, r) }
        else { if (r > 0) { CONV_FIN(ap, r - 1) } CONV_SUMS(ap) }
        __syncthreads();
        if (r + 2 < 64) {
#pragma unroll
            for (int jj = 0; jj < NPOS; ++jj) CONV_PUT(r + 2, c0 + NCOL * jj, pre[jj]);
        }
        __syncthreads();
    }
    if (late) { CONV_FIN(ap, 63) }
#undef CONV_SUMS
#undef CONV_FIN
#undef CONV_PUT
}
__device__ __forceinline__ void phase_conv(const P& p, LAS unsigned char* lds) {
    for (int u = blockIdx.x; u < NB * 16; u += gridDim.x) conv_unit<16>(p, lds, u >> 4, (u & 15) * 128, true);
    for (int u = blockIdx.x; u < NB * 16; u += gridDim.x) conv_unit<8>(p, lds, u >> 4, 2048 + (u & 15) * 64, false);
}

template <bool GLA>
__device__ __forceinline__ void scan_unit(const P& p, LAS unsigned char* lds, int b, int h, int vh) {
    const int tid = threadIdx.x, j = tid >> 2, part = tid & 3;
    LAS float* qf = (LAS float*)lds; LAS float* kf = qf + 32 * 144; LAS float* af = kf + 32 * 144; LAS float* vf = af + 32 * 144; LAS float* ob = vf + 32 * 128;
    LAS float* sa = ob + 32 * 128; LAS float* sb = sa + 32;
    const bf16* qkva = (const bf16*)(p.ws + WS_QKVA); const bf16* pbuf = (const bf16*)(p.ws + WS_PB); const float* small = (const float*)(p.ws + WS_SMALL);
    bf16* on = (bf16*)p.out;
    const int lt = tid >> 4, piece = tid & 15;
    const float scale = 0.08838834764831845f;
    for (int dir = 0; dir < 2; ++dir) {
        float S[32];
#pragma unroll
        for (int i = 0; i < 32; ++i) S[i] = 0.f;
        float wcol[16]; float gbias = 0.f, alog = 0.f, dtb = 0.f;
        if (GLA) { const float* gw = dir ? p.gla_gate_w_b : p.gla_gate_w_f; const int i = tid & 127;
#pragma unroll
            for (int r = 0; r < 16; ++r) wcol[r] = gw[r * 512 + h * 128 + i];
            gbias = (dir ? p.gla_gate_b_b : p.gla_gate_b_f)[h * 128 + i]; }
        else { alog = __expf((dir ? p.a_log_b : p.a_log_f)[h]); dtb = (dir ? p.dt_bias_b : p.dt_bias_f)[h]; }
        for (int s = 0; s < 136; ++s) {
            const bool is_ctx = s < 8;
            const int sci = is_ctx ? (dir ? 7 - s : s) : (dir ? 127 - (s - 8) : s - 8);
            const size_t row0 = is_ctx ? (size_t)(T + b * CTXL + sci * 32) : (size_t)(b * SEQ + sci * 32);
            __syncthreads();
            { v4u qw, kw, vw;
              if (GLA) { const bf16* r = pbuf + (row0 + lt) * 2048; qw = *(const v4u*)(r + h * 128 + piece * 8); kw = *(const v4u*)(r + 512 + h * 128 + piece * 8); vw = *(const v4u*)(r + 1024 + h * 256 + vh * 128 + piece * 8); }
              else { const bf16* r = qkva + (row0 + lt) * 3072; qw = *(const v4u*)(r + h * 128 + piece * 8); kw = *(const v4u*)(r + 1024 + h * 128 + piece * 8); vw = *(const v4u*)(r + 2048 + h * 128 + piece * 8); }
              float f[8]; const int o = lt * 144 + (piece >> 2) * 36 + (piece & 3) * 8;
              unpack8(qw, f);
#pragma unroll
              for (int e = 0; e < 8; ++e) qf[o + e] = f[e] * scale;
              unpack8(kw, f);
#pragma unroll
              for (int e = 0; e < 8; ++e) kf[o + e] = f[e];
              unpack8(vw, f);
#pragma unroll
              for (int e = 0; e < 8; ++e) vf[lt * 128 + piece * 8 + e] = f[e]; }
            if (GLA) { const int i = tid & 127, tq = tid >> 7;
#pragma unroll
                for (int tt = 0; tt < 8; ++tt) { const int t = tq * 8 + tt; const float* z = small + (row0 + t) * 64 + 32 + dir * 16; float u = gbias;
#pragma unroll
                    for (int r = 0; r < 16; ++r) u += z[r] * wcol[r];
                    const float ls = fminf(u, 0.f) - log1pf(__expf(-fabsf(u)));
                    af[t * 144 + (i >> 5) * 36 + (i & 31)] = __expf(ls * (1.0f / 16.0f)); } }
            else if (tid < 32) { const float* sm = small + (row0 + tid) * 64; sb[tid] = sigmoidf_(sm[dir * 8 + h]); sa[tid] = __expf(-alog * softplusf_(sm[16 + dir * 8 + h] + dtb)); }
            __syncthreads();
            for (int tt = 0; tt < 32; ++tt) { const int t = dir ? 31 - tt : tt;
                const LAS float* kp = kf + t * 144 + part * 36; const LAS float* qp = qf + t * 144 + part * 36;
                float kk[32], qq[32];
#pragma unroll
                for (int i = 0; i < 32; i += 4) { const f32x4 a = *(const LAS f32x4*)(kp + i); kk[i] = a.x; kk[i + 1] = a.y; kk[i + 2] = a.z; kk[i + 3] = a.w;
                    const f32x4 q4 = *(const LAS f32x4*)(qp + i); qq[i] = q4.x; qq[i + 1] = q4.y; qq[i + 2] = q4.z; qq[i + 3] = q4.w; }
                const float vj = vf[t * 128 + j];
                float os = 0.f;
                if (GLA) { const LAS float* ap = af + t * 144 + part * 36;
#pragma unroll
                    for (int i = 0; i < 32; i += 4) { const f32x4 a = *(const LAS f32x4*)(ap + i);
                        S[i] = a.x * S[i] + kk[i] * vj; S[i + 1] = a.y * S[i + 1] + kk[i + 1] * vj; S[i + 2] = a.z * S[i + 2] + kk[i + 2] * vj; S[i + 3] = a.w * S[i + 3] + kk[i + 3] * vj; }
                } else { const float a = sa[t], be = sb[t]; float ks = 0.f;
#pragma unroll
                    for (int i = 0; i < 32; ++i) ks += kk[i] * S[i];
                    ks += __shfl_xor(ks, 1); ks += __shfl_xor(ks, 2);
                    const float vn = be * (vj - a * ks);
#pragma unroll
                    for (int i = 0; i < 32; ++i) S[i] = a * S[i] + kk[i] * vn; }
                if (!is_ctx) {
#pragma unroll
                    for (int i = 0; i < 32; ++i) os += qq[i] * S[i];
                    os += __shfl_xor(os, 1); os += __shfl_xor(os, 2);
                    if (part == 0) ob[t * 128 + j] = os; }
            }
            if (!is_ctx) { __syncthreads();
                bf16* dst = on + (row0 + lt) * 2048 + (GLA ? 1024 + h * 256 + vh * 128 : h * 128) + piece * 8; float f[8];
#pragma unroll
                for (int e = 0; e < 8; ++e) f[e] = ob[lt * 128 + piece * 8 + e];
                if (dir) { float g[8]; unpack8(*(const v4u*)dst, g);
#pragma unroll
                    for (int e = 0; e < 8; ++e) f[e] += g[e]; }
                *(v4u*)dst = pack8(f); }
        }
    }
}

typedef short s16x4 __attribute__((ext_vector_type(4)));
typedef __bf16 bf16x2_t __attribute__((ext_vector_type(2)));
#define MF16(a, b, c) __builtin_amdgcn_mfma_f32_16x16x16bf16_1k((a), (b), (c), 0, 0, 0)
#define MF32(a, b, c) __builtin_amdgcn_mfma_f32_16x16x32_bf16((a), (b), (c), 0, 0, 0)
__device__ __forceinline__ unsigned pk2c(float lo, float hi) { const f32x2_t v = {lo, hi}; return __builtin_bit_cast(unsigned, __builtin_convertvector(v, bf16x2_t)); }
__device__ __forceinline__ s16x4 cvt4(const f32x4 v) { v2u p; p.x = pk2c(v[0], v[1]); p.y = pk2c(v[2], v[3]); return __builtin_bit_cast(s16x4, p); }
__device__ __forceinline__ bf16x8 cat8(const s16x4 a, const s16x4 b) { return __builtin_shufflevector(a, b, 0, 1, 2, 3, 4, 5, 6, 7); }
__device__ __forceinline__ bf16x8 ldfrag(const LAS unsigned char* img, int row, int strideB, int s, int q) {
    const LAS unsigned char* p = img + row * strideB + (32 * s + 4 * q) * 2;
    unsigned a2 = (unsigned)(size_t)p + 32u; asm volatile("" : "+v"(a2));
    return cat8(*(const LAS s16x4*)p, *(const LAS s16x4*)(size_t)a2);
}
__device__ __forceinline__ v4u pack8c(const float (&f)[8]) { v4u w; w.x = pk2c(f[0], f[1]); w.y = pk2c(f[2], f[3]); w.z = pk2c(f[4], f[5]); w.w = pk2c(f[6], f[7]); return w; }
constexpr int CS_KS = 272, CS_TS = 144;
constexpr int L_K = 0, L_Q = 17408, L_V = 34816, L_KT = 52224, L_O = 70656, L_AOFF = 88064, L_TD = 91136, L_ATT = 93184, L_SC = 98304;
constexpr float QSCALE = 0.08838834764831845f;
__device__ __forceinline__ int tri_idx(int bi, int bj) { return bi * (bi + 1) / 2 + bj; }
__device__ __forceinline__ int off_idx(int bi, int bj) { return bi * (bi - 1) / 2 + bj; }

__device__ __forceinline__ void build_kt_plain(LAS unsigned char* lds, int tid) {
    const int a = tid & 127, seg = tid >> 7;
#pragma unroll
    for (int mm = 0; mm < 4; ++mm) { unsigned short v[4];
#pragma unroll
        for (int e = 0; e < 4; ++e) v[e] = *(const LAS unsigned short*)(lds + L_K + (16 * seg + 4 * mm + e) * CS_KS + a * 2);
        v2u w; w.x = (unsigned)v[0] | ((unsigned)v[1] << 16); w.y = (unsigned)v[2] | ((unsigned)v[3] << 16);
        *(LAS v2u*)(lds + L_KT + a * CS_TS + (16 * seg + 4 * mm) * 2) = w; }
}

__device__ __forceinline__ float wave_scan_incl(float x) {
#define SCAN_DPP_(ctrl, rmask) x += __builtin_bit_cast(float, __builtin_amdgcn_update_dpp(0, __builtin_bit_cast(int, x), (ctrl), (rmask), 0xF, false))
    SCAN_DPP_(0x111, 0xF); SCAN_DPP_(0x112, 0xF); SCAN_DPP_(0x114, 0xF); SCAN_DPP_(0x118, 0xF); SCAN_DPP_(0x142, 0xA); SCAN_DPP_(0x143, 0xC);
#undef SCAN_DPP_
    return x;
}
constexpr int GP_KS = 288, GP_TS = 160;
constexpr int GP_K = 0, GP_Q = 18432, GP_V = 36864, GP_KT = 54272, GP_O = 74752, GP_AOFF = 92160, GP_TD = 95232, GP_ATT = 97280, GP_SC = 102400;
__device__ __forceinline__ bf16x8 ldf16(const LAS unsigned char* img, int row, int strideB, int s, int q) { return *(const LAS bf16x8*)(img + row * strideB + (32 * s + 8 * q) * 2); }
__device__ __forceinline__ void gdn_build_kt(LAS unsigned char* lds, int tid) {
    const int a = tid & 127, seg = tid >> 7;
    const int pa = 32 * (a >> 5) + 8 * ((a >> 2) & 3) + 4 * ((a >> 4) & 1) + (a & 3);
#pragma unroll
    for (int mm = 0; mm < 4; ++mm) { unsigned short v[4];
#pragma unroll
        for (int e = 0; e < 4; ++e) v[e] = *(const LAS unsigned short*)(lds + GP_K + (16 * seg + 4 * mm + e) * GP_KS + pa * 2);
        v2u w; w.x = (unsigned)v[0] | ((unsigned)v[1] << 16); w.y = (unsigned)v[2] | ((unsigned)v[3] << 16);
        *(LAS v2u*)(lds + GP_KT + a * GP_TS + (32 * (seg >> 1) + 8 * mm + 4 * (seg & 1)) * 2) = w; }
}

__device__ __forceinline__ void gdn_unit(const P& p, LAS unsigned char* lds, const int b, const int h) {
    const int wave = __builtin_amdgcn_readfirstlane(threadIdx.x >> 6);
    const int c0 = wave * 16;
    const bf16* qkva = (const bf16*)(p.ws + WS_QKVA); const float* small = (const float*)(p.ws + WS_SMALL); bf16* on = (bf16*)p.out;
    LAS float* sc0 = (LAS float*)(lds + GP_SC); LAS float* gnl = sc0 + 320;
    __syncthreads();
    if (threadIdx.x < 128) gnl[threadIdx.x] = p.gdn_norm_g[threadIdx.x];
    for (int dir = 0; dir < 2; ++dir) {
        f32x4 S[8];
#pragma unroll
        for (int u = 0; u < 8; ++u) S[u] = (f32x4){0.f, 0.f, 0.f, 0.f};
        const float alog = __expf((dir ? p.a_log_b : p.a_log_f)[h]), dtb = (dir ? p.dt_bias_b : p.dt_bias_f)[h];
        v4u pq[2], pk[2], pv[2]; float pgb = 0.f, pga = 0.f;
#define LANE_VARS int tz_ = threadIdx.x; asm volatile("" : "+v"(tz_)); const int tid = tz_, lane = tz_ & 63, r = lane & 15, q = lane >> 4, lt = tz_ >> 4, piece = tz_ & 15; (void)tid; (void)r; (void)q; (void)lt; (void)piece;
#define GDN_ROW0(s_) (((s_) < 4) ? (size_t)(T + b * CTXL + (dir ? 3 - (s_) : (s_)) * 64) : (size_t)(b * SEQ + (dir ? 63 - ((s_) - 4) : (s_) - 4) * 64))
#define GDN_PREFETCH(s_) do { const size_t r0_ = GDN_ROW0(s_); \
            _Pragma("unroll") for (int jj = 0; jj < 2; ++jj) { const int pp = lt + 32 * jj; const bf16* rp = qkva + (r0_ + (dir ? 63 - pp : pp)) * 3072 + h * 128 + piece * 8; \
                pq[jj] = *(const v4u*)rp; pk[jj] = *(const v4u*)(rp + 1024); pv[jj] = *(const v4u*)(rp + 2048); } \
            if (wave == 0) { const float* sm = small + (r0_ + (dir ? 63 - lane : lane)) * 64; pgb = sm[dir * 8 + h]; pga = sm[16 + dir * 8 + h]; } } while (0)
#define GDN_FLUSH(s_) do { const size_t fr0_ = GDN_ROW0(s_); \
            _Pragma("unroll") for (int jj = 0; jj < 2; ++jj) { const int pp = lt + 32 * jj; float f[8]; unpack8(*(const LAS v4u*)(lds + GP_O + pp * CS_KS + piece * 16), f); \
                bf16* dst = on + (fr0_ + (dir ? 63 - pp : pp)) * 2048 + h * 128 + piece * 8; \
                if (dir) { float g[8]; unpack8(fwdv[jj], g); float ss = 0.f; \
                    _Pragma("unroll") for (int e = 0; e < 8; ++e) { f[e] += g[e]; ss += f[e] * f[e]; } \
                    ss = row16_sum(ss); \
                    const float rstd = rsqrtf_(ss * (1.f / 128.f) + EPS); \
                    const f32x4 g0 = *(const LAS f32x4*)(gnl + piece * 8), g1 = *(const LAS f32x4*)(gnl + piece * 8 + 4); \
                    _Pragma("unroll") for (int e = 0; e < 4; ++e) { f[e] *= rstd * g0[e]; f[4 + e] *= rstd * g1[e]; } } \
                *(v4u*)dst = pack8c(f); } } while (0)
        v4u fwdv[2] = {};
#define GDN_STAGE1(s_) do { LAS float* scn_ = sc0 + (((s_) & 1) << 9); \
            if (wave == 0) { const float be = sigmoid_fast(pgb); const float G = wave_scan_incl(-alog * softplusf_(pga + dtb)); \
                const float G63 = __builtin_bit_cast(float, __builtin_amdgcn_readlane(__builtin_bit_cast(int, G), 63)); \
                scn_[lane] = be; scn_[64 + lane] = G; scn_[128 + lane] = __expf(G); scn_[192 + lane] = __expf(G63 - G); if (lane == 0) scn_[256] = __expf(G63); } \
            _Pragma("unroll") for (int jj = 0; jj < 2; ++jj) { const int pp = lt + 32 * jj; \
                const int po_ = 64 * (piece >> 2) + 32 * (piece & 1) + 8 * ((piece >> 1) & 1);     \
                LAS unsigned char* kr_ = lds + GP_K + pp * GP_KS + po_; LAS unsigned char* qr_ = lds + GP_Q + pp * GP_KS + po_; \
                *(LAS v2u*)kr_ = (v2u){pk[jj].x, pk[jj].y}; *(LAS v2u*)(kr_ + 16) = (v2u){pk[jj].z, pk[jj].w}; *(LAS v2u*)qr_ = (v2u){pq[jj].x, pq[jj].y}; *(LAS v2u*)(qr_ + 16) = (v2u){pq[jj].z, pq[jj].w}; \
                *(LAS v4u*)(lds + GP_V + pp * CS_KS + piece * 16) = pv[jj]; } } while (0)
        { LANE_VARS GDN_PREFETCH(0); __syncthreads(); GDN_STAGE1(0); GDN_PREFETCH(1); }
        for (int s = 0; s < 68; ++s) {
            LANE_VARS
            const bool is_ctx = s < 4;
            const size_t row0 = GDN_ROW0(s);
            LAS float* scb = sc0 + ((s & 1) << 9); LAS float* scG = scb + 64; LAS float* sceG = scb + 128; LAS float* scdK = scb + 192; LAS float* scl = scb + 256;
            __syncthreads();
            if (s > 4) GDN_FLUSH(s - 1);
            if (dir && !is_ctx) {
#pragma unroll
                for (int jj = 0; jj < 2; ++jj) fwdv[jj] = *(const v4u*)(on + (row0 + (63 - (lt + 32 * jj))) * 2048 + h * 128 + piece * 8); }
            gdn_build_kt(lds, tid);
            if (wave < 4) {
                const int bb = wave; f32x4 kk = (f32x4){0.f, 0.f, 0.f, 0.f}, qk = (f32x4){0.f, 0.f, 0.f, 0.f};
#pragma unroll
                for (int ks = 0; ks < 4; ++ks) { const bf16x8 kf = ldf16(lds + GP_K, 16 * bb + r, GP_KS, ks, q); const bf16x8 qf = ldf16(lds + GP_Q, 16 * bb + r, GP_KS, ks, q);
                    kk = MF32(kf, kf, kk); qk = MF32(kf, qf, qk); }
                const float Gr = scG[16 * bb + r], br = scb[16 * bb + r];
                const f32x4 Ge = *(const LAS f32x4*)(scG + 16 * bb + 4 * q), be4 = *(const LAS f32x4*)(scb + 16 * bb + 4 * q);
                f32x4 A, At, att;
#pragma unroll
                for (int e = 0; e < 4; ++e) { const int ie = 4 * q + e; const float dlo = __expf(fminf(Ge[e] - Gr, 0.f)), dhi = __expf(fminf(Gr - Ge[e], 0.f));
                    A[e] = (r < ie) ? be4[e] * kk[e] * dlo : 0.f;
                    At[e] = (ie < r) ? br * kk[e] * dhi : 0.f;
                    att[e] = (ie <= r) ? QSCALE * qk[e] * dhi : 0.f; }
                *(LAS s16x4*)(lds + GP_ATT + tri_idx(bb, bb) * 512 + lane * 8) = cvt4(att);
                const f32x4 Z = (f32x4){0.f, 0.f, 0.f, 0.f};
                f32x4 Rt;
#pragma unroll
                for (int e = 0; e < 4; ++e) Rt[e] = ((4 * q + e) == r ? 1.f : 0.f) - At[e];
                f32x4 Pm = MF16(cvt4(At), cvt4(A), Z), Pt = MF16(cvt4(A), cvt4(At), Z);
                Rt = MF16(cvt4(Pm), cvt4(Rt), Rt);
                f32x4 P2 = MF16(cvt4(Pt), cvt4(Pm), Z), Pt2 = MF16(cvt4(Pm), cvt4(Pt), Z);
                Rt = MF16(cvt4(P2), cvt4(Rt), Rt);
                f32x4 P4 = MF16(cvt4(Pt2), cvt4(P2), Z);
                Rt = MF16(cvt4(P4), cvt4(Rt), Rt);
                *(LAS s16x4*)(lds + GP_TD + bb * 512 + lane * 8) = cvt4(Rt);
            } else {
#pragma unroll
                for (int uu = 0; uu < 3; ++uu) { const int un = (wave - 4) + 4 * uu; const int pr = un % 6; const bool isqk = un >= 6;
                    const int bi = pr == 0 ? 1 : (pr < 3 ? 2 : 3), bj = pr == 0 ? 0 : (pr < 3 ? pr - 1 : pr - 3);
                    f32x4 d = (f32x4){0.f, 0.f, 0.f, 0.f};
                    const LAS unsigned char* bimg = lds + (isqk ? GP_Q : GP_K);
#pragma unroll
                    for (int ks = 0; ks < 4; ++ks) d = MF32(ldf16(lds + GP_K, 16 * bj + r, GP_KS, ks, q), ldf16(bimg, 16 * bi + r, GP_KS, ks, q), d);
                    const float Gi = scG[16 * bi + r], bi_ = scb[16 * bi + r]; const f32x4 Gj = *(const LAS f32x4*)(scG + 16 * bj + 4 * q);
                    const float f = isqk ? QSCALE : -bi_;
#pragma unroll
                    for (int e = 0; e < 4; ++e) d[e] = f * d[e] * __expf(fminf(Gi - Gj[e], 0.f));
                    *(LAS s16x4*)(lds + (isqk ? GP_ATT + tri_idx(bi, bj) * 512 : GP_AOFF + off_idx(bi, bj) * 512) + lane * 8) = cvt4(d); }
            }
            bf16x8 Sb[4];
#pragma unroll
            for (int ks = 0; ks < 4; ++ks) Sb[ks] = cat8(cvt4(S[2 * ks]), cvt4(S[2 * ks + 1]));
            bf16x8 fa[8];
#define LD8(img, t0) do { _Pragma("unroll") for (int t_ = 0; t_ < 2; ++t_) _Pragma("unroll") for (int ks_ = 0; ks_ < 4; ++ks_) fa[t_ * 4 + ks_] = ldf16(lds + (img), 16 * ((t0) + t_) + r, GP_KS, ks_, q); } while (0)
#define LD8T(u0) do { _Pragma("unroll") for (int u_ = 0; u_ < 4; ++u_) { fa[2 * u_] = ldf16(lds + GP_KT, 16 * ((u0) + u_) + r, GP_TS, 0, q); fa[2 * u_ + 1] = ldf16(lds + GP_KT, 16 * ((u0) + u_) + r, GP_TS, 1, q); } } while (0)
#define GDN_XS(dst, t0) do { _Pragma("unroll") for (int t = 0; t < 2; ++t) { f32x4 X = (f32x4){0.f, 0.f, 0.f, 0.f}; \
                _Pragma("unroll") for (int ks = 0; ks < 4; ++ks) X = MF32(fa[t * 4 + ks], Sb[ks], X); \
                dst[(t0) + t] = X; } } while (0)
            f32x4 vn[4], oq[4];
            LD8(GP_K, 0); GDN_XS(vn, 0);
            LD8(GP_K, 2); GDN_XS(vn, 2);
            if (!is_ctx) { LD8(GP_Q, 0); GDN_XS(oq, 0); LD8(GP_Q, 2); GDN_XS(oq, 2); }
            else {
#pragma unroll
                for (int t = 0; t < 4; ++t) oq[t] = (f32x4){0.f, 0.f, 0.f, 0.f}; }
#undef GDN_XS
#pragma unroll
            for (int t = 0; t < 4; ++t) { const f32x4 be4 = *(const LAS f32x4*)(scb + 16 * t + 4 * q), eg4 = *(const LAS f32x4*)(sceG + 16 * t + 4 * q);
#pragma unroll
                for (int e = 0; e < 4; ++e) { const float v = bflo((unsigned)*(const LAS unsigned short*)(lds + GP_V + (16 * t + 4 * q + e) * CS_KS + (c0 + r) * 2));
                    vn[t][e] = be4[e] * (v - eg4[e] * vn[t][e]); } }
            __syncthreads();
            if (wave >= 4 && s + 1 < 68) { GDN_STAGE1(s + 1); if (s + 2 < 68) GDN_PREFETCH(s + 2); }
            LD8T(0);
            { s16x4 td[4], ao[6];
#pragma unroll
              for (int i = 0; i < 4; ++i) td[i] = *(const LAS s16x4*)(lds + GP_TD + i * 512 + lane * 8);
#pragma unroll
              for (int i = 0; i < 6; ++i) ao[i] = *(const LAS s16x4*)(lds + GP_AOFF + i * 512 + lane * 8);
              vn[0] = MF16(td[0], cvt4(vn[0]), ((f32x4){0.f, 0.f, 0.f, 0.f}));
#pragma unroll
              for (int bi = 1; bi < 4; ++bi) { f32x4 a = vn[bi];
#pragma unroll
                  for (int bj = 0; bj < bi; ++bj) a = MF16(ao[off_idx(bi, bj)], cvt4(vn[bj]), a);
                  vn[bi] = MF16(td[bi], cvt4(a), ((f32x4){0.f, 0.f, 0.f, 0.f})); } }
            if (!is_ctx) {
                s16x4 vc[4];
#pragma unroll
                for (int t = 0; t < 4; ++t) vc[t] = cvt4(vn[t]);
#pragma unroll
                for (int t = 0; t < 4; ++t) { f32x4 a = oq[t]; const f32x4 eg4 = *(const LAS f32x4*)(sceG + 16 * t + 4 * q);
#pragma unroll
                    for (int e = 0; e < 4; ++e) a[e] *= QSCALE * eg4[e];
#pragma unroll
                    for (int tj = 0; tj <= t; ++tj) a = MF16(*(const LAS s16x4*)(lds + GP_ATT + tri_idx(t, tj) * 512 + lane * 8), vc[tj], a);
#pragma unroll
                    for (int e = 0; e < 4; ++e) *(LAS unsigned short*)(lds + GP_O + (16 * t + 4 * q + e) * CS_KS + (c0 + r) * 2) = (unsigned short)(pk2c(a[e], 0.f) & 0xffffu); }
            }
            if (wave < 4 && s + 1 < 68) { GDN_STAGE1(s + 1); if (s + 2 < 68) GDN_PREFETCH(s + 2); }
            { const float egl = scl[0]; s16x4 vd[4];
#pragma unroll
              for (int t = 0; t < 4; ++t) { const f32x4 dk4 = *(const LAS f32x4*)(scdK + 16 * t + 4 * q); vd[t] = cvt4(vn[t] * dk4); }
              const bf16x8 vb0 = cat8(vd[0], vd[1]), vb1 = cat8(vd[2], vd[3]);
#pragma unroll
              for (int u = 0; u < 4; ++u) { f32x4 a = S[u] * egl; a = MF32(fa[2 * u], vb0, a); a = MF32(fa[2 * u + 1], vb1, a); S[u] = a; }
              LD8T(4);
#pragma unroll
              for (int u = 0; u < 4; ++u) { f32x4 a = S[4 + u] * egl; a = MF32(fa[2 * u], vb0, a); a = MF32(fa[2 * u + 1], vb1, a); S[4 + u] = a; } }
        }
        { LANE_VARS __syncthreads(); GDN_FLUSH(67); }
#undef GDN_FLUSH
#undef GDN_STAGE1
#undef GDN_PREFETCH
#undef GDN_ROW0
    }
}

constexpr int GL_V = 34816, GL_VS = 528, GL_KT = 68608, GL_ATT = 87040, GL_G = 92160, GL_SC = 125952;
constexpr size_t WS_OB2 = 40 * MiB;
__device__ __forceinline__ void gla_unit(const P& p, LAS unsigned char* lds, const int b, const int h, const int dir) {
    const int wave = __builtin_amdgcn_readfirstlane(threadIdx.x >> 6);
    const bf16* pbuf = (const bf16*)(p.ws + WS_PB); const float* small = (const float*)(p.ws + WS_SMALL);
    bf16* outb = dir ? (bf16*)(p.ws + WS_OB2) + h * 256 : (bf16*)p.out + 1024 + h * 256; const int opitch = dir ? 1024 : 2048;
    LAS float* gl = (LAS float*)(lds + GL_SC);
    LAS unsigned char* zb = lds + GL_SC + 512;
    LAS unsigned char* wb = lds + GL_SC + 2560;
    LAS float* gbias = (LAS float*)(lds + GL_SC + 6656);
    {
        f32x4 S[2][8];
#pragma unroll
        for (int ct = 0; ct < 2; ++ct)
#pragma unroll
            for (int u = 0; u < 8; ++u) S[ct][u] = (f32x4){0.f, 0.f, 0.f, 0.f};
        __syncthreads();
        { const float* gw = dir ? p.gla_gate_w_b : p.gla_gate_w_f; const float* gbp = dir ? p.gla_gate_b_b : p.gla_gate_b_f;
          for (int i = threadIdx.x; i < 2048; i += NTHREADS) { const int dim = i >> 4, k = i & 15; *(LAS unsigned short*)(wb + i * 2) = (unsigned short)(pk2c(gw[k * 512 + h * 128 + dim], 0.f) & 0xffffu); }
          if (threadIdx.x < 128) gbias[threadIdx.x] = gbp[h * 128 + threadIdx.x]; }
        v4u pq[2], pk[2], pv[2][2]; float pz[2];
#define LANE_VARS int tz_ = threadIdx.x; asm volatile("" : "+v"(tz_)); const int tid = tz_, lane = tz_ & 63, r = lane & 15, q = lane >> 4, lt = tz_ >> 4, piece = tz_ & 15; (void)tid; (void)r; (void)q; (void)lt; (void)piece;
#define GLA_ROW0(s_) (((s_) < 4) ? (size_t)(T + b * CTXL + (dir ? 3 - (s_) : (s_)) * 64) : (size_t)(b * SEQ + (dir ? 63 - ((s_) - 4) : (s_) - 4) * 64))
#define GLA_PREFETCH(s_) do { const size_t r0_ = GLA_ROW0(s_); \
            _Pragma("unroll") for (int jj = 0; jj < 2; ++jj) { const int pp = lt + 32 * jj; const bf16* rp = pbuf + (r0_ + (dir ? 63 - pp : pp)) * 2048; \
                pq[jj] = *(const v4u*)(rp + h * 128 + piece * 8); pk[jj] = *(const v4u*)(rp + 512 + h * 128 + piece * 8); \
                pv[jj][0] = *(const v4u*)(rp + 1024 + h * 256 + piece * 8); pv[jj][1] = *(const v4u*)(rp + 1024 + h * 256 + 128 + piece * 8); \
                pz[jj] = small[(r0_ + (dir ? 63 - pp : pp)) * 64 + 32 + dir * 16 + piece]; } } while (0)
        { LANE_VARS GLA_PREFETCH(0); }
        for (int s = 0; s < 68; ++s) {
            LANE_VARS
            const bool is_ctx = s < 4;
            const size_t row0 = GLA_ROW0(s);
            __syncthreads();
#pragma unroll
            for (int jj = 0; jj < 2; ++jj) { const int pp = lt + 32 * jj;
                *(LAS v4u*)(lds + L_K + pp * CS_KS + piece * 16) = pk[jj];
                *(LAS v4u*)(lds + GL_V + pp * GL_VS + piece * 16) = pv[jj][0]; *(LAS v4u*)(lds + GL_V + pp * GL_VS + 256 + piece * 16) = pv[jj][1];
                *(LAS unsigned short*)(zb + (pp * 16 + piece) * 2) = (unsigned short)(pk2c(pz[jj], 0.f) & 0xffffu); }
            __syncthreads();
            { const int c0 = wave * 16;
              const s16x4 wfr = *(const LAS s16x4*)(wb + (c0 + r) * 32 + q * 8); const float bia = gbias[c0 + r];
              s16x4 lgb[4];
#pragma unroll
              for (int t = 0; t < 4; ++t) { f32x4 u = MF16(*(const LAS s16x4*)(zb + (16 * t + r) * 32 + q * 8), wfr, ((f32x4){0.f, 0.f, 0.f, 0.f}));
#pragma unroll
                  for (int e = 0; e < 4; ++e) { const float x = u[e] + bia; u[e] = (fminf(x, 0.f) - 0.69314718f * __builtin_amdgcn_logf(1.0f + __builtin_amdgcn_exp2f(-1.44269504f * fabsf(x)))) * (1.0f / 16.0f); }
                  lgb[t] = cvt4(u); }
              s16x4 ltri, lone;
              { v2u a, o1; const unsigned one = 0x3f80u;
                a.x = ((4 * q + 0 <= r) ? one : 0u) | (((4 * q + 1 <= r) ? one : 0u) << 16); a.y = ((4 * q + 2 <= r) ? one : 0u) | (((4 * q + 3 <= r) ? one : 0u) << 16);
                o1.x = one | (one << 16); o1.y = o1.x; ltri = __builtin_bit_cast(s16x4, a); lone = __builtin_bit_cast(s16x4, o1); }
              f32x4 gc[4];
#pragma unroll
              for (int ti = 0; ti < 4; ++ti) { f32x4 a = (f32x4){0.f, 0.f, 0.f, 0.f};
#pragma unroll
                  for (int tj = 0; tj <= ti; ++tj) a = MF16(tj == ti ? ltri : lone, lgb[tj], a);
                  gc[ti] = a; }
              const float tot = __shfl(gc[3][3], 48 + r);
              if (q == 0) gl[c0 + r] = __expf(tot);
#pragma unroll
              for (int t = 0; t < 4; ++t) { float kd[4];
#pragma unroll
                  for (int e = 0; e < 4; ++e) { *(LAS float*)(lds + GL_G + (16 * t + 4 * q + e) * GL_VS + (c0 + r) * 4) = gc[t][e];
                      const float kv = bflo((unsigned)*(const LAS unsigned short*)(lds + L_K + (16 * t + 4 * q + e) * CS_KS + (c0 + r) * 2));
                      kd[e] = kv * __expf(tot - gc[t][e]); }
                  v2u w; w.x = pk2c(kd[0], kd[1]); w.y = pk2c(kd[2], kd[3]);
                  *(LAS v2u*)(lds + GL_KT + (c0 + r) * CS_TS + (16 * t + 4 * q) * 2) = w; } }
            __syncthreads();
#pragma unroll
            for (int jj = 0; jj < 2; ++jj) { const int pp = lt + 32 * jj;
                const f32x4 g0 = *(const LAS f32x4*)(lds + GL_G + pp * GL_VS + piece * 32), g1 = *(const LAS f32x4*)(lds + GL_G + pp * GL_VS + piece * 32 + 16);
                float qf[8], kf[8]; unpack8(pq[jj], qf); unpack8(pk[jj], kf);
#pragma unroll
                for (int e = 0; e < 4; ++e) { qf[e] *= QSCALE * __expf(g0[e]); kf[e] *= __expf(fminf(-g0[e], 80.f)); qf[4 + e] *= QSCALE * __expf(g1[e]); kf[4 + e] *= __expf(fminf(-g1[e], 80.f)); }
                *(LAS v4u*)(lds + L_Q + pp * CS_KS + piece * 16) = pack8c(qf); *(LAS v4u*)(lds + L_K + pp * CS_KS + piece * 16) = pack8c(kf); }
            if (s + 1 < 68) GLA_PREFETCH(s + 1);
            __syncthreads();
            if (!is_ctx) {
#pragma unroll
                for (int uu = 0; uu < 2; ++uu) { const int un = wave + 8 * uu; if (un < 10) {
                    const int bi = un < 1 ? 0 : (un < 3 ? 1 : (un < 6 ? 2 : 3)), bj = un - bi * (bi + 1) / 2;
                    bf16x8 fk[4], fq[4];
#pragma unroll
                    for (int ks = 0; ks < 4; ++ks) { fk[ks] = ldfrag(lds + L_K, 16 * bj + r, CS_KS, ks, q); fq[ks] = ldfrag(lds + L_Q, 16 * bi + r, CS_KS, ks, q); }
                    f32x4 d = (f32x4){0.f, 0.f, 0.f, 0.f};
#pragma unroll
                    for (int ks = 0; ks < 4; ++ks) d = MF32(fk[ks], fq[ks], d);
                    if (bi == bj) {
#pragma unroll
                        for (int e = 0; e < 4; ++e) d[e] = ((4 * q + e) <= r) ? d[e] : 0.f; }
                    *(LAS s16x4*)(lds + GL_ATT + un * 512 + lane * 8) = cvt4(d); } }
                __syncthreads();
            }
#define GLD8(img, t0) do { _Pragma("unroll") for (int t_ = 0; t_ < 2; ++t_) _Pragma("unroll") for (int ks_ = 0; ks_ < 4; ++ks_) fa[t_ * 4 + ks_] = ldfrag(lds + (img), 16 * ((t0) + t_) + r, CS_KS, ks_, q); } while (0)
#define GLD8T(u0) do { _Pragma("unroll") for (int u_ = 0; u_ < 4; ++u_) { fa[2 * u_] = ldfrag(lds + GL_KT, 16 * ((u0) + u_) + r, CS_TS, 0, q); fa[2 * u_ + 1] = ldfrag(lds + GL_KT, 16 * ((u0) + u_) + r, CS_TS, 1, q); } } while (0)
            { const int cc0 = wave * 16;
              bf16x8 fa[8];
              if (!is_ctx) GLD8(L_Q, 0); else GLD8T(0);
              s16x4 vt[2][4];
#pragma unroll
              for (int ct = 0; ct < 2; ++ct)
#pragma unroll
                  for (int t = 0; t < 4; ++t) { unsigned short v[4];
#pragma unroll
                      for (int e = 0; e < 4; ++e) v[e] = *(const LAS unsigned short*)(lds + GL_V + (16 * t + 4 * q + e) * GL_VS + (ct * 128 + cc0 + r) * 2);
                      v2u w; w.x = (unsigned)v[0] | ((unsigned)v[1] << 16); w.y = (unsigned)v[2] | ((unsigned)v[3] << 16); vt[ct][t] = __builtin_bit_cast(s16x4, w); }
              if (!is_ctx) {
                  f32x4 o[2][4];
                  { bf16x8 Sb[2][4];
#pragma unroll
                    for (int ct = 0; ct < 2; ++ct)
#pragma unroll
                        for (int ks = 0; ks < 4; ++ks) Sb[ct][ks] = cat8(cvt4(S[ct][2 * ks]), cvt4(S[ct][2 * ks + 1]));
#pragma unroll
                    for (int ct = 0; ct < 2; ++ct)
#pragma unroll
                        for (int t = 0; t < 2; ++t) { f32x4 a = (f32x4){0.f, 0.f, 0.f, 0.f};
#pragma unroll
                            for (int ks = 0; ks < 4; ++ks) a = MF32(fa[t * 4 + ks], Sb[ct][ks], a);
                            o[ct][t] = a; }
                    GLD8(L_Q, 2);
#pragma unroll
                    for (int ct = 0; ct < 2; ++ct)
#pragma unroll
                        for (int t = 0; t < 2; ++t) { f32x4 a = (f32x4){0.f, 0.f, 0.f, 0.f};
#pragma unroll
                            for (int ks = 0; ks < 4; ++ks) a = MF32(fa[t * 4 + ks], Sb[ct][ks], a);
                            o[ct][2 + t] = a; } }
                  GLD8T(0);
#pragma unroll
                  for (int t = 0; t < 4; ++t) { s16x4 at[4];
#pragma unroll
                      for (int tj = 0; tj <= t; ++tj) at[tj] = *(const LAS s16x4*)(lds + GL_ATT + tri_idx(t, tj) * 512 + lane * 8);
#pragma unroll
                      for (int ct = 0; ct < 2; ++ct) { f32x4 a = o[ct][t];
#pragma unroll
                          for (int tj = 0; tj <= t; ++tj) a = MF16(at[tj], vt[ct][tj], a);
#pragma unroll
                          for (int e = 0; e < 4; ++e) *(LAS unsigned short*)(lds + GL_G + (16 * t + 4 * q + e) * GL_VS + (ct * 128 + cc0 + r) * 2) = (unsigned short)(pk2c(a[e], 0.f) & 0xffffu); } }
              }
              { bf16x8 vb0[2], vb1[2];
#pragma unroll
                for (int ct = 0; ct < 2; ++ct) { vb0[ct] = cat8(vt[ct][0], vt[ct][1]); vb1[ct] = cat8(vt[ct][2], vt[ct][3]); }
#pragma unroll
                for (int u = 0; u < 4; ++u) { const f32x4 g4 = *(const LAS f32x4*)(gl + 16 * u + 4 * q);
#pragma unroll
                    for (int ct = 0; ct < 2; ++ct) { f32x4 a = S[ct][u] * g4; a = MF32(fa[2 * u], vb0[ct], a); a = MF32(fa[2 * u + 1], vb1[ct], a); S[ct][u] = a; } }
                GLD8T(4);
#pragma unroll
                for (int u = 0; u < 4; ++u) { const f32x4 g4 = *(const LAS f32x4*)(gl + 16 * (4 + u) + 4 * q);
#pragma unroll
                    for (int ct = 0; ct < 2; ++ct) { f32x4 a = S[ct][4 + u] * g4; a = MF32(fa[2 * u], vb0[ct], a); a = MF32(fa[2 * u + 1], vb1[ct], a); S[ct][4 + u] = a; } } }
            }
#undef GLD8
#undef GLD8T
            if (!is_ctx) {
                __syncthreads();
#pragma unroll
                for (int jj = 0; jj < 2; ++jj) { const int pp = lt + 32 * jj; bf16* dst = outb + (row0 + (dir ? 63 - pp : pp)) * opitch + piece * 8;
                    *(v4u*)dst = *(const LAS v4u*)(lds + GL_G + pp * GL_VS + piece * 16); *(v4u*)(dst + 128) = *(const LAS v4u*)(lds + GL_G + pp * GL_VS + 256 + piece * 16); }
            }
        }
#undef GLA_PREFETCH
#undef GLA_ROW0
#undef LANE_VARS
    }
}
#ifndef SCAN_ORACLE
#define SCAN_ORACLE 0
#endif

__device__ __forceinline__ void phase_wconv(const P& p, LAS unsigned char* lds, const int which, const int worker, const int nworkers);
__device__ __forceinline__ void phase_scan(const P& p, LAS unsigned char* lds) {
  const int nrep = p.probe ? 2 : 1;
  for (int rep = 0; rep < nrep; ++rep) {
    const int kinds = rep ? p.probe : 3;
    for (int u = blockIdx.x; u < 256; u += gridDim.x) {
        if (!((kinds >> (u & 1)) & 1)) continue;
#if SCAN_ORACLE
        if (u < 128) scan_unit<false>(p, lds, u >> 3, u & 7, 0);
        else { const int v = u - 128; scan_unit<true>(p, lds, v >> 3, (v >> 1) & 3, v & 1); }
#else
#ifndef GLA_ORACLE
#define GLA_ORACLE 0
#endif
#if !defined(TEST_NO_GDN)
        if ((u & 1) == 0) { const int v = u >> 1; gdn_unit(p, lds, v >> 3, v & 7); }
#else
        if ((u & 1) == 0) {}
#endif
#if defined(TEST_NO_GLA)
        else {}
#elif GLA_ORACLE
        else { const int v = u >> 1; scan_unit<true>(p, lds, v >> 3, (v >> 1) & 3, v & 1); }
#else
        else { const int v = u >> 1; gla_unit(p, lds, v >> 3, (v >> 1) & 3, v & 1); }
#endif
#endif
        __syncthreads();
    }
    __syncthreads();
  }
  { const int nw = (int)gridDim.x >> 1;
    if (nw == 0) phase_wconv(p, lds, 0, 0, 1);
    else if (blockIdx.x & 1) phase_wconv(p, lds, 0, (int)blockIdx.x >> 1, nw); }
}

__device__ __forceinline__ void phase_onorm(const P& p) {
    const int tid = threadIdx.x, lane = tid & 63, wave = tid >> 6;
    const int gw = blockIdx.x * NWAVES + wave, NGW = gridDim.x * NWAVES;
    bf16* on = (bf16*)p.out;
#if SCAN_ORACLE
    const float* gp = lane < 32 ? p.gdn_norm_g + (lane & 3) * 32 : p.gla_norm_g + ((lane - 32) & 7) * 32;
    float g[32];
#pragma unroll
    for (int i = 0; i < 32; ++i) g[i] = gp[i];
    for (int r = gw; r < T; r += NGW) {
        v4u* ptr = (v4u*)(on + (size_t)r * 2048 + lane * 32); float f[32]; float ss = 0.f;
#pragma unroll
        for (int q = 0; q < 4; ++q) { float t8[8]; unpack8(ptr[q], t8);
#pragma unroll
            for (int e = 0; e < 8; ++e) { f[q * 8 + e] = t8[e]; ss += t8[e] * t8[e]; } }
        ss += __shfl_xor(ss, 1); ss += __shfl_xor(ss, 2);
        const float s4 = __shfl_xor(ss, 4);
        const float rstd = lane < 32 ? rsqrtf_(ss * (1.f / 128.f) + EPS) : rsqrtf_((ss + s4) * (1.f / 256.f) + EPS);
#pragma unroll
        for (int q = 0; q < 4; ++q) { float t8[8];
#pragma unroll
            for (int e = 0; e < 8; ++e) t8[e] = f[q * 8 + e] * rstd * g[q * 8 + e];
            ptr[q] = pack8(t8); }
    }
#else
    float g[16];
#pragma unroll
    for (int i = 0; i < 16; ++i) g[i] = p.gla_norm_g[(lane & 15) * 16 + i];
    const bf16* ob2 = (const bf16*)(p.ws + WS_OB2);
    v4u nxt[4];
    if (gw < T) { const v4u* pp = (const v4u*)(on + (size_t)gw * 2048 + 1024 + lane * 16); const v4u* pb = (const v4u*)(ob2 + (size_t)gw * 1024 + lane * 16); nxt[0] = pp[0]; nxt[1] = pp[1]; nxt[2] = pb[0]; nxt[3] = pb[1]; }
    for (int r = gw; r < T; r += NGW) {
        v4u* ptr = (v4u*)(on + (size_t)r * 2048 + 1024 + lane * 16); float f[16]; float ss = 0.f;
        const v4u cur[4] = {nxt[0], nxt[1], nxt[2], nxt[3]};
        if (r + NGW < T) { const v4u* pp = (const v4u*)(on + (size_t)(r + NGW) * 2048 + 1024 + lane * 16); const v4u* pb = (const v4u*)(ob2 + (size_t)(r + NGW) * 1024 + lane * 16); nxt[0] = pp[0]; nxt[1] = pp[1]; nxt[2] = pb[0]; nxt[3] = pb[1]; }
#pragma unroll
        for (int q = 0; q < 2; ++q) { float t8[8], u8[8]; unpack8(cur[q], t8); unpack8(cur[2 + q], u8);
#pragma unroll
            for (int e = 0; e < 8; ++e) { const float x = t8[e] + u8[e]; f[q * 8 + e] = x; ss += x * x; } }
        ss = row16_sum(ss);
        const float rstd = rsqrtf_(ss * (1.f / 256.f) + EPS);
#pragma unroll
        for (int q = 0; q < 2; ++q) { float t8[8];
#pragma unroll
            for (int e = 0; e < 8; ++e) t8[e] = f[q * 8 + e] * rstd * g[q * 8 + e];
            ptr[q] = pack8(t8); }
    }
#endif
}

__device__ __forceinline__ void phase_wconv(const P& p, LAS unsigned char* lds, const int which, const int worker, const int nworkers) {
    const int tid = threadIdx.x, lane = tid & 63, wave = tid >> 6;
    LAS float* scr = (LAS float*)(lds + wave * 8448);
    const int gw = worker * NWAVES + wave, NGW = nworkers * NWAVES;
    constexpr int I_GUE = EARLY_GU * 64 * 16, I_GUL = (NE - EARLY_GU) * 64 * 16, I_DN = NE * 32 * 16;
    const int I_GUH = which ? I_GUL : I_GUE; const int nit = which ? I_GUL : I_GUE + I_DN;
#define WC_ITEM(it_, W_, ld_, c0_, dst_, dr_, k0_) do { if ((it_) < I_GUH) { const int e_ = ((it_) >> 10) + (which ? EARLY_GU : 0), r_ = (it_) & 1023, nb_ = r_ & 63;     \
            W_ = p.w_gu + (size_t)e_ * D * 2048; ld_ = 2048; c0_ = 32 * nb_; dst_ = p.ws + (size_t)wb_gu_mib(e_) * MiB; k0_ = 64 * (r_ >> 6); \
            dr_ = nb_ < 32 ? (nb_ >> 2) * 256 + (nb_ & 3) * 32 : ((nb_ - 32) >> 2) * 256 + 128 + ((nb_ - 32) & 3) * 32; } \
        else { const int r2_ = (it_) - I_GUH, e_ = r2_ >> 9, r_ = r2_ & 511, nb_ = r_ & 31; \
            W_ = p.w_down + (size_t)e_ * D * D; ld_ = D; c0_ = 32 * nb_; dst_ = p.ws + (size_t)wb_dn_mib(e_) * MiB; k0_ = 64 * (r_ >> 5); dr_ = 32 * nb_; } } while (0)
    float tn[32];
    const float* W; int ld, c0, dr, k0; unsigned char* dst;
    if (gw < nit) { WC_ITEM(gw, W, ld, c0, dst, dr, k0); tr8_load(tn, W, ld, c0, k0, lane); }
    for (int it = gw; it < nit; it += NGW) {
        float t[32];
#pragma unroll
        for (int i = 0; i < 32; ++i) t[i] = tn[i];
        unsigned char* cdst = dst; const int cdr = dr, ck0 = k0;
        if (it + NGW < nit) { WC_ITEM(it + NGW, W, ld, c0, dst, dr, k0); tr8_load(tn, W, ld, c0, k0, lane); }
        tr8_finish(t, cdst, cdr, ck0, scr, lane);
    }
#undef WC_ITEM
}

#define DPPF(x, ctrl) __builtin_bit_cast(float, __builtin_amdgcn_update_dpp(0, __builtin_bit_cast(int, (x)), (ctrl), 0xF, 0xF, true))
#define DPPI(x, ctrl) __builtin_amdgcn_update_dpp(0, (x), (ctrl), 0xF, 0xF, true)
#define AMAX_STEP(bv, bi, ctrl) { const float ov = DPPF(bv, ctrl); const int oi = DPPI(bi, ctrl); \
    const bool tk = (ov > bv) || (ov == bv && oi < bi); bv = tk ? ov : bv; bi = tk ? oi : bi; }
__device__ __forceinline__ void phase_ffnprep(const P& p, LAS unsigned char* lds) {
    const int tid = threadIdx.x, lane = tid & 63, wave = tid >> 6;
    LAS float* wp = (LAS float*)lds;
    LAS float* part = (LAS float*)(lds + 131584);
    LAS float* cb = (LAS float*)(lds + 132608);
    LAS float* rs = (LAS float*)(lds + 132736);
    LAS int* lcnt = (LAS int*)(lds + 133760);
    const float* modv = (const float*)(p.ws + WS_MODV); unsigned char* h2 = MOE_GATHER ? p.ws + WS_XG : (unsigned char*)p.out; const bf16* x1b = (const bf16*)(p.ws + WS_X1B);
    int* topi = (int*)(p.ws + WS_TOPI); float* topp = (float*)(p.ws + WS_TOPP);
    { int* st = (int*)(p.ws + WS_SLOT_TOK); float* sp = (float*)(p.ws + WS_SLOT_P);
      for (int i = blockIdx.x * NTHREADS + tid; i < NG * MAXSLOT; i += gridDim.x * NTHREADS) { st[i] = -1; sp[i] = 0.f; } }
    for (int r0 = blockIdx.x * 256; r0 < T; r0 += gridDim.x * 256) {
        const int b = r0 >> 12;
        const float* shp = modv + b * NMOD + 3 * D; const float* scp = modv + b * NMOD + 4 * D;
        __syncthreads();
        { float ca0 = 0.f, ca1 = 0.f, ca2 = 0.f, ca3 = 0.f; const int e4 = tid & 7;
#pragma unroll 4
          for (int it = 0; it < 16; ++it) { const int i4 = tid + NTHREADS * it, k = i4 >> 3;
              const f32x4 wv = ((const f32x4*)p.w_router)[i4]; const float gk = p.norm_ffn_g[k] * (1.0f + scp[k]), sk = shp[k];
              wp[(4 * e4 + 0) * 1028 + k] = wv.x * gk; wp[(4 * e4 + 1) * 1028 + k] = wv.y * gk;
              wp[(4 * e4 + 2) * 1028 + k] = wv.z * gk; wp[(4 * e4 + 3) * 1028 + k] = wv.w * gk;
              ca0 += sk * wv.x; ca1 += sk * wv.y; ca2 += sk * wv.z; ca3 += sk * wv.w; }
#pragma unroll
          for (int m = 8; m < 64; m <<= 1) { ca0 += __shfl_xor(ca0, m); ca1 += __shfl_xor(ca1, m); ca2 += __shfl_xor(ca2, m); ca3 += __shfl_xor(ca3, m); }
          if (lane < 8) { part[wave * 32 + 4 * lane + 0] = ca0; part[wave * 32 + 4 * lane + 1] = ca1; part[wave * 32 + 4 * lane + 2] = ca2; part[wave * 32 + 4 * lane + 3] = ca3; } }
        if (tid < NG * 32) lcnt[tid] = 0;
        __syncthreads();
        if (tid < 32) { float s = p.b_router[tid];
#pragma unroll
            for (int w = 0; w < 8; ++w) s += part[w * 32 + tid];
            cb[tid] = s; }
        const int rw = r0 + 32 * wave;
        { f32x4 gs[4], s1[4];
#pragma unroll
          for (int j = 0; j < 4; ++j) { const f32x4 gg = ((const f32x4*)p.norm_ffn_g)[lane + 64 * j], s2 = ((const f32x4*)scp)[lane + 64 * j];
              gs[j] = gg * (1.0f + s2); s1[j] = ((const f32x4*)shp)[lane + 64 * j]; }
          f32x4 nx[4];
          { const v2u* xr = (const v2u*)(x1b + (size_t)rw * D) + lane;
#pragma unroll
            for (int j = 0; j < 4; ++j) nx[j] = ldx4(xr[64 * j]); }
          for (int t = 0; t < 32; ++t) {
              const int r = rw + t;
              f32x4 v[4]; float s = 0.f;
#pragma unroll
              for (int j = 0; j < 4; ++j) { v[j] = nx[j]; s += (v[j].x * v[j].x + v[j].y * v[j].y) + (v[j].z * v[j].z + v[j].w * v[j].w); }
              if (t + 1 < 32) { const v2u* xr = (const v2u*)(x1b + (size_t)(r + 1) * D) + lane;
#pragma unroll
                  for (int j = 0; j < 4; ++j) nx[j] = ldx4(xr[64 * j]); }
              const float rstd = rsqrtf_(wave_sum(s) * (1.f / D) + EPS);
              if (lane == 0) rs[32 * wave + t] = rstd;
              unsigned* o8 = (unsigned*)(h2 + (size_t)r * D) + lane;
#pragma unroll
              for (int j = 0; j < 4; ++j) { v[j] = v[j] * rstd * gs[j] + s1[j]; o8[64 * j] = pk4f8(v[j].x, v[j].y, v[j].z, v[j].w); }
          } }
        __syncthreads();
        const int n = lane & 15, q = lane >> 4;
#pragma unroll 1
        for (int tt = 0; tt < 2; ++tt) {
            const int tb = rw + 16 * tt;
            const v4u* xr = (const v4u*)(x1b + (size_t)(tb + n) * D) + q;
            const LAS float* w0 = wp + n * 1028 + 8 * q; const LAS float* w1 = w0 + 16 * 1028;
            f32x4 acc0 = {0.f, 0.f, 0.f, 0.f}, acc1 = {0.f, 0.f, 0.f, 0.f};
            v4u xa[8], xb[8];
#pragma unroll
            for (int i = 0; i < 8; ++i) xa[i] = xr[4 * i];
#define FFN_MF(xf, wa, wb) acc0 = __builtin_amdgcn_mfma_f32_16x16x4f32((xf), (wa), acc0, 0, 0, 0); acc1 = __builtin_amdgcn_mfma_f32_16x16x4f32((xf), (wb), acc1, 0, 0, 0);
#define FFN_GRP(X, g) _Pragma("unroll") for (int i = 0; i < 8; ++i) { const int sp_ = 8 * (g) + i; \
                const f32x4 wv0a = *(const LAS f32x4*)(w0 + 32 * sp_), wv0b = *(const LAS f32x4*)(w0 + 32 * sp_ + 4), wv1a = *(const LAS f32x4*)(w1 + 32 * sp_), wv1b = *(const LAS f32x4*)(w1 + 32 * sp_ + 4); \
                FFN_MF(bflo(X[i].x), wv0a.x, wv1a.x) FFN_MF(bfhi(X[i].x), wv0a.y, wv1a.y) FFN_MF(bflo(X[i].y), wv0a.z, wv1a.z) FFN_MF(bfhi(X[i].y), wv0a.w, wv1a.w) \
                FFN_MF(bflo(X[i].z), wv0b.x, wv1b.x) FFN_MF(bfhi(X[i].z), wv0b.y, wv1b.y) FFN_MF(bflo(X[i].w), wv0b.z, wv1b.z) FFN_MF(bfhi(X[i].w), wv0b.w, wv1b.w) }
#pragma unroll 1
            for (int g = 0; g < 4; g += 2) {
#pragma unroll
                for (int i = 0; i < 8; ++i) xb[i] = xr[4 * (8 * (g + 1) + i)];
                FFN_GRP(xa, g)
                if (g + 2 < 4) {
#pragma unroll
                    for (int i = 0; i < 8; ++i) xa[i] = xr[4 * (8 * (g + 2) + i)]; }
                FFN_GRP(xb, g + 1)
            }
#undef FFN_MF
            const float c0 = cb[n], c1 = cb[16 + n];
            float v0[4], v1[4];
#pragma unroll
            for (int j = 0; j < 4; ++j) { const float rsd = rs[32 * wave + 16 * tt + 4 * q + j]; v0[j] = acc0[j] * rsd + c0; v1[j] = acc1[j] * rsd + c1; }
#pragma unroll
            for (int j = 0; j < 4; ++j) {
                int sel[4]; float val[4];
#pragma unroll
                for (int k = 0; k < 4; ++k) {
                    float bv; int bi;
                    if (v1[j] > v0[j]) { bv = v1[j]; bi = 16 + n; } else { bv = v0[j]; bi = n; }
                    AMAX_STEP(bv, bi, 0xB1) AMAX_STEP(bv, bi, 0x4E) AMAX_STEP(bv, bi, 0x141) AMAX_STEP(bv, bi, 0x140)
                    sel[k] = bi; val[k] = bv;
                    v0[j] = (bi == n) ? -3.0e38f : v0[j]; v1[j] = (bi == 16 + n) ? -3.0e38f : v1[j];
                }
                float pe[4], ps = 0.f;
#pragma unroll
                for (int k = 0; k < 4; ++k) { pe[k] = __expf(val[k] - val[0]); ps += pe[k]; }
                if (n < 4) { const int r = tb + 4 * q + j;
                    const int e = n == 0 ? sel[0] : (n == 1 ? sel[1] : (n == 2 ? sel[2] : sel[3])); const float pv = (n == 0 ? pe[0] : (n == 1 ? pe[1] : (n == 2 ? pe[2] : pe[3]))) / ps;
                    topi[r * 4 + n] = e; topp[r * 4 + n] = pv; lds_add(&lcnt[(r / TG) * 32 + e], 1); }
            }
        }
        __syncthreads();
        if (tid < NG * 32) { const int v = lcnt[tid]; if (v) atomicAdd((int*)(p.ws + WS_CTL) + CW_CNT + tid, v); }
    }
}

__device__ __forceinline__ void phase_route(const P& p, LAS unsigned char* lds) {
    const int tid = threadIdx.x;
    LAS int* seg = (LAS int*)lds;
    LAS int* lcnt = seg + 64; LAS int* gb = lcnt + 32;
    int* ctl = (int*)(p.ws + WS_CTL);
    int* tile_e = (int*)(p.ws + WS_TILE_E);
    if (tid < 64) {
        const int c = __hip_atomic_load(ctl + CW_CNT + tid, __ATOMIC_RELAXED, __HIP_MEMORY_SCOPE_AGENT); const int padded = (c + 255) & ~255;
        int incl = padded;
#pragma unroll
        for (int d = 1; d < 32; d <<= 1) { const int t = __shfl_up(incl, d, 32); if ((tid & 31) >= d) incl += t; }
        const int start = incl - padded; seg[tid] = start;
        if (blockIdx.x == 0) { for (int t = start >> 8; t < (start + padded) >> 8; ++t) tile_e[(tid >> 5) * MAXTILE + t] = tid & 31;
            if ((tid & 31) == 31) ctl[CW_NTILE + (tid >> 5)] = incl >> 8; }
    }
    __syncthreads();
    const int* topi = (const int*)(p.ws + WS_TOPI); const float* topp = (const float*)(p.ws + WS_TOPP);
    int* slot_tok = (int*)(p.ws + WS_SLOT_TOK); float* slot_p = (float*)(p.ws + WS_SLOT_P); int* tokslot = (int*)(p.ws + WS_TOKSLOT);
    for (int base = blockIdx.x * 256; base < T; base += gridDim.x * 256) {
        const int g = base / TG;
        if (tid < 32) lcnt[tid] = 0;
        __syncthreads();
        int e2[2], lp[2];
#pragma unroll
        for (int jj = 0; jj < 2; ++jj) { const int i = tid + 512 * jj; e2[jj] = topi[base * 4 + i]; lp[jj] = lds_add(&lcnt[e2[jj]], 1); }
        __syncthreads();
        if (tid < 32) gb[tid] = lcnt[tid] ? atomicAdd(ctl + CW_CUR + g * 32 + tid, lcnt[tid]) : 0;
        __syncthreads();
#pragma unroll
        for (int jj = 0; jj < 2; ++jj) { const int i = tid + 512 * jj; const int slot = seg[g * 32 + e2[jj]] + gb[e2[jj]] + lp[jj];
            slot_tok[g * MAXSLOT + slot] = base + (i >> 2); slot_p[g * MAXSLOT + slot] = topp[base * 4 + i]; tokslot[base * 4 + i] = slot; }
        __syncthreads();
        if (!MOE_GATHER) { const int wave = tid >> 6, lane = tid & 63; const unsigned char* h2 = (const unsigned char*)p.out; unsigned char* xg = p.ws + WS_XG + (size_t)g * MAXSLOT * D;
          for (int i0 = wave * 128; i0 < wave * 128 + 128; i0 += 8) { int sl[8]; v4u rw[8];
#pragma unroll
              for (int j = 0; j < 8; ++j) sl[j] = tokslot[base * 4 + i0 + j];
#pragma unroll
              for (int j = 0; j < 8; ++j) rw[j] = *(const v4u*)(h2 + (size_t)(base + ((i0 + j) >> 2)) * D + lane * 16);
#pragma unroll
              for (int j = 0; j < 8; ++j) *(v4u*)(xg + (size_t)sl[j] * D + lane * 16) = rw[j]; } }
        __syncthreads();
    }
}

__device__ __forceinline__ void phase_combine(const P& p, int g) {
    const int tid = threadIdx.x, lane = tid & 63, wave = tid >> 6;
    const int gw = blockIdx.x * NWAVES + wave, NGW = gridDim.x * NWAVES;
    const float* modv = (const float*)(p.ws + WS_MODV); const bf16* ys = (const bf16*)(p.ws + WS_YSLOT); const int* tokslot = (const int*)(p.ws + WS_TOKSLOT); const bf16* x1b = (const bf16*)(p.ws + WS_X1B);
    int nsl[4]; f32x4 nx[4];
    { const int r0 = g * TG + gw; if (r0 < (g + 1) * TG) { const v2u* xr0 = (const v2u*)(x1b + (size_t)r0 * D) + lane;
#pragma unroll
        for (int k = 0; k < 4; ++k) nsl[k] = tokslot[r0 * 4 + k];
#pragma unroll
        for (int j = 0; j < 4; ++j) nx[j] = ldx4(xr0[64 * j]); } }
    for (int r = g * TG + gw; r < (g + 1) * TG; r += NGW) {
        const int b = r >> 12;
        f32x4* xr = (f32x4*)(p.out + (size_t)r * D) + lane;
        const f32x4* g2 = (const f32x4*)(modv + b * NMOD + 5 * D) + lane;
        unsigned yw[4][4];
#pragma unroll
        for (int k = 0; k < 4; ++k) { const unsigned* yr = (const unsigned*)((const unsigned char*)ys + (size_t)nsl[k] * D) + lane;
#pragma unroll
            for (int j = 0; j < 4; ++j) yw[k][j] = yr[64 * j]; }
        f32x4 xc[4];
#pragma unroll
        for (int j = 0; j < 4; ++j) xc[j] = nx[j];
        if (r + NGW < (g + 1) * TG) { const v2u* xn = (const v2u*)(x1b + (size_t)(r + NGW) * D) + lane;
#pragma unroll
            for (int k = 0; k < 4; ++k) nsl[k] = tokslot[(r + NGW) * 4 + k];
#pragma unroll
            for (int j = 0; j < 4; ++j) nx[j] = ldx4(xn[64 * j]); }
        f32x4 y[4];
#pragma unroll
        for (int j = 0; j < 4; ++j) y[j] = (f32x4){0.f, 0.f, 0.f, 0.f};
#pragma unroll
        for (int k = 0; k < 4; ++k)
#pragma unroll
            for (int j = 0; j < 4; ++j) { const int w = (int)yw[k][j]; y[j].x += __builtin_amdgcn_cvt_f32_fp8(w, 0); y[j].y += __builtin_amdgcn_cvt_f32_fp8(w, 1); y[j].z += __builtin_amdgcn_cvt_f32_fp8(w, 2); y[j].w += __builtin_amdgcn_cvt_f32_fp8(w, 3); }
        f32x4 v[4]; float s = 0.f;
#pragma unroll
        for (int j = 0; j < 4; ++j) { v[j] = xc[j] + (0.0625f * g2[64 * j]) * y[j]; s += (v[j].x * v[j].x + v[j].y * v[j].y) + (v[j].z * v[j].z + v[j].w * v[j].w); }
        const float rstd = rsqrtf_(wave_sum(s) * (1.f / D) + EPS);
        const f32x4* fg = (const f32x4*)p.final_norm_g + lane;
#pragma unroll
        for (int j = 0; j < 4; ++j) xr[64 * j] = v[j] * rstd * fg[64 * j];
    }
}

constexpr int N_PHASES = 11 + 2 * NG;
template <int PH>
__device__ __forceinline__ void run_phase(const P& p, LAS unsigned char* lds) {
    const int G = gridDim.x, c = blockIdx.x;
    unsigned char* ws = p.ws;
    if constexpr (PH == 0) phase_prologue(p, lds);
    else if constexpr (PH == 1) phase_norm1(p);
    else if constexpr (PH == 2) { EpiG1 E{(bf16*)(ws + WS_QKVA), (bf16*)(ws + WS_PB), (float*)(ws + WS_SMALL)};
        if constexpr (G1_NF8 > 0) { pg8::SchedDense S8{TT / 256, G1_NF8, G, c}; pg8::gemm_phase<EpiG1, pg8::SchedDense, true>(lds, (const bf16*)(ws + WS_H8), (const bf16*)(ws + WS_BT_S8), D / 2, S8, E); }
        if constexpr (G1_NF8 < N_S / 256) { pg8::SchedDense S{TT / 256, N_S / 256 - G1_NF8, G, c, G1_NF8}; pg8::gemm_phase(lds, (const bf16*)(ws + WS_H), (const bf16*)(ws + WS_BT_S), D, S, E); } }
    else if constexpr (PH == 3) phase_conv(p, lds);
    else if constexpr (PH == 4) phase_scan(p, lds);
    else if constexpr (PH == 5) { pg8::SchedDense S{T / 256, N_G / 256, G, c}; EpiG2 E{(const bf16*)p.out, (bf16*)(ws + WS_YA_IN), (bf16*)(ws + WS_YB_IN), (bf16*)(ws + WS_GATES), p.gla_norm_g, (LAS float*)(lds + 131072), (const bf16*)(ws + WS_OB2)};
        if constexpr (FP8_G2) pg8::gemm_phase<EpiG2, pg8::SchedDense, true>(lds, (const bf16*)(ws + WS_H8), (const bf16*)(ws + WS_BT_G8), D / 2, S, E);
        else pg8::gemm_phase(lds, (const bf16*)(ws + WS_H), (const bf16*)(ws + WS_BT_G), D, S, E); }
    else if constexpr (PH == 6) { phase_wconv(p, lds, 1, blockIdx.x, gridDim.x); __syncthreads();
        pg8::SchedDense S{T / 256, 4, G, c};
        { EpiG34<0> E{(const bf16*)(ws + WS_GATES), (bf16*)(ws + WS_Y)}; pg8::gemm_phase(lds, (const bf16*)(ws + WS_YA_IN), (const bf16*)(ws + WS_BT_OA), D, S, E); }
        asm volatile("s_waitcnt vmcnt(0)" ::: "memory"); __syncthreads();
        { EpiG34<1> E{(const bf16*)(ws + WS_GATES), (bf16*)(ws + WS_Y)}; pg8::gemm_phase(lds, (const bf16*)(ws + WS_YB_IN), (const bf16*)(ws + WS_BT_OB), D, S, E); } }
    else if constexpr (PH == 7) { pg8::SchedDense S{T / 256, 4, G, c}; EpiG5 E{p.x, (const float*)(ws + WS_MODV), (bf16*)(ws + WS_X1B)};
        pg8::gemm_phase(lds, (const bf16*)(ws + WS_Y), (const bf16*)(ws + WS_BT_O), D, S, E); }
    else if constexpr (PH == 8) phase_ffnprep(p, lds);
    else if constexpr (PH == 9) phase_route(p, lds);
    else if constexpr (PH == 10 + 2 * NG) phase_combine(p, NG - 1);
    else {
        constexpr int g = (PH - 10) / 2, sub = (PH - 10) % 2;
        const int ntile = ((const int*)(ws + WS_CTL))[CW_NTILE + g];
        const int* tile_e = (const int*)(ws + WS_TILE_E) + g * MAXTILE;
        if constexpr (sub == 0) { EpiGU E{p.b_gu, (bf16*)(ws + WS_ACT)};
            if constexpr (MOE_GATHER) { pg8::SchedMoe S{ntile, 8, G, c, tile_e, (const int*)(ws + WS_SLOT_TOK) + g * MAXSLOT, 0};
                pg8::gemm_phase<EpiGU, pg8::SchedMoe, true>(lds, (const bf16*)(ws + WS_XG), (const bf16*)ws, D / 2, S, E); }
            else { pg8::SchedMoeDense S{ntile, 8, G, c, tile_e, 0};
                pg8::gemm_phase<EpiGU, pg8::SchedMoeDense, true>(lds, (const bf16*)(ws + WS_XG + (size_t)g * MAXSLOT * D), (const bf16*)ws, D / 2, S, E); }
            if constexpr (g > 0) phase_combine(p, g - 1); }
        else { pg8::SchedMoeDense S{ntile, 4, G, c, tile_e, 1}; EpiDN E{p.b_down, (const float*)(ws + WS_SLOT_P) + g * MAXSLOT, (bf16*)(ws + WS_YSLOT)};
            pg8::gemm_phase<EpiDN, pg8::SchedMoeDense, true>(lds, (const bf16*)(ws + WS_ACT), (const bf16*)ws, D / 2, S, E); }
    }
}

#ifndef PROBE_DUP_MASK
#define PROBE_DUP_MASK 0u
#endif
#if MK_FUSED
template <int PH>
__device__ __forceinline__ void run_from(const P& p, LAS unsigned char* lds, const XcdBarrier& bar) {
    if constexpr (PH < N_PHASES) { run_phase<PH>(p, lds);
        if constexpr ((PROBE_DUP_MASK >> PH) & 1u) { xcd_barrier(bar); run_phase<PH>(p, lds); }
        if constexpr (PH + 1 < N_PHASES) xcd_barrier(bar); run_from<PH + 1>(p, lds, bar); }
}
__global__ void __launch_bounds__(NTHREADS, 2) k_fused(P p) {
    extern __shared__ __attribute__((aligned(16))) unsigned char lds_raw[];
    LAS unsigned char* lds = (LAS unsigned char*)lds_raw;
    volatile LAS unsigned* misc = (volatile LAS unsigned*)(lds + 144 * 1024 - 64);
    if (threadIdx.x < 4) misc[threadIdx.x] = 0u;
    __syncthreads();
    XcdBarrier bar = xcd_barrier_post((unsigned*)(p.ws + WS_CTL) + CW_BAR, misc);
    run_from<0>(p, lds, bar);
}
#else
template <int PH>
__global__ void __launch_bounds__(NTHREADS, 2) k_phase(P p) {
    extern __shared__ __attribute__((aligned(16))) unsigned char lds_raw[];
    run_phase<PH>(p, (LAS unsigned char*)lds_raw);
}
template <int PH>
static void launch_all(const P& p, int grid, hipStream_t stream) {
    if constexpr (PH < N_PHASES) {
        static bool attr = false;
        if (!attr) { (void)hipFuncSetAttribute((const void*)k_phase<PH>, hipFuncAttributeMaxDynamicSharedMemorySize, LDS_BYTES); attr = true; }
        hipLaunchKernelGGL(k_phase<PH>, dim3(grid), dim3(NTHREADS), LDS_BYTES, stream, p);
        launch_all<PH + 1>(p, grid, stream);
    }
}
#endif

extern "C" void kernel_launch(void* const* d_in, const int* in_sizes, int n_in, void* d_out, int out_size, void* d_ws, size_t ws_size, hipStream_t stream) {
    static int grid = 0;
    if (grid == 0) {
        if (n_in != 30 || in_sizes[0] != T * D || out_size != T * D || ws_size < WS_END) { fprintf(stderr, "kernel_launch: unexpected shapes (n_in %d, in0 %d, out %d, ws %zu)\n", n_in, n_in > 0 ? in_sizes[0] : -1, out_size, ws_size); grid = -1; return; }
        int dev = 0, cus = 0;
        if (hipGetDevice(&dev) != hipSuccess || hipDeviceGetAttribute(&cus, hipDeviceAttributeMultiprocessorCount, dev) != hipSuccess) { grid = -1; return; }
#if MK_FUSED
        if (hipFuncSetAttribute((const void*)k_fused, hipFuncAttributeMaxDynamicSharedMemorySize, LDS_BYTES) != hipSuccess) { fprintf(stderr, "kernel_launch: hipFuncSetAttribute failed\n"); grid = -1; return; }
        int per_cu = 0;
        if (hipOccupancyMaxActiveBlocksPerMultiprocessor(&per_cu, (const void*)k_fused, NTHREADS, LDS_BYTES) != hipSuccess || per_cu < 1) fprintf(stderr, "kernel_launch: occupancy query reports %d\n", per_cu);
        (void)hipGetLastError();
#endif
        grid = cus;
    }
    if (grid < 0) return;
    (void)hipMemsetAsync((char*)d_ws + WS_CTL, 0, CTL_BYTES, stream);
    P p{};
    const float** pp = (const float**)&p;
    for (int i = 0; i < 30; ++i) pp[i] = (const float*)d_in[i];
    p.out = (float*)d_out; p.ws = (unsigned char*)d_ws;
#ifdef PROBE_SCAN_KIND
    p.probe = PROBE_SCAN_KIND;
#endif
#if MK_FUSED
    hipLaunchKernelGGL(k_fused, dim3(grid), dim3(NTHREADS), LDS_BYTES, stream, p);
#else
    launch_all<0>(p, grid, stream);
#endif
}
```
